# Optimizing an MI355X kernel written in HIP

```python
import math
import jax, jax.numpy as jnp
from jax import lax
import numpy as np

D_MODEL = 1024
BATCH = 8
SEQ = 2048
DEPTH = 2
DEC_BATCH = 128
DEC_SEQ = 1
PAST_LEN = 16384
PAGE_SIZE = 128

D_RWKV = D_MODEL
RWKV_HEAD = 64
RWKV_HEADS = D_RWKV // RWKV_HEAD
LORA_W = 64
LORA_A = 64
LNX_EPS = 64e-5
D_MAMBA = D_MODEL
MAMBA_HEADDIM = 64
MAMBA_HEADS = D_MAMBA // MAMBA_HEADDIM
N_GROUPS = 2
HEADS_PER_GROUP = MAMBA_HEADS // N_GROUPS
D_STATE = 128
CONV_W = 4
CONV_DIM = D_MAMBA + 2 * N_GROUPS * D_STATE
CHUNK = 128
D_MIX = D_RWKV + D_MAMBA
R_SHIFT = 3 * D_RWKV + LORA_W + LORA_A
D_IN_RWKV = R_SHIFT + D_RWKV
D_IN_MAMBA = D_MAMBA + CONV_DIM + MAMBA_HEADS
D_IN = D_IN_RWKV + D_IN_MAMBA
NORM_EPS = 1e-5

kernel_name = "hybrid_rwkv7_mamba2_step"


def rmsnorm(x, w, eps=NORM_EPS):
    xf = x.astype(jnp.float32)
    return xf * lax.rsqrt(jnp.mean(xf * xf, axis=-1, keepdims=True) + eps) * w.astype(jnp.float32)


def rwkv7_mix(p_sh, prev_sh, z, S0, mu, w0, w2, a0, a2, k_k, k_a, r_k, lnx_w, lnx_b):
    Bsz, L = p_sh.shape[:2]
    shifted = jnp.concatenate([prev_sh, p_sh[:, :-1]], axis=1)
    xm = p_sh + (shifted - p_sh) * mu
    r, k, v, wl, al = jnp.split(xm, [D_RWKV, 2 * D_RWKV, 3 * D_RWKV, 3 * D_RWKV + LORA_W], axis=-1)
    w_pre = -jax.nn.softplus(-(w0 + jnp.tanh(wl) @ w2)) - 0.5
    decay = jnp.exp(-jnp.exp(w_pre))
    a = jax.nn.sigmoid(a0 + al @ a2)
    heads = lambda t: t.reshape(Bsz, L, RWKV_HEADS, RWKV_HEAD)
    r, k, v, decay, a = map(heads, (r, k, v, decay, a))
    kk = k * k_k.reshape(RWKV_HEADS, RWKV_HEAD)
    kk = kk / jnp.maximum(jnp.sqrt(jnp.sum(kk * kk, axis=-1, keepdims=True)), 1e-12)
    k = k * (1.0 + (a - 1.0) * k_a.reshape(RWKV_HEADS, RWKV_HEAD))

    def step(S, inp):
        r_t, w_t, k_t, v_t, kk_t, a_t = inp
        s_kk = jnp.einsum('bhvk,bhk->bhv', S, kk_t)
        S = (S * w_t[:, :, None, :] - s_kk[..., None] * (kk_t * a_t)[:, :, None, :]
             + v_t[..., None] * k_t[:, :, None, :])
        return S, jnp.einsum('bhvk,bhk->bhv', S, r_t)

    seq_first = lambda t: jnp.moveaxis(t.astype(jnp.float32), 1, 0)
    S_fin, o = lax.scan(step, S0.astype(jnp.float32),
                        tuple(map(seq_first, (r, decay, k, v, kk, a))))
    o = jnp.moveaxis(o, 0, 1)
    mean = jnp.mean(o, axis=-1, keepdims=True)
    var = jnp.mean(jnp.square(o - mean), axis=-1, keepdims=True)
    o = ((o - mean) * lax.rsqrt(var + LNX_EPS)).reshape(Bsz, L, D_RWKV) * lnx_w + lnx_b
    bonus = jnp.sum(r * k * r_k, axis=-1, keepdims=True) * v
    y = (o + bonus.reshape(Bsz, L, D_RWKV)) * jax.nn.silu(z)
    return y, S_fin


def ssd_chunked(xdt, dA, Bm, Cm, h0):
    Bsz, L = xdt.shape[:2]
    Q = min(CHUNK, L)
    pad = (-L) % Q
    if pad:
        padf = lambda t: jnp.pad(t, [(0, 0), (0, pad)] + [(0, 0)] * (t.ndim - 2))
        xdt, dA, Bm, Cm = map(padf, (xdt, dA, Bm, Cm))
    nc = (L + pad) // Q
    chunk = lambda t: t.reshape(Bsz, nc, Q, *t.shape[2:])
    xdt, dA, Bm, Cm = map(chunk, (xdt, dA, Bm, Cm))
    A_cs = jnp.cumsum(dA, axis=2)
    seg = A_cs[:, :, :, None] - A_cs[:, :, None, :]
    causal = jnp.tril(jnp.ones((Q, Q), dtype=bool))[:, :, None, None]
    Lmat = jnp.exp(jnp.where(causal, seg, -jnp.inf))
    CB = jnp.einsum('bclgn,bcsgn->bclsg', Cm, Bm)
    y_diag = jnp.einsum('bclsg,bclsgj,bcsgjp->bclgjp', CB, Lmat, xdt)
    decay_to_end = jnp.exp(A_cs[:, :, -1:] - A_cs)
    states = jnp.einsum('bcsgn,bcsgj,bcsgjp->bcgjpn', Bm, decay_to_end, xdt)
    chunk_decay = jnp.exp(A_cs[:, :, -1])

    def carry(h, inp):
        s_c, d_c = inp
        return h * d_c[..., None, None] + s_c, h

    h_fin, h_in = lax.scan(carry, h0, (jnp.moveaxis(states, 1, 0), jnp.moveaxis(chunk_decay, 1, 0)))
    h_in = jnp.moveaxis(h_in, 0, 1)
    y_off = jnp.einsum('bclgn,bcgjpn,bclgj->bclgjp', Cm, h_in, jnp.exp(A_cs))
    y = (y_diag + y_off).reshape(Bsz, nc * Q, *xdt.shape[3:])[:, :L]
    return y, h_fin


def mamba2_mix(z, xbc, dt_raw, conv0, h0, conv_w, conv_b, dt_bias, a_log, d_skip, gnorm_w):
    f32 = jnp.float32
    Bsz, L = xbc.shape[:2]
    ext = jnp.concatenate([conv0.astype(f32), xbc.astype(f32)], axis=1)
    conv = lax.conv_general_dilated(ext, conv_w[:, None, :].astype(f32), (1,), 'VALID',
                                    dimension_numbers=('NWC', 'WIO', 'NWC'),
                                    feature_group_count=CONV_DIM)
    u = jax.nn.silu(conv + conv_b)
    xs, Bm, Cm = jnp.split(u, [D_MAMBA, D_MAMBA + N_GROUPS * D_STATE], axis=-1)
    xs = xs.reshape(Bsz, L, N_GROUPS, HEADS_PER_GROUP, MAMBA_HEADDIM)
    Bm = Bm.reshape(Bsz, L, N_GROUPS, D_STATE)
    Cm = Cm.reshape(Bsz, L, N_GROUPS, D_STATE)
    dt = jax.nn.softplus(dt_raw + dt_bias).reshape(Bsz, L, N_GROUPS, HEADS_PER_GROUP)
    A = -jnp.exp(a_log.astype(f32)).reshape(N_GROUPS, HEADS_PER_GROUP)
    h0g = h0.astype(f32).reshape(Bsz, N_GROUPS, HEADS_PER_GROUP, MAMBA_HEADDIM, D_STATE)
    y, h_fin = ssd_chunked(xs * dt[..., None], dt * A, Bm, Cm, h0g)
    y = y + d_skip.reshape(N_GROUPS, HEADS_PER_GROUP, 1) * xs
    y = y.reshape(Bsz, L, D_MAMBA) * jax.nn.silu(z)
    yg = y.reshape(Bsz, L, N_GROUPS, D_MAMBA // N_GROUPS)
    yg = yg * lax.rsqrt(jnp.mean(yg * yg, axis=-1, keepdims=True) + NORM_EPS)
    y = yg.reshape(Bsz, L, D_MAMBA) * gnorm_w
    return y, ext[:, L:], h_fin.reshape(Bsz, MAMBA_HEADS, MAMBA_HEADDIM, D_STATE)


def hybrid_layer(x, shift_prev, wkv0, conv0, ssm0, norm_w, w_in, mu_shift, w0, w_lora2, a0,
                 a_lora2, k_k, k_a, r_k, lnx_w, lnx_b, conv_w, conv_b, dt_bias, a_log, d_skip,
                 gnorm_w, w_out):
    xn = rmsnorm(x, norm_w)
    proj = xn @ w_in
    prev_sh = shift_prev[:, None, :].astype(jnp.float32) @ w_in[:, :R_SHIFT]
    p_sh, z_r, z_m, xbc, dt_raw = jnp.split(
        proj, [R_SHIFT, D_IN_RWKV, D_IN_RWKV + D_MAMBA, D_IN_RWKV + D_MAMBA + CONV_DIM], axis=-1)
    y_r, wkv_new = rwkv7_mix(p_sh, prev_sh, z_r, wkv0, mu_shift, w0, w_lora2, a0, a_lora2,
                             k_k, k_a, r_k, lnx_w, lnx_b)
    y_m, conv_new, ssm_new = mamba2_mix(z_m, xbc, dt_raw, conv0, ssm0, conv_w, conv_b,
                                        dt_bias, a_log, d_skip, gnorm_w)
    out = jnp.concatenate([y_r, y_m], axis=-1) @ w_out
    return (x + out).astype(x.dtype), xn[:, -1], wkv_new, conv_new, ssm_new


def run_trunk(x, shift, wkv, conv, ssm, layer_params, final_norm_w):
    st_shift, st_wkv, st_conv, st_ssm = [], [], [], []
    for l in range(DEPTH):
        x, s, w, c, h = hybrid_layer(x, shift[l], wkv[l], conv[l], ssm[l],
                                     *[p[l] for p in layer_params])
        st_shift.append(s)
        st_wkv.append(w)
        st_conv.append(c)
        st_ssm.append(h)
    y = rmsnorm(x, final_norm_w).astype(x.dtype)
    return y, jnp.stack(st_shift), jnp.stack(st_wkv), jnp.stack(st_conv), jnp.stack(st_ssm)


def setup_inputs(seed: int = 0) -> dict:
    key = jax.random.key(seed)
    ks = iter(jax.random.split(key, 32))
    f32 = jnp.float32
    nrm = lambda shape, s: s * jax.random.normal(next(ks), shape, f32)
    x_prompt = nrm((BATCH, SEQ, D_MODEL), 1.0)
    x_sample = nrm((DEC_BATCH, DEC_SEQ, D_MODEL), 1.0)
    state_shift = nrm((DEPTH, DEC_BATCH, D_MODEL), 1.0)
    state_wkv = nrm((DEPTH, DEC_BATCH, RWKV_HEADS, RWKV_HEAD, RWKV_HEAD), 0.2)
    state_conv = nrm((DEPTH, DEC_BATCH, CONV_W - 1, CONV_DIM), 1.0)
    state_ssm = nrm((DEPTH, DEC_BATCH, MAMBA_HEADS, MAMBA_HEADDIM, D_STATE), 0.1)
    norm_w = 1.0 + nrm((DEPTH, D_MODEL), 0.02)
    w_in = nrm((DEPTH, D_MODEL, D_IN), D_MODEL ** -0.5)
    mu_shift = jax.random.uniform(next(ks), (DEPTH, R_SHIFT), f32)
    w0 = nrm((DEPTH, D_RWKV), 0.5)
    w_lora2 = nrm((DEPTH, LORA_W, D_RWKV), 0.1)
    a0 = nrm((DEPTH, D_RWKV), 0.1)
    a_lora2 = nrm((DEPTH, LORA_A, D_RWKV), 0.1)
    k_k = 0.85 + nrm((DEPTH, D_RWKV), 0.05)
    k_a = 1.0 + nrm((DEPTH, D_RWKV), 0.05)
    r_k = nrm((DEPTH, RWKV_HEADS, RWKV_HEAD), 0.1)
    lnx_w = 1.0 + nrm((DEPTH, D_RWKV), 0.02)
    lnx_b = nrm((DEPTH, D_RWKV), 0.01)
    conv_w = nrm((DEPTH, CONV_W, CONV_DIM), CONV_W ** -0.5)
    conv_b = nrm((DEPTH, CONV_DIM), 0.01)
    dt0 = jnp.exp(jax.random.uniform(next(ks), (DEPTH, MAMBA_HEADS), f32,
                                     math.log(1e-3), math.log(1e-1)))
    dt_bias = dt0 + jnp.log(-jnp.expm1(-dt0))
    a_log = jnp.log(jax.random.uniform(next(ks), (DEPTH, MAMBA_HEADS), f32, 1.0, 16.0))
    d_skip = 1.0 + nrm((DEPTH, MAMBA_HEADS), 0.1)
    gnorm_w = 1.0 + nrm((DEPTH, D_MAMBA), 0.02)
    w_out = nrm((DEPTH, D_MIX, D_MODEL), D_MIX ** -0.5)
    final_norm_w = 1.0 + nrm((D_MODEL,), 0.02)
    return {"x_prompt": x_prompt, "x_sample": x_sample, "state_shift": state_shift,
            "state_wkv": state_wkv, "state_conv": state_conv, "state_ssm": state_ssm,
            "norm_w": norm_w, "w_in": w_in, "mu_shift": mu_shift, "w0": w0,
            "w_lora2": w_lora2, "a0": a0, "a_lora2": a_lora2, "k_k": k_k, "k_a": k_a,
            "r_k": r_k, "lnx_w": lnx_w, "lnx_b": lnx_b, "conv_w": conv_w, "conv_b": conv_b,
            "dt_bias": dt_bias, "a_log": a_log, "d_skip": d_skip, "gnorm_w": gnorm_w,
            "w_out": w_out, "final_norm_w": final_norm_w}


def reference(x_prompt, x_sample, state_shift, state_wkv, state_conv, state_ssm, norm_w, w_in,
              mu_shift, w0, w_lora2, a0, a_lora2, k_k, k_a, r_k, lnx_w, lnx_b, conv_w, conv_b,
              dt_bias, a_log, d_skip, gnorm_w, w_out, final_norm_w):
    layer_params = (norm_w, w_in, mu_shift, w0, w_lora2, a0, a_lora2, k_k, k_a, r_k, lnx_w,
                    lnx_b, conv_w, conv_b, dt_bias, a_log, d_skip, gnorm_w, w_out)
    f32 = jnp.float32
    bp = x_prompt.shape[0]
    zero_shift = jnp.zeros((DEPTH, bp, D_MODEL), f32)
    zero_wkv = jnp.zeros((DEPTH, bp, RWKV_HEADS, RWKV_HEAD, RWKV_HEAD), f32)
    zero_conv = jnp.zeros((DEPTH, bp, CONV_W - 1, CONV_DIM), f32)
    zero_ssm = jnp.zeros((DEPTH, bp, MAMBA_HEADS, MAMBA_HEADDIM, D_STATE), f32)
    y_prompt, p_shift, p_wkv, p_conv, p_ssm = run_trunk(
        x_prompt, zero_shift, zero_wkv, zero_conv, zero_ssm, layer_params, final_norm_w)
    y_sample, s_shift, s_wkv, s_conv, s_ssm = run_trunk(
        x_sample, state_shift, state_wkv, state_conv, state_ssm, layer_params, final_norm_w)
    return (y_prompt, y_sample, p_shift, p_wkv, p_conv, p_ssm, s_shift, s_wkv, s_conv, s_ssm)
```

```cpp
#include <hip/hip_runtime.h>
#include <hip/hip_cooperative_groups.h>
#include <cstdio>
namespace cg = cooperative_groups;
namespace pg8 {
#define PG8_LAS __attribute__((address_space(3)))
typedef unsigned short bf16_t;
typedef short bf16x8 __attribute__((ext_vector_type(8)));
typedef float f32x4 __attribute__((ext_vector_type(4)));
typedef unsigned u32x4 __attribute__((ext_vector_type(4)));
constexpr int BM = 256, BK = 64, HALF = 128, HTB = HALF * BK * 2  , STAGE_BYTES = 8 * HTB, NXCD = 8, WGM = 8;

__host__ __device__ __forceinline__ int lds_byte(int r, int c) { const int st = (r >> 4) * 2 + (c >> 5), rr = r & 15, cc = c & 31, ob = rr * 64 + cc * 2; return st * 1024 + (ob ^ (((ob >> 9) & 1) << 5)); }
__host__ __device__ __forceinline__ void stage_rc(int b, int& R, int& C) { const int st = b / 1024, sb = b % 1024, swz = sb ^ (((sb >> 9) & 1) << 5); R = (st >> 1) * 16 + swz / 64; C = (st & 1) * 32 + (swz % 64) / 2; }
__host__ __device__ __forceinline__ int perm32(int rho) { const int n = rho >> 4, i = rho & 15; return 8 * (i >> 2) + 4 * n + (i & 3); }

struct Unit { int pm, pn; };
struct Gemm { const bf16_t* A; const bf16_t* Bt; int M, N, K; };

struct StaticOrder {
    int nM, nN, nwg, G, c;
    __host__ __device__ void init(int M, int N, int G_, int c_) { nM = M / BM; nN = N / BM; nwg = nM * nN; G = G_; c = c_; }
    __host__ __device__ bool next(int i, Unit& u) const {
        const long L = (long)i * G + c; if (L >= nwg) return false;
        int wgid = (int)L; { const int q = nwg / NXCD, r = nwg % NXCD, xcd = wgid % NXCD, off = wgid / NXCD; wgid = (xcd < r ? xcd * (q + 1) : r * (q + 1) + (xcd - r) * q) + off; }
        const int nig = WGM * nN, gid = wgid / nig, fm = gid * WGM, gsz = (nM - fm) < WGM ? (nM - fm) : WGM;
        u.pm = fm + ((wgid % nig) % gsz); u.pn = (wgid % nig) / gsz; return true;
    }
    __device__ __forceinline__ void a_ready(const Unit&) const {}
    __device__ __forceinline__ void done(const Unit&) const {}
};
__device__ __forceinline__ unsigned cvt_pk_bf16(float lo, float hi) { unsigned r; asm volatile("v_cvt_pk_bf16_f32 %0, %1, %2" : "=v"(r) : "v"(lo), "v"(hi)); return r; }
template <class Epi, class Sched, bool STAMP = false>
__device__ __forceinline__ void gemm_phase(PG8_LAS unsigned char* lds, const Gemm g, const Sched& S, const Epi& E, unsigned long long* stamps) {
    int tid_raw = threadIdx.x; asm volatile("" : "+v"(tid_raw)); const int tid = tid_raw, wid = __builtin_amdgcn_readfirstlane(tid >> 6), lane = tid & 63, wr = wid >> 2, wc = wid & 3, fr = lane & 15, fq = lane >> 4;
    const int K = g.K, nt = K / BK;
    int ts_lo = 0, ts_hi = 0, nts = 0; const unsigned long long rt_entry = STAMP ? (unsigned long long)wall_clock64() : 0ull;
#define PG8_STAMP() do { if (STAMP && wid == 0 && nts < 64) { const unsigned long long _c = (unsigned long long)clock64(); \
        ts_lo = (lane == nts) ? (int)(unsigned)_c : ts_lo; ts_hi = (lane == nts) ? (int)(unsigned)(_c >> 32) : ts_hi; ++nts; } } while (0)
    PG8_STAMP();
    unsigned voffA[2], voffB[2];
#pragma unroll
    for (int i = 0; i < 2; ++i) { int R, C; stage_rc(tid * 16 + i * 8192, R, C); const int Rb = Epi::PERM ? ((R & ~31) + perm32(R & 31)) : R;
        voffA[i] = (unsigned)(R * K + C) * 2u; voffB[i] = (unsigned)(Rb * K + C) * 2u; }
    const size_t kstep = (size_t)(BK * 2);
    const size_t hstep = (size_t)HALF * K * 2;
    const size_t tstep = 2 * hstep;
    const unsigned ldsw = (unsigned)wid * 1024u;
    const int aoff = lds_byte(wr * 64 + fr, fq * 8), boff = lds_byte(wc * 32 + fr, fq * 8);
#define PG8_SA(b, h) (((b) * 2 + (h)) * HTB)
#define PG8_SB(b, h) ((4 + (b) * 2 + (h)) * HTB)
#define PG8_STAGE(bufoff, gbase, voff) do { _Pragma("unroll") for (int _i = 0; _i < 2; ++_i) \
        __builtin_amdgcn_global_load_lds((const unsigned*)((const char*)(gbase) + (voff)[_i]), (PG8_LAS unsigned*)(lds + (bufoff) + ldsw + _i * 8192), 16, 0, 0); } while (0)
#define PG8_LDA(dst, b, h) do { _Pragma("unroll") for (int m = 0; m < 4; ++m) _Pragma("unroll") for (int k = 0; k < 2; ++k) dst[m][k] = *(const PG8_LAS bf16x8*)(lds + PG8_SA(b, h) + aoff + m * 2048 + k * 1024); } while (0)
#define PG8_LDB(dst, b, h) do { _Pragma("unroll") for (int n = 0; n < 2; ++n) _Pragma("unroll") for (int k = 0; k < 2; ++k) dst[n][k] = *(const PG8_LAS bf16x8*)(lds + PG8_SB(b, h) + boff + n * 2048 + k * 1024); } while (0)
#define PG8_MMA(ai, bj, At, Bt) do { __builtin_amdgcn_s_setprio(1); _Pragma("unroll") for (int m = 0; m < 4; ++m) _Pragma("unroll") for (int n = 0; n < 2; ++n) _Pragma("unroll") for (int k = 0; k < 2; ++k) \
        acc[ai][bj][m][n] = __builtin_amdgcn_mfma_f32_16x16x32_bf16(Bt[n][k], At[m][k], acc[ai][bj][m][n], 0, 0, 0); __builtin_amdgcn_s_setprio(0); } while (0)
#define PG8_WAIT_V(n) asm volatile("s_waitcnt vmcnt(" #n ")" ::: "memory")
#define PG8_WAIT_L(n) asm volatile("s_waitcnt lgkmcnt(" #n ")" ::: "memory")
#define PG8_BAR __builtin_amdgcn_s_barrier()
#define PG8_SCHED __builtin_amdgcn_sched_barrier(0)
    Unit cur, nxt; int ui = 0;
    if (!S.next(0, cur)) return;
    f32x4 acc[2][2][4][2];
#pragma unroll
    for (int a = 0; a < 2; ++a)
#pragma unroll
        for (int b = 0; b < 2; ++b)
#pragma unroll
            for (int m = 0; m < 4; ++m)
#pragma unroll
                for (int n = 0; n < 2; ++n) acc[a][b][m][n] = (f32x4){0.f, 0.f, 0.f, 0.f};
    bf16x8 At[4][2], B0[2][2], B1[2][2];
    const char* cA = (const char*)g.A + (size_t)cur.pm * tstep; const char* cB = (const char*)g.Bt + (size_t)cur.pn * tstep;
    S.a_ready(cur);
    PG8_STAGE(PG8_SB(0, 0), cB, voffB); PG8_STAGE(PG8_SA(0, 0), cA, voffA); PG8_STAGE(PG8_SB(0, 1), cB + hstep, voffB); PG8_STAGE(PG8_SA(0, 1), cA + hstep, voffA);
    if (wr == 1) PG8_BAR;
    PG8_WAIT_V(4); PG8_BAR;
    PG8_STAGE(PG8_SB(1, 0), cB + kstep, voffB); PG8_STAGE(PG8_SA(1, 0), cA + kstep, voffA); PG8_STAGE(PG8_SB(1, 1), cB + hstep + kstep, voffB);
    PG8_WAIT_V(6); PG8_BAR;
    PG8_STAMP();
    for (;;) {
        const bool has_next = S.next(ui + 1, nxt);
        const char* nA = has_next ? (const char*)g.A + (size_t)nxt.pm * tstep : cA; const char* nB = has_next ? (const char*)g.Bt + (size_t)nxt.pn * tstep : cB;
        for (int t = 0; t < nt; t += 2) {
            const bool last = (t == nt - 2);
            const char* a1 = cA + (size_t)(t + 1) * kstep;
            const char* a2 = last ? nA : cA + (size_t)(t + 2) * kstep; const char* b2 = last ? nB : cB + (size_t)(t + 2) * kstep;
            const char* a3 = a2 + kstep; const char* b3 = b2 + kstep;
            if (last && has_next) S.a_ready(nxt);
            PG8_LDB(B0, 0, 0); PG8_SCHED; PG8_LDA(At, 0, 0); PG8_STAGE(PG8_SA(1, 1), a1 + hstep, voffA);
            PG8_WAIT_L(8); PG8_BAR; PG8_WAIT_L(0); PG8_MMA(0, 0, At, B0); PG8_BAR; PG8_SCHED;
            PG8_LDB(B1, 0, 1); PG8_STAGE(PG8_SB(0, 0), b2, voffB);
            PG8_BAR; PG8_WAIT_L(0); PG8_MMA(0, 1, At, B1); PG8_BAR;
            PG8_LDA(At, 0, 1); PG8_STAGE(PG8_SA(0, 0), a2, voffA);
            PG8_BAR; PG8_WAIT_L(0); PG8_MMA(1, 0, At, B0); PG8_BAR; PG8_SCHED;
            PG8_STAGE(PG8_SB(0, 1), b2 + hstep, voffB);
            PG8_WAIT_V(6); PG8_BAR; PG8_MMA(1, 1, At, B1); PG8_BAR;
            PG8_LDB(B0, 1, 0); PG8_SCHED; PG8_LDA(At, 1, 0); PG8_STAGE(PG8_SA(0, 1), a2 + hstep, voffA);
            PG8_WAIT_L(8); PG8_BAR; PG8_WAIT_L(0); PG8_MMA(0, 0, At, B0); PG8_BAR; PG8_SCHED;
            PG8_LDB(B1, 1, 1); PG8_STAGE(PG8_SB(1, 0), b3, voffB);
            PG8_BAR; PG8_WAIT_L(0); PG8_MMA(0, 1, At, B1); PG8_BAR;
            PG8_LDA(At, 1, 1); PG8_STAGE(PG8_SA(1, 0), a3, voffA);
            PG8_BAR; PG8_WAIT_L(0); PG8_MMA(1, 0, At, B0); PG8_BAR; PG8_SCHED;
            PG8_STAGE(PG8_SB(1, 1), b3 + hstep, voffB);
            PG8_WAIT_V(6); PG8_BAR; PG8_MMA(1, 1, At, B1); PG8_BAR;
        }
        PG8_STAMP();
        if constexpr (!Epi::AFTER_DRAIN) { E(acc, cur, wr, wc, fr, fq); S.done(cur); }
        PG8_STAMP();
        if (!has_next) break;
#pragma unroll
        for (int a = 0; a < 2; ++a)
#pragma unroll
            for (int b = 0; b < 2; ++b)
#pragma unroll
                for (int m = 0; m < 4; ++m)
#pragma unroll
                    for (int n = 0; n < 2; ++n) acc[a][b][m][n] = (f32x4){0.f, 0.f, 0.f, 0.f};
        cur = nxt; cA = nA; cB = nB; ++ui;
    }
    PG8_WAIT_V(0);
    if (wr == 0) PG8_BAR;
    PG8_BAR;
    if constexpr (Epi::AFTER_DRAIN) { E.fused(acc, cur, wr, wc, fr, fq, lds, wid, lane); S.done(cur); }
    PG8_STAMP();
    if (STAMP && wid == 0) { stamps[lane] = lane < nts ? (((unsigned long long)(unsigned)ts_hi << 32) | (unsigned)ts_lo) : 0ull;
        if (lane == 62) stamps[62] = rt_entry; if (lane == 63) stamps[63] = (unsigned long long)wall_clock64(); }
#undef PG8_STAMP
#undef PG8_SA
#undef PG8_SB
#undef PG8_STAGE
#undef PG8_LDA
#undef PG8_LDB
#undef PG8_MMA
#undef PG8_WAIT_V
#undef PG8_WAIT_L
#undef PG8_BAR
#undef PG8_SCHED
}
}
typedef unsigned short bf16_t;
typedef short bf16x8 __attribute__((ext_vector_type(8)));
typedef float f32x4 __attribute__((ext_vector_type(4)));
typedef unsigned u32x4 __attribute__((ext_vector_type(4)));
typedef unsigned u32x2 __attribute__((ext_vector_type(2)));

#ifndef MK_PER_PHASE
#define MK_PER_PHASE 1
#endif

constexpr int TP = 16384, TS = 128, TALL = 16512, M1 = 16640, N1 = 6912, NIN = 6800;
constexpr int C_R = 0, C_K = 1024, C_V = 2048, C_WL = 3072, C_AL = 3136, C_ZR = 3200, C_ZM = 4224, C_XBC = 5248, C_DT = 6784;
constexpr size_t O_YP = 0, O_YS = 16777216, O_PSH = 16908288, O_PWKV = 16924672, O_PCONV = 17973248, O_PSSM = 18046976,
                 O_SSH = 20144128, O_SWKV = 20406272, O_SCONV = 37183488, O_SSSM = 38363136, O_END = 71917568;
constexpr size_t WS_WINT = 0;
constexpr size_t WS_WOUTT = WS_WINT + (size_t)2 * N1 * 1024 * 2;
constexpr size_t WS_A = WS_WOUTT + (size_t)2 * 1024 * 2048 * 2;
constexpr size_t WS_P = WS_A + (size_t)M1 * 2048 * 2;
constexpr size_t WS_ORAW = WS_P + (size_t)M1 * N1 * 2;
constexpr size_t WS_BV = WS_ORAW + (size_t)TALL * 1024 * 4;
constexpr size_t WS_YM = WS_BV + (size_t)TALL * 1024 * 2;
constexpr size_t WS_END = WS_YM + (size_t)TALL * 1024 * 2;
constexpr int LDS_BYTES = 147456;

struct Params { const float* in[26]; float* out; unsigned char* ws; int ph_lo, ph_hi; };
enum { I_XP = 0, I_XS, I_SSHIFT, I_SWKV, I_SCONV, I_SSSM, I_NORMW, I_WIN, I_MU, I_W0, I_W2, I_A0, I_A2, I_KK, I_KA, I_RK, I_LNW, I_LNB, I_CW, I_CB, I_DTB, I_ALOG, I_DSK, I_GNW, I_WOUT, I_FNW };

__device__ __forceinline__ float bf2f(unsigned short b) { return __uint_as_float(((unsigned)b) << 16); }
__device__ __forceinline__ unsigned short f2bf(float f) { unsigned u = __float_as_uint(f); u += 0x7FFFu + ((u >> 16) & 1u); return (unsigned short)(u >> 16); }
__device__ __forceinline__ unsigned pk2(float lo, float hi) { return (unsigned)f2bf(lo) | ((unsigned)f2bf(hi) << 16); }
__device__ __forceinline__ void unpack8(const u32x4 v, float* f) {
    f[0] = __uint_as_float(v.x << 16); f[1] = __uint_as_float(v.x & 0xffff0000u); f[2] = __uint_as_float(v.y << 16); f[3] = __uint_as_float(v.y & 0xffff0000u);
    f[4] = __uint_as_float(v.z << 16); f[5] = __uint_as_float(v.z & 0xffff0000u); f[6] = __uint_as_float(v.w << 16); f[7] = __uint_as_float(v.w & 0xffff0000u); }
__device__ __forceinline__ u32x4 pack8(const float* f) { u32x4 r; r.x = pk2(f[0], f[1]); r.y = pk2(f[2], f[3]); r.z = pk2(f[4], f[5]); r.w = pk2(f[6], f[7]); return r; }
__device__ __forceinline__ float sigmoidf_(float x) { return 1.0f / (1.0f + __expf(-x)); }
__device__ __forceinline__ float siluf_(float x) { return x / (1.0f + __expf(-x)); }
__device__ __forceinline__ float softplusf_(float x) { return x > 20.f ? x : log1pf(__expf(x)); }
template <int CTRL> __device__ __forceinline__ float dppf(float v) { return __int_as_float(__builtin_amdgcn_mov_dpp(__float_as_int(v), CTRL, 0xF, 0xF, true)); }
__device__ __forceinline__ float red8(float x) { x += dppf<0xB1>(x); x += dppf<0x4E>(x); x += dppf<0x141>(x); return x; }
__device__ __forceinline__ float red16(float x) { x = red8(x); x += dppf<0x140>(x); return x; }
__device__ __forceinline__ float wave_sum(float x) {
#pragma unroll
    for (int o = 32; o > 0; o >>= 1) x += __shfl_xor(x, o);
    return x; }
__device__ __forceinline__ void lds_fence() { asm volatile("s_waitcnt lgkmcnt(0)" ::: "memory"); }
__device__ __forceinline__ int tid_l() { int t = threadIdx.x; asm volatile("" : "+v"(t)); return t; }
__device__ __forceinline__ unsigned char* launder_lds(unsigned char* sm) { int off = 0; asm volatile("" : "+s"(off)); return sm + off; }
#define MFMA16(a, b, c) __builtin_amdgcn_mfma_f32_16x16x32_bf16((a), (b), (c), 0, 0, 0)

__device__ void phase_convert(const Params& p, unsigned char* smem_) {
    unsigned char* smem = launder_lds(smem_);
    float* tile = (float*)smem;
    const int tid = tid_l();
    constexpr int NT_IN = 16 * 108, NT_OUT = 32 * 16, PER_L = NT_IN + NT_OUT;
    for (int it = blockIdx.x; it < 2 * PER_L; it += gridDim.x) {
        const int l = it / PER_L; int r = it % PER_L;
        const float* src; bf16_t* dst; int K, Nsrc, kt, nt;
        if (r < NT_IN) { src = p.in[I_WIN] + (size_t)l * 1024 * NIN; dst = (bf16_t*)(p.ws + WS_WINT) + (size_t)l * N1 * 1024; K = 1024; Nsrc = NIN; kt = r & 15; nt = r >> 4; }
        else { r -= NT_IN; src = p.in[I_WOUT] + (size_t)l * 2048 * 1024; dst = (bf16_t*)(p.ws + WS_WOUTT) + (size_t)l * 1024 * 2048; K = 2048; Nsrc = 1024; kt = r & 31; nt = r >> 5; }
#pragma unroll
        for (int i = 0; i < 2; ++i) {
            const int rr = (tid >> 4) + 32 * i, c4 = (tid & 15) * 4, col = nt * 64 + c4;
            float4 v = make_float4(0.f, 0.f, 0.f, 0.f);
            if (col < Nsrc) v = *(const float4*)(src + (size_t)(kt * 64 + rr) * Nsrc + col);
            float* tp = tile + rr * 65 + c4; tp[0] = v.x; tp[1] = v.y; tp[2] = v.z; tp[3] = v.w;
        }
        __syncthreads();
        { const int n = tid >> 3, k8 = (tid & 7) * 8; float f[8];
#pragma unroll
          for (int j = 0; j < 8; ++j) f[j] = tile[(k8 + j) * 65 + n];
          *(u32x4*)(dst + (size_t)(nt * 64 + n) * K + kt * 64 + k8) = pack8(f); }
        __syncthreads();
    }
}

__device__ void phase_norm(const Params& p, int l) {
    const int tid_ = tid_l(); const int lane = tid_ & 63, wid = tid_ >> 6;
    bf16_t* A1 = (bf16_t*)(p.ws + WS_A);
    const float* nw = p.in[I_NORMW] + l * 1024;
    for (int row = blockIdx.x * 8 + wid; row < M1; row += gridDim.x * 8) {
        const float* src;
        if (row < TP) src = (l == 0 ? p.in[I_XP] : p.out + O_YP) + (size_t)row * 1024;
        else if (row < TALL) src = (l == 0 ? p.in[I_XS] : p.out + O_YS) + (size_t)(row - TP) * 1024;
        else src = p.in[I_SSHIFT] + ((size_t)l * TS + (row - TALL)) * 1024;
        float4 v[4]; float ss = 0.f;
#pragma unroll
        for (int i = 0; i < 4; ++i) { v[i] = *(const float4*)(src + i * 256 + lane * 4); ss += v[i].x * v[i].x + v[i].y * v[i].y + v[i].z * v[i].z + v[i].w * v[i].w; }
        if (row < TALL) {
            ss = wave_sum(ss);
            const float rs = rsqrtf(ss * (1.0f / 1024.0f) + 1e-5f);
#pragma unroll
            for (int i = 0; i < 4; ++i) { const float4 w = *(const float4*)(nw + i * 256 + lane * 4); v[i].x *= rs * w.x; v[i].y *= rs * w.y; v[i].z *= rs * w.z; v[i].w *= rs * w.w; }
            float* so = nullptr;
            if (row < TP) { if ((row & 2047) == 2047) so = p.out + O_PSH + ((size_t)l * 8 + (row >> 11)) * 1024; }
            else so = p.out + O_SSH + ((size_t)l * TS + (row - TP)) * 1024;
            if (so) {
#pragma unroll
                for (int i = 0; i < 4; ++i) *(float4*)(so + i * 256 + lane * 4) = v[i]; }
        }
#pragma unroll
        for (int i = 0; i < 4; ++i) { u32x2 w; w.x = pk2(v[i].x, v[i].y); w.y = pk2(v[i].z, v[i].w); *(u32x2*)(A1 + (size_t)row * 1024 + i * 256 + lane * 4) = w; }
    }
}

__device__ void phase_final(const Params& p) {
    const int tid_ = tid_l(); const int lane = tid_ & 63, wid = tid_ >> 6;
    const float* nw = p.in[I_FNW];
    for (int row = blockIdx.x * 8 + wid; row < TALL; row += gridDim.x * 8) {
        float* src = (row < TP) ? p.out + O_YP + (size_t)row * 1024 : p.out + O_YS + (size_t)(row - TP) * 1024;
        float4 v[4]; float ss = 0.f;
#pragma unroll
        for (int i = 0; i < 4; ++i) { v[i] = *(const float4*)(src + i * 256 + lane * 4); ss += v[i].x * v[i].x + v[i].y * v[i].y + v[i].z * v[i].z + v[i].w * v[i].w; }
        ss = wave_sum(ss);
        const float rs = rsqrtf(ss * (1.0f / 1024.0f) + 1e-5f);
#pragma unroll
        for (int i = 0; i < 4; ++i) { const float4 w = *(const float4*)(nw + i * 256 + lane * 4); v[i].x *= rs * w.x; v[i].y *= rs * w.y; v[i].z *= rs * w.z; v[i].w *= rs * w.w;
            *(float4*)(src + i * 256 + lane * 4) = v[i]; }
    }
}

struct EpiP {
    static constexpr bool PERM = true, AFTER_DRAIN = false;
    bf16_t* O; int ldc;
    __device__ __forceinline__ void operator()(const f32x4 (&acc)[2][2][4][2], const pg8::Unit& u, int wr, int wc, int fr, int fq) const {
        const int row0 = u.pm * 256 + wr * 64 + fr, col0 = u.pn * 256 + wc * 32 + 8 * fq;
#pragma unroll
        for (int ai = 0; ai < 2; ++ai)
#pragma unroll
            for (int m = 0; m < 4; ++m) { bf16_t* rowp = O + (size_t)(row0 + ai * 128 + m * 16) * ldc + col0;
#pragma unroll
                for (int bj = 0; bj < 2; ++bj) { const f32x4 v0 = acc[ai][bj][m][0], v1 = acc[ai][bj][m][1];
                    u32x4 w; w.x = pg8::cvt_pk_bf16(v0[0], v0[1]); w.y = pg8::cvt_pk_bf16(v0[2], v0[3]); w.z = pg8::cvt_pk_bf16(v1[0], v1[1]); w.w = pg8::cvt_pk_bf16(v1[2], v1[3]);
                    *(u32x4*)(rowp + bj * 128) = w; } }
    }
};
struct EpiRes {
    static constexpr bool PERM = false, AFTER_DRAIN = false;
    const float* res_p; const float* res_s; float* out_p; float* out_s;
    __device__ __forceinline__ void operator()(const f32x4 (&acc)[2][2][4][2], const pg8::Unit& u, int wr, int wc, int fr, int fq) const {
        const int row0 = u.pm * 256 + wr * 64 + fr, col0 = u.pn * 256 + wc * 32 + 4 * fq;
#pragma unroll
        for (int ai = 0; ai < 2; ++ai)
#pragma unroll
            for (int m = 0; m < 4; ++m) { const int row = row0 + ai * 128 + m * 16;
                if (row < TALL) {
                    const float* rp; float* op;
                    if (row < TP) { rp = res_p + (size_t)row * 1024; op = out_p + (size_t)row * 1024; } else { rp = res_s + (size_t)(row - TP) * 1024; op = out_s + (size_t)(row - TP) * 1024; }
#pragma unroll
                    for (int bj = 0; bj < 2; ++bj)
#pragma unroll
                        for (int n = 0; n < 2; ++n) { const int c = col0 + bj * 128 + n * 16; const f32x4 r = *(const f32x4*)(rp + c); *(f32x4*)(op + c) = acc[ai][bj][m][n] + r; }
                } }
    }
};

__device__ void rwkv_scan_item(const Params& p, int l, int item, unsigned char* smem_) {
    unsigned char* smem = launder_lds(smem_);
    const int tid = tid_l(), wid = tid >> 6, lane = tid & 63;
    const int b = item >> 5, h = (item >> 1) & 15, half = item & 1;
    float* vec = (float*)smem;
    float* vrow = vec + 20480;
    float* sc = vrow + 2048;
    float* exw = sc + 128;
    float* exa = exw + 2048;
    bf16_t* tw = (bf16_t*)(exa + 2048);
    bf16_t* ta = tw + 4608;
    bf16_t* w2t = ta + 4608;
    bf16_t* a2t = w2t + 4608;
    float* cst = (float*)(a2t + 4608);
    const bf16_t* P = (const bf16_t*)(p.ws + WS_P);
    float* ORAW = (float*)(p.ws + WS_ORAW);
    bf16_t* BV = (bf16_t*)(p.ws + WS_BV);
    __syncthreads();
    for (int i = tid; i < 9216; i += 512) tw[i] = 0;
    { const float* w2 = p.in[I_W2] + (size_t)l * 64 * 1024 + h * 64; const float* a2 = p.in[I_A2] + (size_t)l * 64 * 1024 + h * 64;
#pragma unroll
      for (int i = 0; i < 8; ++i) { const int idx = tid + 512 * i, k = idx >> 6, n = idx & 63; w2t[n * 72 + k] = f2bf(w2[(size_t)k * 1024 + n]); a2t[n * 72 + k] = f2bf(a2[(size_t)k * 1024 + n]); } }
    if (tid < 64) { const float* mu = p.in[I_MU] + (size_t)l * 3200; const int gc = h * 64 + tid;
        cst[tid] = mu[C_R + gc]; cst[64 + tid] = mu[C_K + gc]; cst[128 + tid] = mu[C_V + gc]; cst[192 + tid] = mu[C_WL + tid]; cst[256 + tid] = mu[C_AL + tid];
        cst[320 + tid] = p.in[I_KK][l * 1024 + gc]; cst[384 + tid] = p.in[I_KA][l * 1024 + gc]; cst[448 + tid] = p.in[I_RK][l * 1024 + gc];
        cst[512 + tid] = p.in[I_W0][l * 1024 + gc]; cst[576 + tid] = p.in[I_A0][l * 1024 + gc]; }
    __syncthreads();

    if (wid >= 4) {
        const int hw = wid - 4, tok = lane >> 3, cg8 = lane & 7, c0 = cg8 * 8, fr = lane & 15, fq = lane >> 4;
        const float* mu_r = cst + c0; const float* mu_k = cst + 64 + c0; const float* mu_v = cst + 128 + c0; const float* mu_wl = cst + 192 + c0; const float* mu_al = cst + 256 + c0;
        const float* kkc = cst + 320 + c0; const float* kac = cst + 384 + c0; const float* rkc = cst + 448 + c0;
        float w0c[4], a0c[4];
#pragma unroll
        for (int ct = 0; ct < 4; ++ct) { w0c[ct] = cst[512 + ct * 16 + fr]; a0c[ct] = cst[576 + ct * 16 + fr]; }
        for (int c = 0; c < 64; ++c) {
            const int buf = c & 1, tt = hw * 8 + tok, t = c * 32 + tt;
            const size_t grow = (size_t)b * 2048 + t;
            const bf16_t* prow = P + grow * N1;
            float xr[8], xk[8], xv[8], xw[8], xa[8];
            { float cur[8], prv[8];
#define LERP_SEG(dst, col, muv) { unpack8(*(const u32x4*)(prow + (col)), cur); if (t > 0) unpack8(*(const u32x4*)(prow - N1 + (col)), prv); else { _Pragma("unroll") for (int e = 0; e < 8; ++e) prv[e] = 0.f; } \
                _Pragma("unroll") for (int e = 0; e < 8; ++e) dst[e] = cur[e] + (prv[e] - cur[e]) * muv[e]; }
              LERP_SEG(xr, C_R + h * 64 + c0, mu_r) LERP_SEG(xk, C_K + h * 64 + c0, mu_k) LERP_SEG(xv, C_V + h * 64 + c0, mu_v) LERP_SEG(xw, C_WL + c0, mu_wl) LERP_SEG(xa, C_AL + c0, mu_al)
#undef LERP_SEG
            }
#pragma unroll
            for (int e = 0; e < 8; ++e) xw[e] = 1.0f - 2.0f / (__expf(2.0f * xw[e]) + 1.0f);
            *(u32x4*)(tw + (hw * 16 + tok) * 72 + c0) = pack8(xw);
            *(u32x4*)(ta + (hw * 16 + tok) * 72 + c0) = pack8(xa);
            lds_fence();
#pragma unroll
            for (int ct = 0; ct < 4; ++ct) {
                f32x4 aw = {0.f, 0.f, 0.f, 0.f}, aa = {0.f, 0.f, 0.f, 0.f};
#pragma unroll
                for (int ks = 0; ks < 2; ++ks) {
                    const bf16x8 fa = *(const bf16x8*)(tw + (hw * 16 + fr) * 72 + ks * 32 + fq * 8), fb = *(const bf16x8*)(w2t + (ct * 16 + fr) * 72 + ks * 32 + fq * 8);
                    aw = MFMA16(fa, fb, aw);
                    const bf16x8 ga = *(const bf16x8*)(ta + (hw * 16 + fr) * 72 + ks * 32 + fq * 8), gb = *(const bf16x8*)(a2t + (ct * 16 + fr) * 72 + ks * 32 + fq * 8);
                    aa = MFMA16(ga, gb, aa);
                }
                if (lane < 32) {
#pragma unroll
                    for (int j = 0; j < 4; ++j) { const int tj = fq * 4 + j, col = ct * 16 + fr;
                        const float sg = sigmoidf_(w0c[ct] + aw[j]);
                        exw[(hw * 8 + tj) * 64 + col] = __expf(-0.60653066f * sg);
                        exa[(hw * 8 + tj) * 64 + col] = sigmoidf_(a0c[ct] + aa[j]); }
                }
            }
            lds_fence();
            float w8[8], a8[8];
            { const float4 q0 = *(const float4*)(exw + (hw * 8 + tok) * 64 + c0), q1 = *(const float4*)(exw + (hw * 8 + tok) * 64 + c0 + 4);
              w8[0] = q0.x; w8[1] = q0.y; w8[2] = q0.z; w8[3] = q0.w; w8[4] = q1.x; w8[5] = q1.y; w8[6] = q1.z; w8[7] = q1.w;
              const float4 r0 = *(const float4*)(exa + (hw * 8 + tok) * 64 + c0), r1 = *(const float4*)(exa + (hw * 8 + tok) * 64 + c0 + 4);
              a8[0] = r0.x; a8[1] = r0.y; a8[2] = r0.z; a8[3] = r0.w; a8[4] = r1.x; a8[5] = r1.y; a8[6] = r1.z; a8[7] = r1.w; }
            float kk[8], kp[8], bb[8], wr[8]; float ssq = 0.f, br = 0.f, kr = 0.f, beta = 0.f;
#pragma unroll
            for (int e = 0; e < 8; ++e) { kk[e] = xk[e] * kkc[e]; ssq += kk[e] * kk[e]; }
            ssq = red8(ssq);
            const float inv = 1.0f / fmaxf(sqrtf(ssq), 1e-12f);
#pragma unroll
            for (int e = 0; e < 8; ++e) { kk[e] *= inv; kp[e] = xk[e] * (1.0f + (a8[e] - 1.0f) * kac[e]); bb[e] = -kk[e] * a8[e]; wr[e] = w8[e] * xr[e];
                br += bb[e] * xr[e]; kr += kp[e] * xr[e]; beta += xr[e] * kp[e] * rkc[e]; }
            br = red8(br); kr = red8(kr); beta = red8(beta);
            float* vb = vec + (size_t)((buf * 32 + tt) * 5) * 64 + c0;
#define ST8(ptr, arr) { *(float4*)(ptr) = make_float4(arr[0], arr[1], arr[2], arr[3]); *(float4*)((ptr) + 4) = make_float4(arr[4], arr[5], arr[6], arr[7]); }
            ST8(vb, w8) ST8(vb + 64, kk) ST8(vb + 128, bb) ST8(vb + 192, kp) ST8(vb + 256, wr)
            if (cg8 == 0) { sc[(buf * 32 + tt) * 2] = br; sc[(buf * 32 + tt) * 2 + 1] = kr; }
            if ((cg8 >> 2) == half) {
                float* vp = vrow + (buf * 32 + tt) * 32 + (c0 - half * 32);
                ST8(vp, xv)
                float bvv[8];
#pragma unroll
                for (int e = 0; e < 8; ++e) bvv[e] = beta * xv[e];
                *(u32x4*)(BV + grow * 1024 + h * 64 + c0) = pack8(bvv);
            }
#undef ST8
            __syncthreads();
        }
        __syncthreads();
    } else {
        const int rg = lane >> 4, cg = lane & 15, rho0 = wid * 8 + rg * 2;
        float4 S0 = make_float4(0.f, 0.f, 0.f, 0.f), S1 = S0;
        __syncthreads();
        for (int c = 0; c < 64; ++c) {
            const int buf = c & 1;
            float* op = ORAW + ((size_t)b * 2048 + c * 32) * 1024 + h * 64 + half * 32 + rho0;
#pragma unroll 2
            for (int tt = 0; tt < 32; ++tt) {
                const float* vb = vec + (size_t)((buf * 32 + tt) * 5) * 64 + cg * 4;
                const float4 W = *(const float4*)(vb), KK = *(const float4*)(vb + 64), B = *(const float4*)(vb + 128), KP = *(const float4*)(vb + 192), WR = *(const float4*)(vb + 256);
                const float2 vv = *(const float2*)(vrow + (buf * 32 + tt) * 32 + rho0);
                const float2 s2 = *(const float2*)(sc + (buf * 32 + tt) * 2);
                float d0k = S0.x * KK.x + S0.y * KK.y + S0.z * KK.z + S0.w * KK.w;
                float d1k = S1.x * KK.x + S1.y * KK.y + S1.z * KK.z + S1.w * KK.w;
                float d0r = S0.x * WR.x + S0.y * WR.y + S0.z * WR.z + S0.w * WR.w;
                float d1r = S1.x * WR.x + S1.y * WR.y + S1.z * WR.z + S1.w * WR.w;
                d0k = red16(d0k); d1k = red16(d1k); d0r = red16(d0r); d1r = red16(d1r);
                const float o0 = d0r + d0k * s2.x + vv.x * s2.y, o1 = d1r + d1k * s2.x + vv.y * s2.y;
                if (cg == 0) *(float2*)(op + (size_t)tt * 1024) = make_float2(o0, o1);
                S0.x = S0.x * W.x + d0k * B.x + vv.x * KP.x; S0.y = S0.y * W.y + d0k * B.y + vv.x * KP.y; S0.z = S0.z * W.z + d0k * B.z + vv.x * KP.z; S0.w = S0.w * W.w + d0k * B.w + vv.x * KP.w;
                S1.x = S1.x * W.x + d1k * B.x + vv.y * KP.x; S1.y = S1.y * W.y + d1k * B.y + vv.y * KP.y; S1.z = S1.z * W.z + d1k * B.z + vv.y * KP.z; S1.w = S1.w * W.w + d1k * B.w + vv.y * KP.w;
            }
            __syncthreads();
        }
        float* so = p.out + O_PWKV + ((((size_t)l * 8 + b) * 16 + h) * 64 + half * 32 + rho0) * 64 + cg * 4;
        *(float4*)so = S0; *(float4*)(so + 64) = S1;
    }
}

__device__ void rwkv_sample_item(const Params& p, int l, int item, unsigned char* smem_) {
    unsigned char* smem = launder_lds(smem_);
    const int tid = tid_l(), lane = tid & 63;
    const int i = item >> 4, h = item & 15;
    float* s_tw = (float*)smem; float* s_al = s_tw + 64; float* sv = s_al + 64;
    float* s_sc = sv + 384;
    const bf16_t* P = (const bf16_t*)(p.ws + WS_P);
    float* ORAW = (float*)(p.ws + WS_ORAW);
    bf16_t* BV = (bf16_t*)(p.ws + WS_BV);
    const size_t rowp = (size_t)TP + i, rows = (size_t)TALL + i;
    const bf16_t* pc = P + rowp * N1; const bf16_t* pp = P + rows * N1;
    __syncthreads();
    if (tid < 64) {
        const float* mu = p.in[I_MU] + (size_t)l * 3200;
        const int gc = h * 64 + lane;
#define LERP1(col) (bf2f(pc[col]) + (bf2f(pp[col]) - bf2f(pc[col])) * mu[col])
        const float xr = LERP1(C_R + gc), xk = LERP1(C_K + gc), xv = LERP1(C_V + gc), xwl = LERP1(C_WL + lane), xal = LERP1(C_AL + lane);
#undef LERP1
        s_tw[lane] = 1.0f - 2.0f / (__expf(2.0f * xwl) + 1.0f); s_al[lane] = xal;
        lds_fence();
        const float* w2 = p.in[I_W2] + (size_t)l * 64 * 1024 + gc; const float* a2 = p.in[I_A2] + (size_t)l * 64 * 1024 + gc;
        float lw = 0.f, la = 0.f;
#pragma unroll 8
        for (int k = 0; k < 64; ++k) { lw += s_tw[k] * w2[(size_t)k * 1024]; la += s_al[k] * a2[(size_t)k * 1024]; }
        const float w = __expf(-0.60653066f * sigmoidf_(p.in[I_W0][l * 1024 + gc] + lw));
        const float a = sigmoidf_(p.in[I_A0][l * 1024 + gc] + la);
        float kk = xk * p.in[I_KK][l * 1024 + gc];
        const float ssq = wave_sum(kk * kk);
        kk *= 1.0f / fmaxf(sqrtf(ssq), 1e-12f);
        const float kp = xk * (1.0f + (a - 1.0f) * p.in[I_KA][l * 1024 + gc]);
        const float bb = -kk * a, wr = w * xr;
        const float br = wave_sum(bb * xr), kr = wave_sum(kp * xr), beta = wave_sum(xr * kp * p.in[I_RK][l * 1024 + gc]);
        sv[lane] = w; sv[64 + lane] = kk; sv[128 + lane] = bb; sv[192 + lane] = kp; sv[256 + lane] = wr; sv[320 + lane] = xv;
        if (lane == 0) { s_sc[0] = br; s_sc[1] = kr; }
        BV[rowp * 1024 + gc] = f2bf(beta * xv);
    }
    __syncthreads();
    {
        const int row = tid >> 3, cs = (tid & 7) * 8;
        const size_t so = ((((size_t)l * TS + i) * 16 + h) * 64 + row) * 64 + cs;
        const float* sin = p.in[I_SWKV] + so;
        const float4 a0 = *(const float4*)sin, a1 = *(const float4*)(sin + 4);
        float S[8] = {a0.x, a0.y, a0.z, a0.w, a1.x, a1.y, a1.z, a1.w};
        float dk = 0.f, dr = 0.f;
#pragma unroll
        for (int e = 0; e < 8; ++e) { dk += S[e] * sv[64 + cs + e]; dr += S[e] * sv[256 + cs + e]; }
        dk = red8(dk); dr = red8(dr);
        const float vr = sv[320 + row];
        const float o = dr + dk * s_sc[0] + vr * s_sc[1];
        if ((tid & 7) == 0) ORAW[rowp * 1024 + h * 64 + row] = o;
#pragma unroll
        for (int e = 0; e < 8; ++e) S[e] = S[e] * sv[cs + e] + dk * sv[128 + cs + e] + vr * sv[192 + cs + e];
        float* sout = p.out + O_SWKV + so;
        *(float4*)sout = make_float4(S[0], S[1], S[2], S[3]); *(float4*)(sout + 4) = make_float4(S[4], S[5], S[6], S[7]);
    }
}

__device__ void mamba_item(const Params& p, int l, int item, unsigned char* smem_) {
    unsigned char* smem = launder_lds(smem_);
    const int tid = tid_l(), wid = tid >> 6, lane = tid & 63, fr = lane & 15, fq = lane >> 4;
    const int b = item >> 5, j = (item >> 1) & 15, ph = item & 1, g = j >> 3;
    bf16_t* Cm = (bf16_t*)smem;
    bf16_t* Bm = (bf16_t*)(smem + 17408);
    bf16_t* BmT = (bf16_t*)(smem + 34816);
    bf16_t* XT = (bf16_t*)(smem + 53248);
    bf16_t* XwT = (bf16_t*)(smem + 57856);
    bf16_t* G = (bf16_t*)(smem + 62464);
    bf16_t* Hb = (bf16_t*)(smem + 71680);
    float* xs = (float*)(smem + 80384);
    float* acs = (float*)(smem + 88832);
    float* dtv = acs + 64;
    const bf16_t* P = (const bf16_t*)(p.ws + WS_P);
    bf16_t* YM = (bf16_t*)(p.ws + WS_YM);
    __syncthreads();
    for (int i = tid; i < 32 * 136; i += 512) Hb[i] = 0;
    const int q = tid % 72, seg = tid / 72;
    int kind, lc, xcol;
    if (q < 8) { kind = 0; lc = q * 4; xcol = j * 64 + ph * 32 + lc; } else if (q < 40) { kind = 1; lc = (q - 8) * 4; xcol = 1024 + g * 128 + lc; } else { kind = 2; lc = (q - 40) * 4; xcol = 1280 + g * 128 + lc; }
    float4 cw0, cw1, cw2, cw3, cbv;
    { const float* cw = p.in[I_CW] + (size_t)l * 4 * 1536 + xcol; cw0 = *(const float4*)cw; cw1 = *(const float4*)(cw + 1536); cw2 = *(const float4*)(cw + 3072); cw3 = *(const float4*)(cw + 4608);
      cbv = *(const float4*)(p.in[I_CB] + (size_t)l * 1536 + xcol); }
    const float dtb = p.in[I_DTB][l * 16 + j], Aj = -__expf(p.in[I_ALOG][l * 16 + j]), Dj = p.in[I_DSK][l * 16 + j];
    f32x4 hacc[2] = {{0.f, 0.f, 0.f, 0.f}, {0.f, 0.f, 0.f, 0.f}};
    __syncthreads();
    for (int c = 0; c < 32; ++c) {
        const int t0 = c * 64;
        if (tid < 288) {
            const int tb = t0 + seg * 16;
            const bf16_t* pb = P + ((size_t)b * 2048 + tb) * N1 + C_XBC + xcol;
            float4 w0 = make_float4(0.f, 0.f, 0.f, 0.f), w1 = w0, w2 = w0;
#define LD4(dst, ptr) { const u32x2 _v = *(const u32x2*)(ptr); dst = make_float4(__uint_as_float(_v.x << 16), __uint_as_float(_v.x & 0xffff0000u), __uint_as_float(_v.y << 16), __uint_as_float(_v.y & 0xffff0000u)); }
            if (tb >= 3) { LD4(w0, pb - 3 * (size_t)N1) LD4(w1, pb - 2 * (size_t)N1) LD4(w2, pb - (size_t)N1) }
#pragma unroll
            for (int s = 0; s < 16; ++s) {
                float4 cur; LD4(cur, pb + (size_t)s * N1)
                float4 u;
                u.x = cbv.x + cw0.x * w0.x + cw1.x * w1.x + cw2.x * w2.x + cw3.x * cur.x; u.y = cbv.y + cw0.y * w0.y + cw1.y * w1.y + cw2.y * w2.y + cw3.y * cur.y;
                u.z = cbv.z + cw0.z * w0.z + cw1.z * w1.z + cw2.z * w2.z + cw3.z * cur.z; u.w = cbv.w + cw0.w * w0.w + cw1.w * w1.w + cw2.w * w2.w + cw3.w * cur.w;
                u.x = siluf_(u.x); u.y = siluf_(u.y); u.z = siluf_(u.z); u.w = siluf_(u.w);
                w0 = w1; w1 = w2; w2 = cur;
                const int sl = seg * 16 + s;
                if (kind == 0) { float* xp = xs + sl * 33 + lc; xp[0] = u.x; xp[1] = u.y; xp[2] = u.z; xp[3] = u.w; }
                else { u32x2 pk; pk.x = pk2(u.x, u.y); pk.y = pk2(u.z, u.w);
                    if (kind == 1) { *(u32x2*)(Bm + sl * 136 + lc) = pk; BmT[(lc + 0) * 72 + sl] = (bf16_t)(pk.x & 0xffff); BmT[(lc + 1) * 72 + sl] = (bf16_t)(pk.x >> 16); BmT[(lc + 2) * 72 + sl] = (bf16_t)(pk.y & 0xffff); BmT[(lc + 3) * 72 + sl] = (bf16_t)(pk.y >> 16); }
                    else *(u32x2*)(Cm + sl * 136 + lc) = pk; }
            }
#undef LD4
        } else if (wid == 5) {
            const float dr = bf2f(P[((size_t)b * 2048 + t0 + lane) * N1 + C_DT + j]);
            const float dt = softplusf_(dr + dtb);
            float v = dt * Aj;
#pragma unroll
            for (int off = 1; off < 64; off <<= 1) { const float t = __shfl_up(v, off); if (lane >= off) v += t; }
            acs[lane] = v; dtv[lane] = dt;
        }
        __syncthreads();
        { const int pp = tid & 31, s4 = (tid >> 5) * 4; const float aend = acs[63]; float x[4], xw[4];
#pragma unroll
          for (int e = 0; e < 4; ++e) { x[e] = xs[(s4 + e) * 33 + pp]; xw[e] = x[e] * dtv[s4 + e] * __expf(aend - acs[s4 + e]); }
          u32x2 a; a.x = pk2(x[0], x[1]); a.y = pk2(x[2], x[3]); *(u32x2*)(XT + pp * 72 + s4) = a;
          u32x2 bq; bq.x = pk2(xw[0], xw[1]); bq.y = pk2(xw[2], xw[3]); *(u32x2*)(XwT + pp * 72 + s4) = bq; }
#pragma unroll
        for (int e = 0; e < 2; ++e) {
            const int id = wid * 2 + e, lt = id >> 2, st = id & 3;
            f32x4 acc = {0.f, 0.f, 0.f, 0.f};
            if (st <= lt) {
#pragma unroll
                for (int ks = 0; ks < 4; ++ks) { const bf16x8 fa = *(const bf16x8*)(Cm + (lt * 16 + fr) * 136 + ks * 32 + fq * 8), fb = *(const bf16x8*)(Bm + (st * 16 + fr) * 136 + ks * 32 + fq * 8); acc = MFMA16(fa, fb, acc); }
            }
#pragma unroll
            for (int jj = 0; jj < 4; ++jj) { const int lr = lt * 16 + fq * 4 + jj, s = st * 16 + fr;
                const float val = (s <= lr) ? acc[jj] * __expf(acs[lr] - acs[s]) * dtv[s] : 0.f;
                G[lr * 72 + s] = f2bf(val); }
        }
        const int lt = wid >> 1, pt = wid & 1;
        f32x4 accO = {0.f, 0.f, 0.f, 0.f};
#pragma unroll
        for (int ks = 0; ks < 4; ++ks) { const bf16x8 fa = *(const bf16x8*)(Cm + (lt * 16 + fr) * 136 + ks * 32 + fq * 8), fb = *(const bf16x8*)(Hb + (pt * 16 + fr) * 136 + ks * 32 + fq * 8); accO = MFMA16(fa, fb, accO); }
        __syncthreads();
        {
            f32x4 accD = {0.f, 0.f, 0.f, 0.f};
#pragma unroll
            for (int ks = 0; ks < 2; ++ks) { const bf16x8 fa = *(const bf16x8*)(G + (lt * 16 + fr) * 72 + ks * 32 + fq * 8), fb = *(const bf16x8*)(XT + (pt * 16 + fr) * 72 + ks * 32 + fq * 8); accD = MFMA16(fa, fb, accD); }
#pragma unroll
            for (int jj = 0; jj < 4; ++jj) { const int lr = lt * 16 + fq * 4 + jj, pp = pt * 16 + fr;
                float y = accD[jj] + __expf(acs[lr]) * accO[jj] + Dj * xs[lr * 33 + pp];
                const size_t grow = (size_t)b * 2048 + t0 + lr;
                const float z = bf2f(P[grow * N1 + C_ZM + j * 64 + ph * 32 + pp]);
                y *= siluf_(z);
                YM[grow * 1024 + j * 64 + ph * 32 + pp] = f2bf(y); }
            const float cd = __expf(acs[63]); const int ptile = wid >> 2;
#pragma unroll
            for (int e = 0; e < 2; ++e) { const int nt = (wid & 3) * 2 + e;
                hacc[e] *= cd;
#pragma unroll
                for (int ks = 0; ks < 2; ++ks) { const bf16x8 fa = *(const bf16x8*)(XwT + (ptile * 16 + fr) * 72 + ks * 32 + fq * 8), fb = *(const bf16x8*)(BmT + (nt * 16 + fr) * 72 + ks * 32 + fq * 8); hacc[e] = MFMA16(fa, fb, hacc[e]); }
#pragma unroll
                for (int jj = 0; jj < 4; ++jj) Hb[(ptile * 16 + fq * 4 + jj) * 136 + nt * 16 + fr] = f2bf(hacc[e][jj]); }
        }
        __syncthreads();
    }
    { const int ptile = wid >> 2;
#pragma unroll
      for (int e = 0; e < 2; ++e) { const int nt = (wid & 3) * 2 + e;
#pragma unroll
          for (int jj = 0; jj < 4; ++jj) p.out[O_PSSM + ((((size_t)l * 8 + b) * 16 + j) * 64 + ph * 32 + ptile * 16 + fq * 4 + jj) * 128 + nt * 16 + fr] = hacc[e][jj]; } }
}

__device__ void mamba_sample_item(const Params& p, int l, int item, unsigned char* smem_) {
    unsigned char* smem = launder_lds(smem_);
    const int tid = tid_l();
    const int i = item >> 4, j = item & 15, g = j >> 3;
    float* su = (float*)smem;
    float* sd = su + 320;
    const bf16_t* P = (const bf16_t*)(p.ws + WS_P);
    bf16_t* YM = (bf16_t*)(p.ws + WS_YM);
    const size_t rowp = (size_t)TP + i;
    __syncthreads();
    if (tid < 320) {
        const int cc = tid < 64 ? j * 64 + tid : (tid < 192 ? 1024 + g * 128 + (tid - 64) : 1280 + g * 128 + (tid - 192));
        const float* c0 = p.in[I_SCONV] + ((size_t)l * TS + i) * 3 * 1536 + cc;
        const float* cw = p.in[I_CW] + (size_t)l * 4 * 1536 + cc;
        const float v = p.in[I_CB][l * 1536 + cc] + c0[0] * cw[0] + c0[1536] * cw[1536] + c0[3072] * cw[3072] + bf2f(P[rowp * N1 + C_XBC + cc]) * cw[4608];
        su[tid] = siluf_(v);
    } else if (tid == 320) {
        const float dt = softplusf_(bf2f(P[rowp * N1 + C_DT + j]) + p.in[I_DTB][l * 16 + j]);
        sd[0] = dt; sd[1] = __expf(-dt * __expf(p.in[I_ALOG][l * 16 + j]));
    }
    __syncthreads();
    {
        const int pp = tid >> 3, n0 = (tid & 7) * 16;
        const size_t so = ((((size_t)l * TS + i) * 16 + j) * 64 + pp) * 128 + n0;
        const float* hin = p.in[I_SSSM] + so; float* hout = p.out + O_SSSM + so;
        const float dt = sd[0], eA = sd[1], x = su[pp], xdt = x * dt;
        float y = 0.f;
#pragma unroll
        for (int e = 0; e < 4; ++e) { float4 hv = *(const float4*)(hin + e * 4); const float* Bp = su + 64 + n0 + e * 4; const float* Cp = su + 192 + n0 + e * 4;
            hv.x = eA * hv.x + xdt * Bp[0]; hv.y = eA * hv.y + xdt * Bp[1]; hv.z = eA * hv.z + xdt * Bp[2]; hv.w = eA * hv.w + xdt * Bp[3];
            y += hv.x * Cp[0] + hv.y * Cp[1] + hv.z * Cp[2] + hv.w * Cp[3];
            *(float4*)(hout + e * 4) = hv; }
        y = red8(y);
        if ((tid & 7) == 0) { y += p.in[I_DSK][l * 16 + j] * x; const float z = bf2f(P[rowp * N1 + C_ZM + j * 64 + pp]); YM[rowp * 1024 + j * 64 + pp] = f2bf(y * siluf_(z)); }
    }
}

__device__ void phase_mix(const Params& p, int l, unsigned char* smem) {
#if !defined(SUB) || SUB==0
    for (int it = blockIdx.x; it < 256; it += gridDim.x) rwkv_scan_item(p, l, it, smem);
#endif
#if !defined(SUB) || SUB==1
    for (int it = blockIdx.x; it < 256; it += gridDim.x) mamba_item(p, l, it, smem);
#endif
#if !defined(SUB) || SUB==2
    for (int it = blockIdx.x; it < 2048; it += gridDim.x) rwkv_sample_item(p, l, it, smem);
#endif
#if !defined(SUB) || SUB==3
    for (int it = blockIdx.x; it < 2048; it += gridDim.x) mamba_sample_item(p, l, it, smem);
#endif
}

__device__ void phase_post(const Params& p, int l) {
    const int tid_ = tid_l(); const int lane = tid_ & 63, wid = tid_ >> 6;
    const bf16_t* P = (const bf16_t*)(p.ws + WS_P);
    const float* ORAW = (const float*)(p.ws + WS_ORAW);
    const bf16_t* BV = (const bf16_t*)(p.ws + WS_BV);
    const bf16_t* YM = (const bf16_t*)(p.ws + WS_YM);
    bf16_t* A2 = (bf16_t*)(p.ws + WS_A);
    const float* lnw = p.in[I_LNW] + l * 1024; const float* lnb = p.in[I_LNB] + l * 1024; const float* gnw = p.in[I_GNW] + l * 1024;
    for (int row = blockIdx.x * 8 + wid; row < TALL; row += gridDim.x * 8) {
        const bf16_t* prow = P + (size_t)row * N1;
        for (int h = 0; h < 16; ++h) {
            const int col = h * 64 + lane;
            const float o = ORAW[(size_t)row * 1024 + col];
            const float mean = wave_sum(o) * (1.0f / 64.0f); const float d = o - mean;
            const float var = wave_sum(d * d) * (1.0f / 64.0f);
            float y = d * rsqrtf(var + 64e-5f) * lnw[col] + lnb[col] + bf2f(BV[(size_t)row * 1024 + col]);
            y *= siluf_(bf2f(prow[C_ZR + col]));
            A2[(size_t)row * 2048 + col] = f2bf(y);
        }
#pragma unroll
        for (int g = 0; g < 2; ++g) {
            const int col = g * 512 + lane * 8; float f[8];
            unpack8(*(const u32x4*)(YM + (size_t)row * 1024 + col), f);
            float ss = 0.f;
#pragma unroll
            for (int e = 0; e < 8; ++e) ss += f[e] * f[e];
            ss = wave_sum(ss);
            const float rs = rsqrtf(ss * (1.0f / 512.0f) + 1e-5f);
#pragma unroll
            for (int e = 0; e < 8; ++e) f[e] *= rs * gnw[col + e];
            *(u32x4*)(A2 + (size_t)row * 2048 + 1024 + col) = pack8(f);
        }
        if (row < TP) {
            const int tq = row & 2047;
            if (tq >= 2045) { float* dst = p.out + O_PCONV + (((size_t)l * 8 + (row >> 11)) * 3 + (tq - 2045)) * 1536;
                for (int c = lane; c < 1536; c += 64) dst[c] = bf2f(prow[C_XBC + c]); }
        } else {
            const int i = row - TP; float* dst = p.out + O_SCONV + ((size_t)l * TS + i) * 3 * 1536; const float* src = p.in[I_SCONV] + ((size_t)l * TS + i) * 3 * 1536;
            for (int c = lane; c < 1536; c += 64) { dst[c] = src[1536 + c]; dst[1536 + c] = src[3072 + c]; dst[3072 + c] = bf2f(prow[C_XBC + c]); }
        }
    }
}

constexpr int NPHASE = 11;
__global__ __launch_bounds__(512, 2) void mega(Params p) {
    extern __shared__ __attribute__((aligned(16))) unsigned char smem[];
    cg::grid_group grid = cg::this_grid();
    for (int ph = p.ph_lo; ph < p.ph_hi; ++ph) {
        if (ph > p.ph_lo) grid.sync();
        const int l = ph >= 5 ? 1 : 0;
        switch (ph) {
            #if !defined(ONLY) || ONLY==0
            case 0: phase_convert(p, smem); phase_norm(p, 0); break;
#endif
#if !defined(ONLY) || ONLY==0
            case 5: phase_norm(p, 1); break;
#endif
#if (!defined(ONLY) || ONLY==1) && !defined(NOG1)
            case 1: case 6: {
                pg8::Gemm g{(const bf16_t*)(p.ws + WS_A), (const bf16_t*)(p.ws + WS_WINT) + (size_t)l * N1 * 1024, M1, N1, 1024};
                pg8::StaticOrder S; S.init(M1, N1, (int)gridDim.x, (int)blockIdx.x);
                EpiP E{(bf16_t*)(p.ws + WS_P), N1};
                pg8::gemm_phase<EpiP, pg8::StaticOrder, false>((PG8_LAS unsigned char*)smem, g, S, E, nullptr);
            } break;
#endif
#if (!defined(ONLY) || ONLY==2) && !defined(NOMIX)
            case 2: case 7: phase_mix(p, l, smem); break;
#endif
#if !defined(ONLY) || ONLY==3
            case 3: case 8: phase_post(p, l); break;
#endif
#if (!defined(ONLY) || ONLY==4) && !defined(NOG2)
            case 4: case 9: {
                pg8::Gemm g{(const bf16_t*)(p.ws + WS_A), (const bf16_t*)(p.ws + WS_WOUTT) + (size_t)l * 1024 * 2048, M1, 1024, 2048};
                pg8::StaticOrder S; S.init(M1, 1024, (int)gridDim.x, (int)blockIdx.x);
                EpiRes E{l == 0 ? p.in[I_XP] : p.out + O_YP, l == 0 ? p.in[I_XS] : p.out + O_YS, p.out + O_YP, p.out + O_YS};
                pg8::gemm_phase<EpiRes, pg8::StaticOrder, false>((PG8_LAS unsigned char*)smem, g, S, E, nullptr);
            } break;
#endif
#if !defined(ONLY) || ONLY==0
            case 10: phase_final(p); break;
#endif
        }
    }
}

extern "C" void kernel_launch(void* const* d_in, const int* in_sizes, int n_in, void* d_out, int out_size, void* d_ws, size_t ws_size, hipStream_t stream) {
    static int grid = 0;
    if (grid == 0) {
        if (n_in != 26 || (size_t)out_size != O_END || ws_size < WS_END) { fprintf(stderr, "kernel_launch: unexpected shapes: n_in %d out %d ws %zu (need %zu)\n", n_in, out_size, ws_size, (size_t)WS_END); grid = -1; return; }
        int dev = 0, cus = 0, per_cu = 0;
        hipGetDevice(&dev); hipDeviceGetAttribute(&cus, hipDeviceAttributeMultiprocessorCount, dev);
        if (hipFuncSetAttribute((const void*)mega, hipFuncAttributeMaxDynamicSharedMemorySize, LDS_BYTES) != hipSuccess) { fprintf(stderr, "kernel_launch: hipFuncSetAttribute failed\n"); grid = -1; return; }
        if (hipOccupancyMaxActiveBlocksPerMultiprocessor(&per_cu, (const void*)mega, 512, LDS_BYTES) != hipSuccess || per_cu < 1) { fprintf(stderr, "kernel_launch: occupancy query gave %d\n", per_cu); per_cu = 1; }
        (void)hipGetLastError();
        grid = cus * 1;
    }
    if (grid < 0) return;
    Params p{};
    for (int i = 0; i < 26; ++i) p.in[i] = (const float*)d_in[i];
    p.out = (float*)d_out; p.ws = (unsigned char*)d_ws;
#if MK_PER_PHASE
    for (int ph = 0; ph < NPHASE; ++ph) { p.ph_lo = ph; p.ph_hi = ph + 1; hipLaunchKernelGGL(mega, dim3(grid), dim3(512), LDS_BYTES, stream, p); }
#else
    p.ph_lo = 0; p.ph_hi = NPHASE;
    void* args[] = {&p};
    hipError_t e = hipLaunchCooperativeKernel((const void*)mega, dim3(grid), dim3(512), args, LDS_BYTES, stream);
    if (e != hipSuccess) fprintf(stderr, "cooperative launch failed: %s (grid %d)\n", hipGetErrorString(e), grid);
#endif
}
```

```cpp
#include <hip/hip_runtime.h>
#include <hip/hip_cooperative_groups.h>
#include <cstdio>
namespace cg = cooperative_groups;
namespace pg8 {
#define PG8_LAS __attribute__((address_space(3)))
typedef unsigned short bf16_t;
typedef short bf16x8 __attribute__((ext_vector_type(8)));
typedef float f32x4 __attribute__((ext_vector_type(4)));
typedef unsigned u32x4 __attribute__((ext_vector_type(4)));
constexpr int BM = 256, BK = 64, HALF = 128, HTB = HALF * BK * 2  , STAGE_BYTES = 8 * HTB, NXCD = 8, WGM = 8;

__host__ __device__ __forceinline__ int lds_byte(int r, int c) { const int st = (r >> 4) * 2 + (c >> 5), rr = r & 15, cc = c & 31, ob = rr * 64 + cc * 2; return st * 1024 + (ob ^ (((ob >> 9) & 1) << 5)); }
__host__ __device__ __forceinline__ void stage_rc(int b, int& R, int& C) { const int st = b / 1024, sb = b % 1024, swz = sb ^ (((sb >> 9) & 1) << 5); R = (st >> 1) * 16 + swz / 64; C = (st & 1) * 32 + (swz % 64) / 2; }
__host__ __device__ __forceinline__ int perm32(int rho) { const int n = rho >> 4, i = rho & 15; return 8 * (i >> 2) + 4 * n + (i & 3); }

struct Unit { int pm, pn; };
struct Gemm { const bf16_t* A; const bf16_t* Bt; int M, N, K; };

struct StaticOrder {
    int nM, nN, nwg, G, c;
    __host__ __device__ void init(int M, int N, int G_, int c_) { nM = M / BM; nN = N / BM; nwg = nM * nN; G = G_; c = c_; }
    __host__ __device__ bool next(int i, Unit& u) const {
        const long L = (long)i * G + c; if (L >= nwg) return false;
        int wgid = (int)L; { const int q = nwg / NXCD, r = nwg % NXCD, xcd = wgid % NXCD, off = wgid / NXCD; wgid = (xcd < r ? xcd * (q + 1) : r * (q + 1) + (xcd - r) * q) + off; }
        const int nig = WGM * nN, gid = wgid / nig, fm = gid * WGM, gsz = (nM - fm) < WGM ? (nM - fm) : WGM;
        u.pm = fm + ((wgid % nig) % gsz); u.pn = (wgid % nig) / gsz; return true;
    }
    __device__ __forceinline__ void a_ready(const Unit&) const {}
    __device__ __forceinline__ void done(const Unit&) const {}
};
__device__ __forceinline__ unsigned cvt_pk_bf16(float lo, float hi) { unsigned r; asm volatile("v_cvt_pk_bf16_f32 %0, %1, %2" : "=v"(r) : "v"(lo), "v"(hi)); return r; }
template <class Epi, class Sched, bool STAMP = false>
__device__ __forceinline__ void gemm_phase(PG8_LAS unsigned char* lds, const Gemm g, const Sched& S, const Epi& E, unsigned long long* stamps) {
    int tid_raw = threadIdx.x; asm volatile("" : "+v"(tid_raw)); const int tid = tid_raw, wid = __builtin_amdgcn_readfirstlane(tid >> 6), lane = tid & 63, wr = wid >> 2, wc = wid & 3, fr = lane & 15, fq = lane >> 4;
    const int K = g.K, nt = K / BK;
    int ts_lo = 0, ts_hi = 0, nts = 0; const unsigned long long rt_entry = STAMP ? (unsigned long long)wall_clock64() : 0ull;
#define PG8_STAMP() do { if (STAMP && wid == 0 && nts < 64) { const unsigned long long _c = (unsigned long long)clock64(); \
        ts_lo = (lane == nts) ? (int)(unsigned)_c : ts_lo; ts_hi = (lane == nts) ? (int)(unsigned)(_c >> 32) : ts_hi; ++nts; } } while (0)
    PG8_STAMP();
    unsigned voffA[2], voffB[2];
#pragma unroll
    for (int i = 0; i < 2; ++i) { int R, C; stage_rc(tid * 16 + i * 8192, R, C); const int Rb = Epi::PERM ? ((R & ~31) + perm32(R & 31)) : R;
        voffA[i] = (unsigned)(R * K + C) * 2u; voffB[i] = (unsigned)(Rb * K + C) * 2u; }
    const size_t kstep = (size_t)(BK * 2);
    const size_t hstep = (size_t)HALF * K * 2;
    const size_t tstep = 2 * hstep;
    const unsigned ldsw = (unsigned)wid * 1024u;
    const int aoff = lds_byte(wr * 64 + fr, fq * 8), boff = lds_byte(wc * 32 + fr, fq * 8);
#define PG8_SA(b, h) (((b) * 2 + (h)) * HTB)
#define PG8_SB(b, h) ((4 + (b) * 2 + (h)) * HTB)
#define PG8_STAGE(bufoff, gbase, voff) do { _Pragma("unroll") for (int _i = 0; _i < 2; ++_i) \
        __builtin_amdgcn_global_load_lds((const unsigned*)((const char*)(gbase) + (voff)[_i]), (PG8_LAS unsigned*)(lds + (bufoff) + ldsw + _i * 8192), 16, 0, 0); } while (0)
#define PG8_LDA(dst, b, h) do { _Pragma("unroll") for (int m = 0; m < 4; ++m) _Pragma("unroll") for (int k = 0; k < 2; ++k) dst[m][k] = *(const PG8_LAS bf16x8*)(lds + PG8_SA(b, h) + aoff + m * 2048 + k * 1024); } while (0)
#define PG8_LDB(dst, b, h) do { _Pragma("unroll") for (int n = 0; n < 2; ++n) _Pragma("unroll") for (int k = 0; k < 2; ++k) dst[n][k] = *(const PG8_LAS bf16x8*)(lds + PG8_SB(b, h) + boff + n * 2048 + k * 1024); } while (0)
#define PG8_MMA(ai, bj, At, Bt) do { __builtin_amdgcn_s_setprio(1); _Pragma("unroll") for (int m = 0; m < 4; ++m) _Pragma("unroll") for (int n = 0; n < 2; ++n) _Pragma("unroll") for (int k = 0; k < 2; ++k) \
        acc[ai][bj][m][n] = __builtin_amdgcn_mfma_f32_16x16x32_bf16(Bt[n][k], At[m][k], acc[ai][bj][m][n], 0, 0, 0); __builtin_amdgcn_s_setprio(0); } while (0)
#define PG8_WAIT_V(n) asm volatile("s_waitcnt vmcnt(" #n ")" ::: "memory")
#define PG8_WAIT_L(n) asm volatile("s_waitcnt lgkmcnt(" #n ")" ::: "memory")
#define PG8_BAR __builtin_amdgcn_s_barrier()
#define PG8_SCHED __builtin_amdgcn_sched_barrier(0)
    Unit cur, nxt; int ui = 0;
    if (!S.next(0, cur)) return;
    f32x4 acc[2][2][4][2];
#pragma unroll
    for (int a = 0; a < 2; ++a)
#pragma unroll
        for (int b = 0; b < 2; ++b)
#pragma unroll
            for (int m = 0; m < 4; ++m)
#pragma unroll
                for (int n = 0; n < 2; ++n) acc[a][b][m][n] = (f32x4){0.f, 0.f, 0.f, 0.f};
    bf16x8 At[4][2], B0[2][2], B1[2][2];
    const char* cA = (const char*)g.A + (size_t)cur.pm * tstep; const char* cB = (const char*)g.Bt + (size_t)cur.pn * tstep;
    S.a_ready(cur);
    PG8_STAGE(PG8_SB(0, 0), cB, voffB); PG8_STAGE(PG8_SA(0, 0), cA, voffA); PG8_STAGE(PG8_SB(0, 1), cB + hstep, voffB); PG8_STAGE(PG8_SA(0, 1), cA + hstep, voffA);
    if (wr == 1) PG8_BAR;
    PG8_WAIT_V(4); PG8_BAR;
    PG8_STAGE(PG8_SB(1, 0), cB + kstep, voffB); PG8_STAGE(PG8_SA(1, 0), cA + kstep, voffA); PG8_STAGE(PG8_SB(1, 1), cB + hstep + kstep, voffB);
    PG8_WAIT_V(6); PG8_BAR;
    PG8_STAMP();
    for (;;) {
        const bool has_next = S.next(ui + 1, nxt);
        const char* nA = has_next ? (const char*)g.A + (size_t)nxt.pm * tstep : cA; const char* nB = has_next ? (const char*)g.Bt + (size_t)nxt.pn * tstep : cB;
        for (int t = 0; t < nt; t += 2) {
            const bool last = (t == nt - 2);
            const char* a1 = cA + (size_t)(t + 1) * kstep;
            const char* a2 = last ? nA : cA + (size_t)(t + 2) * kstep; const char* b2 = last ? nB : cB + (size_t)(t + 2) * kstep;
            const char* a3 = a2 + kstep; const char* b3 = b2 + kstep;
            if (last && has_next) S.a_ready(nxt);
            PG8_LDB(B0, 0, 0); PG8_SCHED; PG8_LDA(At, 0, 0); PG8_STAGE(PG8_SA(1, 1), a1 + hstep, voffA);
            PG8_WAIT_L(8); PG8_BAR; PG8_WAIT_L(0); PG8_MMA(0, 0, At, B0); PG8_BAR; PG8_SCHED;
            PG8_LDB(B1, 0, 1); PG8_STAGE(PG8_SB(0, 0), b2, voffB);
            PG8_BAR; PG8_WAIT_L(0); PG8_MMA(0, 1, At, B1); PG8_BAR;
            PG8_LDA(At, 0, 1); PG8_STAGE(PG8_SA(0, 0), a2, voffA);
            PG8_BAR; PG8_WAIT_L(0); PG8_MMA(1, 0, At, B0); PG8_BAR; PG8_SCHED;
            PG8_STAGE(PG8_SB(0, 1), b2 + hstep, voffB);
            PG8_WAIT_V(6); PG8_BAR; PG8_MMA(1, 1, At, B1); PG8_BAR;
            PG8_LDB(B0, 1, 0); PG8_SCHED; PG8_LDA(At, 1, 0); PG8_STAGE(PG8_SA(0, 1), a2 + hstep, voffA);
            PG8_WAIT_L(8); PG8_BAR; PG8_WAIT_L(0); PG8_MMA(0, 0, At, B0); PG8_BAR; PG8_SCHED;
            PG8_LDB(B1, 1, 1); PG8_STAGE(PG8_SB(1, 0), b3, voffB);
            PG8_BAR; PG8_WAIT_L(0); PG8_MMA(0, 1, At, B1); PG8_BAR;
            PG8_LDA(At, 1, 1); PG8_STAGE(PG8_SA(1, 0), a3, voffA);
            PG8_BAR; PG8_WAIT_L(0); PG8_MMA(1, 0, At, B0); PG8_BAR; PG8_SCHED;
            PG8_STAGE(PG8_SB(1, 1), b3 + hstep, voffB);
            PG8_WAIT_V(6); PG8_BAR; PG8_MMA(1, 1, At, B1); PG8_BAR;
        }
        PG8_STAMP();
        if constexpr (!Epi::AFTER_DRAIN) { E(acc, cur, wr, wc, fr, fq); S.done(cur); }
        PG8_STAMP();
        if (!has_next) break;
#pragma unroll
        for (int a = 0; a < 2; ++a)
#pragma unroll
            for (int b = 0; b < 2; ++b)
#pragma unroll
                for (int m = 0; m < 4; ++m)
#pragma unroll
                    for (int n = 0; n < 2; ++n) acc[a][b][m][n] = (f32x4){0.f, 0.f, 0.f, 0.f};
        cur = nxt; cA = nA; cB = nB; ++ui;
    }
    PG8_WAIT_V(0);
    if (wr == 0) PG8_BAR;
    PG8_BAR;
    if constexpr (Epi::AFTER_DRAIN) { E.fused(acc, cur, wr, wc, fr, fq, lds, wid, lane); S.done(cur); }
    PG8_STAMP();
    if (STAMP && wid == 0) { stamps[lane] = lane < nts ? (((unsigned long long)(unsigned)ts_hi << 32) | (unsigned)ts_lo) : 0ull;
        if (lane == 62) stamps[62] = rt_entry; if (lane == 63) stamps[63] = (unsigned long long)wall_clock64(); }
#undef PG8_STAMP
#undef PG8_SA
#undef PG8_SB
#undef PG8_STAGE
#undef PG8_LDA
#undef PG8_LDB
#undef PG8_MMA
#undef PG8_WAIT_V
#undef PG8_WAIT_L
#undef PG8_BAR
#undef PG8_SCHED
}
}
typedef unsigned short bf16_t;
typedef short bf16x8 __attribute__((ext_vector_type(8)));
typedef float f32x4 __attribute__((ext_vector_type(4)));
typedef unsigned u32x4 __attribute__((ext_vector_type(4)));
typedef unsigned u32x2 __attribute__((ext_vector_type(2)));

#ifndef MK_PER_PHASE
#define MK_PER_PHASE 0
#endif

constexpr int TP = 16384, TS = 128, TALL = 16512, M1 = 16640, N1 = 6912, NIN = 6800;
constexpr int C_R = 0, C_K = 1024, C_V = 2048, C_WL = 3072, C_AL = 3136, C_ZR = 3200, C_ZM = 4224, C_XBC = 5248, C_DT = 6784;
constexpr size_t O_YP = 0, O_YS = 16777216, O_PSH = 16908288, O_PWKV = 16924672, O_PCONV = 17973248, O_PSSM = 18046976,
                 O_SSH = 20144128, O_SWKV = 20406272, O_SCONV = 37183488, O_SSSM = 38363136, O_END = 71917568;
constexpr size_t WS_WINT = 0;
constexpr size_t WS_WOUTT = WS_WINT + (size_t)2 * N1 * 1024 * 2;
constexpr size_t WS_A = WS_WOUTT + (size_t)2 * 1024 * 2048 * 2;
constexpr size_t WS_P = WS_A + (size_t)M1 * 2048 * 2;
constexpr size_t WS_ORAW = WS_P + (size_t)M1 * N1 * 2;
constexpr size_t WS_BV = WS_ORAW + (size_t)TALL * 1024 * 4;
constexpr size_t WS_YM = WS_BV + (size_t)TALL * 1024 * 2;
constexpr size_t WS_END = WS_YM + (size_t)TALL * 1024 * 2;
constexpr int LDS_BYTES = 147456;

struct Params { const float* in[26]; float* out; unsigned char* ws; int ph_lo, ph_hi; };
enum { I_XP = 0, I_XS, I_SSHIFT, I_SWKV, I_SCONV, I_SSSM, I_NORMW, I_WIN, I_MU, I_W0, I_W2, I_A0, I_A2, I_KK, I_KA, I_RK, I_LNW, I_LNB, I_CW, I_CB, I_DTB, I_ALOG, I_DSK, I_GNW, I_WOUT, I_FNW };

__device__ __forceinline__ float bf2f(unsigned short b) { return __uint_as_float(((unsigned)b) << 16); }
__device__ __forceinline__ unsigned short f2bf(float f) { unsigned u = __float_as_uint(f); u += 0x7FFFu + ((u >> 16) & 1u); return (unsigned short)(u >> 16); }
__device__ __forceinline__ unsigned pk2(float lo, float hi) { return (unsigned)f2bf(lo) | ((unsigned)f2bf(hi) << 16); }
__device__ __forceinline__ void unpack8(const u32x4 v, float* f) {
    f[0] = __uint_as_float(v.x << 16); f[1] = __uint_as_float(v.x & 0xffff0000u); f[2] = __uint_as_float(v.y << 16); f[3] = __uint_as_float(v.y & 0xffff0000u);
    f[4] = __uint_as_float(v.z << 16); f[5] = __uint_as_float(v.z & 0xffff0000u); f[6] = __uint_as_float(v.w << 16); f[7] = __uint_as_float(v.w & 0xffff0000u); }
__device__ __forceinline__ u32x4 pack8(const float* f) { u32x4 r; r.x = pk2(f[0], f[1]); r.y = pk2(f[2], f[3]); r.z = pk2(f[4], f[5]); r.w = pk2(f[6], f[7]); return r; }
__device__ __forceinline__ float sigmoidf_(float x) { return 1.0f / (1.0f + __expf(-x)); }
__device__ __forceinline__ float siluf_(float x) { return x / (1.0f + __expf(-x)); }
__device__ __forceinline__ float softplusf_(float x) { return x > 20.f ? x : log1pf(__expf(x)); }
template <int CTRL> __device__ __forceinline__ float dppf(float v) { return __int_as_float(__builtin_amdgcn_mov_dpp(__float_as_int(v), CTRL, 0xF, 0xF, true)); }
__device__ __forceinline__ float red8(float x) { x += dppf<0xB1>(x); x += dppf<0x4E>(x); x += dppf<0x141>(x); return x; }
__device__ __forceinline__ float red16(float x) { x = red8(x); x += dppf<0x140>(x); return x; }
__device__ __forceinline__ float wave_sum(float x) {
#pragma unroll
    for (int o = 32; o > 0; o >>= 1) x += __shfl_xor(x, o);
    return x; }
__device__ __forceinline__ void lds_fence() { asm volatile("s_waitcnt lgkmcnt(0)" ::: "memory"); }
__device__ __forceinline__ int tid_l() { int t = threadIdx.x; asm volatile("" : "+v"(t)); return t; }
__device__ __forceinline__ unsigned char* launder_lds(unsigned char* sm) { int off = 0; asm volatile("" : "+s"(off)); return sm + off; }
#define MFMA16(a, b, c) __builtin_amdgcn_mfma_f32_16x16x32_bf16((a), (b), (c), 0, 0, 0)

__device__ void phase_convert(const Params& p, unsigned char* smem_) {
    unsigned char* smem = launder_lds(smem_);
    float* tile = (float*)smem;
    const int tid = tid_l();
    constexpr int NT_IN = 16 * 108, NT_OUT = 32 * 16, PER_L = NT_IN + NT_OUT;
    for (int it = blockIdx.x; it < 2 * PER_L; it += gridDim.x) {
        const int l = it / PER_L; int r = it % PER_L;
        const float* src; bf16_t* dst; int K, Nsrc, kt, nt;
        if (r < NT_IN) { src = p.in[I_WIN] + (size_t)l * 1024 * NIN; dst = (bf16_t*)(p.ws + WS_WINT) + (size_t)l * N1 * 1024; K = 1024; Nsrc = NIN; kt = r & 15; nt = r >> 4; }
        else { r -= NT_IN; src = p.in[I_WOUT] + (size_t)l * 2048 * 1024; dst = (bf16_t*)(p.ws + WS_WOUTT) + (size_t)l * 1024 * 2048; K = 2048; Nsrc = 1024; kt = r & 31; nt = r >> 5; }
#pragma unroll
        for (int i = 0; i < 2; ++i) {
            const int rr = (tid >> 4) + 32 * i, c4 = (tid & 15) * 4, col = nt * 64 + c4;
            float4 v = make_float4(0.f, 0.f, 0.f, 0.f);
            if (col < Nsrc) v = *(const float4*)(src + (size_t)(kt * 64 + rr) * Nsrc + col);
            float* tp = tile + rr * 65 + c4; tp[0] = v.x; tp[1] = v.y; tp[2] = v.z; tp[3] = v.w;
        }
        __syncthreads();
        { const int n = tid >> 3, k8 = (tid & 7) * 8; float f[8];
#pragma unroll
          for (int j = 0; j < 8; ++j) f[j] = tile[(k8 + j) * 65 + n];
          *(u32x4*)(dst + (size_t)(nt * 64 + n) * K + kt * 64 + k8) = pack8(f); }
        __syncthreads();
    }
}

__device__ void phase_norm(const Params& p, int l) {
    const int tid_ = tid_l(); const int lane = tid_ & 63, wid = tid_ >> 6;
    bf16_t* A1 = (bf16_t*)(p.ws + WS_A);
    const float* nw = p.in[I_NORMW] + l * 1024;
    for (int row = blockIdx.x * 8 + wid; row < M1; row += gridDim.x * 8) {
        const float* src;
        if (row < TP) src = (l == 0 ? p.in[I_XP] : p.out + O_YP) + (size_t)row * 1024;
        else if (row < TALL) src = (l == 0 ? p.in[I_XS] : p.out + O_YS) + (size_t)(row - TP) * 1024;
        else src = p.in[I_SSHIFT] + ((size_t)l * TS + (row - TALL)) * 1024;
        float4 v[4]; float ss = 0.f;
#pragma unroll
        for (int i = 0; i < 4; ++i) { v[i] = *(const float4*)(src + i * 256 + lane * 4); ss += v[i].x * v[i].x + v[i].y * v[i].y + v[i].z * v[i].z + v[i].w * v[i].w; }
        if (row < TALL) {
            ss = wave_sum(ss);
            const float rs = rsqrtf(ss * (1.0f / 1024.0f) + 1e-5f);
#pragma unroll
            for (int i = 0; i < 4; ++i) { const float4 w = *(const float4*)(nw + i * 256 + lane * 4); v[i].x *= rs * w.x; v[i].y *= rs * w.y; v[i].z *= rs * w.z; v[i].w *= rs * w.w; }
            float* so = nullptr;
            if (row < TP) { if ((row & 2047) == 2047) so = p.out + O_PSH + ((size_t)l * 8 + (row >> 11)) * 1024; }
            else so = p.out + O_SSH + ((size_t)l * TS + (row - TP)) * 1024;
            if (so) {
#pragma unroll
                for (int i = 0; i < 4; ++i) *(float4*)(so + i * 256 + lane * 4) = v[i]; }
        }
#pragma unroll
        for (int i = 0; i < 4; ++i) { u32x2 w; w.x = pk2(v[i].x, v[i].y); w.y = pk2(v[i].z, v[i].w); *(u32x2*)(A1 + (size_t)row * 1024 + i * 256 + lane * 4) = w; }
    }
}

__device__ void phase_final(const Params& p) {
    const int tid_ = tid_l(); const int lane = tid_ & 63, wid = tid_ >> 6;
    const float* nw = p.in[I_FNW];
    for (int row = blockIdx.x * 8 + wid; row < TALL; row += gridDim.x * 8) {
        float* src = (row < TP) ? p.out + O_YP + (size_t)row * 1024 : p.out + O_YS + (size_t)(row - TP) * 1024;
        float4 v[4]; float ss = 0.f;
#pragma unroll
        for (int i = 0; i < 4; ++i) { v[i] = *(const float4*)(src + i * 256 + lane * 4); ss += v[i].x * v[i].x + v[i].y * v[i].y + v[i].z * v[i].z + v[i].w * v[i].w; }
        ss = wave_sum(ss);
        const float rs = rsqrtf(ss * (1.0f / 1024.0f) + 1e-5f);
#pragma unroll
        for (int i = 0; i < 4; ++i) { const float4 w = *(const float4*)(nw + i * 256 + lane * 4); v[i].x *= rs * w.x; v[i].y *= rs * w.y; v[i].z *= rs * w.z; v[i].w *= rs * w.w;
            *(float4*)(src + i * 256 + lane * 4) = v[i]; }
    }
}

struct EpiP {
    static constexpr bool PERM = true, AFTER_DRAIN = false;
    bf16_t* O; int ldc;
    __device__ __forceinline__ void operator()(const f32x4 (&acc)[2][2][4][2], const pg8::Unit& u, int wr, int wc, int fr, int fq) const {
        const int row0 = u.pm * 256 + wr * 64 + fr, col0 = u.pn * 256 + wc * 32 + 8 * fq;
#pragma unroll
        for (int ai = 0; ai < 2; ++ai)
#pragma unroll
            for (int m = 0; m < 4; ++m) { bf16_t* rowp = O + (size_t)(row0 + ai * 128 + m * 16) * ldc + col0;
#pragma unroll
                for (int bj = 0; bj < 2; ++bj) { const f32x4 v0 = acc[ai][bj][m][0], v1 = acc[ai][bj][m][1];
                    u32x4 w; w.x = pg8::cvt_pk_bf16(v0[0], v0[1]); w.y = pg8::cvt_pk_bf16(v0[2], v0[3]); w.z = pg8::cvt_pk_bf16(v1[0], v1[1]); w.w = pg8::cvt_pk_bf16(v1[2], v1[3]);
                    *(u32x4*)(rowp + bj * 128) = w; } }
    }
};
struct EpiRes {
    static constexpr bool PERM = false, AFTER_DRAIN = false;
    const float* res_p; const float* res_s; float* out_p; float* out_s;
    __device__ __forceinline__ void operator()(const f32x4 (&acc)[2][2][4][2], const pg8::Unit& u, int wr, int wc, int fr, int fq) const {
        const int row0 = u.pm * 256 + wr * 64 + fr, col0 = u.pn * 256 + wc * 32 + 4 * fq;
#pragma unroll
        for (int ai = 0; ai < 2; ++ai)
#pragma unroll
            for (int m = 0; m < 4; ++m) { const int row = row0 + ai * 128 + m * 16;
                if (row < TALL) {
                    const float* rp; float* op;
                    if (row < TP) { rp = res_p + (size_t)row * 1024; op = out_p + (size_t)row * 1024; } else { rp = res_s + (size_t)(row - TP) * 1024; op = out_s + (size_t)(row - TP) * 1024; }
#pragma unroll
                    for (int bj = 0; bj < 2; ++bj)
#pragma unroll
                        for (int n = 0; n < 2; ++n) { const int c = col0 + bj * 128 + n * 16; const f32x4 r = *(const f32x4*)(rp + c); *(f32x4*)(op + c) = acc[ai][bj][m][n] + r; }
                } }
    }
};

__device__ void rwkv_scan_item(const Params& p, int l, int item, unsigned char* smem_) {
    unsigned char* smem = launder_lds(smem_);
    const int tid = tid_l(), wid = tid >> 6, lane = tid & 63;
    const int b = item >> 5, h = (item >> 1) & 15, half = item & 1;
    float* vec = (float*)smem;
    float* vrow = vec + 20480;
    float* sc = vrow + 2048;
    float* exw = sc + 128;
    float* exa = exw + 2048;
    bf16_t* tw = (bf16_t*)(exa + 2048);
    bf16_t* ta = tw + 4608;
    bf16_t* w2t = ta + 4608;
    bf16_t* a2t = w2t + 4608;
    float* cst = (float*)(a2t + 4608);
    const bf16_t* P = (const bf16_t*)(p.ws + WS_P);
    float* ORAW = (float*)(p.ws + WS_ORAW);
    bf16_t* BV = (bf16_t*)(p.ws + WS_BV);
    __syncthreads();
    for (int i = tid; i < 9216; i += 512) tw[i] = 0;
    { const float* w2 = p.in[I_W2] + (size_t)l * 64 * 1024 + h * 64; const float* a2 = p.in[I_A2] + (size_t)l * 64 * 1024 + h * 64;
#pragma unroll
      for (int i = 0; i < 8; ++i) { const int idx = tid + 512 * i, k = idx >> 6, n = idx & 63; w2t[n * 72 + k] = f2bf(w2[(size_t)k * 1024 + n]); a2t[n * 72 + k] = f2bf(a2[(size_t)k * 1024 + n]); } }
    if (tid < 64) { const float* mu = p.in[I_MU] + (size_t)l * 3200; const int gc = h * 64 + tid;
        cst[tid] = mu[C_R + gc]; cst[64 + tid] = mu[C_K + gc]; cst[128 + tid] = mu[C_V + gc]; cst[192 + tid] = mu[C_WL + tid]; cst[256 + tid] = mu[C_AL + tid];
        cst[320 + tid] = p.in[I_KK][l * 1024 + gc]; cst[384 + tid] = p.in[I_KA][l * 1024 + gc]; cst[448 + tid] = p.in[I_RK][l * 1024 + gc];
        cst[512 + tid] = p.in[I_W0][l * 1024 + gc]; cst[576 + tid] = p.in[I_A0][l * 1024 + gc]; }
    __syncthreads();

    if (wid >= 4) {
        const int hw = wid - 4, tok = lane >> 3, cg8 = lane & 7, c0 = cg8 * 8, fr = lane & 15, fq = lane >> 4;
        const float* mu_r = cst + c0; const float* mu_k = cst + 64 + c0; const float* mu_v = cst + 128 + c0; const float* mu_wl = cst + 192 + c0; const float* mu_al = cst + 256 + c0;
        const float* kkc = cst + 320 + c0; const float* kac = cst + 384 + c0; const float* rkc = cst + 448 + c0;
        float w0c[4], a0c[4];
#pragma unroll
        for (int ct = 0; ct < 4; ++ct) { w0c[ct] = cst[512 + ct * 16 + fr]; a0c[ct] = cst[576 + ct * 16 + fr]; }
        for (int c = 0; c < 64; ++c) {
            const int buf = c & 1, tt = hw * 8 + tok, t = c * 32 + tt;
            const size_t grow = (size_t)b * 2048 + t;
            const bf16_t* prow = P + grow * N1;
            float xr[8], xk[8], xv[8], xw[8], xa[8];
            { float cur[8], prv[8];
#define LERP_SEG(dst, col, muv) { unpack8(*(const u32x4*)(prow + (col)), cur); if (t > 0) unpack8(*(const u32x4*)(prow - N1 + (col)), prv); else { _Pragma("unroll") for (int e = 0; e < 8; ++e) prv[e] = 0.f; } \
                _Pragma("unroll") for (int e = 0; e < 8; ++e) dst[e] = cur[e] + (prv[e] - cur[e]) * muv[e]; }
              LERP_SEG(xr, C_R + h * 64 + c0, mu_r) LERP_SEG(xk, C_K + h * 64 + c0, mu_k) LERP_SEG(xv, C_V + h * 64 + c0, mu_v) LERP_SEG(xw, C_WL + c0, mu_wl) LERP_SEG(xa, C_AL + c0, mu_al)
#undef LERP_SEG
            }
#pragma unroll
            for (int e = 0; e < 8; ++e) xw[e] = 1.0f - 2.0f / (__expf(2.0f * xw[e]) + 1.0f);
            *(u32x4*)(tw + (hw * 16 + tok) * 72 + c0) = pack8(xw);
            *(u32x4*)(ta + (hw * 16 + tok) * 72 + c0) = pack8(xa);
            lds_fence();
#pragma unroll
            for (int ct = 0; ct < 4; ++ct) {
                f32x4 aw = {0.f, 0.f, 0.f, 0.f}, aa = {0.f, 0.f, 0.f, 0.f};
#pragma unroll
                for (int ks = 0; ks < 2; ++ks) {
                    const bf16x8 fa = *(const bf16x8*)(tw + (hw * 16 + fr) * 72 + ks * 32 + fq * 8), fb = *(const bf16x8*)(w2t + (ct * 16 + fr) * 72 + ks * 32 + fq * 8);
                    aw = MFMA16(fa, fb, aw);
                    const bf16x8 ga = *(const bf16x8*)(ta + (hw * 16 + fr) * 72 + ks * 32 + fq * 8), gb = *(const bf16x8*)(a2t + (ct * 16 + fr) * 72 + ks * 32 + fq * 8);
                    aa = MFMA16(ga, gb, aa);
                }
                if (lane < 32) {
#pragma unroll
                    for (int j = 0; j < 4; ++j) { const int tj = fq * 4 + j, col = ct * 16 + fr;
                        const float sg = sigmoidf_(w0c[ct] + aw[j]);
                        exw[(hw * 8 + tj) * 64 + col] = __expf(-0.60653066f * sg);
                        exa[(hw * 8 + tj) * 64 + col] = sigmoidf_(a0c[ct] + aa[j]); }
                }
            }
            lds_fence();
            float w8[8], a8[8];
            { const float4 q0 = *(const float4*)(exw + (hw * 8 + tok) * 64 + c0), q1 = *(const float4*)(exw + (hw * 8 + tok) * 64 + c0 + 4);
              w8[0] = q0.x; w8[1] = q0.y; w8[2] = q0.z; w8[3] = q0.w; w8[4] = q1.x; w8[5] = q1.y; w8[6] = q1.z; w8[7] = q1.w;
              const float4 r0 = *(const float4*)(exa + (hw * 8 + tok) * 64 + c0), r1 = *(const float4*)(exa + (hw * 8 + tok) * 64 + c0 + 4);
              a8[0] = r0.x; a8[1] = r0.y; a8[2] = r0.z; a8[3] = r0.w; a8[4] = r1.x; a8[5] = r1.y; a8[6] = r1.z; a8[7] = r1.w; }
            float kk[8], kp[8], bb[8], wr[8]; float ssq = 0.f, br = 0.f, kr = 0.f, beta = 0.f;
#pragma unroll
            for (int e = 0; e < 8; ++e) { kk[e] = xk[e] * kkc[e]; ssq += kk[e] * kk[e]; }
            ssq = red8(ssq);
            const float inv = 1.0f / fmaxf(sqrtf(ssq), 1e-12f);
#pragma unroll
            for (int e = 0; e < 8; ++e) { kk[e] *= inv; kp[e] = xk[e] * (1.0f + (a8[e] - 1.0f) * kac[e]); bb[e] = -kk[e] * a8[e]; wr[e] = w8[e] * xr[e];
                br += bb[e] * xr[e]; kr += kp[e] * xr[e]; beta += xr[e] * kp[e] * rkc[e]; }
            br = red8(br); kr = red8(kr); beta = red8(beta);
            float* vb = vec + (size_t)((buf * 32 + tt) * 5) * 64 + c0;
#define ST8(ptr, arr) { *(float4*)(ptr) = make_float4(arr[0], arr[1], arr[2], arr[3]); *(float4*)((ptr) + 4) = make_float4(arr[4], arr[5], arr[6], arr[7]); }
            ST8(vb, w8) ST8(vb + 64, kk) ST8(vb + 128, bb) ST8(vb + 192, kp) ST8(vb + 256, wr)
            if (cg8 == 0) { sc[(buf * 32 + tt) * 2] = br; sc[(buf * 32 + tt) * 2 + 1] = kr; }
            if ((cg8 >> 2) == half) {
                float* vp = vrow + (buf * 32 + tt) * 32 + (c0 - half * 32);
                ST8(vp, xv)
                float bvv[8];
#pragma unroll
                for (int e = 0; e < 8; ++e) bvv[e] = beta * xv[e];
                *(u32x4*)(BV + grow * 1024 + h * 64 + c0) = pack8(bvv);
            }
#undef ST8
            __syncthreads();
        }
        __syncthreads();
    } else {
        const int rg = lane >> 4, cg = lane & 15, rho0 = wid * 8 + rg * 2;
        float4 S0 = make_float4(0.f, 0.f, 0.f, 0.f), S1 = S0;
        __syncthreads();
        for (int c = 0; c < 64; ++c) {
            const int buf = c & 1;
            float* op = ORAW + ((size_t)b * 2048 + c * 32) * 1024 + h * 64 + half * 32 + rho0;
#pragma unroll 2
            for (int tt = 0; tt < 32; ++tt) {
                const float* vb = vec + (size_t)((buf * 32 + tt) * 5) * 64 + cg * 4;
                const float4 W = *(const float4*)(vb), KK = *(const float4*)(vb + 64), B = *(const float4*)(vb + 128), KP = *(const float4*)(vb + 192), WR = *(const float4*)(vb + 256);
                const float2 vv = *(const float2*)(vrow + (buf * 32 + tt) * 32 + rho0);
                const float2 s2 = *(const float2*)(sc + (buf * 32 + tt) * 2);
                float d0k = S0.x * KK.x + S0.y * KK.y + S0.z * KK.z + S0.w * KK.w;
                float d1k = S1.x * KK.x + S1.y * KK.y + S1.z * KK.z + S1.w * KK.w;
                float d0r = S0.x * WR.x + S0.y * WR.y + S0.z * WR.z + S0.w * WR.w;
                float d1r = S1.x * WR.x + S1.y * WR.y + S1.z * WR.z + S1.w * WR.w;
                d0k = red16(d0k); d1k = red16(d1k); d0r = red16(d0r); d1r = red16(d1r);
                const float o0 = d0r + d0k * s2.x + vv.x * s2.y, o1 = d1r + d1k * s2.x + vv.y * s2.y;
                if (cg == 0) *(float2*)(op + (size_t)tt * 1024) = make_float2(o0, o1);
                S0.x = S0.x * W.x + d0k * B.x + vv.x * KP.x; S0.y = S0.y * W.y + d0k * B.y + vv.x * KP.y; S0.z = S0.z * W.z + d0k * B.z + vv.x * KP.z; S0.w = S0.w * W.w + d0k * B.w + vv.x * KP.w;
                S1.x = S1.x * W.x + d1k * B.x + vv.y * KP.x; S1.y = S1.y * W.y + d1k * B.y + vv.y * KP.y; S1.z = S1.z * W.z + d1k * B.z + vv.y * KP.z; S1.w = S1.w * W.w + d1k * B.w + vv.y * KP.w;
            }
            __syncthreads();
        }
        float* so = p.out + O_PWKV + ((((size_t)l * 8 + b) * 16 + h) * 64 + half * 32 + rho0) * 64 + cg * 4;
        *(float4*)so = S0; *(float4*)(so + 64) = S1;
    }
}

__device__ void rwkv_sample_item(const Params& p, int l, int item, unsigned char* smem_) {
    unsigned char* smem = launder_lds(smem_);
    const int tid = tid_l(), lane = tid & 63;
    const int i = item >> 4, h = item & 15;
    float* s_tw = (float*)smem; float* s_al = s_tw + 64; float* sv = s_al + 64;
    float* s_sc = sv + 384;
    const bf16_t* P = (const bf16_t*)(p.ws + WS_P);
    float* ORAW = (float*)(p.ws + WS_ORAW);
    bf16_t* BV = (bf16_t*)(p.ws + WS_BV);
    const size_t rowp = (size_t)TP + i, rows = (size_t)TALL + i;
    const bf16_t* pc = P + rowp * N1; const bf16_t* pp = P + rows * N1;
    __syncthreads();
    if (tid < 64) {
        const float* mu = p.in[I_MU] + (size_t)l * 3200;
        const int gc = h * 64 + lane;
#define LERP1(col) (bf2f(pc[col]) + (bf2f(pp[col]) - bf2f(pc[col])) * mu[col])
        const float xr = LERP1(C_R + gc), xk = LERP1(C_K + gc), xv = LERP1(C_V + gc), xwl = LERP1(C_WL + lane), xal = LERP1(C_AL + lane);
#undef LERP1
        s_tw[lane] = 1.0f - 2.0f / (__expf(2.0f * xwl) + 1.0f); s_al[lane] = xal;
        lds_fence();
        const float* w2 = p.in[I_W2] + (size_t)l * 64 * 1024 + gc; const float* a2 = p.in[I_A2] + (size_t)l * 64 * 1024 + gc;
        float lw = 0.f, la = 0.f;
#pragma unroll 8
        for (int k = 0; k < 64; ++k) { lw += s_tw[k] * w2[(size_t)k * 1024]; la += s_al[k] * a2[(size_t)k * 1024]; }
        const float w = __expf(-0.60653066f * sigmoidf_(p.in[I_W0][l * 1024 + gc] + lw));
        const float a = sigmoidf_(p.in[I_A0][l * 1024 + gc] + la);
        float kk = xk * p.in[I_KK][l * 1024 + gc];
        const float ssq = wave_sum(kk * kk);
        kk *= 1.0f / fmaxf(sqrtf(ssq), 1e-12f);
        const float kp = xk * (1.0f + (a - 1.0f) * p.in[I_KA][l * 1024 + gc]);
        const float bb = -kk * a, wr = w * xr;
        const float br = wave_sum(bb * xr), kr = wave_sum(kp * xr), beta = wave_sum(xr * kp * p.in[I_RK][l * 1024 + gc]);
        sv[lane] = w; sv[64 + lane] = kk; sv[128 + lane] = bb; sv[192 + lane] = kp; sv[256 + lane] = wr; sv[320 + lane] = xv;
        if (lane == 0) { s_sc[0] = br; s_sc[1] = kr; }
        BV[rowp * 1024 + gc] = f2bf(beta * xv);
    }
    __syncthreads();
    {
        const int row = tid >> 3, cs = (tid & 7) * 8;
        const size_t so = ((((size_t)l * TS + i) * 16 + h) * 64 + row) * 64 + cs;
        const float* sin = p.in[I_SWKV] + so;
        const float4 a0 = *(const float4*)sin, a1 = *(const float4*)(sin + 4);
        float S[8] = {a0.x, a0.y, a0.z, a0.w, a1.x, a1.y, a1.z, a1.w};
        float dk = 0.f, dr = 0.f;
#pragma unroll
        for (int e = 0; e < 8; ++e) { dk += S[e] * sv[64 + cs + e]; dr += S[e] * sv[256 + cs + e]; }
        dk = red8(dk); dr = red8(dr);
        const float vr = sv[320 + row];
        const float o = dr + dk * s_sc[0] + vr * s_sc[1];
        if ((tid & 7) == 0) ORAW[rowp * 1024 + h * 64 + row] = o;
#pragma unroll
        for (int e = 0; e < 8; ++e) S[e] = S[e] * sv[cs + e] + dk * sv[128 + cs + e] + vr * sv[192 + cs + e];
        float* sout = p.out + O_SWKV + so;
        *(float4*)sout = make_float4(S[0], S[1], S[2], S[3]); *(float4*)(sout + 4) = make_float4(S[4], S[5], S[6], S[7]);
    }
}

__device__ void mamba_item(const Params& p, int l, int item, unsigned char* smem_) {
    unsigned char* smem = launder_lds(smem_);
    const int tid = tid_l(), wid = tid >> 6, lane = tid & 63, fr = lane & 15, fq = lane >> 4;
    const int b = item >> 5, j = (item >> 1) & 15, ph = item & 1, g = j >> 3;
    bf16_t* Cm = (bf16_t*)smem;
    bf16_t* Bm = (bf16_t*)(smem + 17408);
    bf16_t* BmT = (bf16_t*)(smem + 34816);
    bf16_t* XT = (bf16_t*)(smem + 53248);
    bf16_t* XwT = (bf16_t*)(smem + 57856);
    bf16_t* G = (bf16_t*)(smem + 62464);
    bf16_t* Hb = (bf16_t*)(smem + 71680);
    float* xs = (float*)(smem + 80384);
    float* acs = (float*)(smem + 88832);
    float* dtv = acs + 64;
    const bf16_t* P = (const bf16_t*)(p.ws + WS_P);
    bf16_t* YM = (bf16_t*)(p.ws + WS_YM);
    __syncthreads();
    for (int i = tid; i < 32 * 136; i += 512) Hb[i] = 0;
    const int q = tid % 72, seg = tid / 72;
    int kind, lc, xcol;
    if (q < 8) { kind = 0; lc = q * 4; xcol = j * 64 + ph * 32 + lc; } else if (q < 40) { kind = 1; lc = (q - 8) * 4; xcol = 1024 + g * 128 + lc; } else { kind = 2; lc = (q - 40) * 4; xcol = 1280 + g * 128 + lc; }
    float4 cw0, cw1, cw2, cw3, cbv;
    { const float* cw = p.in[I_CW] + (size_t)l * 4 * 1536 + xcol; cw0 = *(const float4*)cw; cw1 = *(const float4*)(cw + 1536); cw2 = *(const float4*)(cw + 3072); cw3 = *(const float4*)(cw + 4608);
      cbv = *(const float4*)(p.in[I_CB] + (size_t)l * 1536 + xcol); }
    const float dtb = p.in[I_DTB][l * 16 + j], Aj = -__expf(p.in[I_ALOG][l * 16 + j]), Dj = p.in[I_DSK][l * 16 + j];
    f32x4 hacc[2] = {{0.f, 0.f, 0.f, 0.f}, {0.f, 0.f, 0.f, 0.f}};
    __syncthreads();
    for (int c = 0; c < 32; ++c) {
        const int t0 = c * 64;
        if (tid < 288) {
            const int tb = t0 + seg * 16;
            const bf16_t* pb = P + ((size_t)b * 2048 + tb) * N1 + C_XBC + xcol;
            float4 w0 = make_float4(0.f, 0.f, 0.f, 0.f), w1 = w0, w2 = w0;
#define LD4(dst, ptr) { const u32x2 _v = *(const u32x2*)(ptr); dst = make_float4(__uint_as_float(_v.x << 16), __uint_as_float(_v.x & 0xffff0000u), __uint_as_float(_v.y << 16), __uint_as_float(_v.y & 0xffff0000u)); }
            if (tb >= 3) { LD4(w0, pb - 3 * (size_t)N1) LD4(w1, pb - 2 * (size_t)N1) LD4(w2, pb - (size_t)N1) }
#pragma unroll
            for (int s = 0; s < 16; ++s) {
                float4 cur; LD4(cur, pb + (size_t)s * N1)
                float4 u;
                u.x = cbv.x + cw0.x * w0.x + cw1.x * w1.x + cw2.x * w2.x + cw3.x * cur.x; u.y = cbv.y + cw0.y * w0.y + cw1.y * w1.y + cw2.y * w2.y + cw3.y * cur.y;
                u.z = cbv.z + cw0.z * w0.z + cw1.z * w1.z + cw2.z * w2.z + cw3.z * cur.z; u.w = cbv.w + cw0.w * w0.w + cw1.w * w1.w + cw2.w * w2.w + cw3.w * cur.w;
                u.x = siluf_(u.x); u.y = siluf_(u.y); u.z = siluf_(u.z); u.w = siluf_(u.w);
                w0 = w1; w1 = w2; w2 = cur;
                const int sl = seg * 16 + s;
                if (kind == 0) { float* xp = xs + sl * 33 + lc; xp[0] = u.x; xp[1] = u.y; xp[2] = u.z; xp[3] = u.w; }
                else { u32x2 pk; pk.x = pk2(u.x, u.y); pk.y = pk2(u.z, u.w);
                    if (kind == 1) { *(u32x2*)(Bm + sl * 136 + lc) = pk; BmT[(lc + 0) * 72 + sl] = (bf16_t)(pk.x & 0xffff); BmT[(lc + 1) * 72 + sl] = (bf16_t)(pk.x >> 16); BmT[(lc + 2) * 72 + sl] = (bf16_t)(pk.y & 0xffff); BmT[(lc + 3) * 72 + sl] = (bf16_t)(pk.y >> 16); }
                    else *(u32x2*)(Cm + sl * 136 + lc) = pk; }
            }
#undef LD4
        } else if (wid == 5) {
            const float dr = bf2f(P[((size_t)b * 2048 + t0 + lane) * N1 + C_DT + j]);
            const float dt = softplusf_(dr + dtb);
            float v = dt * Aj;
#pragma unroll
            for (int off = 1; off < 64; off <<= 1) { const float t = __shfl_up(v, off); if (lane >= off) v += t; }
            acs[lane] = v; dtv[lane] = dt;
        }
        __syncthreads();
        { const int pp = tid & 31, s4 = (tid >> 5) * 4; const float aend = acs[63]; float x[4], xw[4];
#pragma unroll
          for (int e = 0; e < 4; ++e) { x[e] = xs[(s4 + e) * 33 + pp]; xw[e] = x[e] * dtv[s4 + e] * __expf(aend - acs[s4 + e]); }
          u32x2 a; a.x = pk2(x[0], x[1]); a.y = pk2(x[2], x[3]); *(u32x2*)(XT + pp * 72 + s4) = a;
          u32x2 bq; bq.x = pk2(xw[0], xw[1]); bq.y = pk2(xw[2], xw[3]); *(u32x2*)(XwT + pp * 72 + s4) = bq; }
#pragma unroll
        for (int e = 0; e < 2; ++e) {
            const int id = wid * 2 + e, lt = id >> 2, st = id & 3;
            f32x4 acc = {0.f, 0.f, 0.f, 0.f};
            if (st <= lt) {
#pragma unroll
                for (int ks = 0; ks < 4; ++ks) { const bf16x8 fa = *(const bf16x8*)(Cm + (lt * 16 + fr) * 136 + ks * 32 + fq * 8), fb = *(const bf16x8*)(Bm + (st * 16 + fr) * 136 + ks * 32 + fq * 8); acc = MFMA16(fa, fb, acc); }
            }
#pragma unroll
            for (int jj = 0; jj < 4; ++jj) { const int lr = lt * 16 + fq * 4 + jj, s = st * 16 + fr;
                const float val = (s <= lr) ? acc[jj] * __expf(acs[lr] - acs[s]) * dtv[s] : 0.f;
                G[lr * 72 + s] = f2bf(val); }
        }
        const int lt = wid >> 1, pt = wid & 1;
        f32x4 accO = {0.f, 0.f, 0.f, 0.f};
#pragma unroll
        for (int ks = 0; ks < 4; ++ks) { const bf16x8 fa = *(const bf16x8*)(Cm + (lt * 16 + fr) * 136 + ks * 32 + fq * 8), fb = *(const bf16x8*)(Hb + (pt * 16 + fr) * 136 + ks * 32 + fq * 8); accO = MFMA16(fa, fb, accO); }
        __syncthreads();
        {
            f32x4 accD = {0.f, 0.f, 0.f, 0.f};
#pragma unroll
            for (int ks = 0; ks < 2; ++ks) { const bf16x8 fa = *(const bf16x8*)(G + (lt * 16 + fr) * 72 + ks * 32 + fq * 8), fb = *(const bf16x8*)(XT + (pt * 16 + fr) * 72 + ks * 32 + fq * 8); accD = MFMA16(fa, fb, accD); }
#pragma unroll
            for (int jj = 0; jj < 4; ++jj) { const int lr = lt * 16 + fq * 4 + jj, pp = pt * 16 + fr;
                float y = accD[jj] + __expf(acs[lr]) * accO[jj] + Dj * xs[lr * 33 + pp];
                const size_t grow = (size_t)b * 2048 + t0 + lr;
                const float z = bf2f(P[grow * N1 + C_ZM + j * 64 + ph * 32 + pp]);
                y *= siluf_(z);
                YM[grow * 1024 + j * 64 + ph * 32 + pp] = f2bf(y); }
            const float cd = __expf(acs[63]); const int ptile = wid >> 2;
#pragma unroll
            for (int e = 0; e < 2; ++e) { const int nt = (wid & 3) * 2 + e;
                hacc[e] *= cd;
#pragma unroll
                for (int ks = 0; ks < 2; ++ks) { const bf16x8 fa = *(const bf16x8*)(XwT + (ptile * 16 + fr) * 72 + ks * 32 + fq * 8), fb = *(const bf16x8*)(BmT + (nt * 16 + fr) * 72 + ks * 32 + fq * 8); hacc[e] = MFMA16(fa, fb, hacc[e]); }
#pragma unroll
                for (int jj = 0; jj < 4; ++jj) Hb[(ptile * 16 + fq * 4 + jj) * 136 + nt * 16 + fr] = f2bf(hacc[e][jj]); }
        }
        __syncthreads();
    }
    { const int ptile = wid >> 2;
#pragma unroll
      for (int e = 0; e < 2; ++e) { const int nt = (wid & 3) * 2 + e;
#pragma unroll
          for (int jj = 0; jj < 4; ++jj) p.out[O_PSSM + ((((size_t)l * 8 + b) * 16 + j) * 64 + ph * 32 + ptile * 16 + fq * 4 + jj) * 128 + nt * 16 + fr] = hacc[e][jj]; } }
}

__device__ void mamba_sample_item(const Params& p, int l, int item, unsigned char* smem_) {
    unsigned char* smem = launder_lds(smem_);
    const int tid = tid_l();
    const int i = item >> 4, j = item & 15, g = j >> 3;
    float* su = (float*)smem;
    float* sd = su + 320;
    const bf16_t* P = (const bf16_t*)(p.ws + WS_P);
    bf16_t* YM = (bf16_t*)(p.ws + WS_YM);
    const size_t rowp = (size_t)TP + i;
    __syncthreads();
    if (tid < 320) {
        const int cc = tid < 64 ? j * 64 + tid : (tid < 192 ? 1024 + g * 128 + (tid - 64) : 1280 + g * 128 + (tid - 192));
        const float* c0 = p.in[I_SCONV] + ((size_t)l * TS + i) * 3 * 1536 + cc;
        const float* cw = p.in[I_CW] + (size_t)l * 4 * 1536 + cc;
        const float v = p.in[I_CB][l * 1536 + cc] + c0[0] * cw[0] + c0[1536] * cw[1536] + c0[3072] * cw[3072] + bf2f(P[rowp * N1 + C_XBC + cc]) * cw[4608];
        su[tid] = siluf_(v);
    } else if (tid == 320) {
        const float dt = softplusf_(bf2f(P[rowp * N1 + C_DT + j]) + p.in[I_DTB][l * 16 + j]);
        sd[0] = dt; sd[1] = __expf(-dt * __expf(p.in[I_ALOG][l * 16 + j]));
    }
    __syncthreads();
    {
        const int pp = tid >> 3, n0 = (tid & 7) * 16;
        const size_t so = ((((size_t)l * TS + i) * 16 + j) * 64 + pp) * 128 + n0;
        const float* hin = p.in[I_SSSM] + so; float* hout = p.out + O_SSSM + so;
        const float dt = sd[0], eA = sd[1], x = su[pp], xdt = x * dt;
        float y = 0.f;
#pragma unroll
        for (int e = 0; e < 4; ++e) { float4 hv = *(const float4*)(hin + e * 4); const float* Bp = su + 64 + n0 + e * 4; const float* Cp = su + 192 + n0 + e * 4;
            hv.x = eA * hv.x + xdt * Bp[0]; hv.y = eA * hv.y + xdt * Bp[1]; hv.z = eA * hv.z + xdt * Bp[2]; hv.w = eA * hv.w + xdt * Bp[3];
            y += hv.x * Cp[0] + hv.y * Cp[1] + hv.z * Cp[2] + hv.w * Cp[3];
            *(float4*)(hout + e * 4) = hv; }
        y = red8(y);
        if ((tid & 7) == 0) { y += p.in[I_DSK][l * 16 + j] * x; const float z = bf2f(P[rowp * N1 + C_ZM + j * 64 + pp]); YM[rowp * 1024 + j * 64 + pp] = f2bf(y * siluf_(z)); }
    }
}

__device__ void phase_mix(const Params& p, int l, unsigned char* smem) {
#if !defined(SUB) || SUB==0
    for (int it = blockIdx.x; it < 256; it += gridDim.x) rwkv_scan_item(p, l, it, smem);
#endif
#if !defined(SUB) || SUB==1
    for (int it = blockIdx.x; it < 256; it += gridDim.x) mamba_item(p, l, it, smem);
#endif
#if !defined(SUB) || SUB==2
    for (int it = blockIdx.x; it < 2048; it += gridDim.x) rwkv_sample_item(p, l, it, smem);
#endif
#if !defined(SUB) || SUB==3
    for (int it = blockIdx.x; it < 2048; it += gridDim.x) mamba_sample_item(p, l, it, smem);
#endif
}

__device__ void phase_post(const Params& p, int l) {
    const int tid_ = tid_l(); const int lane = tid_ & 63, wid = tid_ >> 6;
    const bf16_t* P = (const bf16_t*)(p.ws + WS_P);
    const float* ORAW = (const float*)(p.ws + WS_ORAW);
    const bf16_t* BV = (const bf16_t*)(p.ws + WS_BV);
    const bf16_t* YM = (const bf16_t*)(p.ws + WS_YM);
    bf16_t* A2 = (bf16_t*)(p.ws + WS_A);
    const float* lnw = p.in[I_LNW] + l * 1024; const float* lnb = p.in[I_LNB] + l * 1024; const float* gnw = p.in[I_GNW] + l * 1024;
    for (int row = blockIdx.x * 8 + wid; row < TALL; row += gridDim.x * 8) {
        const bf16_t* prow = P + (size_t)row * N1;
        for (int h = 0; h < 16; ++h) {
            const int col = h * 64 + lane;
            const float o = ORAW[(size_t)row * 1024 + col];
            const float mean = wave_sum(o) * (1.0f / 64.0f); const float d = o - mean;
            const float var = wave_sum(d * d) * (1.0f / 64.0f);
            float y = d * rsqrtf(var + 64e-5f) * lnw[col] + lnb[col] + bf2f(BV[(size_t)row * 1024 + col]);
            y *= siluf_(bf2f(prow[C_ZR + col]));
            A2[(size_t)row * 2048 + col] = f2bf(y);
        }
#pragma unroll
        for (int g = 0; g < 2; ++g) {
            const int col = g * 512 + lane * 8; float f[8];
            unpack8(*(const u32x4*)(YM + (size_t)row * 1024 + col), f);
            float ss = 0.f;
#pragma unroll
            for (int e = 0; e < 8; ++e) ss += f[e] * f[e];
            ss = wave_sum(ss);
            const float rs = rsqrtf(ss * (1.0f / 512.0f) + 1e-5f);
#pragma unroll
            for (int e = 0; e < 8; ++e) f[e] *= rs * gnw[col + e];
            *(u32x4*)(A2 + (size_t)row * 2048 + 1024 + col) = pack8(f);
        }
        if (row < TP) {
            const int tq = row & 2047;
            if (tq >= 2045) { float* dst = p.out + O_PCONV + (((size_t)l * 8 + (row >> 11)) * 3 + (tq - 2045)) * 1536;
                for (int c = lane; c < 1536; c += 64) dst[c] = bf2f(prow[C_XBC + c]); }
        } else {
            const int i = row - TP; float* dst = p.out + O_SCONV + ((size_t)l * TS + i) * 3 * 1536; const float* src = p.in[I_SCONV] + ((size_t)l * TS + i) * 3 * 1536;
            for (int c = lane; c < 1536; c += 64) { dst[c] = src[1536 + c]; dst[1536 + c] = src[3072 + c]; dst[3072 + c] = bf2f(prow[C_XBC + c]); }
        }
    }
}

constexpr int NPHASE = 11;
__global__ __launch_bounds__(512, 2) void mega(Params p) {
    extern __shared__ __attribute__((aligned(16))) unsigned char smem[];
    cg::grid_group grid = cg::this_grid();
    for (int ph = p.ph_lo; ph < p.ph_hi; ++ph) {
        if (ph > p.ph_lo) grid.sync();
        const int l = ph >= 5 ? 1 : 0;
        switch (ph) {
            #if !defined(ONLY) || ONLY==0
            case 0: phase_convert(p, smem); phase_norm(p, 0); break;
#endif
#if !defined(ONLY) || ONLY==0
            case 5: phase_norm(p, 1); break;
#endif
#if (!defined(ONLY) || ONLY==1) && !defined(NOG1)
            case 1: case 6: {
                pg8::Gemm g{(const bf16_t*)(p.ws + WS_A), (const bf16_t*)(p.ws + WS_WINT) + (size_t)l * N1 * 1024, M1, N1, 1024};
                pg8::StaticOrder S; S.init(M1, N1, (int)gridDim.x, (int)blockIdx.x);
                EpiP E{(bf16_t*)(p.ws + WS_P), N1};
                pg8::gemm_phase<EpiP, pg8::StaticOrder, false>((PG8_LAS unsigned char*)smem, g, S, E, nullptr);
            } break;
#endif
#if (!defined(ONLY) || ONLY==2) && !defined(NOMIX)
            case 2: case 7: phase_mix(p, l, smem); break;
#endif
#if !defined(ONLY) || ONLY==3
            case 3: case 8: phase_post(p, l); break;
#endif
#if (!defined(ONLY) || ONLY==4) && !defined(NOG2)
            case 4: case 9: {
                pg8::Gemm g{(const bf16_t*)(p.ws + WS_A), (const bf16_t*)(p.ws + WS_WOUTT) + (size_t)l * 1024 * 2048, M1, 1024, 2048};
                pg8::StaticOrder S; S.init(M1, 1024, (int)gridDim.x, (int)blockIdx.x);
                EpiRes E{l == 0 ? p.in[I_XP] : p.out + O_YP, l == 0 ? p.in[I_XS] : p.out + O_YS, p.out + O_YP, p.out + O_YS};
                pg8::gemm_phase<EpiRes, pg8::StaticOrder, false>((PG8_LAS unsigned char*)smem, g, S, E, nullptr);
            } break;
#endif
#if !defined(ONLY) || ONLY==0
            case 10: phase_final(p); break;
#endif
        }
    }
}

extern "C" void kernel_launch(void* const* d_in, const int* in_sizes, int n_in, void* d_out, int out_size, void* d_ws, size_t ws_size, hipStream_t stream) {
    static int grid = 0;
    if (grid == 0) {
        if (n_in != 26 || (size_t)out_size != O_END || ws_size < WS_END) { fprintf(stderr, "kernel_launch: unexpected shapes: n_in %d out %d ws %zu (need %zu)\n", n_in, out_size, ws_size, (size_t)WS_END); grid = -1; return; }
        int dev = 0, cus = 0, per_cu = 0;
        hipGetDevice(&dev); hipDeviceGetAttribute(&cus, hipDeviceAttributeMultiprocessorCount, dev);
        if (hipFuncSetAttribute((const void*)mega, hipFuncAttributeMaxDynamicSharedMemorySize, LDS_BYTES) != hipSuccess) { fprintf(stderr, "kernel_launch: hipFuncSetAttribute failed\n"); grid = -1; return; }
        if (hipOccupancyMaxActiveBlocksPerMultiprocessor(&per_cu, (const void*)mega, 512, LDS_BYTES) != hipSuccess || per_cu < 1) { fprintf(stderr, "kernel_launch: occupancy query gave %d\n", per_cu); per_cu = 1; }
        (void)hipGetLastError();
        grid = cus * 1;
    }
    if (grid < 0) return;
    Params p{};
    for (int i = 0; i < 26; ++i) p.in[i] = (const float*)d_in[i];
    p.out = (float*)d_out; p.ws = (unsigned char*)d_ws;
#if MK_PER_PHASE
    for (int ph = 0; ph < NPHASE; ++ph) { p.ph_lo = ph; p.ph_hi = ph + 1; hipLaunchKernelGGL(mega, dim3(grid), dim3(512), LDS_BYTES, stream, p); }
#else
    p.ph_lo = 0; p.ph_hi = NPHASE;
    void* args[] = {&p};
    hipError_t e = hipLaunchCooperativeKernel((const void*)mega, dim3(grid), dim3(512), args, LDS_BYTES, stream);
    if (e != hipSuccess) fprintf(stderr, "cooperative launch failed: %s (grid %d)\n", hipGetErrorString(e), grid);
#endif
}
```

```cpp
#include <hip/hip_runtime.h>
#include <hip/hip_cooperative_groups.h>
#include <cstdio>
namespace cg = cooperative_groups;
namespace pg8 {
#define PG8_LAS __attribute__((address_space(3)))
typedef unsigned short bf16_t;
typedef short bf16x8 __attribute__((ext_vector_type(8)));
typedef float f32x4 __attribute__((ext_vector_type(4)));
typedef unsigned u32x4 __attribute__((ext_vector_type(4)));
constexpr int BM = 256, BK = 64, HALF = 128, HTB = HALF * BK * 2  , STAGE_BYTES = 8 * HTB, NXCD = 8, WGM = 8;

__host__ __device__ __forceinline__ int lds_byte(int r, int c) { const int st = (r >> 4) * 2 + (c >> 5), rr = r & 15, cc = c & 31, ob = rr * 64 + cc * 2; return st * 1024 + (ob ^ (((ob >> 9) & 1) << 5)); }
__host__ __device__ __forceinline__ void stage_rc(int b, int& R, int& C) { const int st = b / 1024, sb = b % 1024, swz = sb ^ (((sb >> 9) & 1) << 5); R = (st >> 1) * 16 + swz / 64; C = (st & 1) * 32 + (swz % 64) / 2; }
__host__ __device__ __forceinline__ int perm32(int rho) { const int n = rho >> 4, i = rho & 15; return 8 * (i >> 2) + 4 * n + (i & 3); }

struct Unit { int pm, pn; };
struct Gemm { const bf16_t* A; const bf16_t* Bt; int M, N, K; };

struct StaticOrder {
    int nM, nN, nwg, G, c;
    __host__ __device__ void init(int M, int N, int G_, int c_) { nM = M / BM; nN = N / BM; nwg = nM * nN; G = G_; c = c_; }
    __host__ __device__ bool next(int i, Unit& u) const {
        const long L = (long)i * G + c; if (L >= nwg) return false;
        int wgid = (int)L; { const int q = nwg / NXCD, r = nwg % NXCD, xcd = wgid % NXCD, off = wgid / NXCD; wgid = (xcd < r ? xcd * (q + 1) : r * (q + 1) + (xcd - r) * q) + off; }
        const int nig = WGM * nN, gid = wgid / nig, fm = gid * WGM, gsz = (nM - fm) < WGM ? (nM - fm) : WGM;
        u.pm = fm + ((wgid % nig) % gsz); u.pn = (wgid % nig) / gsz; return true;
    }
    __device__ __forceinline__ void a_ready(const Unit&) const {}
    __device__ __forceinline__ void done(const Unit&) const {}
};
__device__ __forceinline__ unsigned cvt_pk_bf16(float lo, float hi) { unsigned r; asm volatile("v_cvt_pk_bf16_f32 %0, %1, %2" : "=v"(r) : "v"(lo), "v"(hi)); return r; }
template <class Epi, class Sched, bool STAMP = false>
__device__ __forceinline__ void gemm_phase(PG8_LAS unsigned char* lds, const Gemm g, const Sched& S, const Epi& E, unsigned long long* stamps) {
    int tid_raw = threadIdx.x; asm volatile("" : "+v"(tid_raw)); const int tid = tid_raw, wid = __builtin_amdgcn_readfirstlane(tid >> 6), lane = tid & 63, wr = wid >> 2, wc = wid & 3, fr = lane & 15, fq = lane >> 4;
    const int K = g.K, nt = K / BK;
    int ts_lo = 0, ts_hi = 0, nts = 0; const unsigned long long rt_entry = STAMP ? (unsigned long long)wall_clock64() : 0ull;
#define PG8_STAMP() do { if (STAMP && wid == 0 && nts < 64) { const unsigned long long _c = (unsigned long long)clock64(); \
        ts_lo = (lane == nts) ? (int)(unsigned)_c : ts_lo; ts_hi = (lane == nts) ? (int)(unsigned)(_c >> 32) : ts_hi; ++nts; } } while (0)
    PG8_STAMP();
    unsigned voffA[2], voffB[2];
#pragma unroll
    for (int i = 0; i < 2; ++i) { int R, C; stage_rc(tid * 16 + i * 8192, R, C); const int Rb = Epi::PERM ? ((R & ~31) + perm32(R & 31)) : R;
        voffA[i] = (unsigned)(R * K + C) * 2u; voffB[i] = (unsigned)(Rb * K + C) * 2u; }
    const size_t kstep = (size_t)(BK * 2);
    const size_t hstep = (size_t)HALF * K * 2;
    const size_t tstep = 2 * hstep;
    const unsigned ldsw = (unsigned)wid * 1024u;
    const int aoff = lds_byte(wr * 64 + fr, fq * 8), boff = lds_byte(wc * 32 + fr, fq * 8);
#define PG8_SA(b, h) (((b) * 2 + (h)) * HTB)
#define PG8_SB(b, h) ((4 + (b) * 2 + (h)) * HTB)
#define PG8_STAGE(bufoff, gbase, voff) do { _Pragma("unroll") for (int _i = 0; _i < 2; ++_i) \
        __builtin_amdgcn_global_load_lds((const unsigned*)((const char*)(gbase) + (voff)[_i]), (PG8_LAS unsigned*)(lds + (bufoff) + ldsw + _i * 8192), 16, 0, 0); } while (0)
#define PG8_LDA(dst, b, h) do { _Pragma("unroll") for (int m = 0; m < 4; ++m) _Pragma("unroll") for (int k = 0; k < 2; ++k) dst[m][k] = *(const PG8_LAS bf16x8*)(lds + PG8_SA(b, h) + aoff + m * 2048 + k * 1024); } while (0)
#define PG8_LDB(dst, b, h) do { _Pragma("unroll") for (int n = 0; n < 2; ++n) _Pragma("unroll") for (int k = 0; k < 2; ++k) dst[n][k] = *(const PG8_LAS bf16x8*)(lds + PG8_SB(b, h) + boff + n * 2048 + k * 1024); } while (0)
#define PG8_MMA(ai, bj, At, Bt) do { __builtin_amdgcn_s_setprio(1); _Pragma("unroll") for (int m = 0; m < 4; ++m) _Pragma("unroll") for (int n = 0; n < 2; ++n) _Pragma("unroll") for (int k = 0; k < 2; ++k) \
        acc[ai][bj][m][n] = __builtin_amdgcn_mfma_f32_16x16x32_bf16(Bt[n][k], At[m][k], acc[ai][bj][m][n], 0, 0, 0); __builtin_amdgcn_s_setprio(0); } while (0)
#define PG8_WAIT_V(n) asm volatile("s_waitcnt vmcnt(" #n ")" ::: "memory")
#define PG8_WAIT_L(n) asm volatile("s_waitcnt lgkmcnt(" #n ")" ::: "memory")
#define PG8_BAR __builtin_amdgcn_s_barrier()
#define PG8_SCHED __builtin_amdgcn_sched_barrier(0)
    Unit cur, nxt; int ui = 0;
    if (!S.next(0, cur)) return;
    f32x4 acc[2][2][4][2];
#pragma unroll
    for (int a = 0; a < 2; ++a)
#pragma unroll
        for (int b = 0; b < 2; ++b)
#pragma unroll
            for (int m = 0; m < 4; ++m)
#pragma unroll
                for (int n = 0; n < 2; ++n) acc[a][b][m][n] = (f32x4){0.f, 0.f, 0.f, 0.f};
    bf16x8 At[4][2], B0[2][2], B1[2][2];
    const char* cA = (const char*)g.A + (size_t)cur.pm * tstep; const char* cB = (const char*)g.Bt + (size_t)cur.pn * tstep;
    S.a_ready(cur);
    PG8_STAGE(PG8_SB(0, 0), cB, voffB); PG8_STAGE(PG8_SA(0, 0), cA, voffA); PG8_STAGE(PG8_SB(0, 1), cB + hstep, voffB); PG8_STAGE(PG8_SA(0, 1), cA + hstep, voffA);
    if (wr == 1) PG8_BAR;
    PG8_WAIT_V(4); PG8_BAR;
    PG8_STAGE(PG8_SB(1, 0), cB + kstep, voffB); PG8_STAGE(PG8_SA(1, 0), cA + kstep, voffA); PG8_STAGE(PG8_SB(1, 1), cB + hstep + kstep, voffB);
    PG8_WAIT_V(6); PG8_BAR;
    PG8_STAMP();
    for (;;) {
        const bool has_next = S.next(ui + 1, nxt);
        const char* nA = has_next ? (const char*)g.A + (size_t)nxt.pm * tstep : cA; const char* nB = has_next ? (const char*)g.Bt + (size_t)nxt.pn * tstep : cB;
        for (int t = 0; t < nt; t += 2) {
            const bool last = (t == nt - 2);
            const char* a1 = cA + (size_t)(t + 1) * kstep;
            const char* a2 = last ? nA : cA + (size_t)(t + 2) * kstep; const char* b2 = last ? nB : cB + (size_t)(t + 2) * kstep;
            const char* a3 = a2 + kstep; const char* b3 = b2 + kstep;
            if (last && has_next) S.a_ready(nxt);
            PG8_LDB(B0, 0, 0); PG8_SCHED; PG8_LDA(At, 0, 0); PG8_STAGE(PG8_SA(1, 1), a1 + hstep, voffA);
            PG8_WAIT_L(8); PG8_BAR; PG8_WAIT_L(0); PG8_MMA(0, 0, At, B0); PG8_BAR; PG8_SCHED;
            PG8_LDB(B1, 0, 1); PG8_STAGE(PG8_SB(0, 0), b2, voffB);
            PG8_BAR; PG8_WAIT_L(0); PG8_MMA(0, 1, At, B1); PG8_BAR;
            PG8_LDA(At, 0, 1); PG8_STAGE(PG8_SA(0, 0), a2, voffA);
            PG8_BAR; PG8_WAIT_L(0); PG8_MMA(1, 0, At, B0); PG8_BAR; PG8_SCHED;
            PG8_STAGE(PG8_SB(0, 1), b2 + hstep, voffB);
            PG8_WAIT_V(6); PG8_BAR; PG8_MMA(1, 1, At, B1); PG8_BAR;
            PG8_LDB(B0, 1, 0); PG8_SCHED; PG8_LDA(At, 1, 0); PG8_STAGE(PG8_SA(0, 1), a2 + hstep, voffA);
            PG8_WAIT_L(8); PG8_BAR; PG8_WAIT_L(0); PG8_MMA(0, 0, At, B0); PG8_BAR; PG8_SCHED;
            PG8_LDB(B1, 1, 1); PG8_STAGE(PG8_SB(1, 0), b3, voffB);
            PG8_BAR; PG8_WAIT_L(0); PG8_MMA(0, 1, At, B1); PG8_BAR;
            PG8_LDA(At, 1, 1); PG8_STAGE(PG8_SA(1, 0), a3, voffA);
            PG8_BAR; PG8_WAIT_L(0); PG8_MMA(1, 0, At, B0); PG8_BAR; PG8_SCHED;
            PG8_STAGE(PG8_SB(1, 1), b3 + hstep, voffB);
            PG8_WAIT_V(6); PG8_BAR; PG8_MMA(1, 1, At, B1); PG8_BAR;
        }
        PG8_STAMP();
        if constexpr (!Epi::AFTER_DRAIN) { E(acc, cur, wr, wc, fr, fq); S.done(cur); }
        PG8_STAMP();
        if (!has_next) break;
#pragma unroll
        for (int a = 0; a < 2; ++a)
#pragma unroll
            for (int b = 0; b < 2; ++b)
#pragma unroll
                for (int m = 0; m < 4; ++m)
#pragma unroll
                    for (int n = 0; n < 2; ++n) acc[a][b][m][n] = (f32x4){0.f, 0.f, 0.f, 0.f};
        cur = nxt; cA = nA; cB = nB; ++ui;
    }
    PG8_WAIT_V(0);
    if (wr == 0) PG8_BAR;
    PG8_BAR;
    if constexpr (Epi::AFTER_DRAIN) { E.fused(acc, cur, wr, wc, fr, fq, lds, wid, lane); S.done(cur); }
    PG8_STAMP();
    if (STAMP && wid == 0) { stamps[lane] = lane < nts ? (((unsigned long long)(unsigned)ts_hi << 32) | (unsigned)ts_lo) : 0ull;
        if (lane == 62) stamps[62] = rt_entry; if (lane == 63) stamps[63] = (unsigned long long)wall_clock64(); }
#undef PG8_STAMP
#undef PG8_SA
#undef PG8_SB
#undef PG8_STAGE
#undef PG8_LDA
#undef PG8_LDB
#undef PG8_MMA
#undef PG8_WAIT_V
#undef PG8_WAIT_L
#undef PG8_BAR
#undef PG8_SCHED
}
}
typedef unsigned short bf16_t;
typedef short bf16x8 __attribute__((ext_vector_type(8)));
typedef float f32x4 __attribute__((ext_vector_type(4)));
typedef unsigned u32x4 __attribute__((ext_vector_type(4)));
typedef unsigned u32x2 __attribute__((ext_vector_type(2)));

#ifndef DUP
#define DUP 0
#endif
#ifndef MK_PER_PHASE
#define MK_PER_PHASE 0
#endif

constexpr int TP = 16384, TS = 128, TALL = 16512, M1 = 16640, N1 = 6912, NIN = 6800;
constexpr int C_R = 0, C_K = 1024, C_V = 2048, C_WL = 3072, C_AL = 3136, C_ZR = 3200, C_ZM = 4224, C_XBC = 5248, C_DT = 6784;
constexpr size_t O_YP = 0, O_YS = 16777216, O_PSH = 16908288, O_PWKV = 16924672, O_PCONV = 17973248, O_PSSM = 18046976,
                 O_SSH = 20144128, O_SWKV = 20406272, O_SCONV = 37183488, O_SSSM = 38363136, O_END = 71917568;
constexpr size_t WS_WINT = 0;
constexpr size_t WS_WOUTT = WS_WINT + (size_t)2 * N1 * 1024 * 2;
constexpr size_t WS_A = WS_WOUTT + (size_t)2 * 1024 * 2048 * 2;
constexpr size_t WS_P = WS_A + (size_t)M1 * 2048 * 2;
constexpr size_t WS_ORAW = WS_P + (size_t)M1 * N1 * 2;
constexpr size_t WS_BV = WS_ORAW + (size_t)TALL * 1024 * 4;
constexpr size_t WS_YM = WS_BV + (size_t)TALL * 1024 * 2;
constexpr size_t WS_END = WS_YM + (size_t)TALL * 1024 * 2;
constexpr size_t WS_U = WS_A;
constexpr size_t WS_DT = WS_U + (size_t)TP * 1536 * 2;
constexpr size_t WS_PART = WS_ORAW;
constexpr int LDS_BYTES = 147456;

struct Params { const float* in[26]; float* out; unsigned char* ws; int ph_lo, ph_hi; };
enum { I_XP = 0, I_XS, I_SSHIFT, I_SWKV, I_SCONV, I_SSSM, I_NORMW, I_WIN, I_MU, I_W0, I_W2, I_A0, I_A2, I_KK, I_KA, I_RK, I_LNW, I_LNB, I_CW, I_CB, I_DTB, I_ALOG, I_DSK, I_GNW, I_WOUT, I_FNW };

__device__ __forceinline__ float bf2f(unsigned short b) { return __uint_as_float(((unsigned)b) << 16); }
__device__ __forceinline__ unsigned short f2bf(float f) { unsigned u = __float_as_uint(f); u += 0x7FFFu + ((u >> 16) & 1u); return (unsigned short)(u >> 16); }
__device__ __forceinline__ unsigned pk2(float lo, float hi) { return (unsigned)f2bf(lo) | ((unsigned)f2bf(hi) << 16); }
__device__ __forceinline__ void unpack8(const u32x4 v, float* f) {
    f[0] = __uint_as_float(v.x << 16); f[1] = __uint_as_float(v.x & 0xffff0000u); f[2] = __uint_as_float(v.y << 16); f[3] = __uint_as_float(v.y & 0xffff0000u);
    f[4] = __uint_as_float(v.z << 16); f[5] = __uint_as_float(v.z & 0xffff0000u); f[6] = __uint_as_float(v.w << 16); f[7] = __uint_as_float(v.w & 0xffff0000u); }
__device__ __forceinline__ u32x4 pack8(const float* f) { u32x4 r; r.x = pk2(f[0], f[1]); r.y = pk2(f[2], f[3]); r.z = pk2(f[4], f[5]); r.w = pk2(f[6], f[7]); return r; }
__device__ __forceinline__ float sigmoidf_(float x) { return 1.0f / (1.0f + __expf(-x)); }
__device__ __forceinline__ float siluf_(float x) { return x / (1.0f + __expf(-x)); }
__device__ __forceinline__ float softplusf_(float x) { return x > 20.f ? x : log1pf(__expf(x)); }
template <int CTRL> __device__ __forceinline__ float dppf(float v) { return __int_as_float(__builtin_amdgcn_mov_dpp(__float_as_int(v), CTRL, 0xF, 0xF, true)); }
__device__ __forceinline__ float red8(float x) { x += dppf<0xB1>(x); x += dppf<0x4E>(x); x += dppf<0x141>(x); return x; }
__device__ __forceinline__ float red16(float x) { x = red8(x); x += dppf<0x140>(x); return x; }
__device__ __forceinline__ float wave_sum(float x) {
#pragma unroll
    for (int o = 32; o > 0; o >>= 1) x += __shfl_xor(x, o);
    return x; }
__device__ __forceinline__ void lds_fence() { asm volatile("s_waitcnt lgkmcnt(0)" ::: "memory"); }
__device__ __forceinline__ int tid_l() { int t = threadIdx.x; asm volatile("" : "+v"(t)); return t; }
__device__ __forceinline__ unsigned char* launder_lds(unsigned char* sm) { int off = 0; asm volatile("" : "+s"(off)); return sm + off; }
#define LBAR() do { asm volatile("s_waitcnt lgkmcnt(0)" ::: "memory"); __builtin_amdgcn_s_barrier(); asm volatile("" ::: "memory"); } while (0)
#define MFMA16(a, b, c) __builtin_amdgcn_mfma_f32_16x16x32_bf16((a), (b), (c), 0, 0, 0)

__device__ void phase_convert(const Params& p, unsigned char* smem_) {
    unsigned char* smem = launder_lds(smem_);
    float* tile = (float*)smem;
    const int tid = tid_l();
    constexpr int NT_IN = 16 * 108, NT_OUT = 32 * 16, PER_L = NT_IN + NT_OUT;
    for (int it = blockIdx.x; it < 2 * PER_L; it += gridDim.x) {
        const int l = it / PER_L; int r = it % PER_L;
        const float* src; bf16_t* dst; int K, Nsrc, kt, nt;
        if (r < NT_IN) { src = p.in[I_WIN] + (size_t)l * 1024 * NIN; dst = (bf16_t*)(p.ws + WS_WINT) + (size_t)l * N1 * 1024; K = 1024; Nsrc = NIN; kt = r & 15; nt = r >> 4; }
        else { r -= NT_IN; src = p.in[I_WOUT] + (size_t)l * 2048 * 1024; dst = (bf16_t*)(p.ws + WS_WOUTT) + (size_t)l * 1024 * 2048; K = 2048; Nsrc = 1024; kt = r & 31; nt = r >> 5; }
#pragma unroll
        for (int i = 0; i < 2; ++i) {
            const int rr = (tid >> 4) + 32 * i, c4 = (tid & 15) * 4, col = nt * 64 + c4;
            float4 v = make_float4(0.f, 0.f, 0.f, 0.f);
            if (col < Nsrc) v = *(const float4*)(src + (size_t)(kt * 64 + rr) * Nsrc + col);
            float* tp = tile + rr * 65 + c4; tp[0] = v.x; tp[1] = v.y; tp[2] = v.z; tp[3] = v.w;
        }
        __syncthreads();
        { const int n = tid >> 3, k8 = (tid & 7) * 8; float f[8];
#pragma unroll
          for (int j = 0; j < 8; ++j) f[j] = tile[(k8 + j) * 65 + n];
          *(u32x4*)(dst + (size_t)(nt * 64 + n) * K + kt * 64 + k8) = pack8(f); }
        __syncthreads();
    }
}

__device__ void phase_norm(const Params& p, int l) {
    const int tid_ = tid_l(); const int lane = tid_ & 63, wid = tid_ >> 6;
    bf16_t* A1 = (bf16_t*)(p.ws + WS_A);
    const float* nw = p.in[I_NORMW] + l * 1024;
    for (int row = blockIdx.x * 8 + wid; row < M1; row += gridDim.x * 8) {
        const float* src;
        if (row < TP) src = (l == 0 ? p.in[I_XP] : p.out + O_YP) + (size_t)row * 1024;
        else if (row < TALL) src = (l == 0 ? p.in[I_XS] : p.out + O_YS) + (size_t)(row - TP) * 1024;
        else src = p.in[I_SSHIFT] + ((size_t)l * TS + (row - TALL)) * 1024;
        float4 v[4]; float ss = 0.f;
#pragma unroll
        for (int i = 0; i < 4; ++i) v[i] = *(const float4*)(src + i * 256 + lane * 4);
        if (l == 1 && row >= TP && row < TALL) {
            const float* x0 = p.in[I_XS] + (size_t)(row - TP) * 1024; const float* pt = (const float*)(p.ws + WS_PART) + (size_t)(row - TP) * 1024;
#pragma unroll
            for (int i = 0; i < 4; ++i) { float4 a = *(const float4*)(x0 + i * 256 + lane * 4);
                for (int q = 0; q < 16; ++q) { const float4 t = *(const float4*)(pt + (size_t)q * TS * 1024 + i * 256 + lane * 4); a.x += t.x; a.y += t.y; a.z += t.z; a.w += t.w; }
                v[i] = a; *(float4*)(p.out + O_YS + (size_t)(row - TP) * 1024 + i * 256 + lane * 4) = a; }
        }
#pragma unroll
        for (int i = 0; i < 4; ++i) ss += v[i].x * v[i].x + v[i].y * v[i].y + v[i].z * v[i].z + v[i].w * v[i].w;
        if (row < TALL) {
            ss = wave_sum(ss);
            const float rs = rsqrtf(ss * (1.0f / 1024.0f) + 1e-5f);
#pragma unroll
            for (int i = 0; i < 4; ++i) { const float4 w = *(const float4*)(nw + i * 256 + lane * 4); v[i].x *= rs * w.x; v[i].y *= rs * w.y; v[i].z *= rs * w.z; v[i].w *= rs * w.w; }
            float* so = nullptr;
            if (row < TP) { if ((row & 2047) == 2047) so = p.out + O_PSH + ((size_t)l * 8 + (row >> 11)) * 1024; }
            else so = p.out + O_SSH + ((size_t)l * TS + (row - TP)) * 1024;
            if (so) {
#pragma unroll
                for (int i = 0; i < 4; ++i) *(float4*)(so + i * 256 + lane * 4) = v[i]; }
        }
#pragma unroll
        for (int i = 0; i < 4; ++i) { u32x2 w; w.x = pk2(v[i].x, v[i].y); w.y = pk2(v[i].z, v[i].w); *(u32x2*)(A1 + (size_t)row * 1024 + i * 256 + lane * 4) = w; }
    }
}

__device__ void phase_final(const Params& p) {
    const int tid_ = tid_l(); const int lane = tid_ & 63, wid = tid_ >> 6;
    const float* nw = p.in[I_FNW];
    for (int row = blockIdx.x * 8 + wid; row < TALL; row += gridDim.x * 8) {
        float* src = (row < TP) ? p.out + O_YP + (size_t)row * 1024 : p.out + O_YS + (size_t)(row - TP) * 1024;
        float4 v[4]; float ss = 0.f;
#pragma unroll
        for (int i = 0; i < 4; ++i) v[i] = *(const float4*)(src + i * 256 + lane * 4);
        if (row >= TP) { const float* pt = (const float*)(p.ws + WS_PART) + (size_t)(row - TP) * 1024;
#pragma unroll
            for (int i = 0; i < 4; ++i) for (int q = 0; q < 16; ++q) { const float4 t = *(const float4*)(pt + (size_t)q * TS * 1024 + i * 256 + lane * 4); v[i].x += t.x; v[i].y += t.y; v[i].z += t.z; v[i].w += t.w; } }
#pragma unroll
        for (int i = 0; i < 4; ++i) ss += v[i].x * v[i].x + v[i].y * v[i].y + v[i].z * v[i].z + v[i].w * v[i].w;
        ss = wave_sum(ss);
        const float rs = rsqrtf(ss * (1.0f / 1024.0f) + 1e-5f);
#pragma unroll
        for (int i = 0; i < 4; ++i) { const float4 w = *(const float4*)(nw + i * 256 + lane * 4); v[i].x *= rs * w.x; v[i].y *= rs * w.y; v[i].z *= rs * w.z; v[i].w *= rs * w.w;
            *(float4*)(src + i * 256 + lane * 4) = v[i]; }
    }
}

struct EpiP {
    static constexpr bool PERM = true, AFTER_DRAIN = false;
    bf16_t* O; int ldc;
    __device__ __forceinline__ void operator()(const f32x4 (&acc)[2][2][4][2], const pg8::Unit& u, int wr, int wc, int fr, int fq) const {
        const int row0 = u.pm * 256 + wr * 64 + fr, col0 = u.pn * 256 + wc * 32 + 8 * fq;
#pragma unroll
        for (int ai = 0; ai < 2; ++ai)
#pragma unroll
            for (int m = 0; m < 4; ++m) { bf16_t* rowp = O + (size_t)(row0 + ai * 128 + m * 16) * ldc + col0;
#pragma unroll
                for (int bj = 0; bj < 2; ++bj) { const f32x4 v0 = acc[ai][bj][m][0], v1 = acc[ai][bj][m][1];
                    u32x4 w; w.x = pg8::cvt_pk_bf16(v0[0], v0[1]); w.y = pg8::cvt_pk_bf16(v0[2], v0[3]); w.z = pg8::cvt_pk_bf16(v1[0], v1[1]); w.w = pg8::cvt_pk_bf16(v1[2], v1[3]);
                    *(u32x4*)(rowp + bj * 128) = w; } }
    }
};
struct EpiRes {
    static constexpr bool PERM = false, AFTER_DRAIN = false;
    const float* res_p; float* out_p;
    __device__ __forceinline__ void operator()(const f32x4 (&acc)[2][2][4][2], const pg8::Unit& u, int wr, int wc, int fr, int fq) const {
        const int row0 = u.pm * 256 + wr * 64 + fr, col0 = u.pn * 256 + wc * 32 + 4 * fq;
#pragma unroll
        for (int ai = 0; ai < 2; ++ai)
#pragma unroll
            for (int m = 0; m < 4; ++m) { const size_t ro = (size_t)(row0 + ai * 128 + m * 16) * 1024;
#pragma unroll
                for (int bj = 0; bj < 2; ++bj)
#pragma unroll
                    for (int n = 0; n < 2; ++n) { const int c = col0 + bj * 128 + n * 16; const f32x4 r = *(const f32x4*)(res_p + ro + c); *(f32x4*)(out_p + ro + c) = acc[ai][bj][m][n] + r; } }
    }
};

__device__ void rwkv_scan_item(const Params& p, int l, int item, unsigned char* smem_) {
    unsigned char* smem = launder_lds(smem_);
    const int tid = tid_l(), wid = tid >> 6, lane = tid & 63;
    const int b = item >> 5, h = (item >> 1) & 15, half = item & 1;
    float* vec = (float*)smem;
    float* vrow = vec + 20480;
    float* sc = vrow + 2048;
    float* exw = sc + 128;
    float* exa = exw + 2048;
    bf16_t* tw = (bf16_t*)(exa + 2048);
    bf16_t* ta = tw + 4608;
    bf16_t* w2t = ta + 4608;
    bf16_t* a2t = w2t + 4608;
    float* cst = (float*)(a2t + 4608);
    const bf16_t* P = (const bf16_t*)(p.ws + WS_P);
    float* ORAW = (float*)(p.ws + WS_ORAW);
    bf16_t* BV = (bf16_t*)(p.ws + WS_BV);
    __syncthreads();
    for (int i = tid; i < 9216; i += 512) tw[i] = 0;
    { const float* w2 = p.in[I_W2] + (size_t)l * 64 * 1024 + h * 64; const float* a2 = p.in[I_A2] + (size_t)l * 64 * 1024 + h * 64;
#pragma unroll
      for (int i = 0; i < 8; ++i) { const int idx = tid + 512 * i, k = idx >> 6, n = idx & 63; w2t[n * 72 + k] = f2bf(w2[(size_t)k * 1024 + n]); a2t[n * 72 + k] = f2bf(a2[(size_t)k * 1024 + n]); } }
    if (tid < 64) { const float* mu = p.in[I_MU] + (size_t)l * 3200; const int gc = h * 64 + tid;
        cst[tid] = mu[C_R + gc]; cst[64 + tid] = mu[C_K + gc]; cst[128 + tid] = mu[C_V + gc]; cst[192 + tid] = mu[C_WL + tid]; cst[256 + tid] = mu[C_AL + tid];
        cst[320 + tid] = p.in[I_KK][l * 1024 + gc]; cst[384 + tid] = p.in[I_KA][l * 1024 + gc]; cst[448 + tid] = p.in[I_RK][l * 1024 + gc];
        cst[512 + tid] = p.in[I_W0][l * 1024 + gc]; cst[576 + tid] = p.in[I_A0][l * 1024 + gc]; }
    __syncthreads();

    if (wid >= 4) {
        const int hw = wid - 4, tok = lane >> 3, cg8 = lane & 7, c0 = cg8 * 8, fr = lane & 15, fq = lane >> 4;
        const float* mu_r = cst + c0; const float* mu_k = cst + 64 + c0; const float* mu_v = cst + 128 + c0; const float* mu_wl = cst + 192 + c0; const float* mu_al = cst + 256 + c0;
        const float* kkc = cst + 320 + c0; const float* kac = cst + 384 + c0; const float* rkc = cst + 448 + c0;
        float w0c[4], a0c[4];
#pragma unroll
        for (int ct = 0; ct < 4; ++ct) { w0c[ct] = cst[512 + ct * 16 + fr]; a0c[ct] = cst[576 + ct * 16 + fr]; }
        for (int c = 0; c < 64; ++c) {
            const int buf = c & 1, tt = hw * 8 + tok, t = c * 32 + tt;
            const size_t grow = (size_t)b * 2048 + t;
            const bf16_t* prow = P + grow * N1;
            float xr[8], xk[8], xv[8], xw[8], xa[8];
            { float cur[8], prv[8];
#define LERP_SEG(dst, col, muv) { unpack8(*(const u32x4*)(prow + (col)), cur); if (t > 0) unpack8(*(const u32x4*)(prow - N1 + (col)), prv); else { _Pragma("unroll") for (int e = 0; e < 8; ++e) prv[e] = 0.f; } \
                _Pragma("unroll") for (int e = 0; e < 8; ++e) dst[e] = cur[e] + (prv[e] - cur[e]) * muv[e]; }
              LERP_SEG(xr, C_R + h * 64 + c0, mu_r) LERP_SEG(xk, C_K + h * 64 + c0, mu_k) LERP_SEG(xv, C_V + h * 64 + c0, mu_v) LERP_SEG(xw, C_WL + c0, mu_wl) LERP_SEG(xa, C_AL + c0, mu_al)
#undef LERP_SEG
            }
#pragma unroll
            for (int e = 0; e < 8; ++e) xw[e] = 1.0f - 2.0f / (__expf(2.0f * xw[e]) + 1.0f);
            *(u32x4*)(tw + (hw * 16 + tok) * 72 + c0) = pack8(xw);
            *(u32x4*)(ta + (hw * 16 + tok) * 72 + c0) = pack8(xa);
            lds_fence();
#pragma unroll
            for (int ct = 0; ct < 4; ++ct) {
                f32x4 aw = {0.f, 0.f, 0.f, 0.f}, aa = {0.f, 0.f, 0.f, 0.f};
#pragma unroll
                for (int ks = 0; ks < 2; ++ks) {
                    const bf16x8 fa = *(const bf16x8*)(tw + (hw * 16 + fr) * 72 + ks * 32 + fq * 8), fb = *(const bf16x8*)(w2t + (ct * 16 + fr) * 72 + ks * 32 + fq * 8);
                    aw = MFMA16(fa, fb, aw);
                    const bf16x8 ga = *(const bf16x8*)(ta + (hw * 16 + fr) * 72 + ks * 32 + fq * 8), gb = *(const bf16x8*)(a2t + (ct * 16 + fr) * 72 + ks * 32 + fq * 8);
                    aa = MFMA16(ga, gb, aa);
                }
                if (lane < 32) {
#pragma unroll
                    for (int j = 0; j < 4; ++j) { const int tj = fq * 4 + j, col = ct * 16 + fr;
                        const float sg = sigmoidf_(w0c[ct] + aw[j]);
                        exw[(hw * 8 + tj) * 64 + col] = __expf(-0.60653066f * sg);
                        exa[(hw * 8 + tj) * 64 + col] = sigmoidf_(a0c[ct] + aa[j]); }
                }
            }
            lds_fence();
            float w8[8], a8[8];
            { const float4 q0 = *(const float4*)(exw + (hw * 8 + tok) * 64 + c0), q1 = *(const float4*)(exw + (hw * 8 + tok) * 64 + c0 + 4);
              w8[0] = q0.x; w8[1] = q0.y; w8[2] = q0.z; w8[3] = q0.w; w8[4] = q1.x; w8[5] = q1.y; w8[6] = q1.z; w8[7] = q1.w;
              const float4 r0 = *(const float4*)(exa + (hw * 8 + tok) * 64 + c0), r1 = *(const float4*)(exa + (hw * 8 + tok) * 64 + c0 + 4);
              a8[0] = r0.x; a8[1] = r0.y; a8[2] = r0.z; a8[3] = r0.w; a8[4] = r1.x; a8[5] = r1.y; a8[6] = r1.z; a8[7] = r1.w; }
            float kk[8], kp[8], bb[8], wr[8]; float ssq = 0.f, br = 0.f, kr = 0.f, beta = 0.f;
#pragma unroll
            for (int e = 0; e < 8; ++e) { kk[e] = xk[e] * kkc[e]; ssq += kk[e] * kk[e]; }
            ssq = red8(ssq);
            const float inv = 1.0f / fmaxf(sqrtf(ssq), 1e-12f);
#pragma unroll
            for (int e = 0; e < 8; ++e) { kk[e] *= inv; kp[e] = xk[e] * (1.0f + (a8[e] - 1.0f) * kac[e]); bb[e] = -kk[e] * a8[e]; wr[e] = w8[e] * xr[e];
                br += bb[e] * xr[e]; kr += kp[e] * xr[e]; beta += xr[e] * kp[e] * rkc[e]; }
            br = red8(br); kr = red8(kr); beta = red8(beta);
            float* vb = vec + (size_t)((buf * 32 + tt) * 5) * 64 + c0;
#define ST8(ptr, arr) { *(float4*)(ptr) = make_float4(arr[0], arr[1], arr[2], arr[3]); *(float4*)((ptr) + 4) = make_float4(arr[4], arr[5], arr[6], arr[7]); }
            ST8(vb, w8) ST8(vb + 64, kk) ST8(vb + 128, bb) ST8(vb + 192, kp) ST8(vb + 256, wr)
            if (cg8 == 0) { sc[(buf * 32 + tt) * 2] = br; sc[(buf * 32 + tt) * 2 + 1] = kr; }
            if ((cg8 >> 2) == half) {
                float* vp = vrow + (buf * 32 + tt) * 32 + (c0 - half * 32);
                ST8(vp, xv)
                float bvv[8];
#pragma unroll
                for (int e = 0; e < 8; ++e) bvv[e] = beta * xv[e];
                *(u32x4*)(BV + grow * 1024 + h * 64 + c0) = pack8(bvv);
            }
#undef ST8
            __syncthreads();
        }
        __syncthreads();
    } else {
        const int rg = lane >> 4, cg = lane & 15, rho0 = wid * 8 + rg * 2;
        float4 S0 = make_float4(0.f, 0.f, 0.f, 0.f), S1 = S0;
        __syncthreads();
        for (int c = 0; c < 64; ++c) {
            const int buf = c & 1;
            float* op = ORAW + ((size_t)b * 2048 + c * 32) * 1024 + h * 64 + half * 32 + rho0;
#pragma unroll 2
            for (int tt = 0; tt < 32; ++tt) {
                const float* vb = vec + (size_t)((buf * 32 + tt) * 5) * 64 + cg * 4;
                const float4 W = *(const float4*)(vb), KK = *(const float4*)(vb + 64), B = *(const float4*)(vb + 128), KP = *(const float4*)(vb + 192), WR = *(const float4*)(vb + 256);
                const float2 vv = *(const float2*)(vrow + (buf * 32 + tt) * 32 + rho0);
                const float2 s2 = *(const float2*)(sc + (buf * 32 + tt) * 2);
                float d0k = S0.x * KK.x + S0.y * KK.y + S0.z * KK.z + S0.w * KK.w;
                float d1k = S1.x * KK.x + S1.y * KK.y + S1.z * KK.z + S1.w * KK.w;
                float d0r = S0.x * WR.x + S0.y * WR.y + S0.z * WR.z + S0.w * WR.w;
                float d1r = S1.x * WR.x + S1.y * WR.y + S1.z * WR.z + S1.w * WR.w;
                d0k = red16(d0k); d1k = red16(d1k); d0r = red16(d0r); d1r = red16(d1r);
                const float o0 = d0r + d0k * s2.x + vv.x * s2.y, o1 = d1r + d1k * s2.x + vv.y * s2.y;
                if (cg == 0) *(float2*)(op + (size_t)tt * 1024) = make_float2(o0, o1);
                S0.x = S0.x * W.x + d0k * B.x + vv.x * KP.x; S0.y = S0.y * W.y + d0k * B.y + vv.x * KP.y; S0.z = S0.z * W.z + d0k * B.z + vv.x * KP.z; S0.w = S0.w * W.w + d0k * B.w + vv.x * KP.w;
                S1.x = S1.x * W.x + d1k * B.x + vv.y * KP.x; S1.y = S1.y * W.y + d1k * B.y + vv.y * KP.y; S1.z = S1.z * W.z + d1k * B.z + vv.y * KP.z; S1.w = S1.w * W.w + d1k * B.w + vv.y * KP.w;
            }
            __syncthreads();
        }
        float* so = p.out + O_PWKV + ((((size_t)l * 8 + b) * 16 + h) * 64 + half * 32 + rho0) * 64 + cg * 4;
        *(float4*)so = S0; *(float4*)(so + 64) = S1;
    }
}

__device__ void rwkv_sample_item(const Params& p, int l, int item, unsigned char* smem_) {
    unsigned char* smem = launder_lds(smem_);
    const int tid = tid_l(), lane = tid & 63, ks = tid >> 6;
    const int i = item >> 4, h = item & 15;
    float* part = (float*)smem;
    float* sv = part + 1024;
    float* s_sc = sv + 384;
    const bf16_t* P = (const bf16_t*)(p.ws + WS_P);
    float* ORAW = (float*)(p.ws + WS_ORAW);
    bf16_t* BV = (bf16_t*)(p.ws + WS_BV);
    const size_t rowp = (size_t)TP + i, rows = (size_t)TALL + i;
    const bf16_t* pc = P + rowp * N1; const bf16_t* pp = P + rows * N1;
    const float* mu = p.in[I_MU] + (size_t)l * 3200;
    const int gc = h * 64 + lane;
    const int row = tid >> 3, cs = (tid & 7) * 8;
    const size_t so = ((((size_t)l * TS + i) * 16 + h) * 64 + row) * 64 + cs;
    const float4 a0 = *(const float4*)(p.in[I_SWKV] + so), a1 = *(const float4*)(p.in[I_SWKV] + so + 4);
#define LERP1(col) (bf2f(pc[col]) + (bf2f(pp[col]) - bf2f(pc[col])) * mu[col])
    { const float* w2 = p.in[I_W2] + (size_t)l * 64 * 1024 + gc; const float* a2 = p.in[I_A2] + (size_t)l * 64 * 1024 + gc;
      float lw = 0.f, la = 0.f;
#pragma unroll
      for (int kk = 0; kk < 8; ++kk) { const int k = ks * 8 + kk; const float xwl = LERP1(C_WL + k), xal = LERP1(C_AL + k);
          lw += (1.0f - 2.0f / (__expf(2.0f * xwl) + 1.0f)) * w2[(size_t)k * 1024]; la += xal * a2[(size_t)k * 1024]; }
      __syncthreads();
      part[ks * 64 + lane] = lw; part[512 + ks * 64 + lane] = la; }
    __syncthreads();
    if (tid < 64) {
        const float xr = LERP1(C_R + gc), xk = LERP1(C_K + gc), xv = LERP1(C_V + gc);
        float lw = 0.f, la = 0.f;
#pragma unroll
        for (int q = 0; q < 8; ++q) { lw += part[q * 64 + lane]; la += part[512 + q * 64 + lane]; }
        const float w = __expf(-0.60653066f * sigmoidf_(p.in[I_W0][l * 1024 + gc] + lw));
        const float a = sigmoidf_(p.in[I_A0][l * 1024 + gc] + la);
        float kk = xk * p.in[I_KK][l * 1024 + gc];
        const float ssq = wave_sum(kk * kk);
        kk *= 1.0f / fmaxf(sqrtf(ssq), 1e-12f);
        const float kp = xk * (1.0f + (a - 1.0f) * p.in[I_KA][l * 1024 + gc]);
        const float bb = -kk * a, wr = w * xr;
        const float br = wave_sum(bb * xr), kr = wave_sum(kp * xr), beta = wave_sum(xr * kp * p.in[I_RK][l * 1024 + gc]);
        sv[lane] = w; sv[64 + lane] = kk; sv[128 + lane] = bb; sv[192 + lane] = kp; sv[256 + lane] = wr; sv[320 + lane] = xv;
        if (lane == 0) { s_sc[0] = br; s_sc[1] = kr; }
        BV[rowp * 1024 + gc] = f2bf(beta * xv);
    }
#undef LERP1
    __syncthreads();
    {
        float S[8] = {a0.x, a0.y, a0.z, a0.w, a1.x, a1.y, a1.z, a1.w};
        float dk = 0.f, dr = 0.f;
#pragma unroll
        for (int e = 0; e < 8; ++e) { dk += S[e] * sv[64 + cs + e]; dr += S[e] * sv[256 + cs + e]; }
        dk = red8(dk); dr = red8(dr);
        const float vr = sv[320 + row];
        const float o = dr + dk * s_sc[0] + vr * s_sc[1];
        if ((tid & 7) == 0) ORAW[rowp * 1024 + h * 64 + row] = o;
#pragma unroll
        for (int e = 0; e < 8; ++e) S[e] = S[e] * sv[cs + e] + dk * sv[128 + cs + e] + vr * sv[192 + cs + e];
        float* sout = p.out + O_SWKV + so;
        *(float4*)sout = make_float4(S[0], S[1], S[2], S[3]); *(float4*)(sout + 4) = make_float4(S[4], S[5], S[6], S[7]);
    }
}

__device__ void phase_conv(const Params& p, int l) {
    const int tid = tid_l();
    const bf16_t* P = (const bf16_t*)(p.ws + WS_P);
    bf16_t* U = (bf16_t*)(p.ws + WS_U); float* DT = (float*)(p.ws + WS_DT);
    for (int id = blockIdx.x * 512 + tid; id < 1024 * 384; id += gridDim.x * 512) {
        const int q = id % 384, seg = id / 384, xcol = q * 4;
        const int bb = seg >> 7, tb = (seg & 127) * 16;
        float4 cw0, cw1, cw2, cw3, cbv;
        { const float* cw = p.in[I_CW] + (size_t)l * 4 * 1536 + xcol; cw0 = *(const float4*)cw; cw1 = *(const float4*)(cw + 1536); cw2 = *(const float4*)(cw + 3072); cw3 = *(const float4*)(cw + 4608);
          cbv = *(const float4*)(p.in[I_CB] + (size_t)l * 1536 + xcol); }
        const bf16_t* pb = P + ((size_t)bb * 2048 + tb) * N1 + C_XBC + xcol;
        bf16_t* ub = U + ((size_t)bb * 2048 + tb) * 1536 + xcol;
        float4 w0 = make_float4(0.f, 0.f, 0.f, 0.f), w1 = w0, w2 = w0;
#define LD4(dst, ptr) { const u32x2 _v = *(const u32x2*)(ptr); dst = make_float4(__uint_as_float(_v.x << 16), __uint_as_float(_v.x & 0xffff0000u), __uint_as_float(_v.y << 16), __uint_as_float(_v.y & 0xffff0000u)); }
        if (tb >= 3) { LD4(w0, pb - 3 * (size_t)N1) LD4(w1, pb - 2 * (size_t)N1) LD4(w2, pb - (size_t)N1) }
#pragma unroll
        for (int s = 0; s < 16; ++s) {
            float4 cur; LD4(cur, pb + (size_t)s * N1)
            float4 u;
            u.x = cbv.x + cw0.x * w0.x + cw1.x * w1.x + cw2.x * w2.x + cw3.x * cur.x; u.y = cbv.y + cw0.y * w0.y + cw1.y * w1.y + cw2.y * w2.y + cw3.y * cur.y;
            u.z = cbv.z + cw0.z * w0.z + cw1.z * w1.z + cw2.z * w2.z + cw3.z * cur.z; u.w = cbv.w + cw0.w * w0.w + cw1.w * w1.w + cw2.w * w2.w + cw3.w * cur.w;
            u32x2 pk; pk.x = pk2(siluf_(u.x), siluf_(u.y)); pk.y = pk2(siluf_(u.z), siluf_(u.w));
            *(u32x2*)(ub + (size_t)s * 1536) = pk;
            w0 = w1; w1 = w2; w2 = cur;
        }
#undef LD4
    }
    for (int id = blockIdx.x * 512 + tid; id < TP * 16; id += gridDim.x * 512) {
        const int t = id >> 4, j = id & 15;
        DT[id] = softplusf_(bf2f(P[(size_t)t * N1 + C_DT + j]) + p.in[I_DTB][l * 16 + j]);
    }
}

__device__ void mamba_item(const Params& p, int l, int item, unsigned char* smem_) {
    unsigned char* smem = launder_lds(smem_);
    const int tid = tid_l(), wid = tid >> 6, lane = tid & 63, fr = lane & 15, fq = lane >> 4;
    const int b = item >> 5, j = (item >> 1) & 15, ph = item & 1, g = j >> 3;
    bf16_t* Cm = (bf16_t*)smem;
    bf16_t* Bm = (bf16_t*)(smem + 17408);
    bf16_t* BmT = (bf16_t*)(smem + 34816);
    bf16_t* XT = (bf16_t*)(smem + 53248);
    bf16_t* XwT = (bf16_t*)(smem + 57856);
    bf16_t* G = (bf16_t*)(smem + 62464);
    bf16_t* Hb = (bf16_t*)(smem + 71680);
    float* acs = (float*)(smem + 80384);
    float* dtv = acs + 64;
    const bf16_t* P = (const bf16_t*)(p.ws + WS_P);
    const bf16_t* U = (const bf16_t*)(p.ws + WS_U); const float* DT = (const float*)(p.ws + WS_DT);
    bf16_t* YM = (bf16_t*)(p.ws + WS_YM);
    __syncthreads();
    for (int i = tid; i < 32 * 136; i += 512) Hb[i] = 0;
    const float Aj = -__expf(p.in[I_ALOG][l * 16 + j]), Dj = p.in[I_DSK][l * 16 + j];
    const int s_a = tid >> 4, c16 = tid & 15, s_x = (tid >> 2) & 63, c4 = tid & 3;
    const int lt = wid >> 1, pt = wid & 1;
    const bf16_t* ub = U + (size_t)b * 2048 * 1536;
    u32x4 rb0, rb1, rc0, rc1, rx = {0u, 0u, 0u, 0u}; float rdt = 0.f;
#define LOADCHUNK(T0) { const bf16_t* r0 = ub + (size_t)((T0) + s_a) * 1536 + g * 128 + c16 * 8; const bf16_t* r1 = r0 + 32 * 1536; \
        rb0 = *(const u32x4*)(r0 + 1024); rb1 = *(const u32x4*)(r1 + 1024); rc0 = *(const u32x4*)(r0 + 1280); rc1 = *(const u32x4*)(r1 + 1280); \
        if (tid < 256) rx = *(const u32x4*)(ub + (size_t)((T0) + s_x) * 1536 + j * 64 + ph * 32 + c4 * 8); \
        if (wid == 5) rdt = DT[((size_t)b * 2048 + (T0) + lane) * 16 + j]; }
    LOADCHUNK(0)
    f32x4 hacc[2] = {{0.f, 0.f, 0.f, 0.f}, {0.f, 0.f, 0.f, 0.f}};
    for (int c = 0; c < 32; ++c) {
        const int t0 = c * 64;
        float zq[4];
#pragma unroll
        for (int jj = 0; jj < 4; ++jj) zq[jj] = bf2f(P[((size_t)b * 2048 + t0 + lt * 16 + fq * 4 + jj) * N1 + C_ZM + j * 64 + ph * 32 + pt * 16 + fr]);
        *(u32x4*)(Cm + s_a * 136 + c16 * 8) = rc0; *(u32x4*)(Cm + (s_a + 32) * 136 + c16 * 8) = rc1;
        *(u32x4*)(Bm + s_a * 136 + c16 * 8) = rb0; *(u32x4*)(Bm + (s_a + 32) * 136 + c16 * 8) = rb1;
#pragma unroll
        for (int e = 0; e < 8; ++e) { const unsigned v0 = rb0[e >> 1], v1 = rb1[e >> 1];
            BmT[(c16 * 8 + e) * 72 + s_a] = (bf16_t)((e & 1) ? (v0 >> 16) : (v0 & 0xffffu)); BmT[(c16 * 8 + e) * 72 + s_a + 32] = (bf16_t)((e & 1) ? (v1 >> 16) : (v1 & 0xffffu)); }
        if (tid < 256) {
#pragma unroll
            for (int e = 0; e < 8; ++e) { const unsigned v0 = rx[e >> 1]; XT[(c4 * 8 + e) * 72 + s_x] = (bf16_t)((e & 1) ? (v0 >> 16) : (v0 & 0xffffu)); }
        }
        if (wid == 5) {
            float v = rdt * Aj;
#pragma unroll
            for (int off = 1; off < 64; off <<= 1) { const float t = __shfl_up(v, off); if (lane >= off) v += t; }
            acs[lane] = v; dtv[lane] = rdt;
        }
        if (c + 1 < 32) LOADCHUNK(t0 + 64)
        LBAR();
        { const int pp = tid & 31, s4 = (tid >> 5) * 4; const float aend = acs[63];
          const u32x2 xv = *(const u32x2*)(XT + pp * 72 + s4);
          const float x0 = __uint_as_float(xv.x << 16), x1 = __uint_as_float(xv.x & 0xffff0000u), x2 = __uint_as_float(xv.y << 16), x3 = __uint_as_float(xv.y & 0xffff0000u);
          u32x2 bq; bq.x = pk2(x0 * dtv[s4] * __expf(aend - acs[s4]), x1 * dtv[s4 + 1] * __expf(aend - acs[s4 + 1]));
          bq.y = pk2(x2 * dtv[s4 + 2] * __expf(aend - acs[s4 + 2]), x3 * dtv[s4 + 3] * __expf(aend - acs[s4 + 3]));
          *(u32x2*)(XwT + pp * 72 + s4) = bq; }
#pragma unroll
        for (int e = 0; e < 2; ++e) {
            const int id = wid * 2 + e, glt = id >> 2, st = id & 3;
            f32x4 acc = {0.f, 0.f, 0.f, 0.f};
            if (st <= glt) {
#pragma unroll
                for (int ks = 0; ks < 4; ++ks) { const bf16x8 fa = *(const bf16x8*)(Cm + (glt * 16 + fr) * 136 + ks * 32 + fq * 8), fb = *(const bf16x8*)(Bm + (st * 16 + fr) * 136 + ks * 32 + fq * 8); acc = MFMA16(fa, fb, acc); }
            }
#pragma unroll
            for (int jj = 0; jj < 4; ++jj) { const int lr = glt * 16 + fq * 4 + jj, s = st * 16 + fr;
                const float val = (s <= lr) ? acc[jj] * __expf(acs[lr] - acs[s]) * dtv[s] : 0.f;
                G[lr * 72 + s] = f2bf(val); }
        }
        f32x4 accO = {0.f, 0.f, 0.f, 0.f};
#pragma unroll
        for (int ks = 0; ks < 4; ++ks) { const bf16x8 fa = *(const bf16x8*)(Cm + (lt * 16 + fr) * 136 + ks * 32 + fq * 8), fb = *(const bf16x8*)(Hb + (pt * 16 + fr) * 136 + ks * 32 + fq * 8); accO = MFMA16(fa, fb, accO); }
        LBAR();
        {
            f32x4 accD = {0.f, 0.f, 0.f, 0.f};
#pragma unroll
            for (int ks = 0; ks < 2; ++ks) { const bf16x8 fa = *(const bf16x8*)(G + (lt * 16 + fr) * 72 + ks * 32 + fq * 8), fb = *(const bf16x8*)(XT + (pt * 16 + fr) * 72 + ks * 32 + fq * 8); accD = MFMA16(fa, fb, accD); }
#pragma unroll
            for (int jj = 0; jj < 4; ++jj) { const int lr = lt * 16 + fq * 4 + jj, pp = pt * 16 + fr;
                float y = accD[jj] + __expf(acs[lr]) * accO[jj] + Dj * bf2f(XT[pp * 72 + lr]);
                y *= siluf_(zq[jj]);
                YM[((size_t)b * 2048 + t0 + lr) * 1024 + j * 64 + ph * 32 + pp] = f2bf(y); }
            const float cd = __expf(acs[63]); const int ptile = wid >> 2;
#pragma unroll
            for (int e = 0; e < 2; ++e) { const int nt = (wid & 3) * 2 + e;
                hacc[e] *= cd;
#pragma unroll
                for (int ks = 0; ks < 2; ++ks) { const bf16x8 fa = *(const bf16x8*)(XwT + (ptile * 16 + fr) * 72 + ks * 32 + fq * 8), fb = *(const bf16x8*)(BmT + (nt * 16 + fr) * 72 + ks * 32 + fq * 8); hacc[e] = MFMA16(fa, fb, hacc[e]); }
#pragma unroll
                for (int jj = 0; jj < 4; ++jj) Hb[(ptile * 16 + fq * 4 + jj) * 136 + nt * 16 + fr] = f2bf(hacc[e][jj]); }
        }
        LBAR();
    }
#undef LOADCHUNK
    { const int ptile = wid >> 2;
#pragma unroll
      for (int e = 0; e < 2; ++e) { const int nt = (wid & 3) * 2 + e;
#pragma unroll
          for (int jj = 0; jj < 4; ++jj) p.out[O_PSSM + ((((size_t)l * 8 + b) * 16 + j) * 64 + ph * 32 + ptile * 16 + fq * 4 + jj) * 128 + nt * 16 + fr] = hacc[e][jj]; } }
    __syncthreads();
}

__device__ void mamba_sample_item(const Params& p, int l, int item, unsigned char* smem_) {
    unsigned char* smem = launder_lds(smem_);
    const int tid = tid_l();
    const int i = item >> 4, j = item & 15, g = j >> 3;
    float* su = (float*)smem;
    float* sd = su + 320;
    const bf16_t* P = (const bf16_t*)(p.ws + WS_P);
    bf16_t* YM = (bf16_t*)(p.ws + WS_YM);
    const size_t rowp = (size_t)TP + i;
    const int pp = tid >> 3, n0 = (tid & 7) * 16;
    const size_t so = ((((size_t)l * TS + i) * 16 + j) * 64 + pp) * 128 + n0;
    float4 hv4[4];
#pragma unroll
    for (int e = 0; e < 4; ++e) hv4[e] = *(const float4*)(p.in[I_SSSM] + so + e * 4);
    __syncthreads();
    if (tid < 320) {
        const int cc = tid < 64 ? j * 64 + tid : (tid < 192 ? 1024 + g * 128 + (tid - 64) : 1280 + g * 128 + (tid - 192));
        const float* c0 = p.in[I_SCONV] + ((size_t)l * TS + i) * 3 * 1536 + cc;
        const float* cw = p.in[I_CW] + (size_t)l * 4 * 1536 + cc;
        const float v = p.in[I_CB][l * 1536 + cc] + c0[0] * cw[0] + c0[1536] * cw[1536] + c0[3072] * cw[3072] + bf2f(P[rowp * N1 + C_XBC + cc]) * cw[4608];
        su[tid] = siluf_(v);
    } else if (tid == 320) {
        const float dt = softplusf_(bf2f(P[rowp * N1 + C_DT + j]) + p.in[I_DTB][l * 16 + j]);
        sd[0] = dt; sd[1] = __expf(-dt * __expf(p.in[I_ALOG][l * 16 + j]));
    }
    __syncthreads();
    {
        float* hout = p.out + O_SSSM + so;
        const float dt = sd[0], eA = sd[1], x = su[pp], xdt = x * dt;
        float y = 0.f;
#pragma unroll
        for (int e = 0; e < 4; ++e) { float4 hv = hv4[e]; const float* Bp = su + 64 + n0 + e * 4; const float* Cp = su + 192 + n0 + e * 4;
            hv.x = eA * hv.x + xdt * Bp[0]; hv.y = eA * hv.y + xdt * Bp[1]; hv.z = eA * hv.z + xdt * Bp[2]; hv.w = eA * hv.w + xdt * Bp[3];
            y += hv.x * Cp[0] + hv.y * Cp[1] + hv.z * Cp[2] + hv.w * Cp[3];
            *(float4*)(hout + e * 4) = hv; }
        y = red8(y);
        if ((tid & 7) == 0) { y += p.in[I_DSK][l * 16 + j] * x; const float z = bf2f(P[rowp * N1 + C_ZM + j * 64 + pp]); YM[rowp * 1024 + j * 64 + pp] = f2bf(y * siluf_(z)); }
    }
}

__device__ void phase_mixa(const Params& p, int l, unsigned char* smem) {
    phase_conv(p, l);
    for (int rep = 0; rep < (DUP == 3 ? 2 : 1); ++rep)
    for (int it = blockIdx.x; it < 2048; it += gridDim.x) rwkv_sample_item(p, l, it, smem);
    for (int rep = 0; rep < (DUP == 4 ? 2 : 1); ++rep)
    for (int it = blockIdx.x; it < 2048; it += gridDim.x) mamba_sample_item(p, l, it, smem);
}
__device__ void phase_mixb(const Params& p, int l, unsigned char* smem) {
    for (int rep = 0; rep < (DUP == 1 ? 2 : 1); ++rep)
    for (int it = blockIdx.x; it < 256; it += gridDim.x) rwkv_scan_item(p, l, it, smem);
    for (int rep = 0; rep < (DUP == 2 ? 2 : 1); ++rep)
    for (int it = blockIdx.x; it < 256; it += gridDim.x) mamba_item(p, l, it, smem);
}

__device__ void sample_outproj(const Params& p, int l) {
    const int tid = tid_l(), wid = tid >> 6, lane = tid & 63, fr = lane & 15, fq = lane >> 4;
    const bf16_t* A2 = (const bf16_t*)(p.ws + WS_A) + (size_t)TP * 2048;
    const bf16_t* W = (const bf16_t*)(p.ws + WS_WOUTT) + (size_t)l * 1024 * 2048;
    float* PART = (float*)(p.ws + WS_PART);
    for (int it = blockIdx.x; it < 256; it += gridDim.x) {
        const int nt = it & 15, ksl = it >> 4;
        f32x4 acc[4] = {{0.f, 0.f, 0.f, 0.f}, {0.f, 0.f, 0.f, 0.f}, {0.f, 0.f, 0.f, 0.f}, {0.f, 0.f, 0.f, 0.f}};
#pragma unroll
        for (int kq = 0; kq < 4; ++kq) {
            const bf16x8 fa = *(const bf16x8*)(A2 + (size_t)(wid * 16 + fr) * 2048 + ksl * 128 + kq * 32 + fq * 8);
#pragma unroll
            for (int ct = 0; ct < 4; ++ct) { const bf16x8 fb = *(const bf16x8*)(W + (size_t)(nt * 64 + ct * 16 + fr) * 2048 + ksl * 128 + kq * 32 + fq * 8); acc[ct] = MFMA16(fa, fb, acc[ct]); }
        }
#pragma unroll
        for (int ct = 0; ct < 4; ++ct)
#pragma unroll
            for (int jj = 0; jj < 4; ++jj) PART[((size_t)ksl * TS + wid * 16 + fq * 4 + jj) * 1024 + nt * 64 + ct * 16 + fr] = acc[ct][jj];
    }
}

__device__ void phase_post(const Params& p, int l) {
    const int tid_ = tid_l(); const int lane = tid_ & 63, wid = tid_ >> 6;
    const bf16_t* P = (const bf16_t*)(p.ws + WS_P);
    const float* ORAW = (const float*)(p.ws + WS_ORAW);
    const bf16_t* BV = (const bf16_t*)(p.ws + WS_BV);
    const bf16_t* YM = (const bf16_t*)(p.ws + WS_YM);
    bf16_t* A2 = (bf16_t*)(p.ws + WS_A);
    const int c0 = lane * 16;
    float lnw[16], lnb[16], gnw[16];
#pragma unroll
    for (int e = 0; e < 16; ++e) { lnw[e] = p.in[I_LNW][l * 1024 + c0 + e]; lnb[e] = p.in[I_LNB][l * 1024 + c0 + e]; gnw[e] = p.in[I_GNW][l * 1024 + c0 + e]; }
    for (int row = blockIdx.x * 8 + wid; row < TALL; row += gridDim.x * 8) {
        const bf16_t* prow = P + (size_t)row * N1;
        float o[16], bv[16], z[16], ym[16];
#pragma unroll
        for (int i = 0; i < 4; ++i) { const float4 t = *(const float4*)(ORAW + (size_t)row * 1024 + c0 + i * 4); o[i * 4] = t.x; o[i * 4 + 1] = t.y; o[i * 4 + 2] = t.z; o[i * 4 + 3] = t.w; }
        unpack8(*(const u32x4*)(BV + (size_t)row * 1024 + c0), bv); unpack8(*(const u32x4*)(BV + (size_t)row * 1024 + c0 + 8), bv + 8);
        unpack8(*(const u32x4*)(prow + C_ZR + c0), z); unpack8(*(const u32x4*)(prow + C_ZR + c0 + 8), z + 8);
        unpack8(*(const u32x4*)(YM + (size_t)row * 1024 + c0), ym); unpack8(*(const u32x4*)(YM + (size_t)row * 1024 + c0 + 8), ym + 8);
        float s = 0.f;
#pragma unroll
        for (int e = 0; e < 16; ++e) s += o[e];
        s += dppf<0xB1>(s); s += dppf<0x4E>(s);
        const float mean = s * (1.0f / 64.0f);
        float v = 0.f;
#pragma unroll
        for (int e = 0; e < 16; ++e) { o[e] -= mean; v += o[e] * o[e]; }
        v += dppf<0xB1>(v); v += dppf<0x4E>(v);
        const float rstd = rsqrtf(v * (1.0f / 64.0f) + 64e-5f);
#pragma unroll
        for (int e = 0; e < 16; ++e) o[e] = (o[e] * rstd * lnw[e] + lnb[e] + bv[e]) * siluf_(z[e]);
        *(u32x4*)(A2 + (size_t)row * 2048 + c0) = pack8(o); *(u32x4*)(A2 + (size_t)row * 2048 + c0 + 8) = pack8(o + 8);
        float ss = 0.f;
#pragma unroll
        for (int e = 0; e < 16; ++e) ss += ym[e] * ym[e];
        ss = red16(ss); ss += __shfl_xor(ss, 16);
        const float rs = rsqrtf(ss * (1.0f / 512.0f) + 1e-5f);
#pragma unroll
        for (int e = 0; e < 16; ++e) ym[e] *= rs * gnw[e];
        *(u32x4*)(A2 + (size_t)row * 2048 + 1024 + c0) = pack8(ym); *(u32x4*)(A2 + (size_t)row * 2048 + 1024 + c0 + 8) = pack8(ym + 8);
        if (row < TP) {
            const int tq = row & 2047;
            if (tq >= 2045) { float* dst = p.out + O_PCONV + (((size_t)l * 8 + (row >> 11)) * 3 + (tq - 2045)) * 1536;
                for (int c = lane; c < 1536; c += 64) dst[c] = bf2f(prow[C_XBC + c]); }
        } else {
            const int i = row - TP; float* dst = p.out + O_SCONV + ((size_t)l * TS + i) * 3 * 1536; const float* src = p.in[I_SCONV] + ((size_t)l * TS + i) * 3 * 1536;
            for (int c = lane; c < 1536; c += 64) { dst[c] = src[1536 + c]; dst[1536 + c] = src[3072 + c]; dst[3072 + c] = bf2f(prow[C_XBC + c]); }
        }
    }
}

constexpr int NPHASE = 13;
__global__ __launch_bounds__(512, 2) void mega(Params p) {
    extern __shared__ __attribute__((aligned(16))) unsigned char smem[];
    cg::grid_group grid = cg::this_grid();
    for (int ph = p.ph_lo; ph < p.ph_hi; ++ph) {
        if (ph > p.ph_lo) grid.sync();
        const int l = ph >= 6 ? 1 : 0;
        switch (ph) {
            case 0: phase_convert(p, smem); phase_norm(p, 0); break;
            case 6: phase_norm(p, 1); break;
            case 1: case 7: {
                pg8::Gemm g{(const bf16_t*)(p.ws + WS_A), (const bf16_t*)(p.ws + WS_WINT) + (size_t)l * N1 * 1024, M1, N1, 1024};
                pg8::StaticOrder S; S.init(M1, N1, (int)gridDim.x, (int)blockIdx.x);
                EpiP E{(bf16_t*)(p.ws + WS_P), N1};
                pg8::gemm_phase<EpiP, pg8::StaticOrder, false>((PG8_LAS unsigned char*)smem, g, S, E, nullptr);
            } break;
            case 2: case 8: phase_mixa(p, l, smem); break;
            case 3: case 9: phase_mixb(p, l, smem); break;
            case 4: case 10: phase_post(p, l); break;
            case 5: case 11: {
                sample_outproj(p, l);
                pg8::Gemm g{(const bf16_t*)(p.ws + WS_A), (const bf16_t*)(p.ws + WS_WOUTT) + (size_t)l * 1024 * 2048, TP, 1024, 2048};
                pg8::StaticOrder S; S.init(TP, 1024, (int)gridDim.x, (int)blockIdx.x);
                EpiRes E{l == 0 ? p.in[I_XP] : p.out + O_YP, p.out + O_YP};
                pg8::gemm_phase<EpiRes, pg8::StaticOrder, false>((PG8_LAS unsigned char*)smem, g, S, E, nullptr);
            } break;
            case 12: phase_final(p); break;
        }
    }
}

extern "C" void kernel_launch(void* const* d_in, const int* in_sizes, int n_in, void* d_out, int out_size, void* d_ws, size_t ws_size, hipStream_t stream) {
    static int grid = 0;
    if (grid == 0) {
        if (n_in != 26 || (size_t)out_size != O_END || ws_size < WS_END) { fprintf(stderr, "kernel_launch: unexpected shapes: n_in %d out %d ws %zu (need %zu)\n", n_in, out_size, ws_size, (size_t)WS_END); grid = -1; return; }
        int dev = 0, cus = 0, per_cu = 0;
        hipGetDevice(&dev); hipDeviceGetAttribute(&cus, hipDeviceAttributeMultiprocessorCount, dev);
        if (hipFuncSetAttribute((const void*)mega, hipFuncAttributeMaxDynamicSharedMemorySize, LDS_BYTES) != hipSuccess) { fprintf(stderr, "kernel_launch: hipFuncSetAttribute failed\n"); grid = -1; return; }
        if (hipOccupancyMaxActiveBlocksPerMultiprocessor(&per_cu, (const void*)mega, 512, LDS_BYTES) != hipSuccess || per_cu < 1) { fprintf(stderr, "kernel_launch: occupancy query gave %d\n", per_cu); per_cu = 1; }
        (void)hipGetLastError();
        grid = cus * 1;
    }
    if (grid < 0) return;
    Params p{};
    for (int i = 0; i < 26; ++i) p.in[i] = (const float*)d_in[i];
    p.out = (float*)d_out; p.ws = (unsigned char*)d_ws;
#if MK_PER_PHASE
    for (int ph = 0; ph < NPHASE; ++ph) { p.ph_lo = ph; p.ph_hi = ph + 1; hipLaunchKernelGGL(mega, dim3(grid), dim3(512), LDS_BYTES, stream, p); }
#else
    p.ph_lo = 0; p.ph_hi = NPHASE;
    void* args[] = {&p};
    hipError_t e = hipLaunchCooperativeKernel((const void*)mega, dim3(grid), dim3(512), args, LDS_BYTES, stream);
    if (e != hipSuccess) fprintf(stderr, "cooperative launch failed: %s (grid %d)\n", hipGetErrorString(e), grid);
#endif
}
```

```cpp
#include <hip/hip_runtime.h>
#include <hip/hip_cooperative_groups.h>
#include <cstdio>
namespace cg = cooperative_groups;
namespace pg8 {
#define PG8_LAS __attribute__((address_space(3)))
typedef unsigned short bf16_t;
typedef short bf16x8 __attribute__((ext_vector_type(8)));
typedef float f32x4 __attribute__((ext_vector_type(4)));
typedef unsigned u32x4 __attribute__((ext_vector_type(4)));
constexpr int BM = 256, BK = 64, HALF = 128, HTB = HALF * BK * 2  , STAGE_BYTES = 8 * HTB, NXCD = 8, WGM = 8;

__host__ __device__ __forceinline__ int lds_byte(int r, int c) { const int st = (r >> 4) * 2 + (c >> 5), rr = r & 15, cc = c & 31, ob = rr * 64 + cc * 2; return st * 1024 + (ob ^ (((ob >> 9) & 1) << 5)); }
__host__ __device__ __forceinline__ void stage_rc(int b, int& R, int& C) { const int st = b / 1024, sb = b % 1024, swz = sb ^ (((sb >> 9) & 1) << 5); R = (st >> 1) * 16 + swz / 64; C = (st & 1) * 32 + (swz % 64) / 2; }
__host__ __device__ __forceinline__ int perm32(int rho) { const int n = rho >> 4, i = rho & 15; return 8 * (i >> 2) + 4 * n + (i & 3); }

struct Unit { int pm, pn; };
struct Gemm { const bf16_t* A; const bf16_t* Bt; int M, N, K; };

struct StaticOrder {
    int nM, nN, nwg, G, c;
    __host__ __device__ void init(int M, int N, int G_, int c_) { nM = M / BM; nN = N / BM; nwg = nM * nN; G = G_; c = c_; }
    __host__ __device__ bool next(int i, Unit& u) const {
        const long L = (long)i * G + c; if (L >= nwg) return false;
        int wgid = (int)L; { const int q = nwg / NXCD, r = nwg % NXCD, xcd = wgid % NXCD, off = wgid / NXCD; wgid = (xcd < r ? xcd * (q + 1) : r * (q + 1) + (xcd - r) * q) + off; }
        const int nig = WGM * nN, gid = wgid / nig, fm = gid * WGM, gsz = (nM - fm) < WGM ? (nM - fm) : WGM;
        u.pm = fm + ((wgid % nig) % gsz); u.pn = (wgid % nig) / gsz; return true;
    }
    __device__ __forceinline__ void a_ready(const Unit&) const {}
    __device__ __forceinline__ void done(const Unit&) const {}
};
__device__ __forceinline__ unsigned cvt_pk_bf16(float lo, float hi) { unsigned r; asm volatile("v_cvt_pk_bf16_f32 %0, %1, %2" : "=v"(r) : "v"(lo), "v"(hi)); return r; }
template <class Epi, class Sched, bool STAMP = false>
__device__ __forceinline__ void gemm_phase(PG8_LAS unsigned char* lds, const Gemm g, const Sched& S, const Epi& E, unsigned long long* stamps) {
    int tid_raw = threadIdx.x; asm volatile("" : "+v"(tid_raw)); const int tid = tid_raw, wid = __builtin_amdgcn_readfirstlane(tid >> 6), lane = tid & 63, wr = wid >> 2, wc = wid & 3, fr = lane & 15, fq = lane >> 4;
    const int K = g.K, nt = K / BK;
    int ts_lo = 0, ts_hi = 0, nts = 0; const unsigned long long rt_entry = STAMP ? (unsigned long long)wall_clock64() : 0ull;
#define PG8_STAMP() do { if (STAMP && wid == 0 && nts < 64) { const unsigned long long _c = (unsigned long long)clock64(); \
        ts_lo = (lane == nts) ? (int)(unsigned)_c : ts_lo; ts_hi = (lane == nts) ? (int)(unsigned)(_c >> 32) : ts_hi; ++nts; } } while (0)
    PG8_STAMP();
    unsigned voffA[2], voffB[2];
#pragma unroll
    for (int i = 0; i < 2; ++i) { int R, C; stage_rc(tid * 16 + i * 8192, R, C); const int Rb = Epi::PERM ? ((R & ~31) + perm32(R & 31)) : R;
        voffA[i] = (unsigned)(R * K + C) * 2u; voffB[i] = (unsigned)(Rb * K + C) * 2u; }
    const size_t kstep = (size_t)(BK * 2);
    const size_t hstep = (size_t)HALF * K * 2;
    const size_t tstep = 2 * hstep;
    const unsigned ldsw = (unsigned)wid * 1024u;
    const int aoff = lds_byte(wr * 64 + fr, fq * 8), boff = lds_byte(wc * 32 + fr, fq * 8);
#define PG8_SA(b, h) (((b) * 2 + (h)) * HTB)
#define PG8_SB(b, h) ((4 + (b) * 2 + (h)) * HTB)
#define PG8_STAGE(bufoff, gbase, voff) do { _Pragma("unroll") for (int _i = 0; _i < 2; ++_i) \
        __builtin_amdgcn_global_load_lds((const unsigned*)((const char*)(gbase) + (voff)[_i]), (PG8_LAS unsigned*)(lds + (bufoff) + ldsw + _i * 8192), 16, 0, 0); } while (0)
#define PG8_LDA(dst, b, h) do { _Pragma("unroll") for (int m = 0; m < 4; ++m) _Pragma("unroll") for (int k = 0; k < 2; ++k) dst[m][k] = *(const PG8_LAS bf16x8*)(lds + PG8_SA(b, h) + aoff + m * 2048 + k * 1024); } while (0)
#define PG8_LDB(dst, b, h) do { _Pragma("unroll") for (int n = 0; n < 2; ++n) _Pragma("unroll") for (int k = 0; k < 2; ++k) dst[n][k] = *(const PG8_LAS bf16x8*)(lds + PG8_SB(b, h) + boff + n * 2048 + k * 1024); } while (0)
#define PG8_MMA(ai, bj, At, Bt) do { __builtin_amdgcn_s_setprio(1); _Pragma("unroll") for (int m = 0; m < 4; ++m) _Pragma("unroll") for (int n = 0; n < 2; ++n) _Pragma("unroll") for (int k = 0; k < 2; ++k) \
        acc[ai][bj][m][n] = __builtin_amdgcn_mfma_f32_16x16x32_bf16(Bt[n][k], At[m][k], acc[ai][bj][m][n], 0, 0, 0); __builtin_amdgcn_s_setprio(0); } while (0)
#define PG8_WAIT_V(n) asm volatile("s_waitcnt vmcnt(" #n ")" ::: "memory")
#define PG8_WAIT_L(n) asm volatile("s_waitcnt lgkmcnt(" #n ")" ::: "memory")
#define PG8_BAR __builtin_amdgcn_s_barrier()
#define PG8_SCHED __builtin_amdgcn_sched_barrier(0)
    Unit cur, nxt; int ui = 0;
    if (!S.next(0, cur)) return;
    f32x4 acc[2][2][4][2];
#pragma unroll
    for (int a = 0; a < 2; ++a)
#pragma unroll
        for (int b = 0; b < 2; ++b)
#pragma unroll
            for (int m = 0; m < 4; ++m)
#pragma unroll
                for (int n = 0; n < 2; ++n) acc[a][b][m][n] = (f32x4){0.f, 0.f, 0.f, 0.f};
    bf16x8 At[4][2], B0[2][2], B1[2][2];
    const char* cA = (const char*)g.A + (size_t)cur.pm * tstep; const char* cB = (const char*)g.Bt + (size_t)cur.pn * tstep;
    S.a_ready(cur);
    PG8_STAGE(PG8_SB(0, 0), cB, voffB); PG8_STAGE(PG8_SA(0, 0), cA, voffA); PG8_STAGE(PG8_SB(0, 1), cB + hstep, voffB); PG8_STAGE(PG8_SA(0, 1), cA + hstep, voffA);
    if (wr == 1) PG8_BAR;
    PG8_WAIT_V(4); PG8_BAR;
    PG8_STAGE(PG8_SB(1, 0), cB + kstep, voffB); PG8_STAGE(PG8_SA(1, 0), cA + kstep, voffA); PG8_STAGE(PG8_SB(1, 1), cB + hstep + kstep, voffB);
    PG8_WAIT_V(6); PG8_BAR;
    PG8_STAMP();
    for (;;) {
        const bool has_next = S.next(ui + 1, nxt);
        const char* nA = has_next ? (const char*)g.A + (size_t)nxt.pm * tstep : cA; const char* nB = has_next ? (const char*)g.Bt + (size_t)nxt.pn * tstep : cB;
        for (int t = 0; t < nt; t += 2) {
            const bool last = (t == nt - 2);
            const char* a1 = cA + (size_t)(t + 1) * kstep;
            const char* a2 = last ? nA : cA + (size_t)(t + 2) * kstep; const char* b2 = last ? nB : cB + (size_t)(t + 2) * kstep;
            const char* a3 = a2 + kstep; const char* b3 = b2 + kstep;
            if (last && has_next) S.a_ready(nxt);
            PG8_LDB(B0, 0, 0); PG8_SCHED; PG8_LDA(At, 0, 0); PG8_STAGE(PG8_SA(1, 1), a1 + hstep, voffA);
            PG8_WAIT_L(8); PG8_BAR; PG8_WAIT_L(0); PG8_MMA(0, 0, At, B0); PG8_BAR; PG8_SCHED;
            PG8_LDB(B1, 0, 1); PG8_STAGE(PG8_SB(0, 0), b2, voffB);
            PG8_BAR; PG8_WAIT_L(0); PG8_MMA(0, 1, At, B1); PG8_BAR;
            PG8_LDA(At, 0, 1); PG8_STAGE(PG8_SA(0, 0), a2, voffA);
            PG8_BAR; PG8_WAIT_L(0); PG8_MMA(1, 0, At, B0); PG8_BAR; PG8_SCHED;
            PG8_STAGE(PG8_SB(0, 1), b2 + hstep, voffB);
            PG8_WAIT_V(6); PG8_BAR; PG8_MMA(1, 1, At, B1); PG8_BAR;
            PG8_LDB(B0, 1, 0); PG8_SCHED; PG8_LDA(At, 1, 0); PG8_STAGE(PG8_SA(0, 1), a2 + hstep, voffA);
            PG8_WAIT_L(8); PG8_BAR; PG8_WAIT_L(0); PG8_MMA(0, 0, At, B0); PG8_BAR; PG8_SCHED;
            PG8_LDB(B1, 1, 1); PG8_STAGE(PG8_SB(1, 0), b3, voffB);
            PG8_BAR; PG8_WAIT_L(0); PG8_MMA(0, 1, At, B1); PG8_BAR;
            PG8_LDA(At, 1, 1); PG8_STAGE(PG8_SA(1, 0), a3, voffA);
            PG8_BAR; PG8_WAIT_L(0); PG8_MMA(1, 0, At, B0); PG8_BAR; PG8_SCHED;
            PG8_STAGE(PG8_SB(1, 1), b3 + hstep, voffB);
            PG8_WAIT_V(6); PG8_BAR; PG8_MMA(1, 1, At, B1); PG8_BAR;
        }
        PG8_STAMP();
        if constexpr (!Epi::AFTER_DRAIN) { E(acc, cur, wr, wc, fr, fq); S.done(cur); }
        PG8_STAMP();
        if (!has_next) break;
#pragma unroll
        for (int a = 0; a < 2; ++a)
#pragma unroll
            for (int b = 0; b < 2; ++b)
#pragma unroll
                for (int m = 0; m < 4; ++m)
#pragma unroll
                    for (int n = 0; n < 2; ++n) acc[a][b][m][n] = (f32x4){0.f, 0.f, 0.f, 0.f};
        cur = nxt; cA = nA; cB = nB; ++ui;
    }
    PG8_WAIT_V(0);
    if (wr == 0) PG8_BAR;
    PG8_BAR;
    if constexpr (Epi::AFTER_DRAIN) { E.fused(acc, cur, wr, wc, fr, fq, lds, wid, lane); S.done(cur); }
    PG8_STAMP();
    if (STAMP && wid == 0) { stamps[lane] = lane < nts ? (((unsigned long long)(unsigned)ts_hi << 32) | (unsigned)ts_lo) : 0ull;
        if (lane == 62) stamps[62] = rt_entry; if (lane == 63) stamps[63] = (unsigned long long)wall_clock64(); }
#undef PG8_STAMP
#undef PG8_SA
#undef PG8_SB
#undef PG8_STAGE
#undef PG8_LDA
#undef PG8_LDB
#undef PG8_MMA
#undef PG8_WAIT_V
#undef PG8_WAIT_L
#undef PG8_BAR
#undef PG8_SCHED
}
}

#define XB_TMO      128
#define XB_XCNT(j)  (256  + 64 * (j))
#define XB_XSUB(j)  (1280 + 64 * (j))
#define XB_XGEN(j)  (2304 + 64 * (j))
#define XB_TOP      3328
#define XB_TOPGEN   3392
#define XCD_BAR_WORDS 3456
#define XB_SPIN_CAP (1u << 18)
#define LAS __attribute__((address_space(3)))

__device__ __forceinline__ unsigned xb_ld(unsigned* p)              { return __hip_atomic_load(p, __ATOMIC_RELAXED, __HIP_MEMORY_SCOPE_AGENT); }
__device__ __forceinline__ unsigned xb_add(unsigned* p, unsigned v) { return __hip_atomic_fetch_add(p, v, __ATOMIC_RELAXED, __HIP_MEMORY_SCOPE_AGENT); }
__device__ __forceinline__ unsigned xb_xcc_id() { return (unsigned)__builtin_amdgcn_s_getreg((3 << 11) | 20) & 0xFu; }
#define XB_SPIN(cond, bar) do { unsigned _sp = 0; while (cond) { __builtin_amdgcn_s_sleep(1); \
    if ((++_sp & 255u) == 0u) { if (xb_ld(&(bar)[XB_TMO])) break; if (_sp > XB_SPIN_CAP) { atomicAdd(&(bar)[XB_TMO], 1u); break; } } } } while (0)
struct XcdBarrier {
    unsigned* bar; unsigned x;
    volatile LAS unsigned* st;
};

__device__ __forceinline__ XcdBarrier xcd_barrier_post(unsigned* bar, volatile LAS unsigned* st) {
    XcdBarrier b; b.bar = bar; b.x = xb_xcc_id(); b.st = st;
    if (threadIdx.x == 0) (void)xb_add(&bar[XB_XCNT(b.x)], 1u);
    return b;
}
__device__ __forceinline__ void xcd_barrier_complete(unsigned* bar, unsigned x, unsigned& nloc, unsigned& nx) {
    const unsigned G = gridDim.x * gridDim.y * gridDim.z;
    unsigned sum, cnt, mine, sp = 0u;
    for (;;) {
        sum = 0u; cnt = 0u; mine = 0u;
#pragma unroll
        for (unsigned j = 0; j < 16; ++j) { const unsigned c = xb_ld(&bar[XB_XCNT(j)]); sum += c; cnt += (c > 0u) ? 1u : 0u; mine = (j == x) ? c : mine; }
        if (sum == G) break;
        __builtin_amdgcn_s_sleep(1);
        if ((++sp & 255u) == 0u) { if (xb_ld(&bar[XB_TMO])) break; if (sp > XB_SPIN_CAP) { atomicAdd(&bar[XB_TMO], 1u); break; } }
    }
    nloc = mine > 0u ? mine : 1u; nx = cnt > 0u ? cnt : 1u;
}

__device__ __forceinline__ void xcd_barrier(const XcdBarrier& b) {
    asm volatile("s_waitcnt vmcnt(0)" ::: "memory");
    __syncthreads();
    if (threadIdx.x == 0) {
        unsigned* bar = b.bar;
        __builtin_amdgcn_s_waitcnt(0);
        unsigned nloc = b.st[0], nx = b.st[1];
        if (nloc == 0u) { xcd_barrier_complete(bar, b.x, nloc, nx); b.st[0] = nloc; b.st[1] = nx; }
        const unsigned old = xb_add(&bar[XB_XSUB(b.x)], 1u);
        const unsigned gen = old / nloc;
        if (old + 1u == (gen + 1u) * nloc) {
            __builtin_amdgcn_fence(__ATOMIC_RELEASE, "agent");
            asm volatile("s_waitcnt vmcnt(0)" ::: "memory");
            const unsigned og = xb_add(&bar[XB_TOP], 1u);
            const unsigned tg = og / nx;
            if (og + 1u == (tg + 1u) * nx) xb_add(&bar[XB_TOPGEN], 1u);
            else XB_SPIN(xb_ld(&bar[XB_TOPGEN]) == tg, bar);
            __builtin_amdgcn_fence(__ATOMIC_ACQUIRE, "agent");
            xb_add(&bar[XB_XGEN(b.x)], 1u);
            asm volatile("s_waitcnt vmcnt(0)" ::: "memory");
        } else {
            XB_SPIN(xb_ld(&bar[XB_XGEN(b.x)]) == gen, bar);
            __builtin_amdgcn_fence(__ATOMIC_ACQUIRE, "agent");
            asm volatile("s_waitcnt vmcnt(0)" ::: "memory");
        }
    }
    __syncthreads();
}

typedef unsigned short bf16_t;
typedef short bf16x8 __attribute__((ext_vector_type(8)));
typedef float f32x4 __attribute__((ext_vector_type(4)));
typedef unsigned u32x4 __attribute__((ext_vector_type(4)));
typedef unsigned u32x2 __attribute__((ext_vector_type(2)));

#ifndef DUP
#define DUP 0
#endif
#ifndef MK_PER_PHASE
#define MK_PER_PHASE 0
#endif

constexpr int TP = 16384, TS = 128, TALL = 16512, M1 = 16640, N1 = 6912, NIN = 6800;
constexpr int C_R = 0, C_K = 1024, C_V = 2048, C_WL = 3072, C_AL = 3136, C_ZR = 3200, C_ZM = 4224, C_XBC = 5248, C_DT = 6784;
constexpr size_t O_YP = 0, O_YS = 16777216, O_PSH = 16908288, O_PWKV = 16924672, O_PCONV = 17973248, O_PSSM = 18046976,
                 O_SSH = 20144128, O_SWKV = 20406272, O_SCONV = 37183488, O_SSSM = 38363136, O_END = 71917568;
constexpr size_t WS_WINT = 0;
constexpr size_t WS_WOUTT = WS_WINT + (size_t)2 * N1 * 1024 * 2;
constexpr size_t WS_A = WS_WOUTT + (size_t)2 * 1024 * 2048 * 2;
constexpr size_t WS_P = WS_A + (size_t)M1 * 2048 * 2;
constexpr size_t WS_ORAW = WS_P + (size_t)M1 * N1 * 2;
constexpr size_t WS_BV = WS_ORAW + (size_t)TALL * 1024 * 4;
constexpr size_t WS_YM = WS_BV + (size_t)TALL * 1024 * 2;
constexpr size_t WS_END = WS_YM + (size_t)TALL * 1024 * 2;
constexpr size_t WS_U = WS_A;
constexpr size_t WS_DT = WS_U + (size_t)TP * 1536 * 2;
constexpr size_t WS_PART = WS_ORAW;
constexpr size_t WS_BAR = (WS_END + 4095) & ~(size_t)4095;
constexpr int LDS_BYTES = 147456, LDS_BARST = 147440;

struct Params { const float* in[26]; float* out; unsigned char* ws; int ph_lo, ph_hi; };
enum { I_XP = 0, I_XS, I_SSHIFT, I_SWKV, I_SCONV, I_SSSM, I_NORMW, I_WIN, I_MU, I_W0, I_W2, I_A0, I_A2, I_KK, I_KA, I_RK, I_LNW, I_LNB, I_CW, I_CB, I_DTB, I_ALOG, I_DSK, I_GNW, I_WOUT, I_FNW };

__device__ __forceinline__ float bf2f(unsigned short b) { return __uint_as_float(((unsigned)b) << 16); }
__device__ __forceinline__ unsigned short f2bf(float f) { unsigned u = __float_as_uint(f); u += 0x7FFFu + ((u >> 16) & 1u); return (unsigned short)(u >> 16); }
__device__ __forceinline__ unsigned pk2(float lo, float hi) { return (unsigned)f2bf(lo) | ((unsigned)f2bf(hi) << 16); }
__device__ __forceinline__ void unpack8(const u32x4 v, float* f) {
    f[0] = __uint_as_float(v.x << 16); f[1] = __uint_as_float(v.x & 0xffff0000u); f[2] = __uint_as_float(v.y << 16); f[3] = __uint_as_float(v.y & 0xffff0000u);
    f[4] = __uint_as_float(v.z << 16); f[5] = __uint_as_float(v.z & 0xffff0000u); f[6] = __uint_as_float(v.w << 16); f[7] = __uint_as_float(v.w & 0xffff0000u); }
__device__ __forceinline__ u32x4 pack8(const float* f) { u32x4 r; r.x = pk2(f[0], f[1]); r.y = pk2(f[2], f[3]); r.z = pk2(f[4], f[5]); r.w = pk2(f[6], f[7]); return r; }
__device__ __forceinline__ float sigmoidf_(float x) { return 1.0f / (1.0f + __expf(-x)); }
__device__ __forceinline__ float siluf_(float x) { return x / (1.0f + __expf(-x)); }
__device__ __forceinline__ float softplusf_(float x) { return x > 20.f ? x : log1pf(__expf(x)); }
template <int CTRL> __device__ __forceinline__ float dppf(float v) { return __int_as_float(__builtin_amdgcn_mov_dpp(__float_as_int(v), CTRL, 0xF, 0xF, true)); }
__device__ __forceinline__ float red8(float x) { x += dppf<0xB1>(x); x += dppf<0x4E>(x); x += dppf<0x141>(x); return x; }
__device__ __forceinline__ float red16(float x) { x = red8(x); x += dppf<0x140>(x); return x; }
__device__ __forceinline__ float wave_sum(float x) {
#pragma unroll
    for (int o = 32; o > 0; o >>= 1) x += __shfl_xor(x, o);
    return x; }
__device__ __forceinline__ void lds_fence() { asm volatile("s_waitcnt lgkmcnt(0)" ::: "memory"); }
__device__ __forceinline__ int tid_l() { int t = threadIdx.x; asm volatile("" : "+v"(t)); return t; }
__device__ __forceinline__ unsigned char* launder_lds(unsigned char* sm) { int off = 0; asm volatile("" : "+s"(off)); return sm + off; }
#define LBAR() do { asm volatile("s_waitcnt lgkmcnt(0)" ::: "memory"); __builtin_amdgcn_s_barrier(); asm volatile("" ::: "memory"); } while (0)
#define MFMA16(a, b, c) __builtin_amdgcn_mfma_f32_16x16x32_bf16((a), (b), (c), 0, 0, 0)

__device__ void phase_convert(const Params& p, unsigned char* smem_) {
    unsigned char* smem = launder_lds(smem_);
    float* tile = (float*)smem;
    const int tid = tid_l();
    constexpr int NT_IN = 16 * 108, NT_OUT = 32 * 16, PER_L = NT_IN + NT_OUT;
    for (int it = blockIdx.x; it < 2 * PER_L; it += gridDim.x) {
        const int l = it / PER_L; int r = it % PER_L;
        const float* src; bf16_t* dst; int K, Nsrc, kt, nt;
        if (r < NT_IN) { src = p.in[I_WIN] + (size_t)l * 1024 * NIN; dst = (bf16_t*)(p.ws + WS_WINT) + (size_t)l * N1 * 1024; K = 1024; Nsrc = NIN; kt = r & 15; nt = r >> 4; }
        else { r -= NT_IN; src = p.in[I_WOUT] + (size_t)l * 2048 * 1024; dst = (bf16_t*)(p.ws + WS_WOUTT) + (size_t)l * 1024 * 2048; K = 2048; Nsrc = 1024; kt = r & 31; nt = r >> 5; }
#pragma unroll
        for (int i = 0; i < 2; ++i) {
            const int rr = (tid >> 4) + 32 * i, c4 = (tid & 15) * 4, col = nt * 64 + c4;
            float4 v = make_float4(0.f, 0.f, 0.f, 0.f);
            if (col < Nsrc) v = *(const float4*)(src + (size_t)(kt * 64 + rr) * Nsrc + col);
            float* tp = tile + rr * 65 + c4; tp[0] = v.x; tp[1] = v.y; tp[2] = v.z; tp[3] = v.w;
        }
        __syncthreads();
        { const int n = tid >> 3, k8 = (tid & 7) * 8; float f[8];
#pragma unroll
          for (int j = 0; j < 8; ++j) f[j] = tile[(k8 + j) * 65 + n];
          *(u32x4*)(dst + (size_t)(nt * 64 + n) * K + kt * 64 + k8) = pack8(f); }
        __syncthreads();
    }
}

__device__ void phase_norm(const Params& p, int l) {
    const int tid_ = tid_l(); const int lane = tid_ & 63, wid = tid_ >> 6;
    bf16_t* A1 = (bf16_t*)(p.ws + WS_A);
    const float* nw = p.in[I_NORMW] + l * 1024;
    for (int row = blockIdx.x * 8 + wid; row < M1; row += gridDim.x * 8) {
        const float* src;
        if (row < TP) src = (l == 0 ? p.in[I_XP] : p.out + O_YP) + (size_t)row * 1024;
        else if (row < TALL) src = (l == 0 ? p.in[I_XS] : p.out + O_YS) + (size_t)(row - TP) * 1024;
        else src = p.in[I_SSHIFT] + ((size_t)l * TS + (row - TALL)) * 1024;
        float4 v[4]; float ss = 0.f;
#pragma unroll
        for (int i = 0; i < 4; ++i) v[i] = *(const float4*)(src + i * 256 + lane * 4);
        if (l == 1 && row >= TP && row < TALL) {
            const float* x0 = p.in[I_XS] + (size_t)(row - TP) * 1024; const float* pt = (const float*)(p.ws + WS_PART) + (size_t)(row - TP) * 1024;
#pragma unroll
            for (int i = 0; i < 4; ++i) { float4 a = *(const float4*)(x0 + i * 256 + lane * 4);
                for (int q = 0; q < 16; ++q) { const float4 t = *(const float4*)(pt + (size_t)q * TS * 1024 + i * 256 + lane * 4); a.x += t.x; a.y += t.y; a.z += t.z; a.w += t.w; }
                v[i] = a; *(float4*)(p.out + O_YS + (size_t)(row - TP) * 1024 + i * 256 + lane * 4) = a; }
        }
#pragma unroll
        for (int i = 0; i < 4; ++i) ss += v[i].x * v[i].x + v[i].y * v[i].y + v[i].z * v[i].z + v[i].w * v[i].w;
        if (row < TALL) {
            ss = wave_sum(ss);
            const float rs = rsqrtf(ss * (1.0f / 1024.0f) + 1e-5f);
#pragma unroll
            for (int i = 0; i < 4; ++i) { const float4 w = *(const float4*)(nw + i * 256 + lane * 4); v[i].x *= rs * w.x; v[i].y *= rs * w.y; v[i].z *= rs * w.z; v[i].w *= rs * w.w; }
            float* so = nullptr;
            if (row < TP) { if ((row & 2047) == 2047) so = p.out + O_PSH + ((size_t)l * 8 + (row >> 11)) * 1024; }
            else so = p.out + O_SSH + ((size_t)l * TS + (row - TP)) * 1024;
            if (so) {
#pragma unroll
                for (int i = 0; i < 4; ++i) *(float4*)(so + i * 256 + lane * 4) = v[i]; }
        }
#pragma unroll
        for (int i = 0; i < 4; ++i) { u32x2 w; w.x = pk2(v[i].x, v[i].y); w.y = pk2(v[i].z, v[i].w); *(u32x2*)(A1 + (size_t)row * 1024 + i * 256 + lane * 4) = w; }
    }
}

__device__ void phase_final(const Params& p) {
    const int tid_ = tid_l(); const int lane = tid_ & 63, wid = tid_ >> 6;
    const float* nw = p.in[I_FNW];
    for (int row = blockIdx.x * 8 + wid; row < TALL; row += gridDim.x * 8) {
        float* src = (row < TP) ? p.out + O_YP + (size_t)row * 1024 : p.out + O_YS + (size_t)(row - TP) * 1024;
        float4 v[4]; float ss = 0.f;
#pragma unroll
        for (int i = 0; i < 4; ++i) v[i] = *(const float4*)(src + i * 256 + lane * 4);
        if (row >= TP) { const float* pt = (const float*)(p.ws + WS_PART) + (size_t)(row - TP) * 1024;
#pragma unroll
            for (int i = 0; i < 4; ++i) for (int q = 0; q < 16; ++q) { const float4 t = *(const float4*)(pt + (size_t)q * TS * 1024 + i * 256 + lane * 4); v[i].x += t.x; v[i].y += t.y; v[i].z += t.z; v[i].w += t.w; } }
#pragma unroll
        for (int i = 0; i < 4; ++i) ss += v[i].x * v[i].x + v[i].y * v[i].y + v[i].z * v[i].z + v[i].w * v[i].w;
        ss = wave_sum(ss);
        const float rs = rsqrtf(ss * (1.0f / 1024.0f) + 1e-5f);
#pragma unroll
        for (int i = 0; i < 4; ++i) { const float4 w = *(const float4*)(nw + i * 256 + lane * 4); v[i].x *= rs * w.x; v[i].y *= rs * w.y; v[i].z *= rs * w.z; v[i].w *= rs * w.w;
            *(float4*)(src + i * 256 + lane * 4) = v[i]; }
    }
}

struct EpiP {
    static constexpr bool PERM = true, AFTER_DRAIN = false;
    bf16_t* O; int ldc;
    __device__ __forceinline__ void operator()(const f32x4 (&acc)[2][2][4][2], const pg8::Unit& u, int wr, int wc, int fr, int fq) const {
        const int row0 = u.pm * 256 + wr * 64 + fr, col0 = u.pn * 256 + wc * 32 + 8 * fq;
#pragma unroll
        for (int ai = 0; ai < 2; ++ai)
#pragma unroll
            for (int m = 0; m < 4; ++m) { bf16_t* rowp = O + (size_t)(row0 + ai * 128 + m * 16) * ldc + col0;
#pragma unroll
                for (int bj = 0; bj < 2; ++bj) { const f32x4 v0 = acc[ai][bj][m][0], v1 = acc[ai][bj][m][1];
                    u32x4 w; w.x = pg8::cvt_pk_bf16(v0[0], v0[1]); w.y = pg8::cvt_pk_bf16(v0[2], v0[3]); w.z = pg8::cvt_pk_bf16(v1[0], v1[1]); w.w = pg8::cvt_pk_bf16(v1[2], v1[3]);
                    *(u32x4*)(rowp + bj * 128) = w; } }
    }
};
struct EpiRes {
    static constexpr bool PERM = false, AFTER_DRAIN = false;
    const float* res_p; float* out_p;
    __device__ __forceinline__ void operator()(const f32x4 (&acc)[2][2][4][2], const pg8::Unit& u, int wr, int wc, int fr, int fq) const {
        const int row0 = u.pm * 256 + wr * 64 + fr, col0 = u.pn * 256 + wc * 32 + 4 * fq;
#pragma unroll
        for (int ai = 0; ai < 2; ++ai)
#pragma unroll
            for (int m = 0; m < 4; ++m) { const size_t ro = (size_t)(row0 + ai * 128 + m * 16) * 1024;
#pragma unroll
                for (int bj = 0; bj < 2; ++bj)
#pragma unroll
                    for (int n = 0; n < 2; ++n) { const int c = col0 + bj * 128 + n * 16; const f32x4 r = *(const f32x4*)(res_p + ro + c); *(f32x4*)(out_p + ro + c) = acc[ai][bj][m][n] + r; } }
    }
};

__device__ void rwkv_scan_item(const Params& p, int l, int item, unsigned char* smem_) {
    unsigned char* smem = launder_lds(smem_);
    const int tid = tid_l(), wid = tid >> 6, lane = tid & 63;
    const int b = item >> 5, h = (item >> 1) & 15, half = item & 1;
    float* vec = (float*)smem;
    float* vrow = vec + 20480;
    float* sc = vrow + 2048;
    float* exw = sc + 128;
    float* exa = exw + 2048;
    bf16_t* tw = (bf16_t*)(exa + 2048);
    bf16_t* ta = tw + 4608;
    bf16_t* w2t = ta + 4608;
    bf16_t* a2t = w2t + 4608;
    float* cst = (float*)(a2t + 4608);
    const bf16_t* P = (const bf16_t*)(p.ws + WS_P);
    float* ORAW = (float*)(p.ws + WS_ORAW);
    bf16_t* BV = (bf16_t*)(p.ws + WS_BV);
    __syncthreads();
    for (int i = tid; i < 9216; i += 512) tw[i] = 0;
    { const float* w2 = p.in[I_W2] + (size_t)l * 64 * 1024 + h * 64; const float* a2 = p.in[I_A2] + (size_t)l * 64 * 1024 + h * 64;
#pragma unroll
      for (int i = 0; i < 8; ++i) { const int idx = tid + 512 * i, k = idx >> 6, n = idx & 63; w2t[n * 72 + k] = f2bf(w2[(size_t)k * 1024 + n]); a2t[n * 72 + k] = f2bf(a2[(size_t)k * 1024 + n]); } }
    if (tid < 64) { const float* mu = p.in[I_MU] + (size_t)l * 3200; const int gc = h * 64 + tid;
        cst[tid] = mu[C_R + gc]; cst[64 + tid] = mu[C_K + gc]; cst[128 + tid] = mu[C_V + gc]; cst[192 + tid] = mu[C_WL + tid]; cst[256 + tid] = mu[C_AL + tid];
        cst[320 + tid] = p.in[I_KK][l * 1024 + gc]; cst[384 + tid] = p.in[I_KA][l * 1024 + gc]; cst[448 + tid] = p.in[I_RK][l * 1024 + gc];
        cst[512 + tid] = p.in[I_W0][l * 1024 + gc]; cst[576 + tid] = p.in[I_A0][l * 1024 + gc]; }
    __syncthreads();

    if (wid >= 4) {
        const int hw = wid - 4, tok = lane >> 3, cg8 = lane & 7, c0 = cg8 * 8, fr = lane & 15, fq = lane >> 4;
        const float* mu_r = cst + c0; const float* mu_k = cst + 64 + c0; const float* mu_v = cst + 128 + c0; const float* mu_wl = cst + 192 + c0; const float* mu_al = cst + 256 + c0;
        const float* kkc = cst + 320 + c0; const float* kac = cst + 384 + c0; const float* rkc = cst + 448 + c0;
        float w0c[4], a0c[4];
#pragma unroll
        for (int ct = 0; ct < 4; ++ct) { w0c[ct] = cst[512 + ct * 16 + fr]; a0c[ct] = cst[576 + ct * 16 + fr]; }
        u32x4 qc[5], qp[5];
        const int segcol[5] = {C_R + h * 64 + c0, C_K + h * 64 + c0, C_V + h * 64 + c0, C_WL + c0, C_AL + c0};
#define HLOAD(C) { const int t_ = (C) * 32 + hw * 8 + tok; const bf16_t* pr_ = P + ((size_t)b * 2048 + t_) * N1; \
            _Pragma("unroll") for (int sg = 0; sg < 5; ++sg) { qc[sg] = *(const u32x4*)(pr_ + segcol[sg]); if (t_ > 0) qp[sg] = *(const u32x4*)(pr_ - N1 + segcol[sg]); else qp[sg] = (u32x4){0u, 0u, 0u, 0u}; } }
        HLOAD(0)
        for (int c = 0; c < 64; ++c) {
            const int buf = c & 1, tt = hw * 8 + tok, t = c * 32 + tt;
            const size_t grow = (size_t)b * 2048 + t;
            float xr[8], xk[8], xv[8], xw[8], xa[8];
            { float cur[8], prv[8];
#define LERP_SEG(dst, sg, muv) { unpack8(qc[sg], cur); unpack8(qp[sg], prv); _Pragma("unroll") for (int e = 0; e < 8; ++e) dst[e] = cur[e] + (prv[e] - cur[e]) * muv[e]; }
              LERP_SEG(xr, 0, mu_r) LERP_SEG(xk, 1, mu_k) LERP_SEG(xv, 2, mu_v) LERP_SEG(xw, 3, mu_wl) LERP_SEG(xa, 4, mu_al)
#undef LERP_SEG
            }
            if (c + 1 < 64) HLOAD(c + 1)
#pragma unroll
            for (int e = 0; e < 8; ++e) xw[e] = 1.0f - 2.0f / (__expf(2.0f * xw[e]) + 1.0f);
            *(u32x4*)(tw + (hw * 16 + tok) * 72 + c0) = pack8(xw);
            *(u32x4*)(ta + (hw * 16 + tok) * 72 + c0) = pack8(xa);
            lds_fence();
#pragma unroll
            for (int ct = 0; ct < 4; ++ct) {
                f32x4 aw = {0.f, 0.f, 0.f, 0.f}, aa = {0.f, 0.f, 0.f, 0.f};
#pragma unroll
                for (int ks = 0; ks < 2; ++ks) {
                    const bf16x8 fa = *(const bf16x8*)(tw + (hw * 16 + fr) * 72 + ks * 32 + fq * 8), fb = *(const bf16x8*)(w2t + (ct * 16 + fr) * 72 + ks * 32 + fq * 8);
                    aw = MFMA16(fa, fb, aw);
                    const bf16x8 ga = *(const bf16x8*)(ta + (hw * 16 + fr) * 72 + ks * 32 + fq * 8), gb = *(const bf16x8*)(a2t + (ct * 16 + fr) * 72 + ks * 32 + fq * 8);
                    aa = MFMA16(ga, gb, aa);
                }
                if (lane < 32) {
#pragma unroll
                    for (int j = 0; j < 4; ++j) { const int tj = fq * 4 + j, col = ct * 16 + fr;
                        const float sg = sigmoidf_(w0c[ct] + aw[j]);
                        exw[(hw * 8 + tj) * 64 + col] = __expf(-0.60653066f * sg);
                        exa[(hw * 8 + tj) * 64 + col] = sigmoidf_(a0c[ct] + aa[j]); }
                }
            }
            lds_fence();
            float w8[8], a8[8];
            { const float4 q0 = *(const float4*)(exw + (hw * 8 + tok) * 64 + c0), q1 = *(const float4*)(exw + (hw * 8 + tok) * 64 + c0 + 4);
              w8[0] = q0.x; w8[1] = q0.y; w8[2] = q0.z; w8[3] = q0.w; w8[4] = q1.x; w8[5] = q1.y; w8[6] = q1.z; w8[7] = q1.w;
              const float4 r0 = *(const float4*)(exa + (hw * 8 + tok) * 64 + c0), r1 = *(const float4*)(exa + (hw * 8 + tok) * 64 + c0 + 4);
              a8[0] = r0.x; a8[1] = r0.y; a8[2] = r0.z; a8[3] = r0.w; a8[4] = r1.x; a8[5] = r1.y; a8[6] = r1.z; a8[7] = r1.w; }
            float kk[8], kp[8], bb[8], wr[8]; float ssq = 0.f, br = 0.f, kr = 0.f, beta = 0.f;
#pragma unroll
            for (int e = 0; e < 8; ++e) { kk[e] = xk[e] * kkc[e]; ssq += kk[e] * kk[e]; }
            ssq = red8(ssq);
            const float inv = 1.0f / fmaxf(sqrtf(ssq), 1e-12f);
#pragma unroll
            for (int e = 0; e < 8; ++e) { kk[e] *= inv; kp[e] = xk[e] * (1.0f + (a8[e] - 1.0f) * kac[e]); bb[e] = -kk[e] * a8[e]; wr[e] = w8[e] * xr[e];
                br += bb[e] * xr[e]; kr += kp[e] * xr[e]; beta += xr[e] * kp[e] * rkc[e]; }
            br = red8(br); kr = red8(kr); beta = red8(beta);
            float* vb = vec + (size_t)((buf * 32 + tt) * 5) * 64 + c0;
#define ST8(ptr, arr) { *(float4*)(ptr) = make_float4(arr[0], arr[1], arr[2], arr[3]); *(float4*)((ptr) + 4) = make_float4(arr[4], arr[5], arr[6], arr[7]); }
            ST8(vb, w8) ST8(vb + 64, kk) ST8(vb + 128, bb) ST8(vb + 192, kp) ST8(vb + 256, wr)
            if (cg8 == 0) { sc[(buf * 32 + tt) * 2] = br; sc[(buf * 32 + tt) * 2 + 1] = kr; }
            if ((cg8 >> 2) == half) {
                float* vp = vrow + (buf * 32 + tt) * 32 + (c0 - half * 32);
                ST8(vp, xv)
                float bvv[8];
#pragma unroll
                for (int e = 0; e < 8; ++e) bvv[e] = beta * xv[e];
                *(u32x4*)(BV + grow * 1024 + h * 64 + c0) = pack8(bvv);
            }
#undef ST8
            LBAR();
        }
        LBAR();
    } else {
        typedef float f2 __attribute__((ext_vector_type(2)));
        const int rg = lane >> 4, cg = lane & 15, rho0 = wid * 8 + rg * 2;
        f2 T0 = {0.f, 0.f}, T1 = T0, T2 = T0, T3 = T0;
        LBAR();
#define SCAN_LOAD(W, KK, B, KP, WR, VV, S2, TT) { const float* vb_ = vec + (size_t)((buf * 32 + (TT)) * 5) * 64 + cg * 4; \
            W = *(const float4*)(vb_); KK = *(const float4*)(vb_ + 64); B = *(const float4*)(vb_ + 128); KP = *(const float4*)(vb_ + 192); WR = *(const float4*)(vb_ + 256); \
            VV = *(const f2*)(vrow + (buf * 32 + (TT)) * 32 + rho0); S2 = *(const f2*)(sc + (buf * 32 + (TT)) * 2); }
#define SCAN_STEP(W, KK, B, KP, WR, VV, S2, TT) { \
            f2 aK = T0 * KK.x; f2 aR = T0 * WR.x; aK += T1 * KK.y; aR += T1 * WR.y; aK += T2 * KK.z; aR += T2 * WR.z; aK += T3 * KK.w; aR += T3 * WR.w; \
            float k0 = aK.x, k1 = aK.y, r0 = aR.x, r1 = aR.y; \
            asm volatile("s_nop 1\n" \
                "v_add_f32_dpp %0, %0, %0 quad_perm:[1,0,3,2] row_mask:0xf bank_mask:0xf bound_ctrl:1\n" "v_add_f32_dpp %1, %1, %1 quad_perm:[1,0,3,2] row_mask:0xf bank_mask:0xf bound_ctrl:1\n" \
                "v_add_f32_dpp %2, %2, %2 quad_perm:[1,0,3,2] row_mask:0xf bank_mask:0xf bound_ctrl:1\n" "v_add_f32_dpp %3, %3, %3 quad_perm:[1,0,3,2] row_mask:0xf bank_mask:0xf bound_ctrl:1\n" \
                "v_add_f32_dpp %0, %0, %0 quad_perm:[2,3,0,1] row_mask:0xf bank_mask:0xf bound_ctrl:1\n" "v_add_f32_dpp %1, %1, %1 quad_perm:[2,3,0,1] row_mask:0xf bank_mask:0xf bound_ctrl:1\n" \
                "v_add_f32_dpp %2, %2, %2 quad_perm:[2,3,0,1] row_mask:0xf bank_mask:0xf bound_ctrl:1\n" "v_add_f32_dpp %3, %3, %3 quad_perm:[2,3,0,1] row_mask:0xf bank_mask:0xf bound_ctrl:1\n" \
                "v_add_f32_dpp %0, %0, %0 row_half_mirror row_mask:0xf bank_mask:0xf bound_ctrl:1\n" "v_add_f32_dpp %1, %1, %1 row_half_mirror row_mask:0xf bank_mask:0xf bound_ctrl:1\n" \
                "v_add_f32_dpp %2, %2, %2 row_half_mirror row_mask:0xf bank_mask:0xf bound_ctrl:1\n" "v_add_f32_dpp %3, %3, %3 row_half_mirror row_mask:0xf bank_mask:0xf bound_ctrl:1\n" \
                "v_add_f32_dpp %0, %0, %0 row_mirror row_mask:0xf bank_mask:0xf bound_ctrl:1\n" "v_add_f32_dpp %1, %1, %1 row_mirror row_mask:0xf bank_mask:0xf bound_ctrl:1\n" \
                "v_add_f32_dpp %2, %2, %2 row_mirror row_mask:0xf bank_mask:0xf bound_ctrl:1\n" "v_add_f32_dpp %3, %3, %3 row_mirror row_mask:0xf bank_mask:0xf bound_ctrl:1\n" \
                "s_nop 1\n" \
                : "+v"(k0), "+v"(k1), "+v"(r0), "+v"(r1)); \
            const f2 dK = {k0, k1}; f2 oo = {r0, r1}; oo += dK * S2.x; oo += VV * S2.y; \
            if (cg == 0) *(f2*)(op + (size_t)(TT) * 1024) = oo; \
            T0 = T0 * W.x + dK * B.x + VV * KP.x; T1 = T1 * W.y + dK * B.y + VV * KP.y; T2 = T2 * W.z + dK * B.z + VV * KP.z; T3 = T3 * W.w + dK * B.w + VV * KP.w; }
        for (int c = 0; c < 64; ++c) {
            const int buf = c & 1;
            float* op = ORAW + ((size_t)b * 2048 + c * 32) * 1024 + h * 64 + half * 32 + rho0;
            float4 Wa, KKa, Ba, KPa, WRa, Wb, KKb, Bb, KPb, WRb; f2 VVa, S2a, VVb, S2b;
            SCAN_LOAD(Wa, KKa, Ba, KPa, WRa, VVa, S2a, 0)
            for (int tt = 0; tt < 32; tt += 2) {
                SCAN_LOAD(Wb, KKb, Bb, KPb, WRb, VVb, S2b, tt + 1)
                SCAN_STEP(Wa, KKa, Ba, KPa, WRa, VVa, S2a, tt)
                if (tt + 2 < 32) SCAN_LOAD(Wa, KKa, Ba, KPa, WRa, VVa, S2a, tt + 2)
                SCAN_STEP(Wb, KKb, Bb, KPb, WRb, VVb, S2b, tt + 1)
            }
            LBAR();
        }
#undef SCAN_LOAD
#undef SCAN_STEP
        float* so = p.out + O_PWKV + ((((size_t)l * 8 + b) * 16 + h) * 64 + half * 32 + rho0) * 64 + cg * 4;
        *(float4*)so = make_float4(T0.x, T1.x, T2.x, T3.x); *(float4*)(so + 64) = make_float4(T0.y, T1.y, T2.y, T3.y);
    }
}

__device__ void rwkv_sample_item(const Params& p, int l, int item, unsigned char* smem_) {
    unsigned char* smem = launder_lds(smem_);
    const int tid = tid_l(), lane = tid & 63, ks = tid >> 6;
    const int i = item >> 4, h = item & 15;
    float* part = (float*)smem;
    float* sv = part + 1024;
    float* s_sc = sv + 384;
    const bf16_t* P = (const bf16_t*)(p.ws + WS_P);
    float* ORAW = (float*)(p.ws + WS_ORAW);
    bf16_t* BV = (bf16_t*)(p.ws + WS_BV);
    const size_t rowp = (size_t)TP + i, rows = (size_t)TALL + i;
    const bf16_t* pc = P + rowp * N1; const bf16_t* pp = P + rows * N1;
    const float* mu = p.in[I_MU] + (size_t)l * 3200;
    const int gc = h * 64 + lane;
    const int row = tid >> 3, cs = (tid & 7) * 8;
    const size_t so = ((((size_t)l * TS + i) * 16 + h) * 64 + row) * 64 + cs;
    const float4 a0 = *(const float4*)(p.in[I_SWKV] + so), a1 = *(const float4*)(p.in[I_SWKV] + so + 4);
#define LERP1(col) (bf2f(pc[col]) + (bf2f(pp[col]) - bf2f(pc[col])) * mu[col])
    { const float* w2 = p.in[I_W2] + (size_t)l * 64 * 1024 + gc; const float* a2 = p.in[I_A2] + (size_t)l * 64 * 1024 + gc;
      float lw = 0.f, la = 0.f;
#pragma unroll
      for (int kk = 0; kk < 8; ++kk) { const int k = ks * 8 + kk; const float xwl = LERP1(C_WL + k), xal = LERP1(C_AL + k);
          lw += (1.0f - 2.0f / (__expf(2.0f * xwl) + 1.0f)) * w2[(size_t)k * 1024]; la += xal * a2[(size_t)k * 1024]; }
      __syncthreads();
      part[ks * 64 + lane] = lw; part[512 + ks * 64 + lane] = la; }
    __syncthreads();
    if (tid < 64) {
        const float xr = LERP1(C_R + gc), xk = LERP1(C_K + gc), xv = LERP1(C_V + gc);
        float lw = 0.f, la = 0.f;
#pragma unroll
        for (int q = 0; q < 8; ++q) { lw += part[q * 64 + lane]; la += part[512 + q * 64 + lane]; }
        const float w = __expf(-0.60653066f * sigmoidf_(p.in[I_W0][l * 1024 + gc] + lw));
        const float a = sigmoidf_(p.in[I_A0][l * 1024 + gc] + la);
        float kk = xk * p.in[I_KK][l * 1024 + gc];
        const float ssq = wave_sum(kk * kk);
        kk *= 1.0f / fmaxf(sqrtf(ssq), 1e-12f);
        const float kp = xk * (1.0f + (a - 1.0f) * p.in[I_KA][l * 1024 + gc]);
        const float bb = -kk * a, wr = w * xr;
        const float br = wave_sum(bb * xr), kr = wave_sum(kp * xr), beta = wave_sum(xr * kp * p.in[I_RK][l * 1024 + gc]);
        sv[lane] = w; sv[64 + lane] = kk; sv[128 + lane] = bb; sv[192 + lane] = kp; sv[256 + lane] = wr; sv[320 + lane] = xv;
        if (lane == 0) { s_sc[0] = br; s_sc[1] = kr; }
        BV[rowp * 1024 + gc] = f2bf(beta * xv);
    }
#undef LERP1
    __syncthreads();
    {
        float S[8] = {a0.x, a0.y, a0.z, a0.w, a1.x, a1.y, a1.z, a1.w};
        float dk = 0.f, dr = 0.f;
#pragma unroll
        for (int e = 0; e < 8; ++e) { dk += S[e] * sv[64 + cs + e]; dr += S[e] * sv[256 + cs + e]; }
        dk = red8(dk); dr = red8(dr);
        const float vr = sv[320 + row];
        const float o = dr + dk * s_sc[0] + vr * s_sc[1];
        if ((tid & 7) == 0) ORAW[rowp * 1024 + h * 64 + row] = o;
#pragma unroll
        for (int e = 0; e < 8; ++e) S[e] = S[e] * sv[cs + e] + dk * sv[128 + cs + e] + vr * sv[192 + cs + e];
        float* sout = p.out + O_SWKV + so;
        *(float4*)sout = make_float4(S[0], S[1], S[2], S[3]); *(float4*)(sout + 4) = make_float4(S[4], S[5], S[6], S[7]);
    }
}

__device__ void phase_conv(const Params& p, int l) {
    const int tid = tid_l();
    const bf16_t* P = (const bf16_t*)(p.ws + WS_P);
    bf16_t* U = (bf16_t*)(p.ws + WS_U); float* DT = (float*)(p.ws + WS_DT);
    for (int id = blockIdx.x * 512 + tid; id < 1024 * 384; id += gridDim.x * 512) {
        const int q = id % 384, seg = id / 384, xcol = q * 4;
        const int bb = seg >> 7, tb = (seg & 127) * 16;
        float4 cw0, cw1, cw2, cw3, cbv;
        { const float* cw = p.in[I_CW] + (size_t)l * 4 * 1536 + xcol; cw0 = *(const float4*)cw; cw1 = *(const float4*)(cw + 1536); cw2 = *(const float4*)(cw + 3072); cw3 = *(const float4*)(cw + 4608);
          cbv = *(const float4*)(p.in[I_CB] + (size_t)l * 1536 + xcol); }
        const bf16_t* pb = P + ((size_t)bb * 2048 + tb) * N1 + C_XBC + xcol;
        bf16_t* ub = U + ((size_t)bb * 2048 + tb) * 1536 + xcol;
        float4 w0 = make_float4(0.f, 0.f, 0.f, 0.f), w1 = w0, w2 = w0;
#define LD4(dst, ptr) { const u32x2 _v = *(const u32x2*)(ptr); dst = make_float4(__uint_as_float(_v.x << 16), __uint_as_float(_v.x & 0xffff0000u), __uint_as_float(_v.y << 16), __uint_as_float(_v.y & 0xffff0000u)); }
        if (tb >= 3) { LD4(w0, pb - 3 * (size_t)N1) LD4(w1, pb - 2 * (size_t)N1) LD4(w2, pb - (size_t)N1) }
#pragma unroll
        for (int s = 0; s < 16; ++s) {
            float4 cur; LD4(cur, pb + (size_t)s * N1)
            float4 u;
            u.x = cbv.x + cw0.x * w0.x + cw1.x * w1.x + cw2.x * w2.x + cw3.x * cur.x; u.y = cbv.y + cw0.y * w0.y + cw1.y * w1.y + cw2.y * w2.y + cw3.y * cur.y;
            u.z = cbv.z + cw0.z * w0.z + cw1.z * w1.z + cw2.z * w2.z + cw3.z * cur.z; u.w = cbv.w + cw0.w * w0.w + cw1.w * w1.w + cw2.w * w2.w + cw3.w * cur.w;
            u32x2 pk; pk.x = pk2(siluf_(u.x), siluf_(u.y)); pk.y = pk2(siluf_(u.z), siluf_(u.w));
            *(u32x2*)(ub + (size_t)s * 1536) = pk;
            w0 = w1; w1 = w2; w2 = cur;
        }
#undef LD4
    }
    for (int id = blockIdx.x * 512 + tid; id < TP * 16; id += gridDim.x * 512) {
        const int t = id >> 4, j = id & 15;
        DT[id] = softplusf_(bf2f(P[(size_t)t * N1 + C_DT + j]) + p.in[I_DTB][l * 16 + j]);
    }
}

__device__ void mamba_item(const Params& p, int l, int item, unsigned char* smem_) {
    unsigned char* smem = launder_lds(smem_);
    const int tid = tid_l(), wid = tid >> 6, lane = tid & 63, fr = lane & 15, fq = lane >> 4;
    const int b = item >> 5, j = (item >> 1) & 15, ph = item & 1, g = j >> 3;
    bf16_t* Cm = (bf16_t*)smem;
    bf16_t* Bm = (bf16_t*)(smem + 17408);
    bf16_t* BmT = (bf16_t*)(smem + 34816);
    bf16_t* XT = (bf16_t*)(smem + 53248);
    bf16_t* XwT = (bf16_t*)(smem + 57856);
    bf16_t* G = (bf16_t*)(smem + 62464);
    bf16_t* Hb = (bf16_t*)(smem + 71680);
    float* acs = (float*)(smem + 80384);
    float* dtv = acs + 64;
    const bf16_t* P = (const bf16_t*)(p.ws + WS_P);
    const bf16_t* U = (const bf16_t*)(p.ws + WS_U); const float* DT = (const float*)(p.ws + WS_DT);
    bf16_t* YM = (bf16_t*)(p.ws + WS_YM);
    __syncthreads();
    for (int i = tid; i < 32 * 136; i += 512) Hb[i] = 0;
    const float Aj = -__expf(p.in[I_ALOG][l * 16 + j]), Dj = p.in[I_DSK][l * 16 + j];
    const int s_a = tid >> 4, c16 = tid & 15, s_x = (tid >> 2) & 63, c4 = tid & 3;
    const int lt = wid >> 1, pt = wid & 1;
    const bf16_t* ub = U + (size_t)b * 2048 * 1536;
    u32x4 rb0, rb1, rc0, rc1, rx = {0u, 0u, 0u, 0u}; float rdt = 0.f;
#define LOADCHUNK(T0) { const bf16_t* r0 = ub + (size_t)((T0) + s_a) * 1536 + g * 128 + c16 * 8; const bf16_t* r1 = r0 + 32 * 1536; \
        rb0 = *(const u32x4*)(r0 + 1024); rb1 = *(const u32x4*)(r1 + 1024); rc0 = *(const u32x4*)(r0 + 1280); rc1 = *(const u32x4*)(r1 + 1280); \
        if (tid < 256) rx = *(const u32x4*)(ub + (size_t)((T0) + s_x) * 1536 + j * 64 + ph * 32 + c4 * 8); \
        if (wid == 5) rdt = DT[((size_t)b * 2048 + (T0) + lane) * 16 + j]; }
    LOADCHUNK(0)
    f32x4 hacc[2] = {{0.f, 0.f, 0.f, 0.f}, {0.f, 0.f, 0.f, 0.f}};
    for (int c = 0; c < 32; ++c) {
        const int t0 = c * 64;
        float zq[4];
#pragma unroll
        for (int jj = 0; jj < 4; ++jj) zq[jj] = bf2f(P[((size_t)b * 2048 + t0 + lt * 16 + fq * 4 + jj) * N1 + C_ZM + j * 64 + ph * 32 + pt * 16 + fr]);
        *(u32x4*)(Cm + s_a * 136 + c16 * 8) = rc0; *(u32x4*)(Cm + (s_a + 32) * 136 + c16 * 8) = rc1;
        *(u32x4*)(Bm + s_a * 136 + c16 * 8) = rb0; *(u32x4*)(Bm + (s_a + 32) * 136 + c16 * 8) = rb1;
#pragma unroll
        for (int e = 0; e < 8; ++e) { const unsigned v0 = rb0[e >> 1], v1 = rb1[e >> 1];
            BmT[(c16 * 8 + e) * 72 + s_a] = (bf16_t)((e & 1) ? (v0 >> 16) : (v0 & 0xffffu)); BmT[(c16 * 8 + e) * 72 + s_a + 32] = (bf16_t)((e & 1) ? (v1 >> 16) : (v1 & 0xffffu)); }
        if (tid < 256) {
#pragma unroll
            for (int e = 0; e < 8; ++e) { const unsigned v0 = rx[e >> 1]; XT[(c4 * 8 + e) * 72 + s_x] = (bf16_t)((e & 1) ? (v0 >> 16) : (v0 & 0xffffu)); }
        }
        if (wid == 5) {
            float v = rdt * Aj;
#pragma unroll
            for (int off = 1; off < 64; off <<= 1) { const float t = __shfl_up(v, off); if (lane >= off) v += t; }
            acs[lane] = v; dtv[lane] = rdt;
        }
        if (c + 1 < 32) LOADCHUNK(t0 + 64)
        LBAR();
        { const int pp = tid & 31, s4 = (tid >> 5) * 4; const float aend = acs[63];
          const u32x2 xv = *(const u32x2*)(XT + pp * 72 + s4);
          const float x0 = __uint_as_float(xv.x << 16), x1 = __uint_as_float(xv.x & 0xffff0000u), x2 = __uint_as_float(xv.y << 16), x3 = __uint_as_float(xv.y & 0xffff0000u);
          u32x2 bq; bq.x = pk2(x0 * dtv[s4] * __expf(aend - acs[s4]), x1 * dtv[s4 + 1] * __expf(aend - acs[s4 + 1]));
          bq.y = pk2(x2 * dtv[s4 + 2] * __expf(aend - acs[s4 + 2]), x3 * dtv[s4 + 3] * __expf(aend - acs[s4 + 3]));
          *(u32x2*)(XwT + pp * 72 + s4) = bq; }
#pragma unroll
        for (int e = 0; e < 2; ++e) {
            const int id = wid * 2 + e, glt = id >> 2, st = id & 3;
            f32x4 acc = {0.f, 0.f, 0.f, 0.f};
            if (st <= glt) {
#pragma unroll
                for (int ks = 0; ks < 4; ++ks) { const bf16x8 fa = *(const bf16x8*)(Cm + (glt * 16 + fr) * 136 + ks * 32 + fq * 8), fb = *(const bf16x8*)(Bm + (st * 16 + fr) * 136 + ks * 32 + fq * 8); acc = MFMA16(fa, fb, acc); }
            }
#pragma unroll
            for (int jj = 0; jj < 4; ++jj) { const int lr = glt * 16 + fq * 4 + jj, s = st * 16 + fr;
                const float val = (s <= lr) ? acc[jj] * __expf(acs[lr] - acs[s]) * dtv[s] : 0.f;
                G[lr * 72 + s] = f2bf(val); }
        }
        f32x4 accO = {0.f, 0.f, 0.f, 0.f};
#pragma unroll
        for (int ks = 0; ks < 4; ++ks) { const bf16x8 fa = *(const bf16x8*)(Cm + (lt * 16 + fr) * 136 + ks * 32 + fq * 8), fb = *(const bf16x8*)(Hb + (pt * 16 + fr) * 136 + ks * 32 + fq * 8); accO = MFMA16(fa, fb, accO); }
        LBAR();
        {
            f32x4 accD = {0.f, 0.f, 0.f, 0.f};
#pragma unroll
            for (int ks = 0; ks < 2; ++ks) { const bf16x8 fa = *(const bf16x8*)(G + (lt * 16 + fr) * 72 + ks * 32 + fq * 8), fb = *(const bf16x8*)(XT + (pt * 16 + fr) * 72 + ks * 32 + fq * 8); accD = MFMA16(fa, fb, accD); }
#pragma unroll
            for (int jj = 0; jj < 4; ++jj) { const int lr = lt * 16 + fq * 4 + jj, pp = pt * 16 + fr;
                float y = accD[jj] + __expf(acs[lr]) * accO[jj] + Dj * bf2f(XT[pp * 72 + lr]);
                y *= siluf_(zq[jj]);
                YM[((size_t)b * 2048 + t0 + lr) * 1024 + j * 64 + ph * 32 + pp] = f2bf(y); }
            const float cd = __expf(acs[63]); const int ptile = wid >> 2;
#pragma unroll
            for (int e = 0; e < 2; ++e) { const int nt = (wid & 3) * 2 + e;
                hacc[e] *= cd;
#pragma unroll
                for (int ks = 0; ks < 2; ++ks) { const bf16x8 fa = *(const bf16x8*)(XwT + (ptile * 16 + fr) * 72 + ks * 32 + fq * 8), fb = *(const bf16x8*)(BmT + (nt * 16 + fr) * 72 + ks * 32 + fq * 8); hacc[e] = MFMA16(fa, fb, hacc[e]); }
#pragma unroll
                for (int jj = 0; jj < 4; ++jj) Hb[(ptile * 16 + fq * 4 + jj) * 136 + nt * 16 + fr] = f2bf(hacc[e][jj]); }
        }
        LBAR();
    }
#undef LOADCHUNK
    { const int ptile = wid >> 2;
#pragma unroll
      for (int e = 0; e < 2; ++e) { const int nt = (wid & 3) * 2 + e;
#pragma unroll
          for (int jj = 0; jj < 4; ++jj) p.out[O_PSSM + ((((size_t)l * 8 + b) * 16 + j) * 64 + ph * 32 + ptile * 16 + fq * 4 + jj) * 128 + nt * 16 + fr] = hacc[e][jj]; } }
    __syncthreads();
}

__device__ void mamba_sample_item(const Params& p, int l, int item, unsigned char* smem_) {
    unsigned char* smem = launder_lds(smem_);
    const int tid = tid_l();
    const int i = item >> 4, j = item & 15, g = j >> 3;
    float* su = (float*)smem;
    float* sd = su + 320;
    const bf16_t* P = (const bf16_t*)(p.ws + WS_P);
    bf16_t* YM = (bf16_t*)(p.ws + WS_YM);
    const size_t rowp = (size_t)TP + i;
    const int pp = tid >> 3, n0 = (tid & 7) * 16;
    const size_t so = ((((size_t)l * TS + i) * 16 + j) * 64 + pp) * 128 + n0;
    float4 hv4[4];
#pragma unroll
    for (int e = 0; e < 4; ++e) hv4[e] = *(const float4*)(p.in[I_SSSM] + so + e * 4);
    __syncthreads();
    if (tid < 320) {
        const int cc = tid < 64 ? j * 64 + tid : (tid < 192 ? 1024 + g * 128 + (tid - 64) : 1280 + g * 128 + (tid - 192));
        const float* c0 = p.in[I_SCONV] + ((size_t)l * TS + i) * 3 * 1536 + cc;
        const float* cw = p.in[I_CW] + (size_t)l * 4 * 1536 + cc;
        const float v = p.in[I_CB][l * 1536 + cc] + c0[0] * cw[0] + c0[1536] * cw[1536] + c0[3072] * cw[3072] + bf2f(P[rowp * N1 + C_XBC + cc]) * cw[4608];
        su[tid] = siluf_(v);
    } else if (tid == 320) {
        const float dt = softplusf_(bf2f(P[rowp * N1 + C_DT + j]) + p.in[I_DTB][l * 16 + j]);
        sd[0] = dt; sd[1] = __expf(-dt * __expf(p.in[I_ALOG][l * 16 + j]));
    }
    __syncthreads();
    {
        float* hout = p.out + O_SSSM + so;
        const float dt = sd[0], eA = sd[1], x = su[pp], xdt = x * dt;
        float y = 0.f;
#pragma unroll
        for (int e = 0; e < 4; ++e) { float4 hv = hv4[e]; const float* Bp = su + 64 + n0 + e * 4; const float* Cp = su + 192 + n0 + e * 4;
            hv.x = eA * hv.x + xdt * Bp[0]; hv.y = eA * hv.y + xdt * Bp[1]; hv.z = eA * hv.z + xdt * Bp[2]; hv.w = eA * hv.w + xdt * Bp[3];
            y += hv.x * Cp[0] + hv.y * Cp[1] + hv.z * Cp[2] + hv.w * Cp[3];
            *(float4*)(hout + e * 4) = hv; }
        y = red8(y);
        if ((tid & 7) == 0) { y += p.in[I_DSK][l * 16 + j] * x; const float z = bf2f(P[rowp * N1 + C_ZM + j * 64 + pp]); YM[rowp * 1024 + j * 64 + pp] = f2bf(y * siluf_(z)); }
    }
}

__device__ void phase_mixa(const Params& p, int l, unsigned char* smem) {
    phase_conv(p, l);
    for (int rep = 0; rep < (DUP == 3 ? 2 : 1); ++rep)
    for (int it = blockIdx.x; it < 2048; it += gridDim.x) rwkv_sample_item(p, l, it, smem);
    for (int rep = 0; rep < (DUP == 4 ? 2 : 1); ++rep)
    for (int it = blockIdx.x; it < 2048; it += gridDim.x) mamba_sample_item(p, l, it, smem);
}
__device__ void phase_mixb(const Params& p, int l, unsigned char* smem) {
    for (int rep = 0; rep < (DUP == 1 ? 2 : 1); ++rep)
    for (int it = blockIdx.x; it < 256; it += gridDim.x) rwkv_scan_item(p, l, it, smem);
    for (int rep = 0; rep < (DUP == 2 ? 2 : 1); ++rep)
    for (int it = blockIdx.x; it < 256; it += gridDim.x) mamba_item(p, l, it, smem);
}

__device__ void sample_outproj(const Params& p, int l) {
    const int tid = tid_l(), wid = tid >> 6, lane = tid & 63, fr = lane & 15, fq = lane >> 4;
    const bf16_t* A2 = (const bf16_t*)(p.ws + WS_A) + (size_t)TP * 2048;
    const bf16_t* W = (const bf16_t*)(p.ws + WS_WOUTT) + (size_t)l * 1024 * 2048;
    float* PART = (float*)(p.ws + WS_PART);
    for (int it = blockIdx.x; it < 256; it += gridDim.x) {
        const int nt = it & 15, ksl = it >> 4;
        f32x4 acc[4] = {{0.f, 0.f, 0.f, 0.f}, {0.f, 0.f, 0.f, 0.f}, {0.f, 0.f, 0.f, 0.f}, {0.f, 0.f, 0.f, 0.f}};
#pragma unroll
        for (int kq = 0; kq < 4; ++kq) {
            const bf16x8 fa = *(const bf16x8*)(A2 + (size_t)(wid * 16 + fr) * 2048 + ksl * 128 + kq * 32 + fq * 8);
#pragma unroll
            for (int ct = 0; ct < 4; ++ct) { const bf16x8 fb = *(const bf16x8*)(W + (size_t)(nt * 64 + ct * 16 + fr) * 2048 + ksl * 128 + kq * 32 + fq * 8); acc[ct] = MFMA16(fa, fb, acc[ct]); }
        }
#pragma unroll
        for (int ct = 0; ct < 4; ++ct)
#pragma unroll
            for (int jj = 0; jj < 4; ++jj) PART[((size_t)ksl * TS + wid * 16 + fq * 4 + jj) * 1024 + nt * 64 + ct * 16 + fr] = acc[ct][jj];
    }
}

__device__ void phase_post(const Params& p, int l) {
    const int tid_ = tid_l(); const int lane = tid_ & 63, wid = tid_ >> 6;
    const bf16_t* P = (const bf16_t*)(p.ws + WS_P);
    const float* ORAW = (const float*)(p.ws + WS_ORAW);
    const bf16_t* BV = (const bf16_t*)(p.ws + WS_BV);
    const bf16_t* YM = (const bf16_t*)(p.ws + WS_YM);
    bf16_t* A2 = (bf16_t*)(p.ws + WS_A);
    const int c0 = lane * 16;
    float lnw[16], lnb[16], gnw[16];
#pragma unroll
    for (int e = 0; e < 16; ++e) { lnw[e] = p.in[I_LNW][l * 1024 + c0 + e]; lnb[e] = p.in[I_LNB][l * 1024 + c0 + e]; gnw[e] = p.in[I_GNW][l * 1024 + c0 + e]; }
    for (int row = blockIdx.x * 8 + wid; row < TALL; row += gridDim.x * 8) {
        const bf16_t* prow = P + (size_t)row * N1;
        float o[16], bv[16], z[16], ym[16];
#pragma unroll
        for (int i = 0; i < 4; ++i) { const float4 t = *(const float4*)(ORAW + (size_t)row * 1024 + c0 + i * 4); o[i * 4] = t.x; o[i * 4 + 1] = t.y; o[i * 4 + 2] = t.z; o[i * 4 + 3] = t.w; }
        unpack8(*(const u32x4*)(BV + (size_t)row * 1024 + c0), bv); unpack8(*(const u32x4*)(BV + (size_t)row * 1024 + c0 + 8), bv + 8);
        unpack8(*(const u32x4*)(prow + C_ZR + c0), z); unpack8(*(const u32x4*)(prow + C_ZR + c0 + 8), z + 8);
        unpack8(*(const u32x4*)(YM + (size_t)row * 1024 + c0), ym); unpack8(*(const u32x4*)(YM + (size_t)row * 1024 + c0 + 8), ym + 8);
        float s = 0.f;
#pragma unroll
        for (int e = 0; e < 16; ++e) s += o[e];
        s += dppf<0xB1>(s); s += dppf<0x4E>(s);
        const float mean = s * (1.0f / 64.0f);
        float v = 0.f;
#pragma unroll
        for (int e = 0; e < 16; ++e) { o[e] -= mean; v += o[e] * o[e]; }
        v += dppf<0xB1>(v); v += dppf<0x4E>(v);
        const float rstd = rsqrtf(v * (1.0f / 64.0f) + 64e-5f);
#pragma unroll
        for (int e = 0; e < 16; ++e) o[e] = (o[e] * rstd * lnw[e] + lnb[e] + bv[e]) * siluf_(z[e]);
        *(u32x4*)(A2 + (size_t)row * 2048 + c0) = pack8(o); *(u32x4*)(A2 + (size_t)row * 2048 + c0 + 8) = pack8(o + 8);
        float ss = 0.f;
#pragma unroll
        for (int e = 0; e < 16; ++e) ss += ym[e] * ym[e];
        ss = red16(ss); ss += __shfl_xor(ss, 16);
        const float rs = rsqrtf(ss * (1.0f / 512.0f) + 1e-5f);
#pragma unroll
        for (int e = 0; e < 16; ++e) ym[e] *= rs * gnw[e];
        *(u32x4*)(A2 + (size_t)row * 2048 + 1024 + c0) = pack8(ym); *(u32x4*)(A2 + (size_t)row * 2048 + 1024 + c0 + 8) = pack8(ym + 8);
        if (row < TP) {
            const int tq = row & 2047;
            if (tq >= 2045) { float* dst = p.out + O_PCONV + (((size_t)l * 8 + (row >> 11)) * 3 + (tq - 2045)) * 1536;
                for (int c = lane; c < 1536; c += 64) dst[c] = bf2f(prow[C_XBC + c]); }
        } else {
            const int i = row - TP; float* dst = p.out + O_SCONV + ((size_t)l * TS + i) * 3 * 1536; const float* src = p.in[I_SCONV] + ((size_t)l * TS + i) * 3 * 1536;
            for (int c = lane; c < 1536; c += 64) { dst[c] = src[1536 + c]; dst[1536 + c] = src[3072 + c]; dst[3072 + c] = bf2f(prow[C_XBC + c]); }
        }
    }
}

constexpr int NPHASE = 13;
__global__ __launch_bounds__(512, 2) void mega(Params p) {
    extern __shared__ __attribute__((aligned(16))) unsigned char smem[];
    cg::grid_group grid = cg::this_grid();
    volatile LAS unsigned* st = (volatile LAS unsigned*)((LAS unsigned char*)smem + LDS_BARST);
    if (threadIdx.x == 0) { st[0] = 0u; st[1] = 0u; }
    __syncthreads();
    const XcdBarrier xbar = xcd_barrier_post((unsigned*)(p.ws + WS_BAR), st);
    if (p.ph_hi > 1000) grid.sync();
    for (int ph = p.ph_lo; ph < p.ph_hi; ++ph) {
        if (ph > p.ph_lo) { xcd_barrier(xbar); if (DUP == 13) { xcd_barrier(xbar); xcd_barrier(xbar); } }
        const int l = ph >= 6 ? 1 : 0;
        for (int rep = 0; rep < ((DUP == 9 && (ph == 2 || ph == 8)) || (DUP == 10 && (ph == 4 || ph == 10)) || (DUP == 11 && (ph == 0 || ph == 6)) || (DUP == 12 && ph == 5) ? 2 : 1); ++rep)
        switch (ph) {
            case 0: phase_convert(p, smem); phase_norm(p, 0); break;
            case 6: phase_norm(p, 1); break;
            case 1: case 7: {
                pg8::Gemm g{(const bf16_t*)(p.ws + WS_A), (const bf16_t*)(p.ws + WS_WINT) + (size_t)l * N1 * 1024, M1, N1, 1024};
                pg8::StaticOrder S; S.init(M1, N1, (int)gridDim.x, (int)blockIdx.x);
                EpiP E{(bf16_t*)(p.ws + WS_P), N1};
                pg8::gemm_phase<EpiP, pg8::StaticOrder, false>((PG8_LAS unsigned char*)smem, g, S, E, nullptr);
            } break;
            case 2: case 8: phase_mixa(p, l, smem); break;
            case 3: case 9: phase_mixb(p, l, smem); break;
            case 4: case 10: phase_post(p, l); break;
            case 5: case 11: {
                sample_outproj(p, l);
                pg8::Gemm g{(const bf16_t*)(p.ws + WS_A), (const bf16_t*)(p.ws + WS_WOUTT) + (size_t)l * 1024 * 2048, TP, 1024, 2048};
                pg8::StaticOrder S; S.init(TP, 1024, (int)gridDim.x, (int)blockIdx.x);
                EpiRes E{l == 0 ? p.in[I_XP] : p.out + O_YP, p.out + O_YP};
                pg8::gemm_phase<EpiRes, pg8::StaticOrder, false>((PG8_LAS unsigned char*)smem, g, S, E, nullptr);
            } break;
            case 12: phase_final(p); break;
        }
    }
}

extern "C" void kernel_launch(void* const* d_in, const int* in_sizes, int n_in, void* d_out, int out_size, void* d_ws, size_t ws_size, hipStream_t stream) {
    static int grid = 0;
    if (grid == 0) {
        if (n_in != 26 || (size_t)out_size != O_END || ws_size < WS_BAR + (size_t)XCD_BAR_WORDS * 4) { fprintf(stderr, "kernel_launch: unexpected shapes: n_in %d out %d ws %zu (need %zu)\n", n_in, out_size, ws_size, (size_t)(WS_BAR + XCD_BAR_WORDS * 4)); grid = -1; return; }
        int dev = 0, cus = 0, per_cu = 0;
        hipGetDevice(&dev); hipDeviceGetAttribute(&cus, hipDeviceAttributeMultiprocessorCount, dev);
        if (hipFuncSetAttribute((const void*)mega, hipFuncAttributeMaxDynamicSharedMemorySize, LDS_BYTES) != hipSuccess) { fprintf(stderr, "kernel_launch: hipFuncSetAttribute failed\n"); grid = -1; return; }
        if (hipOccupancyMaxActiveBlocksPerMultiprocessor(&per_cu, (const void*)mega, 512, LDS_BYTES) != hipSuccess || per_cu < 1) { fprintf(stderr, "kernel_launch: occupancy query gave %d\n", per_cu); per_cu = 1; }
        (void)hipGetLastError();
        grid = cus * 1;
    }
    if (grid < 0) return;
    if (hipMemsetAsync((char*)d_ws + WS_BAR, 0, (size_t)XCD_BAR_WORDS * 4, stream) != hipSuccess) { fprintf(stderr, "kernel_launch: memset of barrier words failed\n"); return; }
    Params p{};
    for (int i = 0; i < 26; ++i) p.in[i] = (const float*)d_in[i];
    p.out = (float*)d_out; p.ws = (unsigned char*)d_ws;
#if MK_PER_PHASE
    for (int ph = 0; ph < NPHASE; ++ph) { p.ph_lo = ph; p.ph_hi = ph + 1; hipLaunchKernelGGL(mega, dim3(grid), dim3(512), LDS_BYTES, stream, p); }
#else
    p.ph_lo = 0; p.ph_hi = NPHASE;
    void* args[] = {&p};
    hipError_t e = hipLaunchCooperativeKernel((const void*)mega, dim3(grid), dim3(512), args, LDS_BYTES, stream);
    if (e != hipSuccess) fprintf(stderr, "cooperative launch failed: %s (grid %d)\n", hipGetErrorString(e), grid);
#endif
}
```

```cpp
#include <hip/hip_runtime.h>
#include <hip/hip_cooperative_groups.h>
#include <cstdio>
namespace cg = cooperative_groups;

#define LDS_WIDTAB 146944
__device__ __forceinline__ int tid_l() {
    const unsigned hw = (unsigned)__builtin_amdgcn_s_getreg((5 << 11) | 4) & 63u;
    const int wid = *(volatile __attribute__((address_space(3))) int*)(unsigned long)(LDS_WIDTAB + hw * 4u);
    int ln; asm volatile("v_mbcnt_lo_u32_b32 %0, -1, 0\n\tv_mbcnt_hi_u32_b32 %0, -1, %0" : "=v"(ln));
    return __builtin_amdgcn_readfirstlane(wid) * 64 + ln; }
namespace pg8 {
#define PG8_LAS __attribute__((address_space(3)))
typedef unsigned short bf16_t;
typedef short bf16x8 __attribute__((ext_vector_type(8)));
typedef float f32x4 __attribute__((ext_vector_type(4)));
typedef unsigned u32x4 __attribute__((ext_vector_type(4)));
constexpr int BM = 256, BK = 64, HALF = 128, HTB = HALF * BK * 2  , STAGE_BYTES = 8 * HTB, NXCD = 8, WGM = 8;

__host__ __device__ __forceinline__ int lds_byte(int r, int c) { const int st = (r >> 4) * 2 + (c >> 5), rr = r & 15, cc = c & 31, ob = rr * 64 + cc * 2; return st * 1024 + (ob ^ (((ob >> 9) & 1) << 5)); }
__host__ __device__ __forceinline__ void stage_rc(int b, int& R, int& C) { const int st = b / 1024, sb = b % 1024, swz = sb ^ (((sb >> 9) & 1) << 5); R = (st >> 1) * 16 + swz / 64; C = (st & 1) * 32 + (swz % 64) / 2; }
__host__ __device__ __forceinline__ int perm32(int rho) { const int n = rho >> 4, i = rho & 15; return 8 * (i >> 2) + 4 * n + (i & 3); }

struct Unit { int pm, pn; };
struct Gemm { const bf16_t* A; const bf16_t* Bt; int M, N, K; };

struct StaticOrder {
    int nM, nN, nwg, G, c;
    __host__ __device__ void init(int M, int N, int G_, int c_) { nM = M / BM; nN = N / BM; nwg = nM * nN; G = G_; c = c_; }
    __host__ __device__ bool next(int i, Unit& u) const {
        const long L = (long)i * G + c; if (L >= nwg) return false;
        int wgid = (int)L; { const int q = nwg / NXCD, r = nwg % NXCD, xcd = wgid % NXCD, off = wgid / NXCD; wgid = (xcd < r ? xcd * (q + 1) : r * (q + 1) + (xcd - r) * q) + off; }
        const int nig = WGM * nN, gid = wgid / nig, fm = gid * WGM, gsz = (nM - fm) < WGM ? (nM - fm) : WGM;
        u.pm = fm + ((wgid % nig) % gsz); u.pn = (wgid % nig) / gsz; return true;
    }
    __device__ __forceinline__ void a_ready(const Unit&) const {}
    __device__ __forceinline__ void done(const Unit&) const {}
};
__device__ __forceinline__ unsigned cvt_pk_bf16(float lo, float hi) { unsigned r; asm volatile("v_cvt_pk_bf16_f32 %0, %1, %2" : "=v"(r) : "v"(lo), "v"(hi)); return r; }
template <class Epi, class Sched, bool STAMP = false>
__device__ __forceinline__ void gemm_phase(PG8_LAS unsigned char* lds, const Gemm g, const Sched& S, const Epi& E, unsigned long long* stamps) {
    const int tid = tid_l(), wid = __builtin_amdgcn_readfirstlane(tid >> 6), lane = tid & 63, wr = wid >> 2, wc = wid & 3, fr = lane & 15, fq = lane >> 4;
    const int K = g.K, nt = K / BK;
    int ts_lo = 0, ts_hi = 0, nts = 0; const unsigned long long rt_entry = STAMP ? (unsigned long long)wall_clock64() : 0ull;
#define PG8_STAMP() do { if (STAMP && wid == 0 && nts < 64) { const unsigned long long _c = (unsigned long long)clock64(); \
        ts_lo = (lane == nts) ? (int)(unsigned)_c : ts_lo; ts_hi = (lane == nts) ? (int)(unsigned)(_c >> 32) : ts_hi; ++nts; } } while (0)
    PG8_STAMP();
    unsigned voffA[2], voffB[2];
#pragma unroll
    for (int i = 0; i < 2; ++i) { int R, C; stage_rc(tid * 16 + i * 8192, R, C); const int Rb = Epi::PERM ? ((R & ~31) + perm32(R & 31)) : R;
        voffA[i] = (unsigned)(R * K + C) * 2u; voffB[i] = (unsigned)(Rb * K + C) * 2u; }
    const size_t kstep = (size_t)(BK * 2);
    const size_t hstep = (size_t)HALF * K * 2;
    const size_t tstep = 2 * hstep;
    const unsigned ldsw = (unsigned)wid * 1024u;
    const int aoff = lds_byte(wr * 64 + fr, fq * 8), boff = lds_byte(wc * 32 + fr, fq * 8);
#define PG8_SA(b, h) (((b) * 2 + (h)) * HTB)
#define PG8_SB(b, h) ((4 + (b) * 2 + (h)) * HTB)
#define PG8_STAGE(bufoff, gbase, voff) do { _Pragma("unroll") for (int _i = 0; _i < 2; ++_i) \
        __builtin_amdgcn_global_load_lds((const unsigned*)((const char*)(gbase) + (voff)[_i]), (PG8_LAS unsigned*)(lds + (bufoff) + ldsw + _i * 8192), 16, 0, 0); } while (0)
#define PG8_LDA(dst, b, h) do { _Pragma("unroll") for (int m = 0; m < 4; ++m) _Pragma("unroll") for (int k = 0; k < 2; ++k) dst[m][k] = *(const PG8_LAS bf16x8*)(lds + PG8_SA(b, h) + aoff + m * 2048 + k * 1024); } while (0)
#define PG8_LDB(dst, b, h) do { _Pragma("unroll") for (int n = 0; n < 2; ++n) _Pragma("unroll") for (int k = 0; k < 2; ++k) dst[n][k] = *(const PG8_LAS bf16x8*)(lds + PG8_SB(b, h) + boff + n * 2048 + k * 1024); } while (0)
#define PG8_MMA(ai, bj, At, Bt) do { __builtin_amdgcn_s_setprio(1); _Pragma("unroll") for (int m = 0; m < 4; ++m) _Pragma("unroll") for (int n = 0; n < 2; ++n) _Pragma("unroll") for (int k = 0; k < 2; ++k) \
        acc[ai][bj][m][n] = __builtin_amdgcn_mfma_f32_16x16x32_bf16(Bt[n][k], At[m][k], acc[ai][bj][m][n], 0, 0, 0); __builtin_amdgcn_s_setprio(0); } while (0)
#define PG8_WAIT_V(n) asm volatile("s_waitcnt vmcnt(" #n ")" ::: "memory")
#define PG8_WAIT_L(n) asm volatile("s_waitcnt lgkmcnt(" #n ")" ::: "memory")
#define PG8_BAR __builtin_amdgcn_s_barrier()
#define PG8_SCHED __builtin_amdgcn_sched_barrier(0)
    Unit cur, nxt; int ui = 0;
    if (!S.next(0, cur)) return;
    f32x4 acc[2][2][4][2];
#pragma unroll
    for (int a = 0; a < 2; ++a)
#pragma unroll
        for (int b = 0; b < 2; ++b)
#pragma unroll
            for (int m = 0; m < 4; ++m)
#pragma unroll
                for (int n = 0; n < 2; ++n) acc[a][b][m][n] = (f32x4){0.f, 0.f, 0.f, 0.f};
    bf16x8 At[4][2], B0[2][2], B1[2][2];
    const char* cA = (const char*)g.A + (size_t)cur.pm * tstep; const char* cB = (const char*)g.Bt + (size_t)cur.pn * tstep;
    S.a_ready(cur);
    PG8_STAGE(PG8_SB(0, 0), cB, voffB); PG8_STAGE(PG8_SA(0, 0), cA, voffA); PG8_STAGE(PG8_SB(0, 1), cB + hstep, voffB); PG8_STAGE(PG8_SA(0, 1), cA + hstep, voffA);
    if (wr == 1) PG8_BAR;
    PG8_WAIT_V(4); PG8_BAR;
    PG8_STAGE(PG8_SB(1, 0), cB + kstep, voffB); PG8_STAGE(PG8_SA(1, 0), cA + kstep, voffA); PG8_STAGE(PG8_SB(1, 1), cB + hstep + kstep, voffB);
    PG8_WAIT_V(6); PG8_BAR;
    PG8_STAMP();
    for (;;) {
        const bool has_next = S.next(ui + 1, nxt);
        const char* nA = has_next ? (const char*)g.A + (size_t)nxt.pm * tstep : cA; const char* nB = has_next ? (const char*)g.Bt + (size_t)nxt.pn * tstep : cB;
        for (int t = 0; t < nt; t += 2) {
            const bool last = (t == nt - 2);
            const char* a1 = cA + (size_t)(t + 1) * kstep;
            const char* a2 = last ? nA : cA + (size_t)(t + 2) * kstep; const char* b2 = last ? nB : cB + (size_t)(t + 2) * kstep;
            const char* a3 = a2 + kstep; const char* b3 = b2 + kstep;
            if (last && has_next) S.a_ready(nxt);
            PG8_LDB(B0, 0, 0); PG8_SCHED; PG8_LDA(At, 0, 0); PG8_STAGE(PG8_SA(1, 1), a1 + hstep, voffA);
            PG8_WAIT_L(8); PG8_BAR; PG8_WAIT_L(0); PG8_MMA(0, 0, At, B0); PG8_BAR; PG8_SCHED;
            PG8_LDB(B1, 0, 1); PG8_STAGE(PG8_SB(0, 0), b2, voffB);
            PG8_BAR; PG8_WAIT_L(0); PG8_MMA(0, 1, At, B1); PG8_BAR;
            PG8_LDA(At, 0, 1); PG8_STAGE(PG8_SA(0, 0), a2, voffA);
            PG8_BAR; PG8_WAIT_L(0); PG8_MMA(1, 0, At, B0); PG8_BAR; PG8_SCHED;
            PG8_STAGE(PG8_SB(0, 1), b2 + hstep, voffB);
            PG8_WAIT_V(6); PG8_BAR; PG8_MMA(1, 1, At, B1); PG8_BAR;
            PG8_LDB(B0, 1, 0); PG8_SCHED; PG8_LDA(At, 1, 0); PG8_STAGE(PG8_SA(0, 1), a2 + hstep, voffA);
            PG8_WAIT_L(8); PG8_BAR; PG8_WAIT_L(0); PG8_MMA(0, 0, At, B0); PG8_BAR; PG8_SCHED;
            PG8_LDB(B1, 1, 1); PG8_STAGE(PG8_SB(1, 0), b3, voffB);
            PG8_BAR; PG8_WAIT_L(0); PG8_MMA(0, 1, At, B1); PG8_BAR;
            PG8_LDA(At, 1, 1); PG8_STAGE(PG8_SA(1, 0), a3, voffA);
            PG8_BAR; PG8_WAIT_L(0); PG8_MMA(1, 0, At, B0); PG8_BAR; PG8_SCHED;
            PG8_STAGE(PG8_SB(1, 1), b3 + hstep, voffB);
            PG8_WAIT_V(6); PG8_BAR; PG8_MMA(1, 1, At, B1); PG8_BAR;
        }
        PG8_STAMP();
        if constexpr (!Epi::AFTER_DRAIN) { E(acc, cur, wr, wc, fr, fq); S.done(cur); }
        PG8_STAMP();
        if (!has_next) break;
#pragma unroll
        for (int a = 0; a < 2; ++a)
#pragma unroll
            for (int b = 0; b < 2; ++b)
#pragma unroll
                for (int m = 0; m < 4; ++m)
#pragma unroll
                    for (int n = 0; n < 2; ++n) acc[a][b][m][n] = (f32x4){0.f, 0.f, 0.f, 0.f};
        cur = nxt; cA = nA; cB = nB; ++ui;
    }
    PG8_WAIT_V(0);
    if (wr == 0) PG8_BAR;
    PG8_BAR;
    if constexpr (Epi::AFTER_DRAIN) { E.fused(acc, cur, wr, wc, fr, fq, lds, wid, lane); S.done(cur); }
    PG8_STAMP();
    if (STAMP && wid == 0) { stamps[lane] = lane < nts ? (((unsigned long long)(unsigned)ts_hi << 32) | (unsigned)ts_lo) : 0ull;
        if (lane == 62) stamps[62] = rt_entry; if (lane == 63) stamps[63] = (unsigned long long)wall_clock64(); }
#undef PG8_STAMP
#undef PG8_SA
#undef PG8_SB
#undef PG8_STAGE
#undef PG8_LDA
#undef PG8_LDB
#undef PG8_MMA
#undef PG8_WAIT_V
#undef PG8_WAIT_L
#undef PG8_BAR
#undef PG8_SCHED
}
}

#define XB_TMO      128
#define XB_XCNT(j)  (256  + 64 * (j))
#define XB_XSUB(j)  (1280 + 64 * (j))
#define XB_XGEN(j)  (2304 + 64 * (j))
#define XB_TOP      3328
#define XB_TOPGEN   3392
#define XCD_BAR_WORDS 3456
#define XB_SPIN_CAP (1u << 18)
#define LAS __attribute__((address_space(3)))

__device__ __forceinline__ unsigned xb_ld(unsigned* p)              { return __hip_atomic_load(p, __ATOMIC_RELAXED, __HIP_MEMORY_SCOPE_AGENT); }
__device__ __forceinline__ unsigned xb_add(unsigned* p, unsigned v) { return __hip_atomic_fetch_add(p, v, __ATOMIC_RELAXED, __HIP_MEMORY_SCOPE_AGENT); }
__device__ __forceinline__ unsigned xb_xcc_id() { return (unsigned)__builtin_amdgcn_s_getreg((3 << 11) | 20) & 0xFu; }
#define XB_SPIN(cond, bar) do { unsigned _sp = 0; while (cond) { __builtin_amdgcn_s_sleep(1); \
    if ((++_sp & 255u) == 0u) { if (xb_ld(&(bar)[XB_TMO])) break; if (_sp > XB_SPIN_CAP) { atomicAdd(&(bar)[XB_TMO], 1u); break; } } } } while (0)
struct XcdBarrier {
    unsigned* bar; unsigned x;
    volatile LAS unsigned* st;
};

__device__ __forceinline__ XcdBarrier xcd_barrier_post(unsigned* bar, volatile LAS unsigned* st) {
    XcdBarrier b; b.bar = bar; b.x = xb_xcc_id(); b.st = st;
    if (tid_l() == 0) (void)xb_add(&bar[XB_XCNT(b.x)], 1u);
    return b;
}
__device__ __forceinline__ void xcd_barrier_complete(unsigned* bar, unsigned x, unsigned& nloc, unsigned& nx) {
    const unsigned G = gridDim.x * gridDim.y * gridDim.z;
    unsigned sum, cnt, mine, sp = 0u;
    for (;;) {
        sum = 0u; cnt = 0u; mine = 0u;
#pragma unroll
        for (unsigned j = 0; j < 16; ++j) { const unsigned c = xb_ld(&bar[XB_XCNT(j)]); sum += c; cnt += (c > 0u) ? 1u : 0u; mine = (j == x) ? c : mine; }
        if (sum == G) break;
        __builtin_amdgcn_s_sleep(1);
        if ((++sp & 255u) == 0u) { if (xb_ld(&bar[XB_TMO])) break; if (sp > XB_SPIN_CAP) { atomicAdd(&bar[XB_TMO], 1u); break; } }
    }
    nloc = mine > 0u ? mine : 1u; nx = cnt > 0u ? cnt : 1u;
}

__device__ __forceinline__ void xcd_barrier(const XcdBarrier& b) {
    asm volatile("s_waitcnt vmcnt(0)" ::: "memory");
    __syncthreads();
    if (tid_l() == 0) {
        unsigned* bar = b.bar;
        __builtin_amdgcn_s_waitcnt(0);
        unsigned nloc = b.st[0], nx = b.st[1];
        if (nloc == 0u) { xcd_barrier_complete(bar, b.x, nloc, nx); b.st[0] = nloc; b.st[1] = nx; }
        const unsigned old = xb_add(&bar[XB_XSUB(b.x)], 1u);
        const unsigned gen = old / nloc;
        if (old + 1u == (gen + 1u) * nloc) {
            __builtin_amdgcn_fence(__ATOMIC_RELEASE, "agent");
            asm volatile("s_waitcnt vmcnt(0)" ::: "memory");
            const unsigned og = xb_add(&bar[XB_TOP], 1u);
            const unsigned tg = og / nx;
            if (og + 1u == (tg + 1u) * nx) xb_add(&bar[XB_TOPGEN], 1u);
            else XB_SPIN(xb_ld(&bar[XB_TOPGEN]) == tg, bar);
            __builtin_amdgcn_fence(__ATOMIC_ACQUIRE, "agent");
            xb_add(&bar[XB_XGEN(b.x)], 1u);
            asm volatile("s_waitcnt vmcnt(0)" ::: "memory");
        } else {
            XB_SPIN(xb_ld(&bar[XB_XGEN(b.x)]) == gen, bar);
            __builtin_amdgcn_fence(__ATOMIC_ACQUIRE, "agent");
            asm volatile("s_waitcnt vmcnt(0)" ::: "memory");
        }
    }
    __syncthreads();
}

typedef unsigned short bf16_t;
typedef short bf16x8 __attribute__((ext_vector_type(8)));
typedef float f32x4 __attribute__((ext_vector_type(4)));
typedef unsigned u32x4 __attribute__((ext_vector_type(4)));
typedef unsigned u32x2 __attribute__((ext_vector_type(2)));

#ifndef DUP
#define DUP 0
#endif
#ifndef MK_PER_PHASE
#define MK_PER_PHASE 0
#endif

constexpr int TP = 16384, TS = 128, TALL = 16512, M1 = 16640, N1 = 6912, NIN = 6800;
constexpr int C_R = 0, C_K = 1024, C_V = 2048, C_WL = 3072, C_AL = 3136, C_ZR = 3200, C_ZM = 4224, C_XBC = 5248, C_DT = 6784;
constexpr size_t O_YP = 0, O_YS = 16777216, O_PSH = 16908288, O_PWKV = 16924672, O_PCONV = 17973248, O_PSSM = 18046976,
                 O_SSH = 20144128, O_SWKV = 20406272, O_SCONV = 37183488, O_SSSM = 38363136, O_END = 71917568;
constexpr size_t WS_WINT = 0;
constexpr size_t WS_WOUTT = WS_WINT + (size_t)2 * N1 * 1024 * 2;
constexpr size_t WS_A = WS_WOUTT + (size_t)2 * 1024 * 2048 * 2;
constexpr size_t WS_P = WS_A + (size_t)M1 * 2048 * 2;
constexpr size_t WS_ORAW = WS_P + (size_t)M1 * N1 * 2;
constexpr size_t WS_BV = WS_ORAW + (size_t)TALL * 1024 * 4;
constexpr size_t WS_YM = WS_BV + (size_t)TALL * 1024 * 2;
constexpr size_t WS_END = WS_YM + (size_t)TALL * 1024 * 2;
constexpr size_t WS_U = WS_A;
constexpr size_t WS_DT = WS_U + (size_t)TP * 1536 * 2;
constexpr size_t WS_PART = WS_ORAW;
constexpr size_t WS_BAR = (WS_END + 4095) & ~(size_t)4095;
constexpr int LDS_BYTES = 147456, LDS_BARST = 147440;

struct Params { const float* in[26]; float* out; unsigned char* ws; int ph_lo, ph_hi; };
enum { I_XP = 0, I_XS, I_SSHIFT, I_SWKV, I_SCONV, I_SSSM, I_NORMW, I_WIN, I_MU, I_W0, I_W2, I_A0, I_A2, I_KK, I_KA, I_RK, I_LNW, I_LNB, I_CW, I_CB, I_DTB, I_ALOG, I_DSK, I_GNW, I_WOUT, I_FNW };

__device__ __forceinline__ float bf2f(unsigned short b) { return __uint_as_float(((unsigned)b) << 16); }
__device__ __forceinline__ unsigned short f2bf(float f) { unsigned u = __float_as_uint(f); u += 0x7FFFu + ((u >> 16) & 1u); return (unsigned short)(u >> 16); }
__device__ __forceinline__ unsigned pk2(float lo, float hi) { return (unsigned)f2bf(lo) | ((unsigned)f2bf(hi) << 16); }
__device__ __forceinline__ void unpack8(const u32x4 v, float* f) {
    f[0] = __uint_as_float(v.x << 16); f[1] = __uint_as_float(v.x & 0xffff0000u); f[2] = __uint_as_float(v.y << 16); f[3] = __uint_as_float(v.y & 0xffff0000u);
    f[4] = __uint_as_float(v.z << 16); f[5] = __uint_as_float(v.z & 0xffff0000u); f[6] = __uint_as_float(v.w << 16); f[7] = __uint_as_float(v.w & 0xffff0000u); }
__device__ __forceinline__ u32x4 pack8(const float* f) { u32x4 r; r.x = pk2(f[0], f[1]); r.y = pk2(f[2], f[3]); r.z = pk2(f[4], f[5]); r.w = pk2(f[6], f[7]); return r; }
__device__ __forceinline__ float sigmoidf_(float x) { return 1.0f / (1.0f + __expf(-x)); }
__device__ __forceinline__ float siluf_(float x) { return x / (1.0f + __expf(-x)); }
__device__ __forceinline__ float softplusf_(float x) { return x > 20.f ? x : log1pf(__expf(x)); }
template <int CTRL> __device__ __forceinline__ float dppf(float v) { return __int_as_float(__builtin_amdgcn_mov_dpp(__float_as_int(v), CTRL, 0xF, 0xF, true)); }
__device__ __forceinline__ float red8(float x) { x += dppf<0xB1>(x); x += dppf<0x4E>(x); x += dppf<0x141>(x); return x; }
__device__ __forceinline__ float red16(float x) { x = red8(x); x += dppf<0x140>(x); return x; }
__device__ __forceinline__ float wave_sum(float x) {
#pragma unroll
    for (int o = 32; o > 0; o >>= 1) x += __shfl_xor(x, o);
    return x; }
__device__ __forceinline__ void lds_fence() { asm volatile("s_waitcnt lgkmcnt(0)" ::: "memory"); }
__device__ __forceinline__ unsigned char* launder_lds(unsigned char* sm) { int off = 0; asm volatile("" : "+s"(off)); return sm + off; }
#define LBAR() do { asm volatile("s_waitcnt lgkmcnt(0)" ::: "memory"); __builtin_amdgcn_s_barrier(); asm volatile("" ::: "memory"); } while (0)
#define MFMA16(a, b, c) __builtin_amdgcn_mfma_f32_16x16x32_bf16((a), (b), (c), 0, 0, 0)

__device__ void phase_convert(const Params& p, unsigned char* smem_) {
    unsigned char* smem = launder_lds(smem_);
    float* tile = (float*)smem;
    const int tid = tid_l();
    constexpr int NT_IN = 16 * 108, NT_OUT = 32 * 16, PER_L = NT_IN + NT_OUT;
    for (int it = blockIdx.x; it < 2 * PER_L; it += gridDim.x) {
        const int l = it / PER_L; int r = it % PER_L;
        const float* src; bf16_t* dst; int K, Nsrc, kt, nt;
        if (r < NT_IN) { src = p.in[I_WIN] + (size_t)l * 1024 * NIN; dst = (bf16_t*)(p.ws + WS_WINT) + (size_t)l * N1 * 1024; K = 1024; Nsrc = NIN; kt = r & 15; nt = r >> 4; }
        else { r -= NT_IN; src = p.in[I_WOUT] + (size_t)l * 2048 * 1024; dst = (bf16_t*)(p.ws + WS_WOUTT) + (size_t)l * 1024 * 2048; K = 2048; Nsrc = 1024; kt = r & 31; nt = r >> 5; }
#pragma unroll
        for (int i = 0; i < 2; ++i) {
            const int rr = (tid >> 4) + 32 * i, c4 = (tid & 15) * 4, col = nt * 64 + c4;
            float4 v = make_float4(0.f, 0.f, 0.f, 0.f);
            if (col < Nsrc) v = *(const float4*)(src + (size_t)(kt * 64 + rr) * Nsrc + col);
            float* tp = tile + rr * 65 + c4; tp[0] = v.x; tp[1] = v.y; tp[2] = v.z; tp[3] = v.w;
        }
        __syncthreads();
        { const int n = tid >> 3, k8 = (tid & 7) * 8; float f[8];
#pragma unroll
          for (int j = 0; j < 8; ++j) f[j] = tile[(k8 + j) * 65 + n];
          *(u32x4*)(dst + (size_t)(nt * 64 + n) * K + kt * 64 + k8) = pack8(f); }
        __syncthreads();
    }
}

__device__ void phase_norm(const Params& p, int l) {
    const int tid_ = tid_l(); const int lane = tid_ & 63, wid = tid_ >> 6;
    bf16_t* A1 = (bf16_t*)(p.ws + WS_A);
    const float* nw = p.in[I_NORMW] + l * 1024;
    for (int row = blockIdx.x * 8 + wid; row < M1; row += gridDim.x * 8) {
        const float* src;
        if (row < TP) src = (l == 0 ? p.in[I_XP] : p.out + O_YP) + (size_t)row * 1024;
        else if (row < TALL) src = (l == 0 ? p.in[I_XS] : p.out + O_YS) + (size_t)(row - TP) * 1024;
        else src = p.in[I_SSHIFT] + ((size_t)l * TS + (row - TALL)) * 1024;
        float4 v[4]; float ss = 0.f;
#pragma unroll
        for (int i = 0; i < 4; ++i) v[i] = *(const float4*)(src + i * 256 + lane * 4);
        if (l == 1 && row >= TP && row < TALL) {
            const float* x0 = p.in[I_XS] + (size_t)(row - TP) * 1024; const float* pt = (const float*)(p.ws + WS_PART) + (size_t)(row - TP) * 1024;
#pragma unroll
            for (int i = 0; i < 4; ++i) { float4 a = *(const float4*)(x0 + i * 256 + lane * 4);
                for (int q = 0; q < 16; ++q) { const float4 t = *(const float4*)(pt + (size_t)q * TS * 1024 + i * 256 + lane * 4); a.x += t.x; a.y += t.y; a.z += t.z; a.w += t.w; }
                v[i] = a; *(float4*)(p.out + O_YS + (size_t)(row - TP) * 1024 + i * 256 + lane * 4) = a; }
        }
#pragma unroll
        for (int i = 0; i < 4; ++i) ss += v[i].x * v[i].x + v[i].y * v[i].y + v[i].z * v[i].z + v[i].w * v[i].w;
        if (row < TALL) {
            ss = wave_sum(ss);
            const float rs = rsqrtf(ss * (1.0f / 1024.0f) + 1e-5f);
#pragma unroll
            for (int i = 0; i < 4; ++i) { const float4 w = *(const float4*)(nw + i * 256 + lane * 4); v[i].x *= rs * w.x; v[i].y *= rs * w.y; v[i].z *= rs * w.z; v[i].w *= rs * w.w; }
            float* so = nullptr;
            if (row < TP) { if ((row & 2047) == 2047) so = p.out + O_PSH + ((size_t)l * 8 + (row >> 11)) * 1024; }
            else so = p.out + O_SSH + ((size_t)l * TS + (row - TP)) * 1024;
            if (so) {
#pragma unroll
                for (int i = 0; i < 4; ++i) *(float4*)(so + i * 256 + lane * 4) = v[i]; }
        }
#pragma unroll
        for (int i = 0; i < 4; ++i) { u32x2 w; w.x = pk2(v[i].x, v[i].y); w.y = pk2(v[i].z, v[i].w); *(u32x2*)(A1 + (size_t)row * 1024 + i * 256 + lane * 4) = w; }
    }
}

__device__ void phase_final(const Params& p) {
    const int tid_ = tid_l(); const int lane = tid_ & 63, wid = tid_ >> 6;
    const float* nw = p.in[I_FNW];
    for (int row = blockIdx.x * 8 + wid; row < TALL; row += gridDim.x * 8) {
        float* src = (row < TP) ? p.out + O_YP + (size_t)row * 1024 : p.out + O_YS + (size_t)(row - TP) * 1024;
        float4 v[4]; float ss = 0.f;
#pragma unroll
        for (int i = 0; i < 4; ++i) v[i] = *(const float4*)(src + i * 256 + lane * 4);
        if (row >= TP) { const float* pt = (const float*)(p.ws + WS_PART) + (size_t)(row - TP) * 1024;
#pragma unroll
            for (int i = 0; i < 4; ++i) for (int q = 0; q < 16; ++q) { const float4 t = *(const float4*)(pt + (size_t)q * TS * 1024 + i * 256 + lane * 4); v[i].x += t.x; v[i].y += t.y; v[i].z += t.z; v[i].w += t.w; } }
#pragma unroll
        for (int i = 0; i < 4; ++i) ss += v[i].x * v[i].x + v[i].y * v[i].y + v[i].z * v[i].z + v[i].w * v[i].w;
        ss = wave_sum(ss);
        const float rs = rsqrtf(ss * (1.0f / 1024.0f) + 1e-5f);
#pragma unroll
        for (int i = 0; i < 4; ++i) { const float4 w = *(const float4*)(nw + i * 256 + lane * 4); v[i].x *= rs * w.x; v[i].y *= rs * w.y; v[i].z *= rs * w.z; v[i].w *= rs * w.w;
            *(float4*)(src + i * 256 + lane * 4) = v[i]; }
    }
}

struct EpiP {
    static constexpr bool PERM = true, AFTER_DRAIN = false;
    bf16_t* O; int ldc;
    __device__ __forceinline__ void operator()(const f32x4 (&acc)[2][2][4][2], const pg8::Unit& u, int wr, int wc, int fr, int fq) const {
        const int row0 = u.pm * 256 + wr * 64 + fr, col0 = u.pn * 256 + wc * 32 + 8 * fq;
#pragma unroll
        for (int ai = 0; ai < 2; ++ai)
#pragma unroll
            for (int m = 0; m < 4; ++m) { bf16_t* rowp = O + (size_t)(row0 + ai * 128 + m * 16) * ldc + col0;
#pragma unroll
                for (int bj = 0; bj < 2; ++bj) { const f32x4 v0 = acc[ai][bj][m][0], v1 = acc[ai][bj][m][1];
                    u32x4 w; w.x = pg8::cvt_pk_bf16(v0[0], v0[1]); w.y = pg8::cvt_pk_bf16(v0[2], v0[3]); w.z = pg8::cvt_pk_bf16(v1[0], v1[1]); w.w = pg8::cvt_pk_bf16(v1[2], v1[3]);
                    *(u32x4*)(rowp + bj * 128) = w; } }
    }
};
struct EpiRes {
    static constexpr bool PERM = false, AFTER_DRAIN = false;
    const float* res_p; float* out_p;
    __device__ __forceinline__ void operator()(const f32x4 (&acc)[2][2][4][2], const pg8::Unit& u, int wr, int wc, int fr, int fq) const {
        const int row0 = u.pm * 256 + wr * 64 + fr, col0 = u.pn * 256 + wc * 32 + 4 * fq;
#pragma unroll
        for (int ai = 0; ai < 2; ++ai)
#pragma unroll
            for (int m = 0; m < 4; ++m) { const size_t ro = (size_t)(row0 + ai * 128 + m * 16) * 1024;
#pragma unroll
                for (int bj = 0; bj < 2; ++bj)
#pragma unroll
                    for (int n = 0; n < 2; ++n) { const int c = col0 + bj * 128 + n * 16; const f32x4 r = *(const f32x4*)(res_p + ro + c); *(f32x4*)(out_p + ro + c) = acc[ai][bj][m][n] + r; } }
    }
};

constexpr int CH_NB = 5, CH_CB = 16384;
constexpr int CB_A1 = 0, CB_A2 = 3328, CB_TT = 6656, CB_A3 = 7936, CB_VT = 13056, CB_GQ = 16128;
constexpr int CH_SCR = CH_NB * CH_CB;
constexpr int SCR_TW = 0, SCR_EXL = 4608, SCR_NM = 8704, SCR_SZ = 9856;
constexpr int CH_W2T = CH_SCR + 4 * SCR_SZ;
constexpr int CH_CST = CH_W2T + 18432;
constexpr int CH_FLG = CH_CST + 2560;
__device__ __forceinline__ unsigned cvtpk(float lo, float hi) { return pg8::cvt_pk_bf16(lo, hi); }
__device__ void rwkv_chain_item(const Params& p, int l, int item, unsigned char* smem_) {
    unsigned char* smem = launder_lds(smem_);
    const int tid = tid_l(), wid = tid >> 6, lane = tid & 63, fr = lane & 15, fq = lane >> 4;
    const int b = item >> 4, h = item & 15;
    bf16_t* w2t = (bf16_t*)(smem + CH_W2T); bf16_t* a2t = w2t + 4608;
    float* cst = (float*)(smem + CH_CST);
    volatile unsigned* ready = (volatile unsigned*)(smem + CH_FLG); volatile unsigned* cons = ready + 128;
    const bf16_t* P = (const bf16_t*)(p.ws + WS_P);
    float* ORAW = (float*)(p.ws + WS_ORAW);
    bf16_t* BV = (bf16_t*)(p.ws + WS_BV);
    __syncthreads();
    for (int i = tid; i < (CH_SCR + 4 * SCR_SZ) / 4; i += 512) ((unsigned*)smem)[i] = 0u;
    if (tid < 256) ((unsigned*)(smem + CH_FLG))[tid] = 0u;
    { const float* w2 = p.in[I_W2] + (size_t)l * 64 * 1024 + h * 64; const float* a2 = p.in[I_A2] + (size_t)l * 64 * 1024 + h * 64;
#pragma unroll
      for (int i = 0; i < 8; ++i) { const int idx = tid + 512 * i, k = idx >> 6, n = idx & 63; w2t[n * 72 + k] = f2bf(w2[(size_t)k * 1024 + n]); a2t[n * 72 + k] = f2bf(a2[(size_t)k * 1024 + n]); } }
    if (tid < 64) { const float* mu = p.in[I_MU] + (size_t)l * 3200; const int gc = h * 64 + tid;
        cst[tid] = mu[C_R + gc]; cst[64 + tid] = mu[C_K + gc]; cst[128 + tid] = mu[C_V + gc]; cst[192 + tid] = mu[C_WL + tid]; cst[256 + tid] = mu[C_AL + tid];
        cst[320 + tid] = p.in[I_KK][l * 1024 + gc]; cst[384 + tid] = p.in[I_KA][l * 1024 + gc]; cst[448 + tid] = p.in[I_RK][l * 1024 + gc];
        cst[512 + tid] = p.in[I_W0][l * 1024 + gc]; cst[576 + tid] = p.in[I_A0][l * 1024 + gc]; }
    __syncthreads();

    if (wid >= 4) {
        const int hw = wid - 4, tok = lane >> 2, q4 = lane & 3, c0 = q4 * 16;
        unsigned char* scr = smem + CH_SCR + hw * SCR_SZ;
        bf16_t* tw = (bf16_t*)(scr + SCR_TW); bf16_t* ta = tw + 1152;
        bf16_t* ZQ = (bf16_t*)(scr + SCR_TW); bf16_t* ZK = ZQ + 1152;
        float* exl = (float*)(scr + SCR_EXL);
        float* Nm = (float*)(scr + SCR_NM);
        const int segcol[5] = {C_R + h * 64 + c0, C_K + h * 64 + c0, C_V + h * 64 + c0, C_WL + c0, C_AL + c0};
        float w0c[4], a0c[4];
#pragma unroll
        for (int ct = 0; ct < 4; ++ct) { w0c[ct] = cst[512 + ct * 16 + fr]; a0c[ct] = cst[576 + ct * 16 + fr]; }
        u32x4 qc[5][2], qp[5][2];
#define CLOAD(C) { const int t_ = (C) * 16 + tok; const bf16_t* pr_ = P + ((size_t)b * 2048 + t_) * N1; \
            _Pragma("unroll") for (int sg = 0; sg < 5; ++sg) _Pragma("unroll") for (int hh = 0; hh < 2; ++hh) { qc[sg][hh] = *(const u32x4*)(pr_ + segcol[sg] + hh * 8); \
                if (t_ > 0) qp[sg][hh] = *(const u32x4*)(pr_ - N1 + segcol[sg] + hh * 8); else qp[sg][hh] = (u32x4){0u, 0u, 0u, 0u}; } }
        CLOAD(hw)
        for (int c = hw; c < 128; c += 4) {
            unsigned char* cb = smem + (c % CH_NB) * CH_CB;
            bf16_t* A1 = (bf16_t*)(cb + CB_A1); bf16_t* A2 = (bf16_t*)(cb + CB_A2); bf16_t* TT = (bf16_t*)(cb + CB_TT); bf16_t* A3 = (bf16_t*)(cb + CB_A3); bf16_t* VT = (bf16_t*)(cb + CB_VT); float* GQ = (float*)(cb + CB_GQ);
            const size_t grow = (size_t)b * 2048 + c * 16 + tok;
            if (c >= CH_NB) { while (cons[c - CH_NB] < 4u) __builtin_amdgcn_s_sleep(1); }
            asm volatile("" ::: "memory");
            float* exa = (float*)(cb + CB_A3);
            float xr[16], xk[16]; unsigned xvp[8];
            { float cur[8], prv[8], xw[8], xa[8], xv[8];
#pragma unroll
              for (int hh = 0; hh < 2; ++hh) {
#define LSEG(dst, sg, mo) { unpack8(qc[sg][hh], cur); unpack8(qp[sg][hh], prv); _Pragma("unroll") for (int e = 0; e < 8; ++e) dst[e] = cur[e] + (prv[e] - cur[e]) * cst[(mo) + c0 + hh * 8 + e]; }
                LSEG((xr + hh * 8), 0, 0) LSEG((xk + hh * 8), 1, 64) LSEG(xv, 2, 128) LSEG(xw, 3, 192) LSEG(xa, 4, 256)
#undef LSEG
                { const u32x4 pv = pack8(xv); xvp[hh * 4] = pv.x; xvp[hh * 4 + 1] = pv.y; xvp[hh * 4 + 2] = pv.z; xvp[hh * 4 + 3] = pv.w; }
#pragma unroll
                for (int e = 0; e < 8; ++e) xw[e] = 1.0f - 2.0f / (__expf(2.0f * xw[e]) + 1.0f);
                *(u32x4*)(tw + tok * 72 + c0 + hh * 8) = pack8(xw); *(u32x4*)(ta + tok * 72 + c0 + hh * 8) = pack8(xa);
              } }
            if (c + 4 < 128) CLOAD(c + 4)
            lds_fence();
#pragma unroll
            for (int ct = 0; ct < 4; ++ct) { f32x4 aw = {0.f, 0.f, 0.f, 0.f}, aa = aw;
#pragma unroll
                for (int ks = 0; ks < 2; ++ks) {
                    aw = MFMA16(*(const bf16x8*)(tw + fr * 72 + ks * 32 + fq * 8), *(const bf16x8*)(w2t + (ct * 16 + fr) * 72 + ks * 32 + fq * 8), aw);
                    aa = MFMA16(*(const bf16x8*)(ta + fr * 72 + ks * 32 + fq * 8), *(const bf16x8*)(a2t + (ct * 16 + fr) * 72 + ks * 32 + fq * 8), aa); }
#pragma unroll
                for (int j = 0; j < 4; ++j) { const int tj = fq * 4 + j, col = ct * 16 + fr;
                    exl[tj * 64 + col] = -0.60653066f * sigmoidf_(w0c[ct] + aw[j]);
                    exa[tj * 64 + col] = sigmoidf_(a0c[ct] + aa[j]); } }
            lds_fence();
            { float Lc = 0.f;
#pragma unroll
              for (int t = 0; t < 16; ++t) { Lc += exl[t * 64 + lane]; exl[t * 64 + lane] = __expf(Lc); }
              GQ[lane] = __expf(Lc); }
            float a16[16];
#pragma unroll
            for (int i = 0; i < 4; ++i) { const float4 t4 = *(const float4*)(exa + tok * 64 + c0 + i * 4); a16[i * 4] = t4.x; a16[i * 4 + 1] = t4.y; a16[i * 4 + 2] = t4.z; a16[i * 4 + 3] = t4.w; }
            float ssq = 0.f, beta = 0.f;
#pragma unroll
            for (int e = 0; e < 16; ++e) { const float kr_ = xk[e] * cst[320 + c0 + e]; ssq += kr_ * kr_; }
            ssq += dppf<0xB1>(ssq); ssq += dppf<0x4E>(ssq);
            const float inv = 1.0f / fmaxf(sqrtf(ssq), 1e-12f);
            lds_fence();
            { const int sq = (tok >> 2) * 8 + (tok & 3);
#pragma unroll
              for (int gI = 0; gI < 4; ++gI) {
                float pt[4], rt[4], qt[4], kt[4];
#pragma unroll
                for (int e3 = 0; e3 < 4; ++e3) { const int e = gI * 4 + e3; const float el = exl[tok * 64 + c0 + e], elm = tok > 0 ? exl[(tok - 1) * 64 + c0 + e] : 1.0f, iv = 1.0f / el;
                    const float kk_ = xk[e] * cst[320 + c0 + e] * inv, kp_ = xk[e] * (1.0f + (a16[e] - 1.0f) * cst[384 + c0 + e]), bb_ = -kk_ * a16[e];
                    beta += xr[e] * kp_ * cst[448 + c0 + e];
                    pt[e3] = kk_ * elm; rt[e3] = xr[e] * el; qt[e3] = bb_ * iv; kt[e3] = kp_ * iv;
                    const unsigned qk = cvtpk(qt[e3], kt[e3]);
                    A3[(c0 + e) * 40 + sq] = (bf16_t)(qk & 0xffffu); A3[(c0 + e) * 40 + sq + 4] = (bf16_t)(qk >> 16);
                    VT[(c0 + e) * 24 + tok] = (bf16_t)((e & 1) ? (xvp[e >> 1] >> 16) : (xvp[e >> 1] & 0xffffu)); }
                const int s0 = (q4 >> 1) * 32 + gI * 8 + (q4 & 1) * 4;
                u32x2 w; w.x = cvtpk(pt[0], pt[1]); w.y = cvtpk(pt[2], pt[3]); *(u32x2*)(A1 + tok * 104 + s0) = w;
                w.x = cvtpk(rt[0], rt[1]); w.y = cvtpk(rt[2], rt[3]); *(u32x2*)(A2 + tok * 104 + s0) = w;
                w.x = cvtpk(qt[0], qt[1]); w.y = cvtpk(qt[2], qt[3]); *(u32x2*)(ZQ + tok * 72 + s0) = w;
                w.x = cvtpk(kt[0], kt[1]); w.y = cvtpk(kt[2], kt[3]); *(u32x2*)(ZK + tok * 72 + s0) = w;
              } }
            beta += dppf<0xB1>(beta); beta += dppf<0x4E>(beta);
            { float bv[16];
#pragma unroll
              for (int e = 0; e < 16; ++e) bv[e] = beta * __uint_as_float((e & 1) ? (xvp[e >> 1] & 0xffff0000u) : (xvp[e >> 1] << 16));
              *(u32x4*)(BV + grow * 1024 + h * 64 + c0) = pack8(bv); *(u32x4*)(BV + grow * 1024 + h * 64 + c0 + 8) = pack8(bv + 8); }
            lds_fence();
            { f32x4 gN = {0.f, 0.f, 0.f, 0.f}, gKP = gN, gQR = gN, gKR = gN;
#pragma unroll
              for (int ks = 0; ks < 2; ++ks) {
                  const bf16x8 fzq = *(const bf16x8*)(ZQ + fr * 72 + ks * 32 + fq * 8), fzk = *(const bf16x8*)(ZK + fr * 72 + ks * 32 + fq * 8);
                  const bf16x8 fp = *(const bf16x8*)(A1 + fr * 104 + ks * 32 + fq * 8), frr = *(const bf16x8*)(A2 + fr * 104 + ks * 32 + fq * 8);
                  gN = MFMA16(fzq, fp, gN); gKP = MFMA16(fzk, fp, gKP); gQR = MFMA16(fzq, frr, gQR); gKR = MFMA16(fzk, frr, gKR); }
#pragma unroll
              for (int jj = 0; jj < 4; ++jj) { const int j = fq * 4 + jj; const bool lt = j < fr, le = j <= fr;
                  gN[jj] = lt ? gN[jj] : 0.f; gKP[jj] = lt ? gKP[jj] : 0.f; gQR[jj] = le ? gQR[jj] : 0.f; gKR[jj] = le ? gKR[jj] : 0.f;
                  Nm[j * 17 + fr] = gN[jj]; }
              u32x4 w1; w1.x = 0u; w1.y = 0u; w1.z = cvtpk(gKP[0], gKP[1]); w1.w = cvtpk(gKP[2], gKP[3]); *(u32x4*)(A1 + fr * 104 + 64 + fq * 8) = w1;
              u32x4 w2; w2.x = cvtpk(gQR[0], gQR[1]); w2.y = cvtpk(gQR[2], gQR[3]); w2.z = cvtpk(gKR[0], gKR[1]); w2.w = cvtpk(gKR[2], gKR[3]); *(u32x4*)(A2 + fr * 104 + 64 + fq * 8) = w2; }
            lds_fence();
            { float Ti[16]; int i = fr; asm volatile("" : "+v"(i));
#pragma unroll
              for (int t = 0; t < 16; ++t) { float s = (i == t) ? 1.0f : 0.0f;
#pragma unroll
                  for (int j = 0; j < t; ++j) s += Ti[j] * Nm[j * 17 + t];
                  Ti[t] = s; }
              if (lane < 16) { const int sq = (i >> 2) * 8 + (i & 3);
#pragma unroll
                  for (int t = 0; t < 16; ++t) TT[t * 40 + sq] = f2bf(Ti[t]); } }
            lds_fence();
            if (lane == 0) ready[c] = 1u;
        }
#undef CLOAD
    } else {
        const int v0 = wid * 16;
        f32x4 acc[4];
#pragma unroll
        for (int kt = 0; kt < 4; ++kt) acc[kt] = (f32x4){0.f, 0.f, 0.f, 0.f};
        for (int c = 0; c < 128; ++c) {
            const unsigned char* cb = smem + (c % CH_NB) * CH_CB;
            const bf16_t* A1 = (const bf16_t*)(cb + CB_A1); const bf16_t* A2 = (const bf16_t*)(cb + CB_A2); const bf16_t* TT = (const bf16_t*)(cb + CB_TT); const bf16_t* A3 = (const bf16_t*)(cb + CB_A3);
            const bf16_t* VT = (const bf16_t*)(cb + CB_VT); const float* GQ = (const float*)(cb + CB_GQ);
            while (ready[c] == 0u) __builtin_amdgcn_s_sleep(1);
            asm volatile("" ::: "memory");
            union { u32x4 u; bf16x8 h; } B0, B1, BX;
            B0.u.x = cvtpk(acc[0][0], acc[0][1]); B0.u.y = cvtpk(acc[0][2], acc[0][3]); B0.u.z = cvtpk(acc[1][0], acc[1][1]); B0.u.w = cvtpk(acc[1][2], acc[1][3]);
            B1.u.x = cvtpk(acc[2][0], acc[2][1]); B1.u.y = cvtpk(acc[2][2], acc[2][3]); B1.u.z = cvtpk(acc[3][0], acc[3][1]); B1.u.w = cvtpk(acc[3][2], acc[3][3]);
            const u32x2 vq = *(const u32x2*)(VT + (v0 + fr) * 24 + fq * 4);
            BX.u.x = 0u; BX.u.y = 0u; BX.u.z = vq.x; BX.u.w = vq.y;
            f32x4 rhs = {0.f, 0.f, 0.f, 0.f};
            rhs = MFMA16(*(const bf16x8*)(A1 + fr * 104 + fq * 8), B0.h, rhs);
            rhs = MFMA16(*(const bf16x8*)(A1 + fr * 104 + 32 + fq * 8), B1.h, rhs);
            rhs = MFMA16(*(const bf16x8*)(A1 + fr * 104 + 64 + fq * 8), BX.h, rhs);
            BX.u.x = pk2(rhs[0], rhs[1]); BX.u.y = pk2(rhs[2], rhs[3]); BX.u.z = 0u; BX.u.w = 0u;
            f32x4 uu = {0.f, 0.f, 0.f, 0.f};
            uu = MFMA16(*(const bf16x8*)(TT + fr * 40 + fq * 8), BX.h, uu);
            BX.u.x = pk2(uu[0], uu[1]); BX.u.y = pk2(uu[2], uu[3]); BX.u.z = vq.x; BX.u.w = vq.y;
            f32x4 oo = {0.f, 0.f, 0.f, 0.f};
            oo = MFMA16(*(const bf16x8*)(A2 + fr * 104 + fq * 8), B0.h, oo);
            oo = MFMA16(*(const bf16x8*)(A2 + fr * 104 + 32 + fq * 8), B1.h, oo);
            oo = MFMA16(*(const bf16x8*)(A2 + fr * 104 + 64 + fq * 8), BX.h, oo);
#pragma unroll
            for (int kt = 0; kt < 4; ++kt) { acc[kt] = MFMA16(*(const bf16x8*)(A3 + (kt * 16 + fr) * 40 + fq * 8), BX.h, acc[kt]);
                const float4 gq = *(const float4*)(GQ + kt * 16 + fq * 4); acc[kt][0] *= gq.x; acc[kt][1] *= gq.y; acc[kt][2] *= gq.z; acc[kt][3] *= gq.w; }
            asm volatile("s_waitcnt lgkmcnt(0)" ::: "memory");
            if (lane == 0) __hip_atomic_fetch_add((unsigned*)&cons[c], 1u, __ATOMIC_RELAXED, __HIP_MEMORY_SCOPE_WORKGROUP);
            float* op = ORAW + ((size_t)b * 2048 + c * 16 + fq * 4) * 1024 + h * 64 + v0 + fr;
#pragma unroll
            for (int jj = 0; jj < 4; ++jj) op[(size_t)jj * 1024] = oo[jj];
        }
        float* so = p.out + O_PWKV + ((((size_t)l * 8 + b) * 16 + h) * 64 + v0 + fr) * 64 + fq * 4;
#pragma unroll
        for (int kt = 0; kt < 4; ++kt) *(float4*)(so + kt * 16) = make_float4(acc[kt][0], acc[kt][1], acc[kt][2], acc[kt][3]);
    }
    __syncthreads();
}

__device__ void rwkv_sample_item(const Params& p, int l, int item, unsigned char* smem_) {
    unsigned char* smem = launder_lds(smem_);
    const int tid = tid_l(), lane = tid & 63, ks = tid >> 6;
    const int i = item >> 4, h = item & 15;
    float* part = (float*)smem;
    float* sv = part + 1024;
    float* s_sc = sv + 384;
    const bf16_t* P = (const bf16_t*)(p.ws + WS_P);
    float* ORAW = (float*)(p.ws + WS_ORAW);
    bf16_t* BV = (bf16_t*)(p.ws + WS_BV);
    const size_t rowp = (size_t)TP + i, rows = (size_t)TALL + i;
    const bf16_t* pc = P + rowp * N1; const bf16_t* pp = P + rows * N1;
    const float* mu = p.in[I_MU] + (size_t)l * 3200;
    const int gc = h * 64 + lane;
    const int row = tid >> 3, cs = (tid & 7) * 8;
    const size_t so = ((((size_t)l * TS + i) * 16 + h) * 64 + row) * 64 + cs;
    const float4 a0 = *(const float4*)(p.in[I_SWKV] + so), a1 = *(const float4*)(p.in[I_SWKV] + so + 4);
#define LERP1(col) (bf2f(pc[col]) + (bf2f(pp[col]) - bf2f(pc[col])) * mu[col])
    { const float* w2 = p.in[I_W2] + (size_t)l * 64 * 1024 + gc; const float* a2 = p.in[I_A2] + (size_t)l * 64 * 1024 + gc;
      float lw = 0.f, la = 0.f;
#pragma unroll
      for (int kk = 0; kk < 8; ++kk) { const int k = ks * 8 + kk; const float xwl = LERP1(C_WL + k), xal = LERP1(C_AL + k);
          lw += (1.0f - 2.0f / (__expf(2.0f * xwl) + 1.0f)) * w2[(size_t)k * 1024]; la += xal * a2[(size_t)k * 1024]; }
      __syncthreads();
      part[ks * 64 + lane] = lw; part[512 + ks * 64 + lane] = la; }
    __syncthreads();
    if (tid < 64) {
        const float xr = LERP1(C_R + gc), xk = LERP1(C_K + gc), xv = LERP1(C_V + gc);
        float lw = 0.f, la = 0.f;
#pragma unroll
        for (int q = 0; q < 8; ++q) { lw += part[q * 64 + lane]; la += part[512 + q * 64 + lane]; }
        const float w = __expf(-0.60653066f * sigmoidf_(p.in[I_W0][l * 1024 + gc] + lw));
        const float a = sigmoidf_(p.in[I_A0][l * 1024 + gc] + la);
        float kk = xk * p.in[I_KK][l * 1024 + gc];
        const float ssq = wave_sum(kk * kk);
        kk *= 1.0f / fmaxf(sqrtf(ssq), 1e-12f);
        const float kp = xk * (1.0f + (a - 1.0f) * p.in[I_KA][l * 1024 + gc]);
        const float bb = -kk * a, wr = w * xr;
        const float br = wave_sum(bb * xr), kr = wave_sum(kp * xr), beta = wave_sum(xr * kp * p.in[I_RK][l * 1024 + gc]);
        sv[lane] = w; sv[64 + lane] = kk; sv[128 + lane] = bb; sv[192 + lane] = kp; sv[256 + lane] = wr; sv[320 + lane] = xv;
        if (lane == 0) { s_sc[0] = br; s_sc[1] = kr; }
        BV[rowp * 1024 + gc] = f2bf(beta * xv);
    }
#undef LERP1
    __syncthreads();
    {
        float S[8] = {a0.x, a0.y, a0.z, a0.w, a1.x, a1.y, a1.z, a1.w};
        float dk = 0.f, dr = 0.f;
#pragma unroll
        for (int e = 0; e < 8; ++e) { dk += S[e] * sv[64 + cs + e]; dr += S[e] * sv[256 + cs + e]; }
        dk = red8(dk); dr = red8(dr);
        const float vr = sv[320 + row];
        const float o = dr + dk * s_sc[0] + vr * s_sc[1];
        if ((tid & 7) == 0) ORAW[rowp * 1024 + h * 64 + row] = o;
#pragma unroll
        for (int e = 0; e < 8; ++e) S[e] = S[e] * sv[cs + e] + dk * sv[128 + cs + e] + vr * sv[192 + cs + e];
        float* sout = p.out + O_SWKV + so;
        *(float4*)sout = make_float4(S[0], S[1], S[2], S[3]); *(float4*)(sout + 4) = make_float4(S[4], S[5], S[6], S[7]);
    }
}

__device__ void phase_conv(const Params& p, int l) {
    const int tid = tid_l();
    const bf16_t* P = (const bf16_t*)(p.ws + WS_P);
    bf16_t* U = (bf16_t*)(p.ws + WS_U); float* DT = (float*)(p.ws + WS_DT);
    for (int id = blockIdx.x * 512 + tid; id < 1024 * 384; id += gridDim.x * 512) {
        const int q = id % 384, seg = id / 384, xcol = q * 4;
        const int bb = seg >> 7, tb = (seg & 127) * 16;
        float4 cw0, cw1, cw2, cw3, cbv;
        { const float* cw = p.in[I_CW] + (size_t)l * 4 * 1536 + xcol; cw0 = *(const float4*)cw; cw1 = *(const float4*)(cw + 1536); cw2 = *(const float4*)(cw + 3072); cw3 = *(const float4*)(cw + 4608);
          cbv = *(const float4*)(p.in[I_CB] + (size_t)l * 1536 + xcol); }
        const bf16_t* pb = P + ((size_t)bb * 2048 + tb) * N1 + C_XBC + xcol;
        bf16_t* ub = U + ((size_t)bb * 2048 + tb) * 1536 + xcol;
        float4 w0 = make_float4(0.f, 0.f, 0.f, 0.f), w1 = w0, w2 = w0;
#define LD4(dst, ptr) { const u32x2 _v = *(const u32x2*)(ptr); dst = make_float4(__uint_as_float(_v.x << 16), __uint_as_float(_v.x & 0xffff0000u), __uint_as_float(_v.y << 16), __uint_as_float(_v.y & 0xffff0000u)); }
        if (tb >= 3) { LD4(w0, pb - 3 * (size_t)N1) LD4(w1, pb - 2 * (size_t)N1) LD4(w2, pb - (size_t)N1) }
#pragma unroll
        for (int s = 0; s < 16; ++s) {
            float4 cur; LD4(cur, pb + (size_t)s * N1)
            float4 u;
            u.x = cbv.x + cw0.x * w0.x + cw1.x * w1.x + cw2.x * w2.x + cw3.x * cur.x; u.y = cbv.y + cw0.y * w0.y + cw1.y * w1.y + cw2.y * w2.y + cw3.y * cur.y;
            u.z = cbv.z + cw0.z * w0.z + cw1.z * w1.z + cw2.z * w2.z + cw3.z * cur.z; u.w = cbv.w + cw0.w * w0.w + cw1.w * w1.w + cw2.w * w2.w + cw3.w * cur.w;
            u32x2 pk; pk.x = pk2(siluf_(u.x), siluf_(u.y)); pk.y = pk2(siluf_(u.z), siluf_(u.w));
            *(u32x2*)(ub + (size_t)s * 1536) = pk;
            w0 = w1; w1 = w2; w2 = cur;
        }
#undef LD4
    }
    for (int id = blockIdx.x * 512 + tid; id < TP * 16; id += gridDim.x * 512) {
        const int t = id >> 4, j = id & 15;
        DT[id] = softplusf_(bf2f(P[(size_t)t * N1 + C_DT + j]) + p.in[I_DTB][l * 16 + j]);
    }
}

__device__ void mamba_item(const Params& p, int l, int item, unsigned char* smem_) {
    unsigned char* smem = launder_lds(smem_);
    const int tid = tid_l(), wid = tid >> 6, lane = tid & 63, fr = lane & 15, fq = lane >> 4;
    const int b = item >> 5, j = (item >> 1) & 15, ph = item & 1, g = j >> 3;
    bf16_t* Cm = (bf16_t*)smem;
    bf16_t* Bm = (bf16_t*)(smem + 17408);
    bf16_t* BmT = (bf16_t*)(smem + 34816);
    bf16_t* XT = (bf16_t*)(smem + 53248);
    bf16_t* XwT = (bf16_t*)(smem + 57856);
    bf16_t* G = (bf16_t*)(smem + 62464);
    bf16_t* Hb = (bf16_t*)(smem + 71680);
    float* acs = (float*)(smem + 80384);
    float* dtv = acs + 64;
    const bf16_t* P = (const bf16_t*)(p.ws + WS_P);
    const bf16_t* U = (const bf16_t*)(p.ws + WS_U); const float* DT = (const float*)(p.ws + WS_DT);
    bf16_t* YM = (bf16_t*)(p.ws + WS_YM);
    __syncthreads();
    for (int i = tid; i < 32 * 136; i += 512) Hb[i] = 0;
    const float Aj = -__expf(p.in[I_ALOG][l * 16 + j]), Dj = p.in[I_DSK][l * 16 + j];
    const int s_a = tid >> 4, c16 = tid & 15, s_x = (tid >> 2) & 63, c4 = tid & 3;
    const int lt = wid >> 1, pt = wid & 1;
    const bf16_t* ub = U + (size_t)b * 2048 * 1536;
    u32x4 rb0, rb1, rc0, rc1, rx = {0u, 0u, 0u, 0u}; float rdt = 0.f;
#define LOADCHUNK(T0) { const bf16_t* r0 = ub + (size_t)((T0) + s_a) * 1536 + g * 128 + c16 * 8; const bf16_t* r1 = r0 + 32 * 1536; \
        rb0 = *(const u32x4*)(r0 + 1024); rb1 = *(const u32x4*)(r1 + 1024); rc0 = *(const u32x4*)(r0 + 1280); rc1 = *(const u32x4*)(r1 + 1280); \
        if (tid < 256) rx = *(const u32x4*)(ub + (size_t)((T0) + s_x) * 1536 + j * 64 + ph * 32 + c4 * 8); \
        if (wid == 5) rdt = DT[((size_t)b * 2048 + (T0) + lane) * 16 + j]; }
    LOADCHUNK(0)
    f32x4 hacc[2] = {{0.f, 0.f, 0.f, 0.f}, {0.f, 0.f, 0.f, 0.f}};
    for (int c = 0; c < 32; ++c) {
        const int t0 = c * 64;
        float zq[4];
#pragma unroll
        for (int jj = 0; jj < 4; ++jj) zq[jj] = bf2f(P[((size_t)b * 2048 + t0 + lt * 16 + fq * 4 + jj) * N1 + C_ZM + j * 64 + ph * 32 + pt * 16 + fr]);
        *(u32x4*)(Cm + s_a * 136 + c16 * 8) = rc0; *(u32x4*)(Cm + (s_a + 32) * 136 + c16 * 8) = rc1;
        *(u32x4*)(Bm + s_a * 136 + c16 * 8) = rb0; *(u32x4*)(Bm + (s_a + 32) * 136 + c16 * 8) = rb1;
#pragma unroll
        for (int e = 0; e < 8; ++e) { const unsigned v0 = rb0[e >> 1], v1 = rb1[e >> 1];
            BmT[(c16 * 8 + e) * 72 + s_a] = (bf16_t)((e & 1) ? (v0 >> 16) : (v0 & 0xffffu)); BmT[(c16 * 8 + e) * 72 + s_a + 32] = (bf16_t)((e & 1) ? (v1 >> 16) : (v1 & 0xffffu)); }
        if (tid < 256) {
#pragma unroll
            for (int e = 0; e < 8; ++e) { const unsigned v0 = rx[e >> 1]; XT[(c4 * 8 + e) * 72 + s_x] = (bf16_t)((e & 1) ? (v0 >> 16) : (v0 & 0xffffu)); }
        }
        if (wid == 5) {
            float v = rdt * Aj;
#pragma unroll
            for (int off = 1; off < 64; off <<= 1) { const float t = __shfl_up(v, off); if (lane >= off) v += t; }
            acs[lane] = v; dtv[lane] = rdt;
        }
        if (c + 1 < 32) LOADCHUNK(t0 + 64)
        LBAR();
        { const int pp = tid & 31, s4 = (tid >> 5) * 4; const float aend = acs[63];
          const u32x2 xv = *(const u32x2*)(XT + pp * 72 + s4);
          const float x0 = __uint_as_float(xv.x << 16), x1 = __uint_as_float(xv.x & 0xffff0000u), x2 = __uint_as_float(xv.y << 16), x3 = __uint_as_float(xv.y & 0xffff0000u);
          u32x2 bq; bq.x = pk2(x0 * dtv[s4] * __expf(aend - acs[s4]), x1 * dtv[s4 + 1] * __expf(aend - acs[s4 + 1]));
          bq.y = pk2(x2 * dtv[s4 + 2] * __expf(aend - acs[s4 + 2]), x3 * dtv[s4 + 3] * __expf(aend - acs[s4 + 3]));
          *(u32x2*)(XwT + pp * 72 + s4) = bq; }
#pragma unroll
        for (int e = 0; e < 2; ++e) {
            const int id = wid * 2 + e, glt = id >> 2, st = id & 3;
            f32x4 acc = {0.f, 0.f, 0.f, 0.f};
            if (st <= glt) {
#pragma unroll
                for (int ks = 0; ks < 4; ++ks) { const bf16x8 fa = *(const bf16x8*)(Cm + (glt * 16 + fr) * 136 + ks * 32 + fq * 8), fb = *(const bf16x8*)(Bm + (st * 16 + fr) * 136 + ks * 32 + fq * 8); acc = MFMA16(fa, fb, acc); }
            }
#pragma unroll
            for (int jj = 0; jj < 4; ++jj) { const int lr = glt * 16 + fq * 4 + jj, s = st * 16 + fr;
                const float val = (s <= lr) ? acc[jj] * __expf(acs[lr] - acs[s]) * dtv[s] : 0.f;
                G[lr * 72 + s] = f2bf(val); }
        }
        f32x4 accO = {0.f, 0.f, 0.f, 0.f};
#pragma unroll
        for (int ks = 0; ks < 4; ++ks) { const bf16x8 fa = *(const bf16x8*)(Cm + (lt * 16 + fr) * 136 + ks * 32 + fq * 8), fb = *(const bf16x8*)(Hb + (pt * 16 + fr) * 136 + ks * 32 + fq * 8); accO = MFMA16(fa, fb, accO); }
        LBAR();
        {
            f32x4 accD = {0.f, 0.f, 0.f, 0.f};
#pragma unroll
            for (int ks = 0; ks < 2; ++ks) { const bf16x8 fa = *(const bf16x8*)(G + (lt * 16 + fr) * 72 + ks * 32 + fq * 8), fb = *(const bf16x8*)(XT + (pt * 16 + fr) * 72 + ks * 32 + fq * 8); accD = MFMA16(fa, fb, accD); }
#pragma unroll
            for (int jj = 0; jj < 4; ++jj) { const int lr = lt * 16 + fq * 4 + jj, pp = pt * 16 + fr;
                float y = accD[jj] + __expf(acs[lr]) * accO[jj] + Dj * bf2f(XT[pp * 72 + lr]);
                y *= siluf_(zq[jj]);
                YM[((size_t)b * 2048 + t0 + lr) * 1024 + j * 64 + ph * 32 + pp] = f2bf(y); }
            const float cd = __expf(acs[63]); const int ptile = wid >> 2;
#pragma unroll
            for (int e = 0; e < 2; ++e) { const int nt = (wid & 3) * 2 + e;
                hacc[e] *= cd;
#pragma unroll
                for (int ks = 0; ks < 2; ++ks) { const bf16x8 fa = *(const bf16x8*)(XwT + (ptile * 16 + fr) * 72 + ks * 32 + fq * 8), fb = *(const bf16x8*)(BmT + (nt * 16 + fr) * 72 + ks * 32 + fq * 8); hacc[e] = MFMA16(fa, fb, hacc[e]); }
#pragma unroll
                for (int jj = 0; jj < 4; ++jj) Hb[(ptile * 16 + fq * 4 + jj) * 136 + nt * 16 + fr] = f2bf(hacc[e][jj]); }
        }
        LBAR();
    }
#undef LOADCHUNK
    { const int ptile = wid >> 2;
#pragma unroll
      for (int e = 0; e < 2; ++e) { const int nt = (wid & 3) * 2 + e;
#pragma unroll
          for (int jj = 0; jj < 4; ++jj) p.out[O_PSSM + ((((size_t)l * 8 + b) * 16 + j) * 64 + ph * 32 + ptile * 16 + fq * 4 + jj) * 128 + nt * 16 + fr] = hacc[e][jj]; } }
    __syncthreads();
}

__device__ void mamba_sample_item(const Params& p, int l, int item, unsigned char* smem_) {
    unsigned char* smem = launder_lds(smem_);
    const int tid = tid_l();
    const int i = item >> 4, j = item & 15, g = j >> 3;
    float* su = (float*)smem;
    float* sd = su + 320;
    const bf16_t* P = (const bf16_t*)(p.ws + WS_P);
    bf16_t* YM = (bf16_t*)(p.ws + WS_YM);
    const size_t rowp = (size_t)TP + i;
    const int pp = tid >> 3, n0 = (tid & 7) * 16;
    const size_t so = ((((size_t)l * TS + i) * 16 + j) * 64 + pp) * 128 + n0;
    float4 hv4[4];
#pragma unroll
    for (int e = 0; e < 4; ++e) hv4[e] = *(const float4*)(p.in[I_SSSM] + so + e * 4);
    __syncthreads();
    if (tid < 320) {
        const int cc = tid < 64 ? j * 64 + tid : (tid < 192 ? 1024 + g * 128 + (tid - 64) : 1280 + g * 128 + (tid - 192));
        const float* c0 = p.in[I_SCONV] + ((size_t)l * TS + i) * 3 * 1536 + cc;
        const float* cw = p.in[I_CW] + (size_t)l * 4 * 1536 + cc;
        const float v = p.in[I_CB][l * 1536 + cc] + c0[0] * cw[0] + c0[1536] * cw[1536] + c0[3072] * cw[3072] + bf2f(P[rowp * N1 + C_XBC + cc]) * cw[4608];
        su[tid] = siluf_(v);
    } else if (tid == 320) {
        const float dt = softplusf_(bf2f(P[rowp * N1 + C_DT + j]) + p.in[I_DTB][l * 16 + j]);
        sd[0] = dt; sd[1] = __expf(-dt * __expf(p.in[I_ALOG][l * 16 + j]));
    }
    __syncthreads();
    {
        float* hout = p.out + O_SSSM + so;
        const float dt = sd[0], eA = sd[1], x = su[pp], xdt = x * dt;
        float y = 0.f;
#pragma unroll
        for (int e = 0; e < 4; ++e) { float4 hv = hv4[e]; const float* Bp = su + 64 + n0 + e * 4; const float* Cp = su + 192 + n0 + e * 4;
            hv.x = eA * hv.x + xdt * Bp[0]; hv.y = eA * hv.y + xdt * Bp[1]; hv.z = eA * hv.z + xdt * Bp[2]; hv.w = eA * hv.w + xdt * Bp[3];
            y += hv.x * Cp[0] + hv.y * Cp[1] + hv.z * Cp[2] + hv.w * Cp[3];
            *(float4*)(hout + e * 4) = hv; }
        y = red8(y);
        if ((tid & 7) == 0) { y += p.in[I_DSK][l * 16 + j] * x; const float z = bf2f(P[rowp * N1 + C_ZM + j * 64 + pp]); YM[rowp * 1024 + j * 64 + pp] = f2bf(y * siluf_(z)); }
    }
}

__device__ void phase_mixa(const Params& p, int l, unsigned char* smem) {
    phase_conv(p, l);
    for (int rep = 0; rep < (DUP == 3 ? 2 : 1); ++rep)
    for (int it = blockIdx.x; it < 2048; it += gridDim.x) rwkv_sample_item(p, l, it, smem);
    for (int rep = 0; rep < (DUP == 4 ? 2 : 1); ++rep)
    for (int it = blockIdx.x; it < 2048; it += gridDim.x) mamba_sample_item(p, l, it, smem);
}
__device__ void phase_mixb(const Params& p, int l, unsigned char* smem) {
    for (int rep = 0; rep < (DUP == 1 ? 2 : 1); ++rep)
    for (int it = blockIdx.x; it < 128; it += gridDim.x) rwkv_chain_item(p, l, it, smem);
    for (int rep = 0; rep < (DUP == 2 ? 2 : 1); ++rep)
    for (int it = blockIdx.x; it < 256; it += gridDim.x) mamba_item(p, l, it, smem);
}

__device__ void sample_outproj(const Params& p, int l) {
    const int tid = tid_l(), wid = tid >> 6, lane = tid & 63, fr = lane & 15, fq = lane >> 4;
    const bf16_t* A2 = (const bf16_t*)(p.ws + WS_A) + (size_t)TP * 2048;
    const bf16_t* W = (const bf16_t*)(p.ws + WS_WOUTT) + (size_t)l * 1024 * 2048;
    float* PART = (float*)(p.ws + WS_PART);
    for (int it = blockIdx.x; it < 256; it += gridDim.x) {
        const int nt = it & 15, ksl = it >> 4;
        f32x4 acc[4] = {{0.f, 0.f, 0.f, 0.f}, {0.f, 0.f, 0.f, 0.f}, {0.f, 0.f, 0.f, 0.f}, {0.f, 0.f, 0.f, 0.f}};
#pragma unroll
        for (int kq = 0; kq < 4; ++kq) {
            const bf16x8 fa = *(const bf16x8*)(A2 + (size_t)(wid * 16 + fr) * 2048 + ksl * 128 + kq * 32 + fq * 8);
#pragma unroll
            for (int ct = 0; ct < 4; ++ct) { const bf16x8 fb = *(const bf16x8*)(W + (size_t)(nt * 64 + ct * 16 + fr) * 2048 + ksl * 128 + kq * 32 + fq * 8); acc[ct] = MFMA16(fa, fb, acc[ct]); }
        }
#pragma unroll
        for (int ct = 0; ct < 4; ++ct)
#pragma unroll
            for (int jj = 0; jj < 4; ++jj) PART[((size_t)ksl * TS + wid * 16 + fq * 4 + jj) * 1024 + nt * 64 + ct * 16 + fr] = acc[ct][jj];
    }
}

__device__ void phase_post(const Params& p, int l) {
    const int tid_ = tid_l(); const int lane = tid_ & 63, wid = tid_ >> 6;
    const bf16_t* P = (const bf16_t*)(p.ws + WS_P);
    const float* ORAW = (const float*)(p.ws + WS_ORAW);
    const bf16_t* BV = (const bf16_t*)(p.ws + WS_BV);
    const bf16_t* YM = (const bf16_t*)(p.ws + WS_YM);
    bf16_t* A2 = (bf16_t*)(p.ws + WS_A);
    const int c0 = lane * 16;
    float lnw[16], lnb[16], gnw[16];
#pragma unroll
    for (int e = 0; e < 16; ++e) { lnw[e] = p.in[I_LNW][l * 1024 + c0 + e]; lnb[e] = p.in[I_LNB][l * 1024 + c0 + e]; gnw[e] = p.in[I_GNW][l * 1024 + c0 + e]; }
    for (int row = blockIdx.x * 8 + wid; row < TALL; row += gridDim.x * 8) {
        const bf16_t* prow = P + (size_t)row * N1;
        float o[16], bv[16], z[16], ym[16];
#pragma unroll
        for (int i = 0; i < 4; ++i) { const float4 t = *(const float4*)(ORAW + (size_t)row * 1024 + c0 + i * 4); o[i * 4] = t.x; o[i * 4 + 1] = t.y; o[i * 4 + 2] = t.z; o[i * 4 + 3] = t.w; }
        unpack8(*(const u32x4*)(BV + (size_t)row * 1024 + c0), bv); unpack8(*(const u32x4*)(BV + (size_t)row * 1024 + c0 + 8), bv + 8);
        unpack8(*(const u32x4*)(prow + C_ZR + c0), z); unpack8(*(const u32x4*)(prow + C_ZR + c0 + 8), z + 8);
        unpack8(*(const u32x4*)(YM + (size_t)row * 1024 + c0), ym); unpack8(*(const u32x4*)(YM + (size_t)row * 1024 + c0 + 8), ym + 8);
        float s = 0.f;
#pragma unroll
        for (int e = 0; e < 16; ++e) s += o[e];
        s += dppf<0xB1>(s); s += dppf<0x4E>(s);
        const float mean = s * (1.0f / 64.0f);
        float v = 0.f;
#pragma unroll
        for (int e = 0; e < 16; ++e) { o[e] -= mean; v += o[e] * o[e]; }
        v += dppf<0xB1>(v); v += dppf<0x4E>(v);
        const float rstd = rsqrtf(v * (1.0f / 64.0f) + 64e-5f);
#pragma unroll
        for (int e = 0; e < 16; ++e) o[e] = (o[e] * rstd * lnw[e] + lnb[e] + bv[e]) * siluf_(z[e]);
        *(u32x4*)(A2 + (size_t)row * 2048 + c0) = pack8(o); *(u32x4*)(A2 + (size_t)row * 2048 + c0 + 8) = pack8(o + 8);
        float ss = 0.f;
#pragma unroll
        for (int e = 0; e < 16; ++e) ss += ym[e] * ym[e];
        ss = red16(ss); ss += __shfl_xor(ss, 16);
        const float rs = rsqrtf(ss * (1.0f / 512.0f) + 1e-5f);
#pragma unroll
        for (int e = 0; e < 16; ++e) ym[e] *= rs * gnw[e];
        *(u32x4*)(A2 + (size_t)row * 2048 + 1024 + c0) = pack8(ym); *(u32x4*)(A2 + (size_t)row * 2048 + 1024 + c0 + 8) = pack8(ym + 8);
        if (row < TP) {
            const int tq = row & 2047;
            if (tq >= 2045) { float* dst = p.out + O_PCONV + (((size_t)l * 8 + (row >> 11)) * 3 + (tq - 2045)) * 1536;
                for (int c = lane; c < 1536; c += 64) dst[c] = bf2f(prow[C_XBC + c]); }
        } else {
            const int i = row - TP; float* dst = p.out + O_SCONV + ((size_t)l * TS + i) * 3 * 1536; const float* src = p.in[I_SCONV] + ((size_t)l * TS + i) * 3 * 1536;
            for (int c = lane; c < 1536; c += 64) { dst[c] = src[1536 + c]; dst[1536 + c] = src[3072 + c]; dst[3072 + c] = bf2f(prow[C_XBC + c]); }
        }
    }
}

constexpr int NPHASE = 13;
__global__ __launch_bounds__(512, 2) void mega(Params p) {
    extern __shared__ __attribute__((aligned(16))) unsigned char smem[];
    cg::grid_group grid = cg::this_grid();
    volatile LAS unsigned* st = (volatile LAS unsigned*)((LAS unsigned char*)smem + LDS_BARST);
    { const unsigned hw = (unsigned)__builtin_amdgcn_s_getreg((5 << 11) | 4) & 63u;
      if ((threadIdx.x & 63) == 0) *(volatile LAS int*)((LAS unsigned char*)smem + LDS_WIDTAB + hw * 4u) = (int)(threadIdx.x >> 6);
      if (threadIdx.x == 0) { st[0] = 0u; st[1] = 0u; } }
    __syncthreads();
    const XcdBarrier xbar = xcd_barrier_post((unsigned*)(p.ws + WS_BAR), st);
    if (p.ph_hi > 1000) grid.sync();
#define PHASE(K, BODY) if (p.ph_lo <= (K) && (K) < p.ph_hi) { if ((K) > p.ph_lo) { xcd_barrier(xbar); if (DUP == 13) { xcd_barrier(xbar); xcd_barrier(xbar); } } BODY }
#define GEMM1(L) { pg8::Gemm g{(const bf16_t*)(p.ws + WS_A), (const bf16_t*)(p.ws + WS_WINT) + (size_t)(L) * N1 * 1024, M1, N1, 1024}; \
        pg8::StaticOrder S; S.init(M1, N1, (int)gridDim.x, (int)blockIdx.x); EpiP E{(bf16_t*)(p.ws + WS_P), N1}; \
        pg8::gemm_phase<EpiP, pg8::StaticOrder, false>((PG8_LAS unsigned char*)smem, g, S, E, nullptr); }
#define GEMM2(L) { sample_outproj(p, (L)); \
        pg8::Gemm g{(const bf16_t*)(p.ws + WS_A), (const bf16_t*)(p.ws + WS_WOUTT) + (size_t)(L) * 1024 * 2048, TP, 1024, 2048}; \
        pg8::StaticOrder S; S.init(TP, 1024, (int)gridDim.x, (int)blockIdx.x); EpiRes E{(L) == 0 ? p.in[I_XP] : p.out + O_YP, p.out + O_YP}; \
        pg8::gemm_phase<EpiRes, pg8::StaticOrder, false>((PG8_LAS unsigned char*)smem, g, S, E, nullptr); }
    PHASE(0, phase_convert(p, smem); phase_norm(p, 0);)
    PHASE(1, GEMM1(0))
    PHASE(2, phase_mixa(p, 0, smem);)
    PHASE(3, phase_mixb(p, 0, smem);)
    PHASE(4, phase_post(p, 0);)
    PHASE(5, GEMM2(0))
    PHASE(6, phase_norm(p, 1);)
    PHASE(7, GEMM1(1))
    PHASE(8, phase_mixa(p, 1, smem);)
    PHASE(9, phase_mixb(p, 1, smem);)
    PHASE(10, phase_post(p, 1);)
    PHASE(11, GEMM2(1))
    PHASE(12, phase_final(p);)
}

extern "C" void kernel_launch(void* const* d_in, const int* in_sizes, int n_in, void* d_out, int out_size, void* d_ws, size_t ws_size, hipStream_t stream) {
    static int grid = 0;
    if (grid == 0) {
        if (n_in != 26 || (size_t)out_size != O_END || ws_size < WS_BAR + (size_t)XCD_BAR_WORDS * 4) { fprintf(stderr, "kernel_launch: unexpected shapes: n_in %d out %d ws %zu (need %zu)\n", n_in, out_size, ws_size, (size_t)(WS_BAR + XCD_BAR_WORDS * 4)); grid = -1; return; }
        int dev = 0, cus = 0, per_cu = 0;
        hipGetDevice(&dev); hipDeviceGetAttribute(&cus, hipDeviceAttributeMultiprocessorCount, dev);
        if (hipFuncSetAttribute((const void*)mega, hipFuncAttributeMaxDynamicSharedMemorySize, LDS_BYTES) != hipSuccess) { fprintf(stderr, "kernel_launch: hipFuncSetAttribute failed\n"); grid = -1; return; }
        if (hipOccupancyMaxActiveBlocksPerMultiprocessor(&per_cu, (const void*)mega, 512, LDS_BYTES) != hipSuccess || per_cu < 1) { fprintf(stderr, "kernel_launch: occupancy query gave %d\n", per_cu); per_cu = 1; }
        (void)hipGetLastError();
        grid = cus * 1;
    }
    if (grid < 0) return;
    if (hipMemsetAsync((char*)d_ws + WS_BAR, 0, (size_t)XCD_BAR_WORDS * 4, stream) != hipSuccess) { fprintf(stderr, "kernel_launch: memset of barrier words failed\n"); return; }
    Params p{};
    for (int i = 0; i < 26; ++i) p.in[i] = (const float*)d_in[i];
    p.out = (float*)d_out; p.ws = (unsigned char*)d_ws;
#if MK_PER_PHASE
    for (int ph = 0; ph < NPHASE; ++ph) { p.ph_lo = ph; p.ph_hi = ph + 1; hipLaunchKernelGGL(mega, dim3(grid), dim3(512), LDS_BYTES, stream, p); }
#else
    p.ph_lo = 0; p.ph_hi = NPHASE;
    void* args[] = {&p};
    hipError_t e = hipLaunchCooperativeKernel((const void*)mega, dim3(grid), dim3(512), args, LDS_BYTES, stream);
    if (e != hipSuccess) fprintf(stderr, "cooperative launch failed: %s (grid %d)\n", hipGetErrorString(e), grid);
#endif
}
```

```cpp
#include <hip/hip_runtime.h>
#include <hip/hip_cooperative_groups.h>
#include <cstdio>
namespace cg = cooperative_groups;

#define LDS_WIDTAB 146944
__device__ __forceinline__ int tid_l() {
    const unsigned hw = (unsigned)__builtin_amdgcn_s_getreg((5 << 11) | 4) & 63u;
    const int wid = *(volatile __attribute__((address_space(3))) int*)(unsigned long)(LDS_WIDTAB + hw * 4u);
    int ln; asm volatile("v_mbcnt_lo_u32_b32 %0, -1, 0\n\tv_mbcnt_hi_u32_b32 %0, -1, %0" : "=v"(ln));
    return __builtin_amdgcn_readfirstlane(wid) * 64 + ln; }
namespace pg8 {
#define PG8_LAS __attribute__((address_space(3)))
typedef unsigned short bf16_t;
typedef short bf16x8 __attribute__((ext_vector_type(8)));
typedef float f32x4 __attribute__((ext_vector_type(4)));
typedef unsigned u32x4 __attribute__((ext_vector_type(4)));
constexpr int BM = 256, BK = 64, HALF = 128, HTB = HALF * BK * 2  , STAGE_BYTES = 8 * HTB, NXCD = 8, WGM = 8;

__host__ __device__ __forceinline__ int lds_byte(int r, int c) { const int st = (r >> 4) * 2 + (c >> 5), rr = r & 15, cc = c & 31, ob = rr * 64 + cc * 2; return st * 1024 + (ob ^ (((ob >> 9) & 1) << 5)); }
__host__ __device__ __forceinline__ void stage_rc(int b, int& R, int& C) { const int st = b / 1024, sb = b % 1024, swz = sb ^ (((sb >> 9) & 1) << 5); R = (st >> 1) * 16 + swz / 64; C = (st & 1) * 32 + (swz % 64) / 2; }
__host__ __device__ __forceinline__ int perm32(int rho) { const int n = rho >> 4, i = rho & 15; return 8 * (i >> 2) + 4 * n + (i & 3); }

struct Unit { int pm, pn; };
struct Gemm { const bf16_t* A; const bf16_t* Bt; int M, N, K; };

struct StaticOrder {
    int nM, nN, nwg, G, c;
    __host__ __device__ void init(int M, int N, int G_, int c_) { nM = M / BM; nN = N / BM; nwg = nM * nN; G = G_; c = c_; }
    __host__ __device__ bool next(int i, Unit& u) const {
        const long L = (long)i * G + c; if (L >= nwg) return false;
        int wgid = (int)L; { const int q = nwg / NXCD, r = nwg % NXCD, xcd = wgid % NXCD, off = wgid / NXCD; wgid = (xcd < r ? xcd * (q + 1) : r * (q + 1) + (xcd - r) * q) + off; }
        const int nig = WGM * nN, gid = wgid / nig, fm = gid * WGM, gsz = (nM - fm) < WGM ? (nM - fm) : WGM;
        u.pm = fm + ((wgid % nig) % gsz); u.pn = (wgid % nig) / gsz; return true;
    }
    __device__ __forceinline__ void a_ready(const Unit&) const {}
    __device__ __forceinline__ void done(const Unit&) const {}
};
__device__ __forceinline__ unsigned cvt_pk_bf16(float lo, float hi) { unsigned r; asm volatile("v_cvt_pk_bf16_f32 %0, %1, %2" : "=v"(r) : "v"(lo), "v"(hi)); return r; }
template <class Epi, class Sched, bool STAMP = false>
__device__ __forceinline__ void gemm_phase(PG8_LAS unsigned char* lds, const Gemm g, const Sched& S, const Epi& E, unsigned long long* stamps) {
    const int tid = tid_l(), wid = __builtin_amdgcn_readfirstlane(tid >> 6), lane = tid & 63, wr = wid >> 2, wc = wid & 3, fr = lane & 15, fq = lane >> 4;
    const int K = g.K, nt = K / BK;
    int ts_lo = 0, ts_hi = 0, nts = 0; const unsigned long long rt_entry = STAMP ? (unsigned long long)wall_clock64() : 0ull;
#define PG8_STAMP() do { if (STAMP && wid == 0 && nts < 64) { const unsigned long long _c = (unsigned long long)clock64(); \
        ts_lo = (lane == nts) ? (int)(unsigned)_c : ts_lo; ts_hi = (lane == nts) ? (int)(unsigned)(_c >> 32) : ts_hi; ++nts; } } while (0)
    PG8_STAMP();
    unsigned voffA[2], voffB[2];
#pragma unroll
    for (int i = 0; i < 2; ++i) { int R, C; stage_rc(tid * 16 + i * 8192, R, C); const int Rb = Epi::PERM ? ((R & ~31) + perm32(R & 31)) : R;
        voffA[i] = (unsigned)(R * K + C) * 2u; voffB[i] = (unsigned)(Rb * K + C) * 2u; }
    const size_t kstep = (size_t)(BK * 2);
    const size_t hstep = (size_t)HALF * K * 2;
    const size_t tstep = 2 * hstep;
    const unsigned ldsw = (unsigned)wid * 1024u;
    const int aoff = lds_byte(wr * 64 + fr, fq * 8), boff = lds_byte(wc * 32 + fr, fq * 8);
#define PG8_SA(b, h) (((b) * 2 + (h)) * HTB)
#define PG8_SB(b, h) ((4 + (b) * 2 + (h)) * HTB)
#define PG8_STAGE(bufoff, gbase, voff) do { _Pragma("unroll") for (int _i = 0; _i < 2; ++_i) \
        __builtin_amdgcn_global_load_lds((const unsigned*)((const char*)(gbase) + (voff)[_i]), (PG8_LAS unsigned*)(lds + (bufoff) + ldsw + _i * 8192), 16, 0, 0); } while (0)
#define PG8_LDA(dst, b, h) do { _Pragma("unroll") for (int m = 0; m < 4; ++m) _Pragma("unroll") for (int k = 0; k < 2; ++k) dst[m][k] = *(const PG8_LAS bf16x8*)(lds + PG8_SA(b, h) + aoff + m * 2048 + k * 1024); } while (0)
#define PG8_LDB(dst, b, h) do { _Pragma("unroll") for (int n = 0; n < 2; ++n) _Pragma("unroll") for (int k = 0; k < 2; ++k) dst[n][k] = *(const PG8_LAS bf16x8*)(lds + PG8_SB(b, h) + boff + n * 2048 + k * 1024); } while (0)
#define PG8_MMA(ai, bj, At, Bt) do { __builtin_amdgcn_s_setprio(1); _Pragma("unroll") for (int m = 0; m < 4; ++m) _Pragma("unroll") for (int n = 0; n < 2; ++n) _Pragma("unroll") for (int k = 0; k < 2; ++k) \
        acc[ai][bj][m][n] = __builtin_amdgcn_mfma_f32_16x16x32_bf16(Bt[n][k], At[m][k], acc[ai][bj][m][n], 0, 0, 0); __builtin_amdgcn_s_setprio(0); } while (0)
#define PG8_WAIT_V(n) asm volatile("s_waitcnt vmcnt(" #n ")" ::: "memory")
#define PG8_WAIT_L(n) asm volatile("s_waitcnt lgkmcnt(" #n ")" ::: "memory")
#define PG8_BAR __builtin_amdgcn_s_barrier()
#define PG8_SCHED __builtin_amdgcn_sched_barrier(0)
    Unit cur, nxt; int ui = 0;
    if (!S.next(0, cur)) return;
    f32x4 acc[2][2][4][2];
#pragma unroll
    for (int a = 0; a < 2; ++a)
#pragma unroll
        for (int b = 0; b < 2; ++b)
#pragma unroll
            for (int m = 0; m < 4; ++m)
#pragma unroll
                for (int n = 0; n < 2; ++n) acc[a][b][m][n] = (f32x4){0.f, 0.f, 0.f, 0.f};
    bf16x8 At[4][2], B0[2][2], B1[2][2];
    const char* cA = (const char*)g.A + (size_t)cur.pm * tstep; const char* cB = (const char*)g.Bt + (size_t)cur.pn * tstep;
    S.a_ready(cur);
    PG8_STAGE(PG8_SB(0, 0), cB, voffB); PG8_STAGE(PG8_SA(0, 0), cA, voffA); PG8_STAGE(PG8_SB(0, 1), cB + hstep, voffB); PG8_STAGE(PG8_SA(0, 1), cA + hstep, voffA);
    if (wr == 1) PG8_BAR;
    PG8_WAIT_V(4); PG8_BAR;
    PG8_STAGE(PG8_SB(1, 0), cB + kstep, voffB); PG8_STAGE(PG8_SA(1, 0), cA + kstep, voffA); PG8_STAGE(PG8_SB(1, 1), cB + hstep + kstep, voffB);
    PG8_WAIT_V(6); PG8_BAR;
    PG8_STAMP();
    for (;;) {
        const bool has_next = S.next(ui + 1, nxt);
        const char* nA = has_next ? (const char*)g.A + (size_t)nxt.pm * tstep : cA; const char* nB = has_next ? (const char*)g.Bt + (size_t)nxt.pn * tstep : cB;
        for (int t = 0; t < nt; t += 2) {
            const bool last = (t == nt - 2);
            const char* a1 = cA + (size_t)(t + 1) * kstep;
            const char* a2 = last ? nA : cA + (size_t)(t + 2) * kstep; const char* b2 = last ? nB : cB + (size_t)(t + 2) * kstep;
            const char* a3 = a2 + kstep; const char* b3 = b2 + kstep;
            if (last && has_next) S.a_ready(nxt);
            PG8_LDB(B0, 0, 0); PG8_SCHED; PG8_LDA(At, 0, 0); PG8_STAGE(PG8_SA(1, 1), a1 + hstep, voffA);
            PG8_WAIT_L(8); PG8_BAR; PG8_WAIT_L(0); PG8_MMA(0, 0, At, B0); PG8_BAR; PG8_SCHED;
            PG8_LDB(B1, 0, 1); PG8_STAGE(PG8_SB(0, 0), b2, voffB);
            PG8_BAR; PG8_WAIT_L(0); PG8_MMA(0, 1, At, B1); PG8_BAR;
            PG8_LDA(At, 0, 1); PG8_STAGE(PG8_SA(0, 0), a2, voffA);
            PG8_BAR; PG8_WAIT_L(0); PG8_MMA(1, 0, At, B0); PG8_BAR; PG8_SCHED;
            PG8_STAGE(PG8_SB(0, 1), b2 + hstep, voffB);
            PG8_WAIT_V(6); PG8_BAR; PG8_MMA(1, 1, At, B1); PG8_BAR;
            PG8_LDB(B0, 1, 0); PG8_SCHED; PG8_LDA(At, 1, 0); PG8_STAGE(PG8_SA(0, 1), a2 + hstep, voffA);
            PG8_WAIT_L(8); PG8_BAR; PG8_WAIT_L(0); PG8_MMA(0, 0, At, B0); PG8_BAR; PG8_SCHED;
            PG8_LDB(B1, 1, 1); PG8_STAGE(PG8_SB(1, 0), b3, voffB);
            PG8_BAR; PG8_WAIT_L(0); PG8_MMA(0, 1, At, B1); PG8_BAR;
            PG8_LDA(At, 1, 1); PG8_STAGE(PG8_SA(1, 0), a3, voffA);
            PG8_BAR; PG8_WAIT_L(0); PG8_MMA(1, 0, At, B0); PG8_BAR; PG8_SCHED;
            PG8_STAGE(PG8_SB(1, 1), b3 + hstep, voffB);
            PG8_WAIT_V(6); PG8_BAR; PG8_MMA(1, 1, At, B1); PG8_BAR;
        }
        PG8_STAMP();
        if constexpr (!Epi::AFTER_DRAIN) { E(acc, cur, wr, wc, fr, fq); S.done(cur); }
        PG8_STAMP();
        if (!has_next) break;
#pragma unroll
        for (int a = 0; a < 2; ++a)
#pragma unroll
            for (int b = 0; b < 2; ++b)
#pragma unroll
                for (int m = 0; m < 4; ++m)
#pragma unroll
                    for (int n = 0; n < 2; ++n) acc[a][b][m][n] = (f32x4){0.f, 0.f, 0.f, 0.f};
        cur = nxt; cA = nA; cB = nB; ++ui;
    }
    PG8_WAIT_V(0);
    if (wr == 0) PG8_BAR;
    PG8_BAR;
    if constexpr (Epi::AFTER_DRAIN) { E.fused(acc, cur, wr, wc, fr, fq, lds, wid, lane); S.done(cur); }
    PG8_STAMP();
    if (STAMP && wid == 0) { stamps[lane] = lane < nts ? (((unsigned long long)(unsigned)ts_hi << 32) | (unsigned)ts_lo) : 0ull;
        if (lane == 62) stamps[62] = rt_entry; if (lane == 63) stamps[63] = (unsigned long long)wall_clock64(); }
#undef PG8_STAMP
#undef PG8_SA
#undef PG8_SB
#undef PG8_STAGE
#undef PG8_LDA
#undef PG8_LDB
#undef PG8_MMA
#undef PG8_WAIT_V
#undef PG8_WAIT_L
#undef PG8_BAR
#undef PG8_SCHED
}
}

#define XB_TMO      128
#define XB_XCNT(j)  (256  + 64 * (j))
#define XB_XSUB(j)  (1280 + 64 * (j))
#define XB_XGEN(j)  (2304 + 64 * (j))
#define XB_TOP      3328
#define XB_TOPGEN   3392
#define XCD_BAR_WORDS 3456
#define XB_SPIN_CAP (1u << 18)
#define LAS __attribute__((address_space(3)))

__device__ __forceinline__ unsigned xb_ld(unsigned* p)              { return __hip_atomic_load(p, __ATOMIC_RELAXED, __HIP_MEMORY_SCOPE_AGENT); }
__device__ __forceinline__ unsigned xb_add(unsigned* p, unsigned v) { return __hip_atomic_fetch_add(p, v, __ATOMIC_RELAXED, __HIP_MEMORY_SCOPE_AGENT); }
__device__ __forceinline__ unsigned xb_xcc_id() { return (unsigned)__builtin_amdgcn_s_getreg((3 << 11) | 20) & 0xFu; }
#define XB_SPIN(cond, bar) do { unsigned _sp = 0; while (cond) { __builtin_amdgcn_s_sleep(1); \
    if ((++_sp & 255u) == 0u) { if (xb_ld(&(bar)[XB_TMO])) break; if (_sp > XB_SPIN_CAP) { atomicAdd(&(bar)[XB_TMO], 1u); break; } } } } while (0)
struct XcdBarrier {
    unsigned* bar; unsigned x;
    volatile LAS unsigned* st;
};

__device__ __forceinline__ XcdBarrier xcd_barrier_post(unsigned* bar, volatile LAS unsigned* st) {
    XcdBarrier b; b.bar = bar; b.x = xb_xcc_id(); b.st = st;
    if (tid_l() == 0) (void)xb_add(&bar[XB_XCNT(b.x)], 1u);
    return b;
}
__device__ __forceinline__ void xcd_barrier_complete(unsigned* bar, unsigned x, unsigned& nloc, unsigned& nx) {
    const unsigned G = gridDim.x * gridDim.y * gridDim.z;
    unsigned sum, cnt, mine, sp = 0u;
    for (;;) {
        sum = 0u; cnt = 0u; mine = 0u;
#pragma unroll
        for (unsigned j = 0; j < 16; ++j) { const unsigned c = xb_ld(&bar[XB_XCNT(j)]); sum += c; cnt += (c > 0u) ? 1u : 0u; mine = (j == x) ? c : mine; }
        if (sum == G) break;
        __builtin_amdgcn_s_sleep(1);
        if ((++sp & 255u) == 0u) { if (xb_ld(&bar[XB_TMO])) break; if (sp > XB_SPIN_CAP) { atomicAdd(&bar[XB_TMO], 1u); break; } }
    }
    nloc = mine > 0u ? mine : 1u; nx = cnt > 0u ? cnt : 1u;
}

__device__ __forceinline__ void xcd_barrier(const XcdBarrier& b) {
    asm volatile("s_waitcnt vmcnt(0)" ::: "memory");
    __syncthreads();
    if (tid_l() == 0) {
        unsigned* bar = b.bar;
        __builtin_amdgcn_s_waitcnt(0);
        unsigned nloc = b.st[0], nx = b.st[1];
        if (nloc == 0u) { xcd_barrier_complete(bar, b.x, nloc, nx); b.st[0] = nloc; b.st[1] = nx; }
        const unsigned old = xb_add(&bar[XB_XSUB(b.x)], 1u);
        const unsigned gen = old / nloc;
        if (old + 1u == (gen + 1u) * nloc) {
            __builtin_amdgcn_fence(__ATOMIC_RELEASE, "agent");
            asm volatile("s_waitcnt vmcnt(0)" ::: "memory");
            const unsigned og = xb_add(&bar[XB_TOP], 1u);
            const unsigned tg = og / nx;
            if (og + 1u == (tg + 1u) * nx) xb_add(&bar[XB_TOPGEN], 1u);
            else XB_SPIN(xb_ld(&bar[XB_TOPGEN]) == tg, bar);
            __builtin_amdgcn_fence(__ATOMIC_ACQUIRE, "agent");
            xb_add(&bar[XB_XGEN(b.x)], 1u);
            asm volatile("s_waitcnt vmcnt(0)" ::: "memory");
        } else {
            XB_SPIN(xb_ld(&bar[XB_XGEN(b.x)]) == gen, bar);
            __builtin_amdgcn_fence(__ATOMIC_ACQUIRE, "agent");
            asm volatile("s_waitcnt vmcnt(0)" ::: "memory");
        }
    }
    __syncthreads();
}

typedef unsigned short bf16_t;
typedef short bf16x8 __attribute__((ext_vector_type(8)));
typedef float f32x4 __attribute__((ext_vector_type(4)));
typedef unsigned u32x4 __attribute__((ext_vector_type(4)));
typedef unsigned u32x2 __attribute__((ext_vector_type(2)));

#ifndef DUP
#define DUP 0
#endif
#ifndef MK_PER_PHASE
#define MK_PER_PHASE 0
#endif

constexpr int TP = 16384, TS = 128, TALL = 16512, M1 = 16640, N1 = 6912, NIN = 6800;
constexpr int C_R = 0, C_K = 1024, C_V = 2048, C_WL = 3072, C_AL = 3136, C_ZR = 3200, C_ZM = 4224, C_XBC = 5248, C_DT = 6784;
constexpr size_t O_YP = 0, O_YS = 16777216, O_PSH = 16908288, O_PWKV = 16924672, O_PCONV = 17973248, O_PSSM = 18046976,
                 O_SSH = 20144128, O_SWKV = 20406272, O_SCONV = 37183488, O_SSSM = 38363136, O_END = 71917568;
constexpr size_t WS_WINT = 0;
constexpr size_t WS_WOUTT = WS_WINT + (size_t)2 * N1 * 1024 * 2;
constexpr size_t WS_A = WS_WOUTT + (size_t)2 * 1024 * 2048 * 2;
constexpr size_t WS_P = WS_A + (size_t)M1 * 2048 * 2;
constexpr size_t WS_ORAW = WS_P + (size_t)M1 * N1 * 2;
constexpr size_t WS_BV = WS_ORAW + (size_t)TALL * 1024 * 4;
constexpr size_t WS_YM = WS_BV + (size_t)TALL * 1024 * 2;
constexpr size_t WS_END = WS_YM + (size_t)TALL * 1024 * 2;
constexpr size_t WS_U = WS_A;
constexpr size_t WS_DT = WS_U + (size_t)TP * 1536 * 2;
constexpr size_t WS_PART = WS_ORAW;
constexpr size_t WS_BAR = (WS_END + 4095) & ~(size_t)4095;
constexpr int LDS_BYTES = 147456, LDS_BARST = 147440;

struct Params { const float* in[26]; float* out; unsigned char* ws; int ph_lo, ph_hi; };
enum { I_XP = 0, I_XS, I_SSHIFT, I_SWKV, I_SCONV, I_SSSM, I_NORMW, I_WIN, I_MU, I_W0, I_W2, I_A0, I_A2, I_KK, I_KA, I_RK, I_LNW, I_LNB, I_CW, I_CB, I_DTB, I_ALOG, I_DSK, I_GNW, I_WOUT, I_FNW };

__device__ __forceinline__ float bf2f(unsigned short b) { return __uint_as_float(((unsigned)b) << 16); }
__device__ __forceinline__ unsigned short f2bf(float f) { unsigned u = __float_as_uint(f); u += 0x7FFFu + ((u >> 16) & 1u); return (unsigned short)(u >> 16); }
__device__ __forceinline__ unsigned pk2(float lo, float hi) { return (unsigned)f2bf(lo) | ((unsigned)f2bf(hi) << 16); }
__device__ __forceinline__ void unpack8(const u32x4 v, float* f) {
    f[0] = __uint_as_float(v.x << 16); f[1] = __uint_as_float(v.x & 0xffff0000u); f[2] = __uint_as_float(v.y << 16); f[3] = __uint_as_float(v.y & 0xffff0000u);
    f[4] = __uint_as_float(v.z << 16); f[5] = __uint_as_float(v.z & 0xffff0000u); f[6] = __uint_as_float(v.w << 16); f[7] = __uint_as_float(v.w & 0xffff0000u); }
__device__ __forceinline__ u32x4 pack8(const float* f) { u32x4 r; r.x = pk2(f[0], f[1]); r.y = pk2(f[2], f[3]); r.z = pk2(f[4], f[5]); r.w = pk2(f[6], f[7]); return r; }
__device__ __forceinline__ float sigmoidf_(float x) { return 1.0f / (1.0f + __expf(-x)); }
__device__ __forceinline__ float siluf_(float x) { return x / (1.0f + __expf(-x)); }
__device__ __forceinline__ float softplusf_(float x) { return x > 20.f ? x : log1pf(__expf(x)); }
template <int CTRL> __device__ __forceinline__ float dppf(float v) { return __int_as_float(__builtin_amdgcn_mov_dpp(__float_as_int(v), CTRL, 0xF, 0xF, true)); }
__device__ __forceinline__ float red8(float x) { x += dppf<0xB1>(x); x += dppf<0x4E>(x); x += dppf<0x141>(x); return x; }
__device__ __forceinline__ float red16(float x) { x = red8(x); x += dppf<0x140>(x); return x; }
__device__ __forceinline__ float wave_sum(float x) {
#pragma unroll
    for (int o = 32; o > 0; o >>= 1) x += __shfl_xor(x, o);
    return x; }
__device__ __forceinline__ void lds_fence() { asm volatile("s_waitcnt lgkmcnt(0)" ::: "memory"); }
__device__ __forceinline__ unsigned char* launder_lds(unsigned char* sm) { int off = 0; asm volatile("" : "+s"(off)); return sm + off; }
#define LBAR() do { asm volatile("s_waitcnt lgkmcnt(0)" ::: "memory"); __builtin_amdgcn_s_barrier(); asm volatile("" ::: "memory"); } while (0)
#define MFMA16(a, b, c) __builtin_amdgcn_mfma_f32_16x16x32_bf16((a), (b), (c), 0, 0, 0)

__device__ void phase_convert(const Params& p, unsigned char* smem_) {
    unsigned char* smem = launder_lds(smem_);
    float* tile = (float*)smem;
    const int tid = tid_l();
    constexpr int NT_IN = 16 * 108, NT_OUT = 32 * 16, PER_L = NT_IN + NT_OUT;
    for (int it = blockIdx.x; it < 2 * PER_L; it += gridDim.x) {
        const int l = it / PER_L; int r = it % PER_L;
        const float* src; bf16_t* dst; int K, Nsrc, kt, nt;
        if (r < NT_IN) { src = p.in[I_WIN] + (size_t)l * 1024 * NIN; dst = (bf16_t*)(p.ws + WS_WINT) + (size_t)l * N1 * 1024; K = 1024; Nsrc = NIN; kt = r & 15; nt = r >> 4; }
        else { r -= NT_IN; src = p.in[I_WOUT] + (size_t)l * 2048 * 1024; dst = (bf16_t*)(p.ws + WS_WOUTT) + (size_t)l * 1024 * 2048; K = 2048; Nsrc = 1024; kt = r & 31; nt = r >> 5; }
#pragma unroll
        for (int i = 0; i < 2; ++i) {
            const int rr = (tid >> 4) + 32 * i, c4 = (tid & 15) * 4, col = nt * 64 + c4;
            float4 v = make_float4(0.f, 0.f, 0.f, 0.f);
            if (col < Nsrc) v = *(const float4*)(src + (size_t)(kt * 64 + rr) * Nsrc + col);
            float* tp = tile + rr * 65 + c4; tp[0] = v.x; tp[1] = v.y; tp[2] = v.z; tp[3] = v.w;
        }
        __syncthreads();
        { const int n = tid >> 3, k8 = (tid & 7) * 8; float f[8];
#pragma unroll
          for (int j = 0; j < 8; ++j) f[j] = tile[(k8 + j) * 65 + n];
          *(u32x4*)(dst + (size_t)(nt * 64 + n) * K + kt * 64 + k8) = pack8(f); }
        __syncthreads();
    }
}

__device__ void phase_norm(const Params& p, int l) {
    const int tid_ = tid_l(); const int lane = tid_ & 63, wid = tid_ >> 6;
    bf16_t* A1 = (bf16_t*)(p.ws + WS_A);
    const float* nw = p.in[I_NORMW] + l * 1024;
    for (int row = blockIdx.x * 8 + wid; row < M1; row += gridDim.x * 8) {
        const float* src;
        if (row < TP) src = (l == 0 ? p.in[I_XP] : p.out + O_YP) + (size_t)row * 1024;
        else if (row < TALL) src = (l == 0 ? p.in[I_XS] : p.out + O_YS) + (size_t)(row - TP) * 1024;
        else src = p.in[I_SSHIFT] + ((size_t)l * TS + (row - TALL)) * 1024;
        float4 v[4]; float ss = 0.f;
#pragma unroll
        for (int i = 0; i < 4; ++i) v[i] = *(const float4*)(src + i * 256 + lane * 4);
        if (l == 1 && row >= TP && row < TALL) {
            const float* x0 = p.in[I_XS] + (size_t)(row - TP) * 1024; const float* pt = (const float*)(p.ws + WS_PART) + (size_t)(row - TP) * 1024;
#pragma unroll
            for (int i = 0; i < 4; ++i) { float4 a = *(const float4*)(x0 + i * 256 + lane * 4);
                for (int q = 0; q < 16; ++q) { const float4 t = *(const float4*)(pt + (size_t)q * TS * 1024 + i * 256 + lane * 4); a.x += t.x; a.y += t.y; a.z += t.z; a.w += t.w; }
                v[i] = a; *(float4*)(p.out + O_YS + (size_t)(row - TP) * 1024 + i * 256 + lane * 4) = a; }
        }
#pragma unroll
        for (int i = 0; i < 4; ++i) ss += v[i].x * v[i].x + v[i].y * v[i].y + v[i].z * v[i].z + v[i].w * v[i].w;
        if (row < TALL) {
            ss = wave_sum(ss);
            const float rs = rsqrtf(ss * (1.0f / 1024.0f) + 1e-5f);
#pragma unroll
            for (int i = 0; i < 4; ++i) { const float4 w = *(const float4*)(nw + i * 256 + lane * 4); v[i].x *= rs * w.x; v[i].y *= rs * w.y; v[i].z *= rs * w.z; v[i].w *= rs * w.w; }
            float* so = nullptr;
            if (row < TP) { if ((row & 2047) == 2047) so = p.out + O_PSH + ((size_t)l * 8 + (row >> 11)) * 1024; }
            else so = p.out + O_SSH + ((size_t)l * TS + (row - TP)) * 1024;
            if (so) {
#pragma unroll
                for (int i = 0; i < 4; ++i) *(float4*)(so + i * 256 + lane * 4) = v[i]; }
        }
#pragma unroll
        for (int i = 0; i < 4; ++i) { u32x2 w; w.x = pk2(v[i].x, v[i].y); w.y = pk2(v[i].z, v[i].w); *(u32x2*)(A1 + (size_t)row * 1024 + i * 256 + lane * 4) = w; }
    }
}

__device__ void phase_final(const Params& p) {
    const int tid_ = tid_l(); const int lane = tid_ & 63, wid = tid_ >> 6;
    const float* nw = p.in[I_FNW];
    for (int row = blockIdx.x * 8 + wid; row < TALL; row += gridDim.x * 8) {
        float* src = (row < TP) ? p.out + O_YP + (size_t)row * 1024 : p.out + O_YS + (size_t)(row - TP) * 1024;
        float4 v[4]; float ss = 0.f;
#pragma unroll
        for (int i = 0; i < 4; ++i) v[i] = *(const float4*)(src + i * 256 + lane * 4);
        if (row >= TP) { const float* pt = (const float*)(p.ws + WS_PART) + (size_t)(row - TP) * 1024;
#pragma unroll
            for (int i = 0; i < 4; ++i) for (int q = 0; q < 16; ++q) { const float4 t = *(const float4*)(pt + (size_t)q * TS * 1024 + i * 256 + lane * 4); v[i].x += t.x; v[i].y += t.y; v[i].z += t.z; v[i].w += t.w; } }
#pragma unroll
        for (int i = 0; i < 4; ++i) ss += v[i].x * v[i].x + v[i].y * v[i].y + v[i].z * v[i].z + v[i].w * v[i].w;
        ss = wave_sum(ss);
        const float rs = rsqrtf(ss * (1.0f / 1024.0f) + 1e-5f);
#pragma unroll
        for (int i = 0; i < 4; ++i) { const float4 w = *(const float4*)(nw + i * 256 + lane * 4); v[i].x *= rs * w.x; v[i].y *= rs * w.y; v[i].z *= rs * w.z; v[i].w *= rs * w.w;
            *(float4*)(src + i * 256 + lane * 4) = v[i]; }
    }
}

struct EpiP {
    static constexpr bool PERM = true, AFTER_DRAIN = false;
    bf16_t* O; int ldc;
    __device__ __forceinline__ void operator()(const f32x4 (&acc)[2][2][4][2], const pg8::Unit& u, int wr, int wc, int fr, int fq) const {
        const int row0 = u.pm * 256 + wr * 64 + fr, col0 = u.pn * 256 + wc * 32 + 8 * fq;
#pragma unroll
        for (int ai = 0; ai < 2; ++ai)
#pragma unroll
            for (int m = 0; m < 4; ++m) { bf16_t* rowp = O + (size_t)(row0 + ai * 128 + m * 16) * ldc + col0;
#pragma unroll
                for (int bj = 0; bj < 2; ++bj) { const f32x4 v0 = acc[ai][bj][m][0], v1 = acc[ai][bj][m][1];
                    u32x4 w; w.x = pg8::cvt_pk_bf16(v0[0], v0[1]); w.y = pg8::cvt_pk_bf16(v0[2], v0[3]); w.z = pg8::cvt_pk_bf16(v1[0], v1[1]); w.w = pg8::cvt_pk_bf16(v1[2], v1[3]);
                    *(u32x4*)(rowp + bj * 128) = w; } }
    }
};
struct EpiRes {
    static constexpr bool PERM = false, AFTER_DRAIN = false;
    const float* res_p; float* out_p;
    __device__ __forceinline__ void operator()(const f32x4 (&acc)[2][2][4][2], const pg8::Unit& u, int wr, int wc, int fr, int fq) const {
        const int row0 = u.pm * 256 + wr * 64 + fr, col0 = u.pn * 256 + wc * 32 + 4 * fq;
#pragma unroll
        for (int ai = 0; ai < 2; ++ai)
#pragma unroll
            for (int m = 0; m < 4; ++m) { const size_t ro = (size_t)(row0 + ai * 128 + m * 16) * 1024;
#pragma unroll
                for (int bj = 0; bj < 2; ++bj)
#pragma unroll
                    for (int n = 0; n < 2; ++n) { const int c = col0 + bj * 128 + n * 16; const f32x4 r = *(const f32x4*)(res_p + ro + c); *(f32x4*)(out_p + ro + c) = acc[ai][bj][m][n] + r; } }
    }
};

constexpr int CH_NB = 5, CH_CB = 16384;
constexpr int CB_A1 = 0, CB_A2 = 3328, CB_TT = 6656, CB_A3 = 7936, CB_VT = 13056, CB_GQ = 16128;
constexpr int CH_SCR = CH_NB * CH_CB;
constexpr int SCR_TW = 0, SCR_EXL = 4608, SCR_NM = 8704, SCR_SZ = 9856;
constexpr int CH_W2T = CH_SCR + 4 * SCR_SZ;
constexpr int CH_CST = CH_W2T + 18432;
constexpr int CH_FLG = CH_CST + 2560;
__device__ __forceinline__ unsigned cvtpk(float lo, float hi) { return pg8::cvt_pk_bf16(lo, hi); }
__device__ void rwkv_chain_item(const Params& p, int l, int item, unsigned char* smem_) {
    unsigned char* smem = launder_lds(smem_);
    const int tid = tid_l(), wid = tid >> 6, lane = tid & 63, fr = lane & 15, fq = lane >> 4;
    const int b = item >> 4, h = item & 15;
    bf16_t* w2t = (bf16_t*)(smem + CH_W2T); bf16_t* a2t = w2t + 4608;
    float* cst = (float*)(smem + CH_CST);
    volatile unsigned* ready = (volatile unsigned*)(smem + CH_FLG); volatile unsigned* cons = ready + 128;
    const bf16_t* P = (const bf16_t*)(p.ws + WS_P);
    float* ORAW = (float*)(p.ws + WS_ORAW);
    bf16_t* BV = (bf16_t*)(p.ws + WS_BV);
    __syncthreads();
    for (int i = tid; i < (CH_SCR + 4 * SCR_SZ) / 4; i += 512) ((unsigned*)smem)[i] = 0u;
    if (tid < 256) ((unsigned*)(smem + CH_FLG))[tid] = 0u;
    { const float* w2 = p.in[I_W2] + (size_t)l * 64 * 1024 + h * 64; const float* a2 = p.in[I_A2] + (size_t)l * 64 * 1024 + h * 64;
#pragma unroll
      for (int i = 0; i < 8; ++i) { const int idx = tid + 512 * i, k = idx >> 6, n = idx & 63; w2t[n * 72 + k] = f2bf(w2[(size_t)k * 1024 + n]); a2t[n * 72 + k] = f2bf(a2[(size_t)k * 1024 + n]); } }
    if (tid < 64) { const float* mu = p.in[I_MU] + (size_t)l * 3200; const int gc = h * 64 + tid;
        cst[tid] = mu[C_R + gc]; cst[64 + tid] = mu[C_K + gc]; cst[128 + tid] = mu[C_V + gc]; cst[192 + tid] = mu[C_WL + tid]; cst[256 + tid] = mu[C_AL + tid];
        cst[320 + tid] = p.in[I_KK][l * 1024 + gc]; cst[384 + tid] = p.in[I_KA][l * 1024 + gc]; cst[448 + tid] = p.in[I_RK][l * 1024 + gc];
        cst[512 + tid] = p.in[I_W0][l * 1024 + gc]; cst[576 + tid] = p.in[I_A0][l * 1024 + gc]; }
    __syncthreads();

    if (wid >= 4) {
        const int hw = wid - 4, tok = lane >> 2, q4 = lane & 3, c0 = q4 * 16;
        unsigned char* scr = smem + CH_SCR + hw * SCR_SZ;
        bf16_t* tw = (bf16_t*)(scr + SCR_TW); bf16_t* ta = tw + 1152;
        bf16_t* ZQ = (bf16_t*)(scr + SCR_TW); bf16_t* ZK = ZQ + 1152;
        float* exl = (float*)(scr + SCR_EXL);
        float* Nm = (float*)(scr + SCR_NM);
        const int segcol[5] = {C_R + h * 64 + c0, C_K + h * 64 + c0, C_V + h * 64 + c0, C_WL + c0, C_AL + c0};
        float w0c[4], a0c[4];
#pragma unroll
        for (int ct = 0; ct < 4; ++ct) { w0c[ct] = cst[512 + ct * 16 + fr]; a0c[ct] = cst[576 + ct * 16 + fr]; }
        u32x4 qc[5][2], qp[5][2];
#define CLOAD(C) { const int t_ = (C) * 16 + tok; const bf16_t* pr_ = P + ((size_t)b * 2048 + t_) * N1; \
            _Pragma("unroll") for (int sg = 0; sg < 5; ++sg) _Pragma("unroll") for (int hh = 0; hh < 2; ++hh) { qc[sg][hh] = *(const u32x4*)(pr_ + segcol[sg] + hh * 8); \
                if (t_ > 0) qp[sg][hh] = *(const u32x4*)(pr_ - N1 + segcol[sg] + hh * 8); else qp[sg][hh] = (u32x4){0u, 0u, 0u, 0u}; } }
        CLOAD(hw)
        for (int c = hw; c < 128; c += 4) {
            unsigned char* cb = smem + (c % CH_NB) * CH_CB;
            bf16_t* A1 = (bf16_t*)(cb + CB_A1); bf16_t* A2 = (bf16_t*)(cb + CB_A2); bf16_t* TT = (bf16_t*)(cb + CB_TT); bf16_t* A3 = (bf16_t*)(cb + CB_A3); bf16_t* VT = (bf16_t*)(cb + CB_VT); float* GQ = (float*)(cb + CB_GQ);
            const size_t grow = (size_t)b * 2048 + c * 16 + tok;
            if (c >= CH_NB) { while (cons[c - CH_NB] < 4u) __builtin_amdgcn_s_sleep(1); }
            asm volatile("" ::: "memory");
            float* exa = (float*)(cb + CB_A3);
            float xr[16], xk[16]; unsigned xvp[8];
            { float cur[8], prv[8], xw[8], xa[8], xv[8];
#pragma unroll
              for (int hh = 0; hh < 2; ++hh) {
#define LSEG(dst, sg, mo) { unpack8(qc[sg][hh], cur); unpack8(qp[sg][hh], prv); _Pragma("unroll") for (int e = 0; e < 8; ++e) dst[e] = cur[e] + (prv[e] - cur[e]) * cst[(mo) + c0 + hh * 8 + e]; }
                LSEG((xr + hh * 8), 0, 0) LSEG((xk + hh * 8), 1, 64) LSEG(xv, 2, 128) LSEG(xw, 3, 192) LSEG(xa, 4, 256)
#undef LSEG
                { const u32x4 pv = pack8(xv); xvp[hh * 4] = pv.x; xvp[hh * 4 + 1] = pv.y; xvp[hh * 4 + 2] = pv.z; xvp[hh * 4 + 3] = pv.w; }
#pragma unroll
                for (int e = 0; e < 8; ++e) xw[e] = 1.0f - 2.0f / (__expf(2.0f * xw[e]) + 1.0f);
                *(u32x4*)(tw + tok * 72 + c0 + hh * 8) = pack8(xw); *(u32x4*)(ta + tok * 72 + c0 + hh * 8) = pack8(xa);
              } }
            if (c + 4 < 128) CLOAD(c + 4)
            lds_fence();
#pragma unroll
            for (int ct = 0; ct < 4; ++ct) { f32x4 aw = {0.f, 0.f, 0.f, 0.f}, aa = aw;
#pragma unroll
                for (int ks = 0; ks < 2; ++ks) {
                    aw = MFMA16(*(const bf16x8*)(tw + fr * 72 + ks * 32 + fq * 8), *(const bf16x8*)(w2t + (ct * 16 + fr) * 72 + ks * 32 + fq * 8), aw);
                    aa = MFMA16(*(const bf16x8*)(ta + fr * 72 + ks * 32 + fq * 8), *(const bf16x8*)(a2t + (ct * 16 + fr) * 72 + ks * 32 + fq * 8), aa); }
#pragma unroll
                for (int j = 0; j < 4; ++j) { const int tj = fq * 4 + j, col = ct * 16 + fr;
                    exl[tj * 64 + col] = -0.60653066f * sigmoidf_(w0c[ct] + aw[j]);
                    exa[tj * 64 + col] = sigmoidf_(a0c[ct] + aa[j]); } }
            lds_fence();
            { float Lc = 0.f;
#pragma unroll
              for (int t = 0; t < 16; ++t) { Lc += exl[t * 64 + lane]; exl[t * 64 + lane] = __expf(Lc); }
              GQ[lane] = __expf(Lc); }
            float a16[16];
#pragma unroll
            for (int i = 0; i < 4; ++i) { const float4 t4 = *(const float4*)(exa + tok * 64 + c0 + i * 4); a16[i * 4] = t4.x; a16[i * 4 + 1] = t4.y; a16[i * 4 + 2] = t4.z; a16[i * 4 + 3] = t4.w; }
            float ssq = 0.f, beta = 0.f;
#pragma unroll
            for (int e = 0; e < 16; ++e) { const float kr_ = xk[e] * cst[320 + c0 + e]; ssq += kr_ * kr_; }
            ssq += dppf<0xB1>(ssq); ssq += dppf<0x4E>(ssq);
            const float inv = 1.0f / fmaxf(sqrtf(ssq), 1e-12f);
            lds_fence();
            { const int sq = (tok >> 2) * 8 + (tok & 3);
#pragma unroll
              for (int gI = 0; gI < 4; ++gI) {
                float pt[4], rt[4], qt[4], kt[4];
#pragma unroll
                for (int e3 = 0; e3 < 4; ++e3) { const int e = gI * 4 + e3; const float el = exl[tok * 64 + c0 + e], elm = tok > 0 ? exl[(tok - 1) * 64 + c0 + e] : 1.0f, iv = 1.0f / el;
                    const float kk_ = xk[e] * cst[320 + c0 + e] * inv, kp_ = xk[e] * (1.0f + (a16[e] - 1.0f) * cst[384 + c0 + e]), bb_ = -kk_ * a16[e];
                    beta += xr[e] * kp_ * cst[448 + c0 + e];
                    pt[e3] = kk_ * elm; rt[e3] = xr[e] * el; qt[e3] = bb_ * iv; kt[e3] = kp_ * iv;
                    const unsigned qk = cvtpk(qt[e3], kt[e3]);
                    A3[(c0 + e) * 40 + sq] = (bf16_t)(qk & 0xffffu); A3[(c0 + e) * 40 + sq + 4] = (bf16_t)(qk >> 16);
                    VT[(c0 + e) * 24 + tok] = (bf16_t)((e & 1) ? (xvp[e >> 1] >> 16) : (xvp[e >> 1] & 0xffffu)); }
                const int s0 = (q4 >> 1) * 32 + gI * 8 + (q4 & 1) * 4;
                u32x2 w; w.x = cvtpk(pt[0], pt[1]); w.y = cvtpk(pt[2], pt[3]); *(u32x2*)(A1 + tok * 104 + s0) = w;
                w.x = cvtpk(rt[0], rt[1]); w.y = cvtpk(rt[2], rt[3]); *(u32x2*)(A2 + tok * 104 + s0) = w;
                w.x = cvtpk(qt[0], qt[1]); w.y = cvtpk(qt[2], qt[3]); *(u32x2*)(ZQ + tok * 72 + s0) = w;
                w.x = cvtpk(kt[0], kt[1]); w.y = cvtpk(kt[2], kt[3]); *(u32x2*)(ZK + tok * 72 + s0) = w;
              } }
            beta += dppf<0xB1>(beta); beta += dppf<0x4E>(beta);
            { float bv[16];
#pragma unroll
              for (int e = 0; e < 16; ++e) bv[e] = beta * __uint_as_float((e & 1) ? (xvp[e >> 1] & 0xffff0000u) : (xvp[e >> 1] << 16));
              *(u32x4*)(BV + grow * 1024 + h * 64 + c0) = pack8(bv); *(u32x4*)(BV + grow * 1024 + h * 64 + c0 + 8) = pack8(bv + 8); }
            lds_fence();
            { f32x4 gN = {0.f, 0.f, 0.f, 0.f}, gKP = gN, gQR = gN, gKR = gN;
#pragma unroll
              for (int ks = 0; ks < 2; ++ks) {
                  const bf16x8 fzq = *(const bf16x8*)(ZQ + fr * 72 + ks * 32 + fq * 8), fzk = *(const bf16x8*)(ZK + fr * 72 + ks * 32 + fq * 8);
                  const bf16x8 fp = *(const bf16x8*)(A1 + fr * 104 + ks * 32 + fq * 8), frr = *(const bf16x8*)(A2 + fr * 104 + ks * 32 + fq * 8);
                  gN = MFMA16(fzq, fp, gN); gKP = MFMA16(fzk, fp, gKP); gQR = MFMA16(fzq, frr, gQR); gKR = MFMA16(fzk, frr, gKR); }
#pragma unroll
              for (int jj = 0; jj < 4; ++jj) { const int j = fq * 4 + jj; const bool lt = j < fr, le = j <= fr;
                  gN[jj] = lt ? gN[jj] : 0.f; gKP[jj] = lt ? gKP[jj] : 0.f; gQR[jj] = le ? gQR[jj] : 0.f; gKR[jj] = le ? gKR[jj] : 0.f;
                  Nm[j * 17 + fr] = gN[jj]; }
              u32x4 w1; w1.x = 0u; w1.y = 0u; w1.z = cvtpk(gKP[0], gKP[1]); w1.w = cvtpk(gKP[2], gKP[3]); *(u32x4*)(A1 + fr * 104 + 64 + fq * 8) = w1;
              u32x4 w2; w2.x = cvtpk(gQR[0], gQR[1]); w2.y = cvtpk(gQR[2], gQR[3]); w2.z = cvtpk(gKR[0], gKR[1]); w2.w = cvtpk(gKR[2], gKR[3]); *(u32x4*)(A2 + fr * 104 + 64 + fq * 8) = w2; }
            lds_fence();
            { float Ti[16]; int i = fr; asm volatile("" : "+v"(i));
#pragma unroll
              for (int t = 0; t < 16; ++t) { float s = (i == t) ? 1.0f : 0.0f;
#pragma unroll
                  for (int j = 0; j < t; ++j) s += Ti[j] * Nm[j * 17 + t];
                  Ti[t] = s; }
              if (lane < 16) { const int sq = (i >> 2) * 8 + (i & 3);
#pragma unroll
                  for (int t = 0; t < 16; ++t) TT[t * 40 + sq] = f2bf(Ti[t]); } }
            lds_fence();
            if (lane == 0) ready[c] = 1u;
        }
#undef CLOAD
    } else {
        const int v0 = wid * 16;
        f32x4 acc[4];
#pragma unroll
        for (int kt = 0; kt < 4; ++kt) acc[kt] = (f32x4){0.f, 0.f, 0.f, 0.f};
        for (int c = 0; c < 128; ++c) {
            const unsigned char* cb = smem + (c % CH_NB) * CH_CB;
            const bf16_t* A1 = (const bf16_t*)(cb + CB_A1); const bf16_t* A2 = (const bf16_t*)(cb + CB_A2); const bf16_t* TT = (const bf16_t*)(cb + CB_TT); const bf16_t* A3 = (const bf16_t*)(cb + CB_A3);
            const bf16_t* VT = (const bf16_t*)(cb + CB_VT); const float* GQ = (const float*)(cb + CB_GQ);
            while (ready[c] == 0u) __builtin_amdgcn_s_sleep(1);
            asm volatile("" ::: "memory");
            union { u32x4 u; bf16x8 h; } B0, B1, BX;
            B0.u.x = cvtpk(acc[0][0], acc[0][1]); B0.u.y = cvtpk(acc[0][2], acc[0][3]); B0.u.z = cvtpk(acc[1][0], acc[1][1]); B0.u.w = cvtpk(acc[1][2], acc[1][3]);
            B1.u.x = cvtpk(acc[2][0], acc[2][1]); B1.u.y = cvtpk(acc[2][2], acc[2][3]); B1.u.z = cvtpk(acc[3][0], acc[3][1]); B1.u.w = cvtpk(acc[3][2], acc[3][3]);
            const u32x2 vq = *(const u32x2*)(VT + (v0 + fr) * 24 + fq * 4);
            BX.u.x = 0u; BX.u.y = 0u; BX.u.z = vq.x; BX.u.w = vq.y;
            f32x4 rhs = {0.f, 0.f, 0.f, 0.f};
            rhs = MFMA16(*(const bf16x8*)(A1 + fr * 104 + fq * 8), B0.h, rhs);
            rhs = MFMA16(*(const bf16x8*)(A1 + fr * 104 + 32 + fq * 8), B1.h, rhs);
            rhs = MFMA16(*(const bf16x8*)(A1 + fr * 104 + 64 + fq * 8), BX.h, rhs);
            BX.u.x = pk2(rhs[0], rhs[1]); BX.u.y = pk2(rhs[2], rhs[3]); BX.u.z = 0u; BX.u.w = 0u;
            f32x4 uu = {0.f, 0.f, 0.f, 0.f};
            uu = MFMA16(*(const bf16x8*)(TT + fr * 40 + fq * 8), BX.h, uu);
            BX.u.x = pk2(uu[0], uu[1]); BX.u.y = pk2(uu[2], uu[3]); BX.u.z = vq.x; BX.u.w = vq.y;
            f32x4 oo = {0.f, 0.f, 0.f, 0.f};
            oo = MFMA16(*(const bf16x8*)(A2 + fr * 104 + fq * 8), B0.h, oo);
            oo = MFMA16(*(const bf16x8*)(A2 + fr * 104 + 32 + fq * 8), B1.h, oo);
            oo = MFMA16(*(const bf16x8*)(A2 + fr * 104 + 64 + fq * 8), BX.h, oo);
#pragma unroll
            for (int kt = 0; kt < 4; ++kt) { acc[kt] = MFMA16(*(const bf16x8*)(A3 + (kt * 16 + fr) * 40 + fq * 8), BX.h, acc[kt]);
                const float4 gq = *(const float4*)(GQ + kt * 16 + fq * 4); acc[kt][0] *= gq.x; acc[kt][1] *= gq.y; acc[kt][2] *= gq.z; acc[kt][3] *= gq.w; }
            asm volatile("s_waitcnt lgkmcnt(0)" ::: "memory");
            if (lane == 0) __hip_atomic_fetch_add((unsigned*)&cons[c], 1u, __ATOMIC_RELAXED, __HIP_MEMORY_SCOPE_WORKGROUP);
            float* op = ORAW + ((size_t)b * 2048 + c * 16 + fq * 4) * 1024 + h * 64 + v0 + fr;
#pragma unroll
            for (int jj = 0; jj < 4; ++jj) op[(size_t)jj * 1024] = oo[jj];
        }
        float* so = p.out + O_PWKV + ((((size_t)l * 8 + b) * 16 + h) * 64 + v0 + fr) * 64 + fq * 4;
#pragma unroll
        for (int kt = 0; kt < 4; ++kt) *(float4*)(so + kt * 16) = make_float4(acc[kt][0], acc[kt][1], acc[kt][2], acc[kt][3]);
    }
    __syncthreads();
}

__device__ void rwkv_sample_item(const Params& p, int l, int item, unsigned char* smem_) {
    unsigned char* smem = launder_lds(smem_);
    const int tid = tid_l(), lane = tid & 63, ks = tid >> 6;
    const int i = item >> 4, h = item & 15;
    float* part = (float*)smem;
    float* sv = part + 1024;
    float* s_sc = sv + 384;
    const bf16_t* P = (const bf16_t*)(p.ws + WS_P);
    float* ORAW = (float*)(p.ws + WS_ORAW);
    bf16_t* BV = (bf16_t*)(p.ws + WS_BV);
    const size_t rowp = (size_t)TP + i, rows = (size_t)TALL + i;
    const bf16_t* pc = P + rowp * N1; const bf16_t* pp = P + rows * N1;
    const float* mu = p.in[I_MU] + (size_t)l * 3200;
    const int gc = h * 64 + lane;
    const int row = tid >> 3, cs = (tid & 7) * 8;
    const size_t so = ((((size_t)l * TS + i) * 16 + h) * 64 + row) * 64 + cs;
    const float4 a0 = *(const float4*)(p.in[I_SWKV] + so), a1 = *(const float4*)(p.in[I_SWKV] + so + 4);
#define LERP1(col) (bf2f(pc[col]) + (bf2f(pp[col]) - bf2f(pc[col])) * mu[col])
    { const float* w2 = p.in[I_W2] + (size_t)l * 64 * 1024 + gc; const float* a2 = p.in[I_A2] + (size_t)l * 64 * 1024 + gc;
      float lw = 0.f, la = 0.f;
#pragma unroll
      for (int kk = 0; kk < 8; ++kk) { const int k = ks * 8 + kk; const float xwl = LERP1(C_WL + k), xal = LERP1(C_AL + k);
          lw += (1.0f - 2.0f / (__expf(2.0f * xwl) + 1.0f)) * w2[(size_t)k * 1024]; la += xal * a2[(size_t)k * 1024]; }
      __syncthreads();
      part[ks * 64 + lane] = lw; part[512 + ks * 64 + lane] = la; }
    __syncthreads();
    if (tid < 64) {
        const float xr = LERP1(C_R + gc), xk = LERP1(C_K + gc), xv = LERP1(C_V + gc);
        float lw = 0.f, la = 0.f;
#pragma unroll
        for (int q = 0; q < 8; ++q) { lw += part[q * 64 + lane]; la += part[512 + q * 64 + lane]; }
        const float w = __expf(-0.60653066f * sigmoidf_(p.in[I_W0][l * 1024 + gc] + lw));
        const float a = sigmoidf_(p.in[I_A0][l * 1024 + gc] + la);
        float kk = xk * p.in[I_KK][l * 1024 + gc];
        const float ssq = wave_sum(kk * kk);
        kk *= 1.0f / fmaxf(sqrtf(ssq), 1e-12f);
        const float kp = xk * (1.0f + (a - 1.0f) * p.in[I_KA][l * 1024 + gc]);
        const float bb = -kk * a, wr = w * xr;
        const float br = wave_sum(bb * xr), kr = wave_sum(kp * xr), beta = wave_sum(xr * kp * p.in[I_RK][l * 1024 + gc]);
        sv[lane] = w; sv[64 + lane] = kk; sv[128 + lane] = bb; sv[192 + lane] = kp; sv[256 + lane] = wr; sv[320 + lane] = xv;
        if (lane == 0) { s_sc[0] = br; s_sc[1] = kr; }
        BV[rowp * 1024 + gc] = f2bf(beta * xv);
    }
#undef LERP1
    __syncthreads();
    {
        float S[8] = {a0.x, a0.y, a0.z, a0.w, a1.x, a1.y, a1.z, a1.w};
        float dk = 0.f, dr = 0.f;
#pragma unroll
        for (int e = 0; e < 8; ++e) { dk += S[e] * sv[64 + cs + e]; dr += S[e] * sv[256 + cs + e]; }
        dk = red8(dk); dr = red8(dr);
        const float vr = sv[320 + row];
        const float o = dr + dk * s_sc[0] + vr * s_sc[1];
        if ((tid & 7) == 0) ORAW[rowp * 1024 + h * 64 + row] = o;
#pragma unroll
        for (int e = 0; e < 8; ++e) S[e] = S[e] * sv[cs + e] + dk * sv[128 + cs + e] + vr * sv[192 + cs + e];
        float* sout = p.out + O_SWKV + so;
        *(float4*)sout = make_float4(S[0], S[1], S[2], S[3]); *(float4*)(sout + 4) = make_float4(S[4], S[5], S[6], S[7]);
    }
}

__device__ void phase_conv(const Params& p, int l) {
    const int tid = tid_l();
    const bf16_t* P = (const bf16_t*)(p.ws + WS_P);
    bf16_t* U = (bf16_t*)(p.ws + WS_U); float* DT = (float*)(p.ws + WS_DT);
    for (int id = blockIdx.x * 512 + tid; id < 1024 * 384; id += gridDim.x * 512) {
        const int q = id % 384, seg = id / 384, xcol = q * 4;
        const int bb = seg >> 7, tb = (seg & 127) * 16;
        float4 cw0, cw1, cw2, cw3, cbv;
        { const float* cw = p.in[I_CW] + (size_t)l * 4 * 1536 + xcol; cw0 = *(const float4*)cw; cw1 = *(const float4*)(cw + 1536); cw2 = *(const float4*)(cw + 3072); cw3 = *(const float4*)(cw + 4608);
          cbv = *(const float4*)(p.in[I_CB] + (size_t)l * 1536 + xcol); }
        const bf16_t* pb = P + ((size_t)bb * 2048 + tb) * N1 + C_XBC + xcol;
        bf16_t* ub = U + ((size_t)bb * 2048 + tb) * 1536 + xcol;
        float4 w0 = make_float4(0.f, 0.f, 0.f, 0.f), w1 = w0, w2 = w0;
#define LD4(dst, ptr) { const u32x2 _v = *(const u32x2*)(ptr); dst = make_float4(__uint_as_float(_v.x << 16), __uint_as_float(_v.x & 0xffff0000u), __uint_as_float(_v.y << 16), __uint_as_float(_v.y & 0xffff0000u)); }
        if (tb >= 3) { LD4(w0, pb - 3 * (size_t)N1) LD4(w1, pb - 2 * (size_t)N1) LD4(w2, pb - (size_t)N1) }
#pragma unroll
        for (int s = 0; s < 16; ++s) {
            float4 cur; LD4(cur, pb + (size_t)s * N1)
            float4 u;
            u.x = cbv.x + cw0.x * w0.x + cw1.x * w1.x + cw2.x * w2.x + cw3.x * cur.x; u.y = cbv.y + cw0.y * w0.y + cw1.y * w1.y + cw2.y * w2.y + cw3.y * cur.y;
            u.z = cbv.z + cw0.z * w0.z + cw1.z * w1.z + cw2.z * w2.z + cw3.z * cur.z; u.w = cbv.w + cw0.w * w0.w + cw1.w * w1.w + cw2.w * w2.w + cw3.w * cur.w;
            u32x2 pk; pk.x = pk2(siluf_(u.x), siluf_(u.y)); pk.y = pk2(siluf_(u.z), siluf_(u.w));
            *(u32x2*)(ub + (size_t)s * 1536) = pk;
            w0 = w1; w1 = w2; w2 = cur;
        }
#undef LD4
    }
    for (int id = blockIdx.x * 512 + tid; id < TP * 16; id += gridDim.x * 512) {
        const int t = id >> 4, j = id & 15;
        DT[id] = softplusf_(bf2f(P[(size_t)t * N1 + C_DT + j]) + p.in[I_DTB][l * 16 + j]);
    }
}

__device__ void mamba_item(const Params& p, int l, int item, unsigned char* smem_) {
    unsigned char* smem = launder_lds(smem_);
    const int tid = tid_l(), wid = tid >> 6, lane = tid & 63, fr = lane & 15, fq = lane >> 4;
    const int b = item >> 5, j = (item >> 1) & 15, ph = item & 1, g = j >> 3;
    bf16_t* Cm = (bf16_t*)smem;
    bf16_t* Bm = (bf16_t*)(smem + 17408);
    bf16_t* BmT = (bf16_t*)(smem + 34816);
    bf16_t* XT = (bf16_t*)(smem + 53248);
    bf16_t* XwT = (bf16_t*)(smem + 57856);
    bf16_t* G = (bf16_t*)(smem + 62464);
    bf16_t* Hb = (bf16_t*)(smem + 71680);
    float* acs = (float*)(smem + 80384);
    float* dtv = acs + 64;
    const bf16_t* P = (const bf16_t*)(p.ws + WS_P);
    const bf16_t* U = (const bf16_t*)(p.ws + WS_U); const float* DT = (const float*)(p.ws + WS_DT);
    bf16_t* YM = (bf16_t*)(p.ws + WS_YM);
    __syncthreads();
    for (int i = tid; i < 32 * 136; i += 512) Hb[i] = 0;
    const float Aj = -__expf(p.in[I_ALOG][l * 16 + j]), Dj = p.in[I_DSK][l * 16 + j];
    const int s_a = tid >> 4, c16 = tid & 15, s_x = (tid >> 2) & 63, c4 = tid & 3;
    const int lt = wid >> 1, pt = wid & 1;
    const bf16_t* ub = U + (size_t)b * 2048 * 1536;
    u32x4 rb0, rb1, rc0, rc1, rx = {0u, 0u, 0u, 0u}; float rdt = 0.f;
#define LOADCHUNK(T0) { const bf16_t* r0 = ub + (size_t)((T0) + s_a) * 1536 + g * 128 + c16 * 8; const bf16_t* r1 = r0 + 32 * 1536; \
        rb0 = *(const u32x4*)(r0 + 1024); rb1 = *(const u32x4*)(r1 + 1024); rc0 = *(const u32x4*)(r0 + 1280); rc1 = *(const u32x4*)(r1 + 1280); \
        if (tid < 256) rx = *(const u32x4*)(ub + (size_t)((T0) + s_x) * 1536 + j * 64 + ph * 32 + c4 * 8); \
        if (wid == 5) rdt = DT[((size_t)b * 2048 + (T0) + lane) * 16 + j]; }
    LOADCHUNK(0)
    f32x4 hacc[2] = {{0.f, 0.f, 0.f, 0.f}, {0.f, 0.f, 0.f, 0.f}};
    for (int c = 0; c < 32; ++c) {
        const int t0 = c * 64;
        float zq[4];
#pragma unroll
        for (int jj = 0; jj < 4; ++jj) zq[jj] = bf2f(P[((size_t)b * 2048 + t0 + lt * 16 + fq * 4 + jj) * N1 + C_ZM + j * 64 + ph * 32 + pt * 16 + fr]);
        *(u32x4*)(Cm + s_a * 136 + c16 * 8) = rc0; *(u32x4*)(Cm + (s_a + 32) * 136 + c16 * 8) = rc1;
        *(u32x4*)(Bm + s_a * 136 + c16 * 8) = rb0; *(u32x4*)(Bm + (s_a + 32) * 136 + c16 * 8) = rb1;
#pragma unroll
        for (int e = 0; e < 8; ++e) { const unsigned v0 = rb0[e >> 1], v1 = rb1[e >> 1];
            BmT[(c16 * 8 + e) * 72 + s_a] = (bf16_t)((e & 1) ? (v0 >> 16) : (v0 & 0xffffu)); BmT[(c16 * 8 + e) * 72 + s_a + 32] = (bf16_t)((e & 1) ? (v1 >> 16) : (v1 & 0xffffu)); }
        if (tid < 256) {
#pragma unroll
            for (int e = 0; e < 8; ++e) { const unsigned v0 = rx[e >> 1]; XT[(c4 * 8 + e) * 72 + s_x] = (bf16_t)((e & 1) ? (v0 >> 16) : (v0 & 0xffffu)); }
        }
        if (wid == 5) {
            float v = rdt * Aj;
#pragma unroll
            for (int off = 1; off < 64; off <<= 1) { const float t = __shfl_up(v, off); if (lane >= off) v += t; }
            acs[lane] = v; dtv[lane] = rdt;
        }
        if (c + 1 < 32) LOADCHUNK(t0 + 64)
        LBAR();
        { const int pp = tid & 31, s4 = (tid >> 5) * 4; const float aend = acs[63];
          const u32x2 xv = *(const u32x2*)(XT + pp * 72 + s4);
          const float x0 = __uint_as_float(xv.x << 16), x1 = __uint_as_float(xv.x & 0xffff0000u), x2 = __uint_as_float(xv.y << 16), x3 = __uint_as_float(xv.y & 0xffff0000u);
          u32x2 bq; bq.x = pk2(x0 * dtv[s4] * __expf(aend - acs[s4]), x1 * dtv[s4 + 1] * __expf(aend - acs[s4 + 1]));
          bq.y = pk2(x2 * dtv[s4 + 2] * __expf(aend - acs[s4 + 2]), x3 * dtv[s4 + 3] * __expf(aend - acs[s4 + 3]));
          *(u32x2*)(XwT + pp * 72 + s4) = bq; }
#pragma unroll
        for (int e = 0; e < 2; ++e) {
            const int id = wid * 2 + e, glt = id >> 2, st = id & 3;
            f32x4 acc = {0.f, 0.f, 0.f, 0.f};
            if (st <= glt) {
#pragma unroll
                for (int ks = 0; ks < 4; ++ks) { const bf16x8 fa = *(const bf16x8*)(Cm + (glt * 16 + fr) * 136 + ks * 32 + fq * 8), fb = *(const bf16x8*)(Bm + (st * 16 + fr) * 136 + ks * 32 + fq * 8); acc = MFMA16(fa, fb, acc); }
            }
#pragma unroll
            for (int jj = 0; jj < 4; ++jj) { const int lr = glt * 16 + fq * 4 + jj, s = st * 16 + fr;
                const float val = (s <= lr) ? acc[jj] * __expf(acs[lr] - acs[s]) * dtv[s] : 0.f;
                G[lr * 72 + s] = f2bf(val); }
        }
        f32x4 accO = {0.f, 0.f, 0.f, 0.f};
#pragma unroll
        for (int ks = 0; ks < 4; ++ks) { const bf16x8 fa = *(const bf16x8*)(Cm + (lt * 16 + fr) * 136 + ks * 32 + fq * 8), fb = *(const bf16x8*)(Hb + (pt * 16 + fr) * 136 + ks * 32 + fq * 8); accO = MFMA16(fa, fb, accO); }
        LBAR();
        {
            f32x4 accD = {0.f, 0.f, 0.f, 0.f};
#pragma unroll
            for (int ks = 0; ks < 2; ++ks) { const bf16x8 fa = *(const bf16x8*)(G + (lt * 16 + fr) * 72 + ks * 32 + fq * 8), fb = *(const bf16x8*)(XT + (pt * 16 + fr) * 72 + ks * 32 + fq * 8); accD = MFMA16(fa, fb, accD); }
#pragma unroll
            for (int jj = 0; jj < 4; ++jj) { const int lr = lt * 16 + fq * 4 + jj, pp = pt * 16 + fr;
                float y = accD[jj] + __expf(acs[lr]) * accO[jj] + Dj * bf2f(XT[pp * 72 + lr]);
                y *= siluf_(zq[jj]);
                YM[((size_t)b * 2048 + t0 + lr) * 1024 + j * 64 + ph * 32 + pp] = f2bf(y); }
            const float cd = __expf(acs[63]); const int ptile = wid >> 2;
#pragma unroll
            for (int e = 0; e < 2; ++e) { const int nt = (wid & 3) * 2 + e;
                hacc[e] *= cd;
#pragma unroll
                for (int ks = 0; ks < 2; ++ks) { const bf16x8 fa = *(const bf16x8*)(XwT + (ptile * 16 + fr) * 72 + ks * 32 + fq * 8), fb = *(const bf16x8*)(BmT + (nt * 16 + fr) * 72 + ks * 32 + fq * 8); hacc[e] = MFMA16(fa, fb, hacc[e]); }
#pragma unroll
                for (int jj = 0; jj < 4; ++jj) Hb[(ptile * 16 + fq * 4 + jj) * 136 + nt * 16 + fr] = f2bf(hacc[e][jj]); }
        }
        LBAR();
    }
#undef LOADCHUNK
    { const int ptile = wid >> 2;
#pragma unroll
      for (int e = 0; e < 2; ++e) { const int nt = (wid & 3) * 2 + e;
#pragma unroll
          for (int jj = 0; jj < 4; ++jj) p.out[O_PSSM + ((((size_t)l * 8 + b) * 16 + j) * 64 + ph * 32 + ptile * 16 + fq * 4 + jj) * 128 + nt * 16 + fr] = hacc[e][jj]; } }
    __syncthreads();
}

__device__ void mamba_sample_item(const Params& p, int l, int item, unsigned char* smem_) {
    unsigned char* smem = launder_lds(smem_);
    const int tid = tid_l();
    const int i = item >> 4, j = item & 15, g = j >> 3;
    float* su = (float*)smem;
    float* sd = su + 320;
    const bf16_t* P = (const bf16_t*)(p.ws + WS_P);
    bf16_t* YM = (bf16_t*)(p.ws + WS_YM);
    const size_t rowp = (size_t)TP + i;
    const int pp = tid >> 3, n0 = (tid & 7) * 16;
    const size_t so = ((((size_t)l * TS + i) * 16 + j) * 64 + pp) * 128 + n0;
    float4 hv4[4];
#pragma unroll
    for (int e = 0; e < 4; ++e) hv4[e] = *(const float4*)(p.in[I_SSSM] + so + e * 4);
    __syncthreads();
    if (tid < 320) {
        const int cc = tid < 64 ? j * 64 + tid : (tid < 192 ? 1024 + g * 128 + (tid - 64) : 1280 + g * 128 + (tid - 192));
        const float* c0 = p.in[I_SCONV] + ((size_t)l * TS + i) * 3 * 1536 + cc;
        const float* cw = p.in[I_CW] + (size_t)l * 4 * 1536 + cc;
        const float v = p.in[I_CB][l * 1536 + cc] + c0[0] * cw[0] + c0[1536] * cw[1536] + c0[3072] * cw[3072] + bf2f(P[rowp * N1 + C_XBC + cc]) * cw[4608];
        su[tid] = siluf_(v);
    } else if (tid == 320) {
        const float dt = softplusf_(bf2f(P[rowp * N1 + C_DT + j]) + p.in[I_DTB][l * 16 + j]);
        sd[0] = dt; sd[1] = __expf(-dt * __expf(p.in[I_ALOG][l * 16 + j]));
    }
    __syncthreads();
    {
        float* hout = p.out + O_SSSM + so;
        const float dt = sd[0], eA = sd[1], x = su[pp], xdt = x * dt;
        float y = 0.f;
#pragma unroll
        for (int e = 0; e < 4; ++e) { float4 hv = hv4[e]; const float* Bp = su + 64 + n0 + e * 4; const float* Cp = su + 192 + n0 + e * 4;
            hv.x = eA * hv.x + xdt * Bp[0]; hv.y = eA * hv.y + xdt * Bp[1]; hv.z = eA * hv.z + xdt * Bp[2]; hv.w = eA * hv.w + xdt * Bp[3];
            y += hv.x * Cp[0] + hv.y * Cp[1] + hv.z * Cp[2] + hv.w * Cp[3];
            *(float4*)(hout + e * 4) = hv; }
        y = red8(y);
        if ((tid & 7) == 0) { y += p.in[I_DSK][l * 16 + j] * x; const float z = bf2f(P[rowp * N1 + C_ZM + j * 64 + pp]); YM[rowp * 1024 + j * 64 + pp] = f2bf(y * siluf_(z)); }
    }
}

__device__ void phase_mixa(const Params& p, int l, unsigned char* smem) {
    phase_conv(p, l);
    for (int rep = 0; rep < (DUP == 3 ? 2 : 1); ++rep)
    for (int it = blockIdx.x; it < 2048; it += gridDim.x) rwkv_sample_item(p, l, it, smem);
    for (int rep = 0; rep < (DUP == 4 ? 2 : 1); ++rep)
    for (int it = blockIdx.x; it < 2048; it += gridDim.x) mamba_sample_item(p, l, it, smem);
}
__device__ void phase_mixb(const Params& p, int l, unsigned char* smem) {
    const int G = (int)gridDim.x, nch = G >= 256 ? 128 : 0;
    if ((int)blockIdx.x < nch || nch == 0) {
        for (int rep = 0; rep < (DUP == 1 ? 2 : 1); ++rep)
        for (int it = blockIdx.x; it < 128; it += (nch ? nch : G)) rwkv_chain_item(p, l, it, smem);
    }
    if ((int)blockIdx.x >= nch) {
        for (int rep = 0; rep < (DUP == 2 ? 2 : 1); ++rep)
        for (int it = (int)blockIdx.x - nch; it < 256; it += G - nch) mamba_item(p, l, it, smem);
    }
}

__device__ void sample_outproj(const Params& p, int l) {
    const int tid = tid_l(), wid = tid >> 6, lane = tid & 63, fr = lane & 15, fq = lane >> 4;
    const bf16_t* A2 = (const bf16_t*)(p.ws + WS_A) + (size_t)TP * 2048;
    const bf16_t* W = (const bf16_t*)(p.ws + WS_WOUTT) + (size_t)l * 1024 * 2048;
    float* PART = (float*)(p.ws + WS_PART);
    for (int it = blockIdx.x; it < 256; it += gridDim.x) {
        const int nt = it & 15, ksl = it >> 4;
        f32x4 acc[4] = {{0.f, 0.f, 0.f, 0.f}, {0.f, 0.f, 0.f, 0.f}, {0.f, 0.f, 0.f, 0.f}, {0.f, 0.f, 0.f, 0.f}};
#pragma unroll
        for (int kq = 0; kq < 4; ++kq) {
            const bf16x8 fa = *(const bf16x8*)(A2 + (size_t)(wid * 16 + fr) * 2048 + ksl * 128 + kq * 32 + fq * 8);
#pragma unroll
            for (int ct = 0; ct < 4; ++ct) { const bf16x8 fb = *(const bf16x8*)(W + (size_t)(nt * 64 + ct * 16 + fr) * 2048 + ksl * 128 + kq * 32 + fq * 8); acc[ct] = MFMA16(fa, fb, acc[ct]); }
        }
#pragma unroll
        for (int ct = 0; ct < 4; ++ct)
#pragma unroll
            for (int jj = 0; jj < 4; ++jj) PART[((size_t)ksl * TS + wid * 16 + fq * 4 + jj) * 1024 + nt * 64 + ct * 16 + fr] = acc[ct][jj];
    }
}

__device__ void phase_post(const Params& p, int l) {
    const int tid_ = tid_l(); const int lane = tid_ & 63, wid = tid_ >> 6;
    const bf16_t* P = (const bf16_t*)(p.ws + WS_P);
    const float* ORAW = (const float*)(p.ws + WS_ORAW);
    const bf16_t* BV = (const bf16_t*)(p.ws + WS_BV);
    const bf16_t* YM = (const bf16_t*)(p.ws + WS_YM);
    bf16_t* A2 = (bf16_t*)(p.ws + WS_A);
    const int c0 = lane * 16;
    float lnw[16], lnb[16], gnw[16];
#pragma unroll
    for (int e = 0; e < 16; ++e) { lnw[e] = p.in[I_LNW][l * 1024 + c0 + e]; lnb[e] = p.in[I_LNB][l * 1024 + c0 + e]; gnw[e] = p.in[I_GNW][l * 1024 + c0 + e]; }
    for (int row = blockIdx.x * 8 + wid; row < TALL; row += gridDim.x * 8) {
        const bf16_t* prow = P + (size_t)row * N1;
        float o[16], bv[16], z[16], ym[16];
#pragma unroll
        for (int i = 0; i < 4; ++i) { const float4 t = *(const float4*)(ORAW + (size_t)row * 1024 + c0 + i * 4); o[i * 4] = t.x; o[i * 4 + 1] = t.y; o[i * 4 + 2] = t.z; o[i * 4 + 3] = t.w; }
        unpack8(*(const u32x4*)(BV + (size_t)row * 1024 + c0), bv); unpack8(*(const u32x4*)(BV + (size_t)row * 1024 + c0 + 8), bv + 8);
        unpack8(*(const u32x4*)(prow + C_ZR + c0), z); unpack8(*(const u32x4*)(prow + C_ZR + c0 + 8), z + 8);
        unpack8(*(const u32x4*)(YM + (size_t)row * 1024 + c0), ym); unpack8(*(const u32x4*)(YM + (size_t)row * 1024 + c0 + 8), ym + 8);
        float s = 0.f;
#pragma unroll
        for (int e = 0; e < 16; ++e) s += o[e];
        s += dppf<0xB1>(s); s += dppf<0x4E>(s);
        const float mean = s * (1.0f / 64.0f);
        float v = 0.f;
#pragma unroll
        for (int e = 0; e < 16; ++e) { o[e] -= mean; v += o[e] * o[e]; }
        v += dppf<0xB1>(v); v += dppf<0x4E>(v);
        const float rstd = rsqrtf(v * (1.0f / 64.0f) + 64e-5f);
#pragma unroll
        for (int e = 0; e < 16; ++e) o[e] = (o[e] * rstd * lnw[e] + lnb[e] + bv[e]) * siluf_(z[e]);
        *(u32x4*)(A2 + (size_t)row * 2048 + c0) = pack8(o); *(u32x4*)(A2 + (size_t)row * 2048 + c0 + 8) = pack8(o + 8);
        float ss = 0.f;
#pragma unroll
        for (int e = 0; e < 16; ++e) ss += ym[e] * ym[e];
        ss = red16(ss); ss += __shfl_xor(ss, 16);
        const float rs = rsqrtf(ss * (1.0f / 512.0f) + 1e-5f);
#pragma unroll
        for (int e = 0; e < 16; ++e) ym[e] *= rs * gnw[e];
        *(u32x4*)(A2 + (size_t)row * 2048 + 1024 + c0) = pack8(ym); *(u32x4*)(A2 + (size_t)row * 2048 + 1024 + c0 + 8) = pack8(ym + 8);
        if (row < TP) {
            const int tq = row & 2047;
            if (tq >= 2045) { float* dst = p.out + O_PCONV + (((size_t)l * 8 + (row >> 11)) * 3 + (tq - 2045)) * 1536;
                for (int c = lane; c < 1536; c += 64) dst[c] = bf2f(prow[C_XBC + c]); }
        } else {
            const int i = row - TP; float* dst = p.out + O_SCONV + ((size_t)l * TS + i) * 3 * 1536; const float* src = p.in[I_SCONV] + ((size_t)l * TS + i) * 3 * 1536;
            for (int c = lane; c < 1536; c += 64) { dst[c] = src[1536 + c]; dst[1536 + c] = src[3072 + c]; dst[3072 + c] = bf2f(prow[C_XBC + c]); }
        }
    }
}

constexpr int NPHASE = 13;
__global__ __launch_bounds__(512, 2) void mega(Params p) {
    extern __shared__ __attribute__((aligned(16))) unsigned char smem[];
    cg::grid_group grid = cg::this_grid();
    volatile LAS unsigned* st = (volatile LAS unsigned*)((LAS unsigned char*)smem + LDS_BARST);
    { const unsigned hw = (unsigned)__builtin_amdgcn_s_getreg((5 << 11) | 4) & 63u;
      if ((threadIdx.x & 63) == 0) *(volatile LAS int*)((LAS unsigned char*)smem + LDS_WIDTAB + hw * 4u) = (int)(threadIdx.x >> 6);
      if (threadIdx.x == 0) { st[0] = 0u; st[1] = 0u; } }
    __syncthreads();
    const XcdBarrier xbar = xcd_barrier_post((unsigned*)(p.ws + WS_BAR), st);
    if (p.ph_hi > 1000) grid.sync();
#define PHASE(K, BODY) if (p.ph_lo <= (K) && (K) < p.ph_hi) { if ((K) > p.ph_lo) { xcd_barrier(xbar); if (DUP == 13) { xcd_barrier(xbar); xcd_barrier(xbar); } } BODY }
#define GEMM1(L) { pg8::Gemm g{(const bf16_t*)(p.ws + WS_A), (const bf16_t*)(p.ws + WS_WINT) + (size_t)(L) * N1 * 1024, M1, N1, 1024}; \
        pg8::StaticOrder S; S.init(M1, N1, (int)gridDim.x, (int)blockIdx.x); EpiP E{(bf16_t*)(p.ws + WS_P), N1}; \
        pg8::gemm_phase<EpiP, pg8::StaticOrder, false>((PG8_LAS unsigned char*)smem, g, S, E, nullptr); }
#define GEMM2(L) { sample_outproj(p, (L)); \
        pg8::Gemm g{(const bf16_t*)(p.ws + WS_A), (const bf16_t*)(p.ws + WS_WOUTT) + (size_t)(L) * 1024 * 2048, TP, 1024, 2048}; \
        pg8::StaticOrder S; S.init(TP, 1024, (int)gridDim.x, (int)blockIdx.x); EpiRes E{(L) == 0 ? p.in[I_XP] : p.out + O_YP, p.out + O_YP}; \
        pg8::gemm_phase<EpiRes, pg8::StaticOrder, false>((PG8_LAS unsigned char*)smem, g, S, E, nullptr); }
    PHASE(0, phase_convert(p, smem); phase_norm(p, 0);)
    PHASE(1, GEMM1(0))
    PHASE(2, phase_mixa(p, 0, smem);)
    PHASE(3, phase_mixb(p, 0, smem);)
    PHASE(4, phase_post(p, 0);)
    PHASE(5, GEMM2(0))
    PHASE(6, phase_norm(p, 1);)
    PHASE(7, GEMM1(1))
    PHASE(8, phase_mixa(p, 1, smem);)
    PHASE(9, phase_mixb(p, 1, smem);)
    PHASE(10, phase_post(p, 1);)
    PHASE(11, GEMM2(1))
    PHASE(12, phase_final(p);)
}

extern "C" void kernel_launch(void* const* d_in, const int* in_sizes, int n_in, void* d_out, int out_size, void* d_ws, size_t ws_size, hipStream_t stream) {
    static int grid = 0;
    if (grid == 0) {
        if (n_in != 26 || (size_t)out_size != O_END || ws_size < WS_BAR + (size_t)XCD_BAR_WORDS * 4) { fprintf(stderr, "kernel_launch: unexpected shapes: n_in %d out %d ws %zu (need %zu)\n", n_in, out_size, ws_size, (size_t)(WS_BAR + XCD_BAR_WORDS * 4)); grid = -1; return; }
        int dev = 0, cus = 0, per_cu = 0;
        hipGetDevice(&dev); hipDeviceGetAttribute(&cus, hipDeviceAttributeMultiprocessorCount, dev);
        if (hipFuncSetAttribute((const void*)mega, hipFuncAttributeMaxDynamicSharedMemorySize, LDS_BYTES) != hipSuccess) { fprintf(stderr, "kernel_launch: hipFuncSetAttribute failed\n"); grid = -1; return; }
        if (hipOccupancyMaxActiveBlocksPerMultiprocessor(&per_cu, (const void*)mega, 512, LDS_BYTES) != hipSuccess || per_cu < 1) { fprintf(stderr, "kernel_launch: occupancy query gave %d\n", per_cu); per_cu = 1; }
        (void)hipGetLastError();
        grid = cus * 1;
    }
    if (grid < 0) return;
    if (hipMemsetAsync((char*)d_ws + WS_BAR, 0, (size_t)XCD_BAR_WORDS * 4, stream) != hipSuccess) { fprintf(stderr, "kernel_launch: memset of barrier words failed\n"); return; }
    Params p{};
    for (int i = 0; i < 26; ++i) p.in[i] = (const float*)d_in[i];
    p.out = (float*)d_out; p.ws = (unsigned char*)d_ws;
#if MK_PER_PHASE
    for (int ph = 0; ph < NPHASE; ++ph) { p.ph_lo = ph; p.ph_hi = ph + 1; hipLaunchKernelGGL(mega, dim3(grid), dim3(512), LDS_BYTES, stream, p); }
#else
    p.ph_lo = 0; p.ph_hi = NPHASE;
    void* args[] = {&p};
    hipError_t e = hipLaunchCooperativeKernel((const void*)mega, dim3(grid), dim3(512), args, LDS_BYTES, stream);
    if (e != hipSuccess) fprintf(stderr, "cooperative launch failed: %s (grid %d)\n", hipGetErrorString(e), grid);
#endif
}
```

```cpp
#include <hip/hip_runtime.h>
#include <hip/hip_cooperative_groups.h>
#include <cstdio>
namespace cg = cooperative_groups;

#define LDS_WIDTAB 146944
__device__ __forceinline__ int tid_l() {
    const unsigned hw = (unsigned)__builtin_amdgcn_s_getreg((5 << 11) | 4) & 63u;
    const int wid = *(volatile __attribute__((address_space(3))) int*)(unsigned long)(LDS_WIDTAB + hw * 4u);
    int ln; asm volatile("v_mbcnt_lo_u32_b32 %0, -1, 0\n\tv_mbcnt_hi_u32_b32 %0, -1, %0" : "=v"(ln));
    return __builtin_amdgcn_readfirstlane(wid) * 64 + ln; }
namespace pg8 {
#define PG8_LAS __attribute__((address_space(3)))
typedef unsigned short bf16_t;
typedef short bf16x8 __attribute__((ext_vector_type(8)));
typedef float f32x4 __attribute__((ext_vector_type(4)));
typedef unsigned u32x4 __attribute__((ext_vector_type(4)));
constexpr int BM = 256, BK = 64, HALF = 128, HTB = HALF * BK * 2  , STAGE_BYTES = 8 * HTB, NXCD = 8, WGM = 8;

__host__ __device__ __forceinline__ int lds_byte(int r, int c) { const int st = (r >> 4) * 2 + (c >> 5), rr = r & 15, cc = c & 31, ob = rr * 64 + cc * 2; return st * 1024 + (ob ^ (((ob >> 9) & 1) << 5)); }
__host__ __device__ __forceinline__ void stage_rc(int b, int& R, int& C) { const int st = b / 1024, sb = b % 1024, swz = sb ^ (((sb >> 9) & 1) << 5); R = (st >> 1) * 16 + swz / 64; C = (st & 1) * 32 + (swz % 64) / 2; }
__host__ __device__ __forceinline__ int perm32(int rho) { const int n = rho >> 4, i = rho & 15; return 8 * (i >> 2) + 4 * n + (i & 3); }

struct Unit { int pm, pn; };
struct Gemm { const bf16_t* A; const bf16_t* Bt; int M, N, K; };

struct StaticOrder {
    int nM, nN, nwg, G, c;
    __host__ __device__ void init(int M, int N, int G_, int c_) { nM = M / BM; nN = N / BM; nwg = nM * nN; G = G_; c = c_; }
    __host__ __device__ bool next(int i, Unit& u) const {
        const long L = (long)i * G + c; if (L >= nwg) return false;
        int wgid = (int)L; { const int q = nwg / NXCD, r = nwg % NXCD, xcd = wgid % NXCD, off = wgid / NXCD; wgid = (xcd < r ? xcd * (q + 1) : r * (q + 1) + (xcd - r) * q) + off; }
        const int nig = WGM * nN, gid = wgid / nig, fm = gid * WGM, gsz = (nM - fm) < WGM ? (nM - fm) : WGM;
        u.pm = fm + ((wgid % nig) % gsz); u.pn = (wgid % nig) / gsz; return true;
    }
    __device__ __forceinline__ void a_ready(const Unit&) const {}
    __device__ __forceinline__ void done(const Unit&) const {}
};
__device__ __forceinline__ unsigned cvt_pk_bf16(float lo, float hi) { unsigned r; asm volatile("v_cvt_pk_bf16_f32 %0, %1, %2" : "=v"(r) : "v"(lo), "v"(hi)); return r; }
template <class Epi, class Sched, bool STAMP = false>
__device__ __forceinline__ void gemm_phase(PG8_LAS unsigned char* lds, const Gemm g, const Sched& S, const Epi& E, unsigned long long* stamps) {
    const int tid = tid_l(), wid = __builtin_amdgcn_readfirstlane(tid >> 6), lane = tid & 63, wr = wid >> 2, wc = wid & 3, fr = lane & 15, fq = lane >> 4;
    const int K = g.K, nt = K / BK;
    int ts_lo = 0, ts_hi = 0, nts = 0; const unsigned long long rt_entry = STAMP ? (unsigned long long)wall_clock64() : 0ull;
#define PG8_STAMP() do { if (STAMP && wid == 0 && nts < 64) { const unsigned long long _c = (unsigned long long)clock64(); \
        ts_lo = (lane == nts) ? (int)(unsigned)_c : ts_lo; ts_hi = (lane == nts) ? (int)(unsigned)(_c >> 32) : ts_hi; ++nts; } } while (0)
    PG8_STAMP();
    unsigned voffA[2], voffB[2];
#pragma unroll
    for (int i = 0; i < 2; ++i) { int R, C; stage_rc(tid * 16 + i * 8192, R, C); const int Rb = Epi::PERM ? ((R & ~31) + perm32(R & 31)) : R;
        voffA[i] = (unsigned)(R * K + C) * 2u; voffB[i] = (unsigned)(Rb * K + C) * 2u; }
    const size_t kstep = (size_t)(BK * 2);
    const size_t hstep = (size_t)HALF * K * 2;
    const size_t tstep = 2 * hstep;
    const unsigned ldsw = (unsigned)wid * 1024u;
    const int aoff = lds_byte(wr * 64 + fr, fq * 8), boff = lds_byte(wc * 32 + fr, fq * 8);
#define PG8_SA(b, h) (((b) * 2 + (h)) * HTB)
#define PG8_SB(b, h) ((4 + (b) * 2 + (h)) * HTB)
#define PG8_STAGE(bufoff, gbase, voff) do { _Pragma("unroll") for (int _i = 0; _i < 2; ++_i) \
        __builtin_amdgcn_global_load_lds((const unsigned*)((const char*)(gbase) + (voff)[_i]), (PG8_LAS unsigned*)(lds + (bufoff) + ldsw + _i * 8192), 16, 0, 0); } while (0)
#define PG8_LDA(dst, b, h) do { _Pragma("unroll") for (int m = 0; m < 4; ++m) _Pragma("unroll") for (int k = 0; k < 2; ++k) dst[m][k] = *(const PG8_LAS bf16x8*)(lds + PG8_SA(b, h) + aoff + m * 2048 + k * 1024); } while (0)
#define PG8_LDB(dst, b, h) do { _Pragma("unroll") for (int n = 0; n < 2; ++n) _Pragma("unroll") for (int k = 0; k < 2; ++k) dst[n][k] = *(const PG8_LAS bf16x8*)(lds + PG8_SB(b, h) + boff + n * 2048 + k * 1024); } while (0)
#define PG8_MMA(ai, bj, At, Bt) do { __builtin_amdgcn_s_setprio(1); _Pragma("unroll") for (int m = 0; m < 4; ++m) _Pragma("unroll") for (int n = 0; n < 2; ++n) _Pragma("unroll") for (int k = 0; k < 2; ++k) \
        acc[ai][bj][m][n] = __builtin_amdgcn_mfma_f32_16x16x32_bf16(Bt[n][k], At[m][k], acc[ai][bj][m][n], 0, 0, 0); __builtin_amdgcn_s_setprio(0); } while (0)
#define PG8_WAIT_V(n) asm volatile("s_waitcnt vmcnt(" #n ")" ::: "memory")
#define PG8_WAIT_L(n) asm volatile("s_waitcnt lgkmcnt(" #n ")" ::: "memory")
#define PG8_BAR __builtin_amdgcn_s_barrier()
#define PG8_SCHED __builtin_amdgcn_sched_barrier(0)
    Unit cur, nxt; int ui = 0;
    if (!S.next(0, cur)) return;
    f32x4 acc[2][2][4][2];
#pragma unroll
    for (int a = 0; a < 2; ++a)
#pragma unroll
        for (int b = 0; b < 2; ++b)
#pragma unroll
            for (int m = 0; m < 4; ++m)
#pragma unroll
                for (int n = 0; n < 2; ++n) acc[a][b][m][n] = (f32x4){0.f, 0.f, 0.f, 0.f};
    bf16x8 At[4][2], B0[2][2], B1[2][2];
    const char* cA = (const char*)g.A + (size_t)cur.pm * tstep; const char* cB = (const char*)g.Bt + (size_t)cur.pn * tstep;
    S.a_ready(cur);
    PG8_STAGE(PG8_SB(0, 0), cB, voffB); PG8_STAGE(PG8_SA(0, 0), cA, voffA); PG8_STAGE(PG8_SB(0, 1), cB + hstep, voffB); PG8_STAGE(PG8_SA(0, 1), cA + hstep, voffA);
    if (wr == 1) PG8_BAR;
    PG8_WAIT_V(4); PG8_BAR;
    PG8_STAGE(PG8_SB(1, 0), cB + kstep, voffB); PG8_STAGE(PG8_SA(1, 0), cA + kstep, voffA); PG8_STAGE(PG8_SB(1, 1), cB + hstep + kstep, voffB);
    PG8_WAIT_V(6); PG8_BAR;
    PG8_STAMP();
    for (;;) {
        const bool has_next = S.next(ui + 1, nxt);
        const char* nA = has_next ? (const char*)g.A + (size_t)nxt.pm * tstep : cA; const char* nB = has_next ? (const char*)g.Bt + (size_t)nxt.pn * tstep : cB;
        for (int t = 0; t < nt; t += 2) {
            const bool last = (t == nt - 2);
            const char* a1 = cA + (size_t)(t + 1) * kstep;
            const char* a2 = last ? nA : cA + (size_t)(t + 2) * kstep; const char* b2 = last ? nB : cB + (size_t)(t + 2) * kstep;
            const char* a3 = a2 + kstep; const char* b3 = b2 + kstep;
            if (last && has_next) S.a_ready(nxt);
            PG8_LDB(B0, 0, 0); PG8_SCHED; PG8_LDA(At, 0, 0); PG8_STAGE(PG8_SA(1, 1), a1 + hstep, voffA);
            PG8_WAIT_L(8); PG8_BAR; PG8_WAIT_L(0); PG8_MMA(0, 0, At, B0); PG8_BAR; PG8_SCHED;
            PG8_LDB(B1, 0, 1); PG8_STAGE(PG8_SB(0, 0), b2, voffB);
            PG8_BAR; PG8_WAIT_L(0); PG8_MMA(0, 1, At, B1); PG8_BAR;
            PG8_LDA(At, 0, 1); PG8_STAGE(PG8_SA(0, 0), a2, voffA);
            PG8_BAR; PG8_WAIT_L(0); PG8_MMA(1, 0, At, B0); PG8_BAR; PG8_SCHED;
            PG8_STAGE(PG8_SB(0, 1), b2 + hstep, voffB);
            PG8_WAIT_V(6); PG8_BAR; PG8_MMA(1, 1, At, B1); PG8_BAR;
            PG8_LDB(B0, 1, 0); PG8_SCHED; PG8_LDA(At, 1, 0); PG8_STAGE(PG8_SA(0, 1), a2 + hstep, voffA);
            PG8_WAIT_L(8); PG8_BAR; PG8_WAIT_L(0); PG8_MMA(0, 0, At, B0); PG8_BAR; PG8_SCHED;
            PG8_LDB(B1, 1, 1); PG8_STAGE(PG8_SB(1, 0), b3, voffB);
            PG8_BAR; PG8_WAIT_L(0); PG8_MMA(0, 1, At, B1); PG8_BAR;
            PG8_LDA(At, 1, 1); PG8_STAGE(PG8_SA(1, 0), a3, voffA);
            PG8_BAR; PG8_WAIT_L(0); PG8_MMA(1, 0, At, B0); PG8_BAR; PG8_SCHED;
            PG8_STAGE(PG8_SB(1, 1), b3 + hstep, voffB);
            PG8_WAIT_V(6); PG8_BAR; PG8_MMA(1, 1, At, B1); PG8_BAR;
        }
        PG8_STAMP();
        if constexpr (!Epi::AFTER_DRAIN) { E(acc, cur, wr, wc, fr, fq); S.done(cur); }
        PG8_STAMP();
        if (!has_next) break;
#pragma unroll
        for (int a = 0; a < 2; ++a)
#pragma unroll
            for (int b = 0; b < 2; ++b)
#pragma unroll
                for (int m = 0; m < 4; ++m)
#pragma unroll
                    for (int n = 0; n < 2; ++n) acc[a][b][m][n] = (f32x4){0.f, 0.f, 0.f, 0.f};
        cur = nxt; cA = nA; cB = nB; ++ui;
    }
    PG8_WAIT_V(0);
    if (wr == 0) PG8_BAR;
    PG8_BAR;
    if constexpr (Epi::AFTER_DRAIN) { E.fused(acc, cur, wr, wc, fr, fq, lds, wid, lane); S.done(cur); }
    PG8_STAMP();
    if (STAMP && wid == 0) { stamps[lane] = lane < nts ? (((unsigned long long)(unsigned)ts_hi << 32) | (unsigned)ts_lo) : 0ull;
        if (lane == 62) stamps[62] = rt_entry; if (lane == 63) stamps[63] = (unsigned long long)wall_clock64(); }
#undef PG8_STAMP
#undef PG8_SA
#undef PG8_SB
#undef PG8_STAGE
#undef PG8_LDA
#undef PG8_LDB
#undef PG8_MMA
#undef PG8_WAIT_V
#undef PG8_WAIT_L
#undef PG8_BAR
#undef PG8_SCHED
}
}

#define XB_TMO      128
#define XB_XCNT(j)  (256  + 64 * (j))
#define XB_XSUB(j)  (1280 + 64 * (j))
#define XB_XGEN(j)  (2304 + 64 * (j))
#define XB_TOP      3328
#define XB_TOPGEN   3392
#define XCD_BAR_WORDS 3456
#define XB_SPIN_CAP (1u << 18)
#define LAS __attribute__((address_space(3)))

__device__ __forceinline__ unsigned xb_ld(unsigned* p)              { return __hip_atomic_load(p, __ATOMIC_RELAXED, __HIP_MEMORY_SCOPE_AGENT); }
__device__ __forceinline__ unsigned xb_add(unsigned* p, unsigned v) { return __hip_atomic_fetch_add(p, v, __ATOMIC_RELAXED, __HIP_MEMORY_SCOPE_AGENT); }
__device__ __forceinline__ unsigned xb_xcc_id() { return (unsigned)__builtin_amdgcn_s_getreg((3 << 11) | 20) & 0xFu; }
#define XB_SPIN(cond, bar) do { unsigned _sp = 0; while (cond) { __builtin_amdgcn_s_sleep(1); \
    if ((++_sp & 255u) == 0u) { if (xb_ld(&(bar)[XB_TMO])) break; if (_sp > XB_SPIN_CAP) { atomicAdd(&(bar)[XB_TMO], 1u); break; } } } } while (0)
struct XcdBarrier {
    unsigned* bar; unsigned x;
    volatile LAS unsigned* st;
};

__device__ __forceinline__ XcdBarrier xcd_barrier_post(unsigned* bar, volatile LAS unsigned* st) {
    XcdBarrier b; b.bar = bar; b.x = xb_xcc_id(); b.st = st;
    if (tid_l() == 0) (void)xb_add(&bar[XB_XCNT(b.x)], 1u);
    return b;
}
__device__ __forceinline__ void xcd_barrier_complete(unsigned* bar, unsigned x, unsigned& nloc, unsigned& nx) {
    const unsigned G = gridDim.x * gridDim.y * gridDim.z;
    unsigned sum, cnt, mine, sp = 0u;
    for (;;) {
        sum = 0u; cnt = 0u; mine = 0u;
#pragma unroll
        for (unsigned j = 0; j < 16; ++j) { const unsigned c = xb_ld(&bar[XB_XCNT(j)]); sum += c; cnt += (c > 0u) ? 1u : 0u; mine = (j == x) ? c : mine; }
        if (sum == G) break;
        __builtin_amdgcn_s_sleep(1);
        if ((++sp & 255u) == 0u) { if (xb_ld(&bar[XB_TMO])) break; if (sp > XB_SPIN_CAP) { atomicAdd(&bar[XB_TMO], 1u); break; } }
    }
    nloc = mine > 0u ? mine : 1u; nx = cnt > 0u ? cnt : 1u;
}

__device__ __forceinline__ void xcd_barrier(const XcdBarrier& b) {
    asm volatile("s_waitcnt vmcnt(0)" ::: "memory");
    __syncthreads();
    if (tid_l() == 0) {
        unsigned* bar = b.bar;
        __builtin_amdgcn_s_waitcnt(0);
        unsigned nloc = b.st[0], nx = b.st[1];
        if (nloc == 0u) { xcd_barrier_complete(bar, b.x, nloc, nx); b.st[0] = nloc; b.st[1] = nx; }
        const unsigned old = xb_add(&bar[XB_XSUB(b.x)], 1u);
        const unsigned gen = old / nloc;
        if (old + 1u == (gen + 1u) * nloc) {
            __builtin_amdgcn_fence(__ATOMIC_RELEASE, "agent");
            asm volatile("s_waitcnt vmcnt(0)" ::: "memory");
            const unsigned og = xb_add(&bar[XB_TOP], 1u);
            const unsigned tg = og / nx;
            if (og + 1u == (tg + 1u) * nx) xb_add(&bar[XB_TOPGEN], 1u);
            else XB_SPIN(xb_ld(&bar[XB_TOPGEN]) == tg, bar);
            __builtin_amdgcn_fence(__ATOMIC_ACQUIRE, "agent");
            xb_add(&bar[XB_XGEN(b.x)], 1u);
            asm volatile("s_waitcnt vmcnt(0)" ::: "memory");
        } else {
            XB_SPIN(xb_ld(&bar[XB_XGEN(b.x)]) == gen, bar);
            __builtin_amdgcn_fence(__ATOMIC_ACQUIRE, "agent");
            asm volatile("s_waitcnt vmcnt(0)" ::: "memory");
        }
    }
    __syncthreads();
}

typedef unsigned short bf16_t;
typedef short bf16x8 __attribute__((ext_vector_type(8)));
typedef float f32x4 __attribute__((ext_vector_type(4)));
typedef unsigned u32x4 __attribute__((ext_vector_type(4)));
typedef unsigned u32x2 __attribute__((ext_vector_type(2)));

#ifndef DUP
#define DUP 0
#endif
#ifndef MK_PER_PHASE
#define MK_PER_PHASE 0
#endif

constexpr int TP = 16384, TS = 128, TALL = 16512, M1 = 16640, N1 = 6912, NIN = 6800;
constexpr int C_R = 0, C_K = 1024, C_V = 2048, C_WL = 3072, C_AL = 3136, C_ZR = 3200, C_ZM = 4224, C_XBC = 5248, C_DT = 6784;
constexpr size_t O_YP = 0, O_YS = 16777216, O_PSH = 16908288, O_PWKV = 16924672, O_PCONV = 17973248, O_PSSM = 18046976,
                 O_SSH = 20144128, O_SWKV = 20406272, O_SCONV = 37183488, O_SSSM = 38363136, O_END = 71917568;
constexpr size_t WS_WINT = 0;
constexpr size_t WS_WOUTT = WS_WINT + (size_t)2 * N1 * 1024 * 2;
constexpr size_t WS_A = WS_WOUTT + (size_t)2 * 1024 * 2048 * 2;
constexpr size_t WS_P = WS_A + (size_t)M1 * 2048 * 2;
constexpr size_t WS_ORAW = WS_P + (size_t)M1 * N1 * 2;
constexpr size_t WS_BV = WS_ORAW + (size_t)TALL * 1024 * 4;
constexpr size_t WS_YM = WS_BV + (size_t)TALL * 1024 * 2;
constexpr size_t WS_END = WS_YM + (size_t)TALL * 1024 * 2;
constexpr size_t WS_U = WS_A;
constexpr size_t WS_DT = WS_U + (size_t)TP * 1536 * 2;
constexpr size_t WS_PART = WS_ORAW;
constexpr size_t WS_BAR = (WS_END + 4095) & ~(size_t)4095;
constexpr int LDS_BYTES = 147456, LDS_BARST = 147440;

struct Params { const float* in[26]; float* out; unsigned char* ws; int ph_lo, ph_hi; };
enum { I_XP = 0, I_XS, I_SSHIFT, I_SWKV, I_SCONV, I_SSSM, I_NORMW, I_WIN, I_MU, I_W0, I_W2, I_A0, I_A2, I_KK, I_KA, I_RK, I_LNW, I_LNB, I_CW, I_CB, I_DTB, I_ALOG, I_DSK, I_GNW, I_WOUT, I_FNW };

__device__ __forceinline__ float bf2f(unsigned short b) { return __uint_as_float(((unsigned)b) << 16); }
__device__ __forceinline__ unsigned short f2bf(float f) { unsigned u = __float_as_uint(f); u += 0x7FFFu + ((u >> 16) & 1u); return (unsigned short)(u >> 16); }
__device__ __forceinline__ unsigned pk2(float lo, float hi) { return (unsigned)f2bf(lo) | ((unsigned)f2bf(hi) << 16); }
__device__ __forceinline__ void unpack8(const u32x4 v, float* f) {
    f[0] = __uint_as_float(v.x << 16); f[1] = __uint_as_float(v.x & 0xffff0000u); f[2] = __uint_as_float(v.y << 16); f[3] = __uint_as_float(v.y & 0xffff0000u);
    f[4] = __uint_as_float(v.z << 16); f[5] = __uint_as_float(v.z & 0xffff0000u); f[6] = __uint_as_float(v.w << 16); f[7] = __uint_as_float(v.w & 0xffff0000u); }
__device__ __forceinline__ u32x4 pack8(const float* f) { u32x4 r; r.x = pk2(f[0], f[1]); r.y = pk2(f[2], f[3]); r.z = pk2(f[4], f[5]); r.w = pk2(f[6], f[7]); return r; }
__device__ __forceinline__ float frcp(float x) { return __builtin_amdgcn_rcpf(x); }
__device__ __forceinline__ float sigmoidf_(float x) { return frcp(1.0f + __expf(-x)); }
__device__ __forceinline__ float siluf_(float x) { return x * frcp(1.0f + __expf(-x)); }
__device__ __forceinline__ float softplusf_(float x) { return x > 20.f ? x : log1pf(__expf(x)); }
template <int CTRL> __device__ __forceinline__ float dppf(float v) { return __int_as_float(__builtin_amdgcn_mov_dpp(__float_as_int(v), CTRL, 0xF, 0xF, true)); }
__device__ __forceinline__ float red8(float x) { x += dppf<0xB1>(x); x += dppf<0x4E>(x); x += dppf<0x141>(x); return x; }
__device__ __forceinline__ float red16(float x) { x = red8(x); x += dppf<0x140>(x); return x; }
__device__ __forceinline__ float wave_sum(float x) {
#pragma unroll
    for (int o = 32; o > 0; o >>= 1) x += __shfl_xor(x, o);
    return x; }
__device__ __forceinline__ void lds_fence() { asm volatile("s_waitcnt lgkmcnt(0)" ::: "memory"); }
__device__ __forceinline__ unsigned char* launder_lds(unsigned char* sm) { int off = 0; asm volatile("" : "+s"(off)); return sm + off; }
#define LBAR() do { asm volatile("s_waitcnt lgkmcnt(0)" ::: "memory"); __builtin_amdgcn_s_barrier(); asm volatile("" ::: "memory"); } while (0)
#define MFMA16(a, b, c) __builtin_amdgcn_mfma_f32_16x16x32_bf16((a), (b), (c), 0, 0, 0)

__device__ void phase_convert(const Params& p, unsigned char* smem_) {
    unsigned char* smem = launder_lds(smem_);
    float* tile = (float*)smem;
    const int tid = tid_l();
    constexpr int NT_IN = 16 * 108, NT_OUT = 32 * 16, PER_L = NT_IN + NT_OUT;
    for (int it = blockIdx.x; it < 2 * PER_L; it += gridDim.x) {
        const int l = it / PER_L; int r = it % PER_L;
        const float* src; bf16_t* dst; int K, Nsrc, kt, nt;
        if (r < NT_IN) { src = p.in[I_WIN] + (size_t)l * 1024 * NIN; dst = (bf16_t*)(p.ws + WS_WINT) + (size_t)l * N1 * 1024; K = 1024; Nsrc = NIN; kt = r & 15; nt = r >> 4; }
        else { r -= NT_IN; src = p.in[I_WOUT] + (size_t)l * 2048 * 1024; dst = (bf16_t*)(p.ws + WS_WOUTT) + (size_t)l * 1024 * 2048; K = 2048; Nsrc = 1024; kt = r & 31; nt = r >> 5; }
#pragma unroll
        for (int i = 0; i < 2; ++i) {
            const int rr = (tid >> 4) + 32 * i, c4 = (tid & 15) * 4, col = nt * 64 + c4;
            float4 v = make_float4(0.f, 0.f, 0.f, 0.f);
            if (col < Nsrc) v = *(const float4*)(src + (size_t)(kt * 64 + rr) * Nsrc + col);
            float* tp = tile + rr * 65 + c4; tp[0] = v.x; tp[1] = v.y; tp[2] = v.z; tp[3] = v.w;
        }
        __syncthreads();
        { const int n = tid >> 3, k8 = (tid & 7) * 8; float f[8];
#pragma unroll
          for (int j = 0; j < 8; ++j) f[j] = tile[(k8 + j) * 65 + n];
          *(u32x4*)(dst + (size_t)(nt * 64 + n) * K + kt * 64 + k8) = pack8(f); }
        __syncthreads();
    }
}

__device__ void phase_norm(const Params& p, int l) {
    const int tid_ = tid_l(); const int lane = tid_ & 63, wid = tid_ >> 6;
    bf16_t* A1 = (bf16_t*)(p.ws + WS_A);
    const float* nw = p.in[I_NORMW] + l * 1024;
    for (int row = blockIdx.x * 8 + wid; row < M1; row += gridDim.x * 8) {
        const float* src;
        if (row < TP) src = (l == 0 ? p.in[I_XP] : p.out + O_YP) + (size_t)row * 1024;
        else if (row < TALL) src = (l == 0 ? p.in[I_XS] : p.out + O_YS) + (size_t)(row - TP) * 1024;
        else src = p.in[I_SSHIFT] + ((size_t)l * TS + (row - TALL)) * 1024;
        float4 v[4]; float ss = 0.f;
#pragma unroll
        for (int i = 0; i < 4; ++i) v[i] = *(const float4*)(src + i * 256 + lane * 4);
        if (l == 1 && row >= TP && row < TALL) {
            const float* x0 = p.in[I_XS] + (size_t)(row - TP) * 1024; const float* pt = (const float*)(p.ws + WS_PART) + (size_t)(row - TP) * 1024;
#pragma unroll
            for (int i = 0; i < 4; ++i) { float4 a = *(const float4*)(x0 + i * 256 + lane * 4);
                for (int q = 0; q < 16; ++q) { const float4 t = *(const float4*)(pt + (size_t)q * TS * 1024 + i * 256 + lane * 4); a.x += t.x; a.y += t.y; a.z += t.z; a.w += t.w; }
                v[i] = a; *(float4*)(p.out + O_YS + (size_t)(row - TP) * 1024 + i * 256 + lane * 4) = a; }
        }
#pragma unroll
        for (int i = 0; i < 4; ++i) ss += v[i].x * v[i].x + v[i].y * v[i].y + v[i].z * v[i].z + v[i].w * v[i].w;
        if (row < TALL) {
            ss = wave_sum(ss);
            const float rs = rsqrtf(ss * (1.0f / 1024.0f) + 1e-5f);
#pragma unroll
            for (int i = 0; i < 4; ++i) { const float4 w = *(const float4*)(nw + i * 256 + lane * 4); v[i].x *= rs * w.x; v[i].y *= rs * w.y; v[i].z *= rs * w.z; v[i].w *= rs * w.w; }
            float* so = nullptr;
            if (row < TP) { if ((row & 2047) == 2047) so = p.out + O_PSH + ((size_t)l * 8 + (row >> 11)) * 1024; }
            else so = p.out + O_SSH + ((size_t)l * TS + (row - TP)) * 1024;
            if (so) {
#pragma unroll
                for (int i = 0; i < 4; ++i) *(float4*)(so + i * 256 + lane * 4) = v[i]; }
        }
#pragma unroll
        for (int i = 0; i < 4; ++i) { u32x2 w; w.x = pk2(v[i].x, v[i].y); w.y = pk2(v[i].z, v[i].w); *(u32x2*)(A1 + (size_t)row * 1024 + i * 256 + lane * 4) = w; }
    }
}

__device__ void phase_final(const Params& p) {
    const int tid_ = tid_l(); const int lane = tid_ & 63, wid = tid_ >> 6;
    const float* nw = p.in[I_FNW];
    for (int row = blockIdx.x * 8 + wid; row < TALL; row += gridDim.x * 8) {
        float* src = (row < TP) ? p.out + O_YP + (size_t)row * 1024 : p.out + O_YS + (size_t)(row - TP) * 1024;
        float4 v[4]; float ss = 0.f;
#pragma unroll
        for (int i = 0; i < 4; ++i) v[i] = *(const float4*)(src + i * 256 + lane * 4);
        if (row >= TP) { const float* pt = (const float*)(p.ws + WS_PART) + (size_t)(row - TP) * 1024;
#pragma unroll
            for (int i = 0; i < 4; ++i) for (int q = 0; q < 16; ++q) { const float4 t = *(const float4*)(pt + (size_t)q * TS * 1024 + i * 256 + lane * 4); v[i].x += t.x; v[i].y += t.y; v[i].z += t.z; v[i].w += t.w; } }
#pragma unroll
        for (int i = 0; i < 4; ++i) ss += v[i].x * v[i].x + v[i].y * v[i].y + v[i].z * v[i].z + v[i].w * v[i].w;
        ss = wave_sum(ss);
        const float rs = rsqrtf(ss * (1.0f / 1024.0f) + 1e-5f);
#pragma unroll
        for (int i = 0; i < 4; ++i) { const float4 w = *(const float4*)(nw + i * 256 + lane * 4); v[i].x *= rs * w.x; v[i].y *= rs * w.y; v[i].z *= rs * w.z; v[i].w *= rs * w.w;
            *(float4*)(src + i * 256 + lane * 4) = v[i]; }
    }
}

struct EpiP {
    static constexpr bool PERM = true, AFTER_DRAIN = false;
    bf16_t* O; int ldc;
    __device__ __forceinline__ void operator()(const f32x4 (&acc)[2][2][4][2], const pg8::Unit& u, int wr, int wc, int fr, int fq) const {
        const int row0 = u.pm * 256 + wr * 64 + fr, col0 = u.pn * 256 + wc * 32 + 8 * fq;
#pragma unroll
        for (int ai = 0; ai < 2; ++ai)
#pragma unroll
            for (int m = 0; m < 4; ++m) { bf16_t* rowp = O + (size_t)(row0 + ai * 128 + m * 16) * ldc + col0;
#pragma unroll
                for (int bj = 0; bj < 2; ++bj) { const f32x4 v0 = acc[ai][bj][m][0], v1 = acc[ai][bj][m][1];
                    u32x4 w; w.x = pg8::cvt_pk_bf16(v0[0], v0[1]); w.y = pg8::cvt_pk_bf16(v0[2], v0[3]); w.z = pg8::cvt_pk_bf16(v1[0], v1[1]); w.w = pg8::cvt_pk_bf16(v1[2], v1[3]);
                    *(u32x4*)(rowp + bj * 128) = w; } }
    }
};
struct EpiRes {
    static constexpr bool PERM = false, AFTER_DRAIN = false;
    const float* res_p; float* out_p;
    __device__ __forceinline__ void operator()(const f32x4 (&acc)[2][2][4][2], const pg8::Unit& u, int wr, int wc, int fr, int fq) const {
        const int row0 = u.pm * 256 + wr * 64 + fr, col0 = u.pn * 256 + wc * 32 + 4 * fq;
#pragma unroll
        for (int ai = 0; ai < 2; ++ai)
#pragma unroll
            for (int m = 0; m < 4; ++m) { const size_t ro = (size_t)(row0 + ai * 128 + m * 16) * 1024;
#pragma unroll
                for (int bj = 0; bj < 2; ++bj)
#pragma unroll
                    for (int n = 0; n < 2; ++n) { const int c = col0 + bj * 128 + n * 16; const f32x4 r = *(const f32x4*)(res_p + ro + c); *(f32x4*)(out_p + ro + c) = acc[ai][bj][m][n] + r; } }
    }
};

constexpr int CH_NB = 5, CH_CB = 16384;
constexpr int CB_A1 = 0, CB_A2 = 3328, CB_TT = 6656, CB_A3 = 7936, CB_VT = 13056, CB_GQ = 16128;
constexpr int CH_SCR = CH_NB * CH_CB;
constexpr int SCR_TW = 0, SCR_EXL = 4608, SCR_NM = 8704, SCR_SZ = 9856;
constexpr int CH_W2T = CH_SCR + 4 * SCR_SZ;
constexpr int CH_CST = CH_W2T + 18432;
constexpr int CH_FLG = CH_CST + 2560;
__device__ __forceinline__ unsigned cvtpk(float lo, float hi) { return pg8::cvt_pk_bf16(lo, hi); }
__device__ void rwkv_chain_item(const Params& p, int l, int item, unsigned char* smem_) {
    unsigned char* smem = launder_lds(smem_);
    const int tid = tid_l(), wid = tid >> 6, lane = tid & 63, fr = lane & 15, fq = lane >> 4;
    const int b = item >> 4, h = item & 15;
    bf16_t* w2t = (bf16_t*)(smem + CH_W2T); bf16_t* a2t = w2t + 4608;
    float* cst = (float*)(smem + CH_CST);
    volatile unsigned* ready = (volatile unsigned*)(smem + CH_FLG); volatile unsigned* cons = ready + 128;
    const bf16_t* P = (const bf16_t*)(p.ws + WS_P);
    float* ORAW = (float*)(p.ws + WS_ORAW);
    bf16_t* BV = (bf16_t*)(p.ws + WS_BV);
    __syncthreads();
    for (int i = tid; i < (CH_SCR + 4 * SCR_SZ) / 4; i += 512) ((unsigned*)smem)[i] = 0u;
    if (tid < 256) ((unsigned*)(smem + CH_FLG))[tid] = 0u;
    { const float* w2 = p.in[I_W2] + (size_t)l * 64 * 1024 + h * 64; const float* a2 = p.in[I_A2] + (size_t)l * 64 * 1024 + h * 64;
#pragma unroll
      for (int i = 0; i < 8; ++i) { const int idx = tid + 512 * i, k = idx >> 6, n = idx & 63; w2t[n * 72 + k] = f2bf(w2[(size_t)k * 1024 + n]); a2t[n * 72 + k] = f2bf(a2[(size_t)k * 1024 + n]); } }
    if (tid < 64) { const float* mu = p.in[I_MU] + (size_t)l * 3200; const int gc = h * 64 + tid;
        cst[tid] = mu[C_R + gc]; cst[64 + tid] = mu[C_K + gc]; cst[128 + tid] = mu[C_V + gc]; cst[192 + tid] = mu[C_WL + tid]; cst[256 + tid] = mu[C_AL + tid];
        cst[320 + tid] = p.in[I_KK][l * 1024 + gc]; cst[384 + tid] = p.in[I_KA][l * 1024 + gc]; cst[448 + tid] = p.in[I_RK][l * 1024 + gc];
        cst[512 + tid] = p.in[I_W0][l * 1024 + gc]; cst[576 + tid] = p.in[I_A0][l * 1024 + gc]; }
    __syncthreads();

    if (wid >= 4) {
        const int hw = wid - 4, tok = lane >> 2, q4 = lane & 3, c0 = q4 * 16;
        unsigned char* scr = smem + CH_SCR + hw * SCR_SZ;
        bf16_t* tw = (bf16_t*)(scr + SCR_TW); bf16_t* ta = tw + 1152;
        bf16_t* ZQ = (bf16_t*)(scr + SCR_TW); bf16_t* ZK = ZQ + 1152;
        float* exl = (float*)(scr + SCR_EXL);
        float* Nm = (float*)(scr + SCR_NM);
        const int segcol[5] = {C_R + h * 64 + c0, C_K + h * 64 + c0, C_V + h * 64 + c0, C_WL + c0, C_AL + c0};
        float w0c[4], a0c[4];
#pragma unroll
        for (int ct = 0; ct < 4; ++ct) { w0c[ct] = cst[512 + ct * 16 + fr]; a0c[ct] = cst[576 + ct * 16 + fr]; }
        u32x4 qc[5][2], qp[5][2];
#define CLOAD(C) { const int t_ = (C) * 16 + tok; const bf16_t* pr_ = P + ((size_t)b * 2048 + t_) * N1; \
            _Pragma("unroll") for (int sg = 0; sg < 5; ++sg) _Pragma("unroll") for (int hh = 0; hh < 2; ++hh) { qc[sg][hh] = *(const u32x4*)(pr_ + segcol[sg] + hh * 8); \
                if (t_ > 0) qp[sg][hh] = *(const u32x4*)(pr_ - N1 + segcol[sg] + hh * 8); else qp[sg][hh] = (u32x4){0u, 0u, 0u, 0u}; } }
        CLOAD(hw)
        for (int c = hw; c < 128; c += 4) {
            unsigned char* cb = smem + (c % CH_NB) * CH_CB;
            bf16_t* A1 = (bf16_t*)(cb + CB_A1); bf16_t* A2 = (bf16_t*)(cb + CB_A2); bf16_t* TT = (bf16_t*)(cb + CB_TT); bf16_t* A3 = (bf16_t*)(cb + CB_A3); bf16_t* VT = (bf16_t*)(cb + CB_VT); float* GQ = (float*)(cb + CB_GQ);
            const size_t grow = (size_t)b * 2048 + c * 16 + tok;
            if (c >= CH_NB) { while (cons[c - CH_NB] < 4u) __builtin_amdgcn_s_sleep(1); }
            asm volatile("" ::: "memory");
            float* exa = (float*)(cb + CB_A3);
            float xr[16], xk[16]; unsigned xvp[8];
            { float cur[8], prv[8], xw[8], xa[8], xv[8];
#pragma unroll
              for (int hh = 0; hh < 2; ++hh) {
#define LSEG(dst, sg, mo) { unpack8(qc[sg][hh], cur); unpack8(qp[sg][hh], prv); _Pragma("unroll") for (int e = 0; e < 8; ++e) dst[e] = cur[e] + (prv[e] - cur[e]) * cst[(mo) + c0 + hh * 8 + e]; }
                LSEG((xr + hh * 8), 0, 0) LSEG((xk + hh * 8), 1, 64) LSEG(xv, 2, 128) LSEG(xw, 3, 192) LSEG(xa, 4, 256)
#undef LSEG
                { const u32x4 pv = pack8(xv); xvp[hh * 4] = pv.x; xvp[hh * 4 + 1] = pv.y; xvp[hh * 4 + 2] = pv.z; xvp[hh * 4 + 3] = pv.w; }
#pragma unroll
                for (int e = 0; e < 8; ++e) xw[e] = 1.0f - 2.0f * frcp(__expf(2.0f * xw[e]) + 1.0f);
                *(u32x4*)(tw + tok * 72 + c0 + hh * 8) = pack8(xw); *(u32x4*)(ta + tok * 72 + c0 + hh * 8) = pack8(xa);
              } }
            if (c + 4 < 128) CLOAD(c + 4)
            lds_fence();
#pragma unroll
            for (int ct = 0; ct < 4; ++ct) { f32x4 aw = {0.f, 0.f, 0.f, 0.f}, aa = aw;
#pragma unroll
                for (int ks = 0; ks < 2; ++ks) {
                    aw = MFMA16(*(const bf16x8*)(tw + fr * 72 + ks * 32 + fq * 8), *(const bf16x8*)(w2t + (ct * 16 + fr) * 72 + ks * 32 + fq * 8), aw);
                    aa = MFMA16(*(const bf16x8*)(ta + fr * 72 + ks * 32 + fq * 8), *(const bf16x8*)(a2t + (ct * 16 + fr) * 72 + ks * 32 + fq * 8), aa); }
#pragma unroll
                for (int j = 0; j < 4; ++j) { const int tj = fq * 4 + j, col = ct * 16 + fr;
                    exl[tj * 64 + col] = -0.60653066f * sigmoidf_(w0c[ct] + aw[j]);
                    exa[tj * 64 + col] = sigmoidf_(a0c[ct] + aa[j]); } }
            lds_fence();
            { float Lc = 0.f;
#pragma unroll
              for (int t = 0; t < 16; ++t) { Lc += exl[t * 64 + lane]; exl[t * 64 + lane] = __expf(Lc); }
              GQ[lane] = __expf(Lc); }
            float a16[16];
#pragma unroll
            for (int i = 0; i < 4; ++i) { const float4 t4 = *(const float4*)(exa + tok * 64 + c0 + i * 4); a16[i * 4] = t4.x; a16[i * 4 + 1] = t4.y; a16[i * 4 + 2] = t4.z; a16[i * 4 + 3] = t4.w; }
            float ssq = 0.f, beta = 0.f;
#pragma unroll
            for (int e = 0; e < 16; ++e) { const float kr_ = xk[e] * cst[320 + c0 + e]; ssq += kr_ * kr_; }
            ssq += dppf<0xB1>(ssq); ssq += dppf<0x4E>(ssq);
            const float inv = frcp(fmaxf(__builtin_amdgcn_sqrtf(ssq), 1e-12f));
            lds_fence();
            { const int sq = (tok >> 2) * 8 + (tok & 3);
#pragma unroll
              for (int gI = 0; gI < 4; ++gI) {
                float pt[4], rt[4], qt[4], kt[4];
#pragma unroll
                for (int e3 = 0; e3 < 4; ++e3) { const int e = gI * 4 + e3; const float el = exl[tok * 64 + c0 + e], elm = tok > 0 ? exl[(tok - 1) * 64 + c0 + e] : 1.0f, iv = frcp(el);
                    const float kk_ = xk[e] * cst[320 + c0 + e] * inv, kp_ = xk[e] * (1.0f + (a16[e] - 1.0f) * cst[384 + c0 + e]), bb_ = -kk_ * a16[e];
                    beta += xr[e] * kp_ * cst[448 + c0 + e];
                    pt[e3] = kk_ * elm; rt[e3] = xr[e] * el; qt[e3] = bb_ * iv; kt[e3] = kp_ * iv;
                    const unsigned qk = cvtpk(qt[e3], kt[e3]);
                    A3[(c0 + e) * 40 + sq] = (bf16_t)(qk & 0xffffu); A3[(c0 + e) * 40 + sq + 4] = (bf16_t)(qk >> 16);
                    VT[(c0 + e) * 24 + tok] = (bf16_t)((e & 1) ? (xvp[e >> 1] >> 16) : (xvp[e >> 1] & 0xffffu)); }
                const int s0 = (q4 >> 1) * 32 + gI * 8 + (q4 & 1) * 4;
                u32x2 w; w.x = cvtpk(pt[0], pt[1]); w.y = cvtpk(pt[2], pt[3]); *(u32x2*)(A1 + tok * 104 + s0) = w;
                w.x = cvtpk(rt[0], rt[1]); w.y = cvtpk(rt[2], rt[3]); *(u32x2*)(A2 + tok * 104 + s0) = w;
                w.x = cvtpk(qt[0], qt[1]); w.y = cvtpk(qt[2], qt[3]); *(u32x2*)(ZQ + tok * 72 + s0) = w;
                w.x = cvtpk(kt[0], kt[1]); w.y = cvtpk(kt[2], kt[3]); *(u32x2*)(ZK + tok * 72 + s0) = w;
              } }
            beta += dppf<0xB1>(beta); beta += dppf<0x4E>(beta);
            { float bv[16];
#pragma unroll
              for (int e = 0; e < 16; ++e) bv[e] = beta * __uint_as_float((e & 1) ? (xvp[e >> 1] & 0xffff0000u) : (xvp[e >> 1] << 16));
              *(u32x4*)(BV + grow * 1024 + h * 64 + c0) = pack8(bv); *(u32x4*)(BV + grow * 1024 + h * 64 + c0 + 8) = pack8(bv + 8); }
            lds_fence();
            { f32x4 gN = {0.f, 0.f, 0.f, 0.f}, gKP = gN, gQR = gN, gKR = gN;
#pragma unroll
              for (int ks = 0; ks < 2; ++ks) {
                  const bf16x8 fzq = *(const bf16x8*)(ZQ + fr * 72 + ks * 32 + fq * 8), fzk = *(const bf16x8*)(ZK + fr * 72 + ks * 32 + fq * 8);
                  const bf16x8 fp = *(const bf16x8*)(A1 + fr * 104 + ks * 32 + fq * 8), frr = *(const bf16x8*)(A2 + fr * 104 + ks * 32 + fq * 8);
                  gN = MFMA16(fzq, fp, gN); gKP = MFMA16(fzk, fp, gKP); gQR = MFMA16(fzq, frr, gQR); gKR = MFMA16(fzk, frr, gKR); }
#pragma unroll
              for (int jj = 0; jj < 4; ++jj) { const int j = fq * 4 + jj; const bool lt = j < fr, le = j <= fr;
                  gN[jj] = lt ? gN[jj] : 0.f; gKP[jj] = lt ? gKP[jj] : 0.f; gQR[jj] = le ? gQR[jj] : 0.f; gKR[jj] = le ? gKR[jj] : 0.f;
                  Nm[j * 17 + fr] = gN[jj]; }
              u32x4 w1; w1.x = 0u; w1.y = 0u; w1.z = cvtpk(gKP[0], gKP[1]); w1.w = cvtpk(gKP[2], gKP[3]); *(u32x4*)(A1 + fr * 104 + 64 + fq * 8) = w1;
              u32x4 w2; w2.x = cvtpk(gQR[0], gQR[1]); w2.y = cvtpk(gQR[2], gQR[3]); w2.z = cvtpk(gKR[0], gKR[1]); w2.w = cvtpk(gKR[2], gKR[3]); *(u32x4*)(A2 + fr * 104 + 64 + fq * 8) = w2; }
            lds_fence();
            { float Ti[16]; int i = fr; asm volatile("" : "+v"(i));
#pragma unroll
              for (int t = 0; t < 16; ++t) { float s = (i == t) ? 1.0f : 0.0f;
#pragma unroll
                  for (int j = 0; j < t; ++j) s += Ti[j] * Nm[j * 17 + t];
                  Ti[t] = s; }
              if (lane < 16) { const int sq = (i >> 2) * 8 + (i & 3);
#pragma unroll
                  for (int t = 0; t < 16; ++t) TT[t * 40 + sq] = f2bf(Ti[t]); } }
            lds_fence();
            if (lane == 0) ready[c] = 1u;
        }
#undef CLOAD
    } else {
        const int v0 = wid * 16;
        f32x4 acc[4];
#pragma unroll
        for (int kt = 0; kt < 4; ++kt) acc[kt] = (f32x4){0.f, 0.f, 0.f, 0.f};
        for (int c = 0; c < 128; ++c) {
            const unsigned char* cb = smem + (c % CH_NB) * CH_CB;
            const bf16_t* A1 = (const bf16_t*)(cb + CB_A1); const bf16_t* A2 = (const bf16_t*)(cb + CB_A2); const bf16_t* TT = (const bf16_t*)(cb + CB_TT); const bf16_t* A3 = (const bf16_t*)(cb + CB_A3);
            const bf16_t* VT = (const bf16_t*)(cb + CB_VT); const float* GQ = (const float*)(cb + CB_GQ);
            while (ready[c] == 0u) __builtin_amdgcn_s_sleep(1);
            asm volatile("" ::: "memory");
            union { u32x4 u; bf16x8 h; } B0, B1, BX;
            B0.u.x = cvtpk(acc[0][0], acc[0][1]); B0.u.y = cvtpk(acc[0][2], acc[0][3]); B0.u.z = cvtpk(acc[1][0], acc[1][1]); B0.u.w = cvtpk(acc[1][2], acc[1][3]);
            B1.u.x = cvtpk(acc[2][0], acc[2][1]); B1.u.y = cvtpk(acc[2][2], acc[2][3]); B1.u.z = cvtpk(acc[3][0], acc[3][1]); B1.u.w = cvtpk(acc[3][2], acc[3][3]);
            const u32x2 vq = *(const u32x2*)(VT + (v0 + fr) * 24 + fq * 4);
            BX.u.x = 0u; BX.u.y = 0u; BX.u.z = vq.x; BX.u.w = vq.y;
            f32x4 rhs = {0.f, 0.f, 0.f, 0.f};
            rhs = MFMA16(*(const bf16x8*)(A1 + fr * 104 + fq * 8), B0.h, rhs);
            rhs = MFMA16(*(const bf16x8*)(A1 + fr * 104 + 32 + fq * 8), B1.h, rhs);
            rhs = MFMA16(*(const bf16x8*)(A1 + fr * 104 + 64 + fq * 8), BX.h, rhs);
            BX.u.x = pk2(rhs[0], rhs[1]); BX.u.y = pk2(rhs[2], rhs[3]); BX.u.z = 0u; BX.u.w = 0u;
            f32x4 uu = {0.f, 0.f, 0.f, 0.f};
            uu = MFMA16(*(const bf16x8*)(TT + fr * 40 + fq * 8), BX.h, uu);
            BX.u.x = pk2(uu[0], uu[1]); BX.u.y = pk2(uu[2], uu[3]); BX.u.z = vq.x; BX.u.w = vq.y;
            f32x4 oo = {0.f, 0.f, 0.f, 0.f};
            oo = MFMA16(*(const bf16x8*)(A2 + fr * 104 + fq * 8), B0.h, oo);
            oo = MFMA16(*(const bf16x8*)(A2 + fr * 104 + 32 + fq * 8), B1.h, oo);
            oo = MFMA16(*(const bf16x8*)(A2 + fr * 104 + 64 + fq * 8), BX.h, oo);
#pragma unroll
            for (int kt = 0; kt < 4; ++kt) { acc[kt] = MFMA16(*(const bf16x8*)(A3 + (kt * 16 + fr) * 40 + fq * 8), BX.h, acc[kt]);
                const float4 gq = *(const float4*)(GQ + kt * 16 + fq * 4); acc[kt][0] *= gq.x; acc[kt][1] *= gq.y; acc[kt][2] *= gq.z; acc[kt][3] *= gq.w; }
            asm volatile("s_waitcnt lgkmcnt(0)" ::: "memory");
            if (lane == 0) __hip_atomic_fetch_add((unsigned*)&cons[c], 1u, __ATOMIC_RELAXED, __HIP_MEMORY_SCOPE_WORKGROUP);
            float* op = ORAW + ((size_t)b * 2048 + c * 16 + fq * 4) * 1024 + h * 64 + v0 + fr;
#pragma unroll
            for (int jj = 0; jj < 4; ++jj) op[(size_t)jj * 1024] = oo[jj];
        }
        float* so = p.out + O_PWKV + ((((size_t)l * 8 + b) * 16 + h) * 64 + v0 + fr) * 64 + fq * 4;
#pragma unroll
        for (int kt = 0; kt < 4; ++kt) *(float4*)(so + kt * 16) = make_float4(acc[kt][0], acc[kt][1], acc[kt][2], acc[kt][3]);
    }
    __syncthreads();
}

__device__ void rwkv_sample_item(const Params& p, int l, int item, unsigned char* smem_) {
    unsigned char* smem = launder_lds(smem_);
    const int tid = tid_l(), lane = tid & 63, ks = tid >> 6;
    const int i = item >> 4, h = item & 15;
    float* part = (float*)smem;
    float* sv = part + 1024;
    float* s_sc = sv + 384;
    const bf16_t* P = (const bf16_t*)(p.ws + WS_P);
    float* ORAW = (float*)(p.ws + WS_ORAW);
    bf16_t* BV = (bf16_t*)(p.ws + WS_BV);
    const size_t rowp = (size_t)TP + i, rows = (size_t)TALL + i;
    const bf16_t* pc = P + rowp * N1; const bf16_t* pp = P + rows * N1;
    const float* mu = p.in[I_MU] + (size_t)l * 3200;
    const int gc = h * 64 + lane;
    const int row = tid >> 3, cs = (tid & 7) * 8;
    const size_t so = ((((size_t)l * TS + i) * 16 + h) * 64 + row) * 64 + cs;
    const float4 a0 = *(const float4*)(p.in[I_SWKV] + so), a1 = *(const float4*)(p.in[I_SWKV] + so + 4);
#define LERP1(col) (bf2f(pc[col]) + (bf2f(pp[col]) - bf2f(pc[col])) * mu[col])
    { const float* w2 = p.in[I_W2] + (size_t)l * 64 * 1024 + gc; const float* a2 = p.in[I_A2] + (size_t)l * 64 * 1024 + gc;
      float lw = 0.f, la = 0.f;
#pragma unroll
      for (int kk = 0; kk < 8; ++kk) { const int k = ks * 8 + kk; const float xwl = LERP1(C_WL + k), xal = LERP1(C_AL + k);
          lw += (1.0f - 2.0f * frcp(__expf(2.0f * xwl) + 1.0f)) * w2[(size_t)k * 1024]; la += xal * a2[(size_t)k * 1024]; }
      __syncthreads();
      part[ks * 64 + lane] = lw; part[512 + ks * 64 + lane] = la; }
    __syncthreads();
    if (tid < 64) {
        const float xr = LERP1(C_R + gc), xk = LERP1(C_K + gc), xv = LERP1(C_V + gc);
        float lw = 0.f, la = 0.f;
#pragma unroll
        for (int q = 0; q < 8; ++q) { lw += part[q * 64 + lane]; la += part[512 + q * 64 + lane]; }
        const float w = __expf(-0.60653066f * sigmoidf_(p.in[I_W0][l * 1024 + gc] + lw));
        const float a = sigmoidf_(p.in[I_A0][l * 1024 + gc] + la);
        float kk = xk * p.in[I_KK][l * 1024 + gc];
        const float ssq = wave_sum(kk * kk);
        kk *= 1.0f / fmaxf(sqrtf(ssq), 1e-12f);
        const float kp = xk * (1.0f + (a - 1.0f) * p.in[I_KA][l * 1024 + gc]);
        const float bb = -kk * a, wr = w * xr;
        const float br = wave_sum(bb * xr), kr = wave_sum(kp * xr), beta = wave_sum(xr * kp * p.in[I_RK][l * 1024 + gc]);
        sv[lane] = w; sv[64 + lane] = kk; sv[128 + lane] = bb; sv[192 + lane] = kp; sv[256 + lane] = wr; sv[320 + lane] = xv;
        if (lane == 0) { s_sc[0] = br; s_sc[1] = kr; }
        BV[rowp * 1024 + gc] = f2bf(beta * xv);
    }
#undef LERP1
    __syncthreads();
    {
        float S[8] = {a0.x, a0.y, a0.z, a0.w, a1.x, a1.y, a1.z, a1.w};
        float dk = 0.f, dr = 0.f;
#pragma unroll
        for (int e = 0; e < 8; ++e) { dk += S[e] * sv[64 + cs + e]; dr += S[e] * sv[256 + cs + e]; }
        dk = red8(dk); dr = red8(dr);
        const float vr = sv[320 + row];
        const float o = dr + dk * s_sc[0] + vr * s_sc[1];
        if ((tid & 7) == 0) ORAW[rowp * 1024 + h * 64 + row] = o;
#pragma unroll
        for (int e = 0; e < 8; ++e) S[e] = S[e] * sv[cs + e] + dk * sv[128 + cs + e] + vr * sv[192 + cs + e];
        float* sout = p.out + O_SWKV + so;
        *(float4*)sout = make_float4(S[0], S[1], S[2], S[3]); *(float4*)(sout + 4) = make_float4(S[4], S[5], S[6], S[7]);
    }
}

__device__ void phase_conv(const Params& p, int l) {
    const int tid = tid_l();
    const bf16_t* P = (const bf16_t*)(p.ws + WS_P);
    bf16_t* U = (bf16_t*)(p.ws + WS_U); float* DT = (float*)(p.ws + WS_DT);
    for (int id = blockIdx.x * 512 + tid; id < 1024 * 384; id += gridDim.x * 512) {
        const int q = id % 384, seg = id / 384, xcol = q * 4;
        const int bb = seg >> 7, tb = (seg & 127) * 16;
        float4 cw0, cw1, cw2, cw3, cbv;
        { const float* cw = p.in[I_CW] + (size_t)l * 4 * 1536 + xcol; cw0 = *(const float4*)cw; cw1 = *(const float4*)(cw + 1536); cw2 = *(const float4*)(cw + 3072); cw3 = *(const float4*)(cw + 4608);
          cbv = *(const float4*)(p.in[I_CB] + (size_t)l * 1536 + xcol); }
        const bf16_t* pb = P + ((size_t)bb * 2048 + tb) * N1 + C_XBC + xcol;
        bf16_t* ub = U + ((size_t)bb * 2048 + tb) * 1536 + xcol;
        float4 w0 = make_float4(0.f, 0.f, 0.f, 0.f), w1 = w0, w2 = w0;
#define LD4(dst, ptr) { const u32x2 _v = *(const u32x2*)(ptr); dst = make_float4(__uint_as_float(_v.x << 16), __uint_as_float(_v.x & 0xffff0000u), __uint_as_float(_v.y << 16), __uint_as_float(_v.y & 0xffff0000u)); }
        if (tb >= 3) { LD4(w0, pb - 3 * (size_t)N1) LD4(w1, pb - 2 * (size_t)N1) LD4(w2, pb - (size_t)N1) }
#pragma unroll
        for (int s = 0; s < 16; ++s) {
            float4 cur; LD4(cur, pb + (size_t)s * N1)
            float4 u;
            u.x = cbv.x + cw0.x * w0.x + cw1.x * w1.x + cw2.x * w2.x + cw3.x * cur.x; u.y = cbv.y + cw0.y * w0.y + cw1.y * w1.y + cw2.y * w2.y + cw3.y * cur.y;
            u.z = cbv.z + cw0.z * w0.z + cw1.z * w1.z + cw2.z * w2.z + cw3.z * cur.z; u.w = cbv.w + cw0.w * w0.w + cw1.w * w1.w + cw2.w * w2.w + cw3.w * cur.w;
            u32x2 pk; pk.x = pk2(siluf_(u.x), siluf_(u.y)); pk.y = pk2(siluf_(u.z), siluf_(u.w));
            *(u32x2*)(ub + (size_t)s * 1536) = pk;
            w0 = w1; w1 = w2; w2 = cur;
        }
#undef LD4
    }
    for (int id = blockIdx.x * 512 + tid; id < TP * 16; id += gridDim.x * 512) {
        const int t = id >> 4, j = id & 15;
        DT[id] = softplusf_(bf2f(P[(size_t)t * N1 + C_DT + j]) + p.in[I_DTB][l * 16 + j]);
    }
}

__device__ void mamba_item(const Params& p, int l, int item, unsigned char* smem_) {
    unsigned char* smem = launder_lds(smem_);
    const int tid = tid_l(), wid = tid >> 6, lane = tid & 63, fr = lane & 15, fq = lane >> 4;
    const int b = item >> 5, j = (item >> 1) & 15, ph = item & 1, g = j >> 3;
    bf16_t* Cm = (bf16_t*)smem;
    bf16_t* Bm = (bf16_t*)(smem + 17408);
    bf16_t* BmT = (bf16_t*)(smem + 34816);
    bf16_t* XT = (bf16_t*)(smem + 53248);
    bf16_t* XwT = (bf16_t*)(smem + 57856);
    bf16_t* G = (bf16_t*)(smem + 62464);
    bf16_t* Hb = (bf16_t*)(smem + 71680);
    float* acs = (float*)(smem + 80384);
    float* dtv = acs + 64;
    const bf16_t* P = (const bf16_t*)(p.ws + WS_P);
    const bf16_t* U = (const bf16_t*)(p.ws + WS_U); const float* DT = (const float*)(p.ws + WS_DT);
    bf16_t* YM = (bf16_t*)(p.ws + WS_YM);
    __syncthreads();
    for (int i = tid; i < 32 * 136; i += 512) Hb[i] = 0;
    const float Aj = -__expf(p.in[I_ALOG][l * 16 + j]), Dj = p.in[I_DSK][l * 16 + j];
    const int c16a = wid * 2, c16b = wid * 2 + 1, c4 = wid & 3;
    const int lt = wid >> 1, pt = wid & 1;
    const bf16_t* ub = U + (size_t)b * 2048 * 1536;
    u32x4 rb0, rb1, rc0, rc1, rx = {0u, 0u, 0u, 0u}; float rdt = 0.f;
#define LOADCHUNK(T0) { const bf16_t* r0 = ub + (size_t)((T0) + lane) * 1536 + g * 128; \
        rb0 = *(const u32x4*)(r0 + 1024 + c16a * 8); rb1 = *(const u32x4*)(r0 + 1024 + c16b * 8); rc0 = *(const u32x4*)(r0 + 1280 + c16a * 8); rc1 = *(const u32x4*)(r0 + 1280 + c16b * 8); \
        if (tid < 256) rx = *(const u32x4*)(ub + (size_t)((T0) + lane) * 1536 + j * 64 + ph * 32 + c4 * 8); \
        if (wid == 5) rdt = DT[((size_t)b * 2048 + (T0) + lane) * 16 + j]; }
    LOADCHUNK(0)
    f32x4 hacc[2] = {{0.f, 0.f, 0.f, 0.f}, {0.f, 0.f, 0.f, 0.f}};
    for (int c = 0; c < 32; ++c) {
        const int t0 = c * 64;
        float zq[4];
#pragma unroll
        for (int jj = 0; jj < 4; ++jj) zq[jj] = bf2f(P[((size_t)b * 2048 + t0 + lt * 16 + fq * 4 + jj) * N1 + C_ZM + j * 64 + ph * 32 + pt * 16 + fr]);
        *(u32x4*)(Cm + lane * 136 + c16a * 8) = rc0; *(u32x4*)(Cm + lane * 136 + c16b * 8) = rc1;
        *(u32x4*)(Bm + lane * 136 + c16a * 8) = rb0; *(u32x4*)(Bm + lane * 136 + c16b * 8) = rb1;
#pragma unroll
        for (int e = 0; e < 8; ++e) { const unsigned v0 = rb0[e >> 1], v1 = rb1[e >> 1];
            BmT[(c16a * 8 + e) * 72 + lane] = (bf16_t)((e & 1) ? (v0 >> 16) : (v0 & 0xffffu)); BmT[(c16b * 8 + e) * 72 + lane] = (bf16_t)((e & 1) ? (v1 >> 16) : (v1 & 0xffffu)); }
        if (tid < 256) {
#pragma unroll
            for (int e = 0; e < 8; ++e) { const unsigned v0 = rx[e >> 1]; XT[(c4 * 8 + e) * 72 + lane] = (bf16_t)((e & 1) ? (v0 >> 16) : (v0 & 0xffffu)); }
        }
        if (wid == 5) {
            float v = rdt * Aj;
#pragma unroll
            for (int off = 1; off < 64; off <<= 1) { const float t = __shfl_up(v, off); if (lane >= off) v += t; }
            acs[lane] = v; dtv[lane] = rdt;
        }
        if (c + 1 < 32) LOADCHUNK(t0 + 64)
        LBAR();
        { const int pp = tid & 31, s4 = (tid >> 5) * 4; const float aend = acs[63];
          const u32x2 xv = *(const u32x2*)(XT + pp * 72 + s4);
          const float x0 = __uint_as_float(xv.x << 16), x1 = __uint_as_float(xv.x & 0xffff0000u), x2 = __uint_as_float(xv.y << 16), x3 = __uint_as_float(xv.y & 0xffff0000u);
          u32x2 bq; bq.x = pk2(x0 * dtv[s4] * __expf(aend - acs[s4]), x1 * dtv[s4 + 1] * __expf(aend - acs[s4 + 1]));
          bq.y = pk2(x2 * dtv[s4 + 2] * __expf(aend - acs[s4 + 2]), x3 * dtv[s4 + 3] * __expf(aend - acs[s4 + 3]));
          *(u32x2*)(XwT + pp * 72 + s4) = bq; }
#pragma unroll
        for (int e = 0; e < 2; ++e) {
            const int id = wid * 2 + e, glt = id >> 2, st = id & 3;
            f32x4 acc = {0.f, 0.f, 0.f, 0.f};
            if (st <= glt) {
#pragma unroll
                for (int ks = 0; ks < 4; ++ks) { const bf16x8 fa = *(const bf16x8*)(Cm + (glt * 16 + fr) * 136 + ks * 32 + fq * 8), fb = *(const bf16x8*)(Bm + (st * 16 + fr) * 136 + ks * 32 + fq * 8); acc = MFMA16(fa, fb, acc); }
            }
#pragma unroll
            for (int jj = 0; jj < 4; ++jj) { const int lr = glt * 16 + fq * 4 + jj, s = st * 16 + fr;
                const float val = (s <= lr) ? acc[jj] * __expf(acs[lr] - acs[s]) * dtv[s] : 0.f;
                G[lr * 72 + s] = f2bf(val); }
        }
        f32x4 accO = {0.f, 0.f, 0.f, 0.f};
#pragma unroll
        for (int ks = 0; ks < 4; ++ks) { const bf16x8 fa = *(const bf16x8*)(Cm + (lt * 16 + fr) * 136 + ks * 32 + fq * 8), fb = *(const bf16x8*)(Hb + (pt * 16 + fr) * 136 + ks * 32 + fq * 8); accO = MFMA16(fa, fb, accO); }
        LBAR();
        {
            f32x4 accD = {0.f, 0.f, 0.f, 0.f};
#pragma unroll
            for (int ks = 0; ks < 2; ++ks) { const bf16x8 fa = *(const bf16x8*)(G + (lt * 16 + fr) * 72 + ks * 32 + fq * 8), fb = *(const bf16x8*)(XT + (pt * 16 + fr) * 72 + ks * 32 + fq * 8); accD = MFMA16(fa, fb, accD); }
#pragma unroll
            for (int jj = 0; jj < 4; ++jj) { const int lr = lt * 16 + fq * 4 + jj, pp = pt * 16 + fr;
                float y = accD[jj] + __expf(acs[lr]) * accO[jj] + Dj * bf2f(XT[pp * 72 + lr]);
                y *= siluf_(zq[jj]);
                YM[((size_t)b * 2048 + t0 + lr) * 1024 + j * 64 + ph * 32 + pp] = f2bf(y); }
            const float cd = __expf(acs[63]); const int ptile = wid >> 2;
#pragma unroll
            for (int e = 0; e < 2; ++e) { const int nt = (wid & 3) * 2 + e;
                hacc[e] *= cd;
#pragma unroll
                for (int ks = 0; ks < 2; ++ks) { const bf16x8 fa = *(const bf16x8*)(XwT + (ptile * 16 + fr) * 72 + ks * 32 + fq * 8), fb = *(const bf16x8*)(BmT + (nt * 16 + fr) * 72 + ks * 32 + fq * 8); hacc[e] = MFMA16(fa, fb, hacc[e]); }
#pragma unroll
                for (int jj = 0; jj < 4; ++jj) Hb[(ptile * 16 + fq * 4 + jj) * 136 + nt * 16 + fr] = f2bf(hacc[e][jj]); }
        }
        LBAR();
    }
#undef LOADCHUNK
    { const int ptile = wid >> 2;
#pragma unroll
      for (int e = 0; e < 2; ++e) { const int nt = (wid & 3) * 2 + e;
#pragma unroll
          for (int jj = 0; jj < 4; ++jj) p.out[O_PSSM + ((((size_t)l * 8 + b) * 16 + j) * 64 + ph * 32 + ptile * 16 + fq * 4 + jj) * 128 + nt * 16 + fr] = hacc[e][jj]; } }
    __syncthreads();
}

__device__ void mamba_sample_item(const Params& p, int l, int item, unsigned char* smem_) {
    unsigned char* smem = launder_lds(smem_);
    const int tid = tid_l();
    const int i = item >> 4, j = item & 15, g = j >> 3;
    float* su = (float*)smem;
    float* sd = su + 320;
    const bf16_t* P = (const bf16_t*)(p.ws + WS_P);
    bf16_t* YM = (bf16_t*)(p.ws + WS_YM);
    const size_t rowp = (size_t)TP + i;
    const int pp = tid >> 3, n0 = (tid & 7) * 16;
    const size_t so = ((((size_t)l * TS + i) * 16 + j) * 64 + pp) * 128 + n0;
    float4 hv4[4];
#pragma unroll
    for (int e = 0; e < 4; ++e) hv4[e] = *(const float4*)(p.in[I_SSSM] + so + e * 4);
    __syncthreads();
    if (tid < 320) {
        const int cc = tid < 64 ? j * 64 + tid : (tid < 192 ? 1024 + g * 128 + (tid - 64) : 1280 + g * 128 + (tid - 192));
        const float* c0 = p.in[I_SCONV] + ((size_t)l * TS + i) * 3 * 1536 + cc;
        const float* cw = p.in[I_CW] + (size_t)l * 4 * 1536 + cc;
        const float v = p.in[I_CB][l * 1536 + cc] + c0[0] * cw[0] + c0[1536] * cw[1536] + c0[3072] * cw[3072] + bf2f(P[rowp * N1 + C_XBC + cc]) * cw[4608];
        su[tid] = siluf_(v);
    } else if (tid == 320) {
        const float dt = softplusf_(bf2f(P[rowp * N1 + C_DT + j]) + p.in[I_DTB][l * 16 + j]);
        sd[0] = dt; sd[1] = __expf(-dt * __expf(p.in[I_ALOG][l * 16 + j]));
    }
    __syncthreads();
    {
        float* hout = p.out + O_SSSM + so;
        const float dt = sd[0], eA = sd[1], x = su[pp], xdt = x * dt;
        float y = 0.f;
#pragma unroll
        for (int e = 0; e < 4; ++e) { float4 hv = hv4[e]; const float* Bp = su + 64 + n0 + e * 4; const float* Cp = su + 192 + n0 + e * 4;
            hv.x = eA * hv.x + xdt * Bp[0]; hv.y = eA * hv.y + xdt * Bp[1]; hv.z = eA * hv.z + xdt * Bp[2]; hv.w = eA * hv.w + xdt * Bp[3];
            y += hv.x * Cp[0] + hv.y * Cp[1] + hv.z * Cp[2] + hv.w * Cp[3];
            *(float4*)(hout + e * 4) = hv; }
        y = red8(y);
        if ((tid & 7) == 0) { y += p.in[I_DSK][l * 16 + j] * x; const float z = bf2f(P[rowp * N1 + C_ZM + j * 64 + pp]); YM[rowp * 1024 + j * 64 + pp] = f2bf(y * siluf_(z)); }
    }
}

__device__ void phase_mixa(const Params& p, int l, unsigned char* smem) {
    phase_conv(p, l);
    for (int rep = 0; rep < (DUP == 3 ? 2 : 1); ++rep)
    for (int it = blockIdx.x; it < 2048; it += gridDim.x) rwkv_sample_item(p, l, it, smem);
    for (int rep = 0; rep < (DUP == 4 ? 2 : 1); ++rep)
    for (int it = blockIdx.x; it < 2048; it += gridDim.x) mamba_sample_item(p, l, it, smem);
}
__device__ void phase_mixb(const Params& p, int l, unsigned char* smem) {
    const int G = (int)gridDim.x, nch = G >= 256 ? 128 : G;
    if ((int)blockIdx.x < nch) {
        for (int rep = 0; rep < (DUP == 1 ? 2 : 1); ++rep)
        for (int it = blockIdx.x; it < 128; it += nch) rwkv_chain_item(p, l, it, smem);
    }
    unsigned* ticket = (unsigned*)(p.ws + WS_BAR) + XCD_BAR_WORDS + 64 * l;
    volatile LAS int* slot = (volatile LAS int*)((LAS unsigned char*)smem + LDS_BARST + 8);
    for (;;) {
        __syncthreads();
        if (tid_l() == 0) *slot = (int)__hip_atomic_fetch_add(ticket, 1u, __ATOMIC_RELAXED, __HIP_MEMORY_SCOPE_AGENT);
        __syncthreads();
        const int it = *slot;
        if (it >= 256 * (DUP == 2 ? 2 : 1)) break;
        mamba_item(p, l, it & 255, smem);
    }
}

__device__ void sample_outproj(const Params& p, int l) {
    const int tid = tid_l(), wid = tid >> 6, lane = tid & 63, fr = lane & 15, fq = lane >> 4;
    const bf16_t* A2 = (const bf16_t*)(p.ws + WS_A) + (size_t)TP * 2048;
    const bf16_t* W = (const bf16_t*)(p.ws + WS_WOUTT) + (size_t)l * 1024 * 2048;
    float* PART = (float*)(p.ws + WS_PART);
    for (int it = blockIdx.x; it < 256; it += gridDim.x) {
        const int nt = it & 15, ksl = it >> 4;
        f32x4 acc[4] = {{0.f, 0.f, 0.f, 0.f}, {0.f, 0.f, 0.f, 0.f}, {0.f, 0.f, 0.f, 0.f}, {0.f, 0.f, 0.f, 0.f}};
#pragma unroll
        for (int kq = 0; kq < 4; ++kq) {
            const bf16x8 fa = *(const bf16x8*)(A2 + (size_t)(wid * 16 + fr) * 2048 + ksl * 128 + kq * 32 + fq * 8);
#pragma unroll
            for (int ct = 0; ct < 4; ++ct) { const bf16x8 fb = *(const bf16x8*)(W + (size_t)(nt * 64 + ct * 16 + fr) * 2048 + ksl * 128 + kq * 32 + fq * 8); acc[ct] = MFMA16(fa, fb, acc[ct]); }
        }
#pragma unroll
        for (int ct = 0; ct < 4; ++ct)
#pragma unroll
            for (int jj = 0; jj < 4; ++jj) PART[((size_t)ksl * TS + wid * 16 + fq * 4 + jj) * 1024 + nt * 64 + ct * 16 + fr] = acc[ct][jj];
    }
}

__device__ void phase_post(const Params& p, int l) {
    const int tid_ = tid_l(); const int lane = tid_ & 63, wid = tid_ >> 6;
    const bf16_t* P = (const bf16_t*)(p.ws + WS_P);
    const float* ORAW = (const float*)(p.ws + WS_ORAW);
    const bf16_t* BV = (const bf16_t*)(p.ws + WS_BV);
    const bf16_t* YM = (const bf16_t*)(p.ws + WS_YM);
    bf16_t* A2 = (bf16_t*)(p.ws + WS_A);
    const int c0 = lane * 16;
    float lnw[16], lnb[16], gnw[16];
#pragma unroll
    for (int e = 0; e < 16; ++e) { lnw[e] = p.in[I_LNW][l * 1024 + c0 + e]; lnb[e] = p.in[I_LNB][l * 1024 + c0 + e]; gnw[e] = p.in[I_GNW][l * 1024 + c0 + e]; }
    for (int row = blockIdx.x * 8 + wid; row < TALL; row += gridDim.x * 8) {
        const bf16_t* prow = P + (size_t)row * N1;
        float o[16], bv[16], z[16], ym[16];
#pragma unroll
        for (int i = 0; i < 4; ++i) { const float4 t = *(const float4*)(ORAW + (size_t)row * 1024 + c0 + i * 4); o[i * 4] = t.x; o[i * 4 + 1] = t.y; o[i * 4 + 2] = t.z; o[i * 4 + 3] = t.w; }
        unpack8(*(const u32x4*)(BV + (size_t)row * 1024 + c0), bv); unpack8(*(const u32x4*)(BV + (size_t)row * 1024 + c0 + 8), bv + 8);
        unpack8(*(const u32x4*)(prow + C_ZR + c0), z); unpack8(*(const u32x4*)(prow + C_ZR + c0 + 8), z + 8);
        unpack8(*(const u32x4*)(YM + (size_t)row * 1024 + c0), ym); unpack8(*(const u32x4*)(YM + (size_t)row * 1024 + c0 + 8), ym + 8);
        float s = 0.f;
#pragma unroll
        for (int e = 0; e < 16; ++e) s += o[e];
        s += dppf<0xB1>(s); s += dppf<0x4E>(s);
        const float mean = s * (1.0f / 64.0f);
        float v = 0.f;
#pragma unroll
        for (int e = 0; e < 16; ++e) { o[e] -= mean; v += o[e] * o[e]; }
        v += dppf<0xB1>(v); v += dppf<0x4E>(v);
        const float rstd = rsqrtf(v * (1.0f / 64.0f) + 64e-5f);
#pragma unroll
        for (int e = 0; e < 16; ++e) o[e] = (o[e] * rstd * lnw[e] + lnb[e] + bv[e]) * siluf_(z[e]);
        *(u32x4*)(A2 + (size_t)row * 2048 + c0) = pack8(o); *(u32x4*)(A2 + (size_t)row * 2048 + c0 + 8) = pack8(o + 8);
        float ss = 0.f;
#pragma unroll
        for (int e = 0; e < 16; ++e) ss += ym[e] * ym[e];
        ss = red16(ss); ss += __shfl_xor(ss, 16);
        const float rs = rsqrtf(ss * (1.0f / 512.0f) + 1e-5f);
#pragma unroll
        for (int e = 0; e < 16; ++e) ym[e] *= rs * gnw[e];
        *(u32x4*)(A2 + (size_t)row * 2048 + 1024 + c0) = pack8(ym); *(u32x4*)(A2 + (size_t)row * 2048 + 1024 + c0 + 8) = pack8(ym + 8);
        if (row < TP) {
            const int tq = row & 2047;
            if (tq >= 2045) { float* dst = p.out + O_PCONV + (((size_t)l * 8 + (row >> 11)) * 3 + (tq - 2045)) * 1536;
                for (int c = lane; c < 1536; c += 64) dst[c] = bf2f(prow[C_XBC + c]); }
        } else {
            const int i = row - TP; float* dst = p.out + O_SCONV + ((size_t)l * TS + i) * 3 * 1536; const float* src = p.in[I_SCONV] + ((size_t)l * TS + i) * 3 * 1536;
            for (int c = lane; c < 1536; c += 64) { dst[c] = src[1536 + c]; dst[1536 + c] = src[3072 + c]; dst[3072 + c] = bf2f(prow[C_XBC + c]); }
        }
    }
}

constexpr int NPHASE = 13;
__global__ __launch_bounds__(512, 2) void mega(Params p) {
    extern __shared__ __attribute__((aligned(16))) unsigned char smem[];
    cg::grid_group grid = cg::this_grid();
    volatile LAS unsigned* st = (volatile LAS unsigned*)((LAS unsigned char*)smem + LDS_BARST);
    { const unsigned hw = (unsigned)__builtin_amdgcn_s_getreg((5 << 11) | 4) & 63u;
      if ((threadIdx.x & 63) == 0) *(volatile LAS int*)((LAS unsigned char*)smem + LDS_WIDTAB + hw * 4u) = (int)(threadIdx.x >> 6);
      if (threadIdx.x == 0) { st[0] = 0u; st[1] = 0u; } }
    __syncthreads();
    const XcdBarrier xbar = xcd_barrier_post((unsigned*)(p.ws + WS_BAR), st);
    if (p.ph_hi > 1000) grid.sync();
#define PHASE(K, BODY) if (p.ph_lo <= (K) && (K) < p.ph_hi) { if ((K) > p.ph_lo) { xcd_barrier(xbar); if (DUP == 13) { xcd_barrier(xbar); xcd_barrier(xbar); } } BODY }
#define GEMM1(L) { pg8::Gemm g{(const bf16_t*)(p.ws + WS_A), (const bf16_t*)(p.ws + WS_WINT) + (size_t)(L) * N1 * 1024, M1, N1, 1024}; \
        pg8::StaticOrder S; S.init(M1, N1, (int)gridDim.x, (int)blockIdx.x); EpiP E{(bf16_t*)(p.ws + WS_P), N1}; \
        pg8::gemm_phase<EpiP, pg8::StaticOrder, false>((PG8_LAS unsigned char*)smem, g, S, E, nullptr); }
#define GEMM2(L) { sample_outproj(p, (L)); \
        pg8::Gemm g{(const bf16_t*)(p.ws + WS_A), (const bf16_t*)(p.ws + WS_WOUTT) + (size_t)(L) * 1024 * 2048, TP, 1024, 2048}; \
        pg8::StaticOrder S; S.init(TP, 1024, (int)gridDim.x, (int)blockIdx.x); EpiRes E{(L) == 0 ? p.in[I_XP] : p.out + O_YP, p.out + O_YP}; \
        pg8::gemm_phase<EpiRes, pg8::StaticOrder, false>((PG8_LAS unsigned char*)smem, g, S, E, nullptr); }
    PHASE(0, phase_convert(p, smem); phase_norm(p, 0);)
    PHASE(1, GEMM1(0))
    PHASE(2, phase_mixa(p, 0, smem);)
    PHASE(3, phase_mixb(p, 0, smem);)
    PHASE(4, phase_post(p, 0);)
    PHASE(5, GEMM2(0))
    PHASE(6, phase_norm(p, 1);)
    PHASE(7, GEMM1(1))
    PHASE(8, phase_mixa(p, 1, smem);)
    PHASE(9, phase_mixb(p, 1, smem);)
    PHASE(10, phase_post(p, 1);)
    PHASE(11, GEMM2(1))
    PHASE(12, phase_final(p);)
}

extern "C" void kernel_launch(void* const* d_in, const int* in_sizes, int n_in, void* d_out, int out_size, void* d_ws, size_t ws_size, hipStream_t stream) {
    static int grid = 0;
    if (grid == 0) {
        if (n_in != 26 || (size_t)out_size != O_END || ws_size < WS_BAR + (size_t)(XCD_BAR_WORDS + 128) * 4) { fprintf(stderr, "kernel_launch: unexpected shapes: n_in %d out %d ws %zu (need %zu)\n", n_in, out_size, ws_size, (size_t)(WS_BAR + XCD_BAR_WORDS * 4)); grid = -1; return; }
        int dev = 0, cus = 0, per_cu = 0;
        hipGetDevice(&dev); hipDeviceGetAttribute(&cus, hipDeviceAttributeMultiprocessorCount, dev);
        if (hipFuncSetAttribute((const void*)mega, hipFuncAttributeMaxDynamicSharedMemorySize, LDS_BYTES) != hipSuccess) { fprintf(stderr, "kernel_launch: hipFuncSetAttribute failed\n"); grid = -1; return; }
        if (hipOccupancyMaxActiveBlocksPerMultiprocessor(&per_cu, (const void*)mega, 512, LDS_BYTES) != hipSuccess || per_cu < 1) { fprintf(stderr, "kernel_launch: occupancy query gave %d\n", per_cu); per_cu = 1; }
        (void)hipGetLastError();
        grid = cus * 1;
    }
    if (grid < 0) return;
    if (hipMemsetAsync((char*)d_ws + WS_BAR, 0, (size_t)(XCD_BAR_WORDS + 128) * 4, stream) != hipSuccess) { fprintf(stderr, "kernel_launch: memset of barrier words failed\n"); return; }
    Params p{};
    for (int i = 0; i < 26; ++i) p.in[i] = (const float*)d_in[i];
    p.out = (float*)d_out; p.ws = (unsigned char*)d_ws;
#if MK_PER_PHASE
    for (int ph = 0; ph < NPHASE; ++ph) { p.ph_lo = ph; p.ph_hi = ph + 1; hipLaunchKernelGGL(mega, dim3(grid), dim3(512), LDS_BYTES, stream, p); }
#else
    p.ph_lo = 0; p.ph_hi = NPHASE;
    void* args[] = {&p};
    hipError_t e = hipLaunchCooperativeKernel((const void*)mega, dim3(grid), dim3(512), args, LDS_BYTES, stream);
    if (e != hipSuccess) fprintf(stderr, "cooperative launch failed: %s (grid %d)\n", hipGetErrorString(e), grid);
#endif
}
```

```cpp
#include <hip/hip_runtime.h>
#include <hip/hip_cooperative_groups.h>
#include <cstdio>
namespace cg = cooperative_groups;

#define LDS_WIDTAB 146944
__device__ __forceinline__ int tid_l() {
    const unsigned hw = (unsigned)__builtin_amdgcn_s_getreg((5 << 11) | 4) & 63u;
    const int wid = *(volatile __attribute__((address_space(3))) int*)(unsigned long)(LDS_WIDTAB + hw * 4u);
    int ln; asm volatile("v_mbcnt_lo_u32_b32 %0, -1, 0\n\tv_mbcnt_hi_u32_b32 %0, -1, %0" : "=v"(ln));
    return __builtin_amdgcn_readfirstlane(wid) * 64 + ln; }
namespace pg8 {
#define PG8_LAS __attribute__((address_space(3)))
typedef unsigned short bf16_t;
typedef short bf16x8 __attribute__((ext_vector_type(8)));
typedef float f32x4 __attribute__((ext_vector_type(4)));
typedef unsigned u32x4 __attribute__((ext_vector_type(4)));
constexpr int BM = 256, BK = 64, HALF = 128, HTB = HALF * BK * 2  , STAGE_BYTES = 8 * HTB, NXCD = 8, WGM = 8;

__host__ __device__ __forceinline__ int lds_byte(int r, int c) { const int st = (r >> 4) * 2 + (c >> 5), rr = r & 15, cc = c & 31, ob = rr * 64 + cc * 2; return st * 1024 + (ob ^ (((ob >> 9) & 1) << 5)); }
__host__ __device__ __forceinline__ void stage_rc(int b, int& R, int& C) { const int st = b / 1024, sb = b % 1024, swz = sb ^ (((sb >> 9) & 1) << 5); R = (st >> 1) * 16 + swz / 64; C = (st & 1) * 32 + (swz % 64) / 2; }
__host__ __device__ __forceinline__ int perm32(int rho) { const int n = rho >> 4, i = rho & 15; return 8 * (i >> 2) + 4 * n + (i & 3); }

struct Unit { int pm, pn; };
struct Gemm { const bf16_t* A; const bf16_t* Bt; int M, N, K; };

struct StaticOrder {
    int nM, nN, nwg, G, c;
    __host__ __device__ void init(int M, int N, int G_, int c_) { nM = M / BM; nN = N / BM; nwg = nM * nN; G = G_; c = c_; }
    __host__ __device__ bool next(int i, Unit& u) const {
        const long L = (long)i * G + c; if (L >= nwg) return false;
        int wgid = (int)L; { const int q = nwg / NXCD, r = nwg % NXCD, xcd = wgid % NXCD, off = wgid / NXCD; wgid = (xcd < r ? xcd * (q + 1) : r * (q + 1) + (xcd - r) * q) + off; }
        const int nig = WGM * nN, gid = wgid / nig, fm = gid * WGM, gsz = (nM - fm) < WGM ? (nM - fm) : WGM;
        u.pm = fm + ((wgid % nig) % gsz); u.pn = (wgid % nig) / gsz; return true;
    }
    __device__ __forceinline__ void a_ready(const Unit&) const {}
    __device__ __forceinline__ void done(const Unit&) const {}
};
__device__ __forceinline__ unsigned cvt_pk_bf16(float lo, float hi) { unsigned r; asm volatile("v_cvt_pk_bf16_f32 %0, %1, %2" : "=v"(r) : "v"(lo), "v"(hi)); return r; }
template <class Epi, class Sched, bool STAMP = false>
__device__ __forceinline__ void gemm_phase(PG8_LAS unsigned char* lds, const Gemm g, const Sched& S, const Epi& E, unsigned long long* stamps) {
    const int tid = tid_l(), wid = __builtin_amdgcn_readfirstlane(tid >> 6), lane = tid & 63, wr = wid >> 2, wc = wid & 3, fr = lane & 15, fq = lane >> 4;
    const int K = g.K, nt = K / BK;
    int ts_lo = 0, ts_hi = 0, nts = 0; const unsigned long long rt_entry = STAMP ? (unsigned long long)wall_clock64() : 0ull;
#define PG8_STAMP() do { if (STAMP && wid == 0 && nts < 64) { const unsigned long long _c = (unsigned long long)clock64(); \
        ts_lo = (lane == nts) ? (int)(unsigned)_c : ts_lo; ts_hi = (lane == nts) ? (int)(unsigned)(_c >> 32) : ts_hi; ++nts; } } while (0)
    PG8_STAMP();
    unsigned voffA[2], voffB[2];
#pragma unroll
    for (int i = 0; i < 2; ++i) { int R, C; stage_rc(tid * 16 + i * 8192, R, C); const int Rb = Epi::PERM ? ((R & ~31) + perm32(R & 31)) : R;
        voffA[i] = (unsigned)(R * K + C) * 2u; voffB[i] = (unsigned)(Rb * K + C) * 2u; }
    const size_t kstep = (size_t)(BK * 2);
    const size_t hstep = (size_t)HALF * K * 2;
    const size_t tstep = 2 * hstep;
    const unsigned ldsw = (unsigned)wid * 1024u;
    const int aoff = lds_byte(wr * 64 + fr, fq * 8), boff = lds_byte(wc * 32 + fr, fq * 8);
#define PG8_SA(b, h) (((b) * 2 + (h)) * HTB)
#define PG8_SB(b, h) ((4 + (b) * 2 + (h)) * HTB)
#define PG8_STAGE(bufoff, gbase, voff) do { _Pragma("unroll") for (int _i = 0; _i < 2; ++_i) \
        __builtin_amdgcn_global_load_lds((const unsigned*)((const char*)(gbase) + (voff)[_i]), (PG8_LAS unsigned*)(lds + (bufoff) + ldsw + _i * 8192), 16, 0, 0); } while (0)
#define PG8_LDA(dst, b, h) do { _Pragma("unroll") for (int m = 0; m < 4; ++m) _Pragma("unroll") for (int k = 0; k < 2; ++k) dst[m][k] = *(const PG8_LAS bf16x8*)(lds + PG8_SA(b, h) + aoff + m * 2048 + k * 1024); } while (0)
#define PG8_LDB(dst, b, h) do { _Pragma("unroll") for (int n = 0; n < 2; ++n) _Pragma("unroll") for (int k = 0; k < 2; ++k) dst[n][k] = *(const PG8_LAS bf16x8*)(lds + PG8_SB(b, h) + boff + n * 2048 + k * 1024); } while (0)
#define PG8_MMA(ai, bj, At, Bt) do { __builtin_amdgcn_s_setprio(1); _Pragma("unroll") for (int m = 0; m < 4; ++m) _Pragma("unroll") for (int n = 0; n < 2; ++n) _Pragma("unroll") for (int k = 0; k < 2; ++k) \
        acc[ai][bj][m][n] = __builtin_amdgcn_mfma_f32_16x16x32_bf16(Bt[n][k], At[m][k], acc[ai][bj][m][n], 0, 0, 0); __builtin_amdgcn_s_setprio(0); } while (0)
#define PG8_WAIT_V(n) asm volatile("s_waitcnt vmcnt(" #n ")" ::: "memory")
#define PG8_WAIT_L(n) asm volatile("s_waitcnt lgkmcnt(" #n ")" ::: "memory")
#define PG8_BAR __builtin_amdgcn_s_barrier()
#define PG8_SCHED __builtin_amdgcn_sched_barrier(0)
    Unit cur, nxt; int ui = 0;
    if (!S.next(0, cur)) return;
    f32x4 acc[2][2][4][2];
#pragma unroll
    for (int a = 0; a < 2; ++a)
#pragma unroll
        for (int b = 0; b < 2; ++b)
#pragma unroll
            for (int m = 0; m < 4; ++m)
#pragma unroll
                for (int n = 0; n < 2; ++n) acc[a][b][m][n] = (f32x4){0.f, 0.f, 0.f, 0.f};
    bf16x8 At[4][2], B0[2][2], B1[2][2];
    const char* cA = (const char*)g.A + (size_t)cur.pm * tstep; const char* cB = (const char*)g.Bt + (size_t)cur.pn * tstep;
    S.a_ready(cur);
    PG8_STAGE(PG8_SB(0, 0), cB, voffB); PG8_STAGE(PG8_SA(0, 0), cA, voffA); PG8_STAGE(PG8_SB(0, 1), cB + hstep, voffB); PG8_STAGE(PG8_SA(0, 1), cA + hstep, voffA);
    if (wr == 1) PG8_BAR;
    PG8_WAIT_V(4); PG8_BAR;
    PG8_STAGE(PG8_SB(1, 0), cB + kstep, voffB); PG8_STAGE(PG8_SA(1, 0), cA + kstep, voffA); PG8_STAGE(PG8_SB(1, 1), cB + hstep + kstep, voffB);
    PG8_WAIT_V(6); PG8_BAR;
    PG8_STAMP();
    for (;;) {
        const bool has_next = S.next(ui + 1, nxt);
        const char* nA = has_next ? (const char*)g.A + (size_t)nxt.pm * tstep : cA; const char* nB = has_next ? (const char*)g.Bt + (size_t)nxt.pn * tstep : cB;
        for (int t = 0; t < nt; t += 2) {
            const bool last = (t == nt - 2);
            const char* a1 = cA + (size_t)(t + 1) * kstep;
            const char* a2 = last ? nA : cA + (size_t)(t + 2) * kstep; const char* b2 = last ? nB : cB + (size_t)(t + 2) * kstep;
            const char* a3 = a2 + kstep; const char* b3 = b2 + kstep;
            if (last && has_next) S.a_ready(nxt);
            PG8_LDB(B0, 0, 0); PG8_SCHED; PG8_LDA(At, 0, 0); PG8_STAGE(PG8_SA(1, 1), a1 + hstep, voffA);
            PG8_WAIT_L(8); PG8_BAR; PG8_WAIT_L(0); PG8_MMA(0, 0, At, B0); PG8_BAR; PG8_SCHED;
            PG8_LDB(B1, 0, 1); PG8_STAGE(PG8_SB(0, 0), b2, voffB);
            PG8_BAR; PG8_WAIT_L(0); PG8_MMA(0, 1, At, B1); PG8_BAR;
            PG8_LDA(At, 0, 1); PG8_STAGE(PG8_SA(0, 0), a2, voffA);
            PG8_BAR; PG8_WAIT_L(0); PG8_MMA(1, 0, At, B0); PG8_BAR; PG8_SCHED;
            PG8_STAGE(PG8_SB(0, 1), b2 + hstep, voffB);
            PG8_WAIT_V(6); PG8_BAR; PG8_MMA(1, 1, At, B1); PG8_BAR;
            PG8_LDB(B0, 1, 0); PG8_SCHED; PG8_LDA(At, 1, 0); PG8_STAGE(PG8_SA(0, 1), a2 + hstep, voffA);
            PG8_WAIT_L(8); PG8_BAR; PG8_WAIT_L(0); PG8_MMA(0, 0, At, B0); PG8_BAR; PG8_SCHED;
            PG8_LDB(B1, 1, 1); PG8_STAGE(PG8_SB(1, 0), b3, voffB);
            PG8_BAR; PG8_WAIT_L(0); PG8_MMA(0, 1, At, B1); PG8_BAR;
            PG8_LDA(At, 1, 1); PG8_STAGE(PG8_SA(1, 0), a3, voffA);
            PG8_BAR; PG8_WAIT_L(0); PG8_MMA(1, 0, At, B0); PG8_BAR; PG8_SCHED;
            PG8_STAGE(PG8_SB(1, 1), b3 + hstep, voffB);
            PG8_WAIT_V(6); PG8_BAR; PG8_MMA(1, 1, At, B1); PG8_BAR;
        }
        PG8_STAMP();
        if constexpr (!Epi::AFTER_DRAIN) { E(acc, cur, wr, wc, fr, fq); S.done(cur); }
        PG8_STAMP();
        if (!has_next) break;
#pragma unroll
        for (int a = 0; a < 2; ++a)
#pragma unroll
            for (int b = 0; b < 2; ++b)
#pragma unroll
                for (int m = 0; m < 4; ++m)
#pragma unroll
                    for (int n = 0; n < 2; ++n) acc[a][b][m][n] = (f32x4){0.f, 0.f, 0.f, 0.f};
        cur = nxt; cA = nA; cB = nB; ++ui;
    }
    PG8_WAIT_V(0);
    if (wr == 0) PG8_BAR;
    PG8_BAR;
    if constexpr (Epi::AFTER_DRAIN) { E.fused(acc, cur, wr, wc, fr, fq, lds, wid, lane); S.done(cur); }
    PG8_STAMP();
    if (STAMP && wid == 0) { stamps[lane] = lane < nts ? (((unsigned long long)(unsigned)ts_hi << 32) | (unsigned)ts_lo) : 0ull;
        if (lane == 62) stamps[62] = rt_entry; if (lane == 63) stamps[63] = (unsigned long long)wall_clock64(); }
#undef PG8_STAMP
#undef PG8_SA
#undef PG8_SB
#undef PG8_STAGE
#undef PG8_LDA
#undef PG8_LDB
#undef PG8_MMA
#undef PG8_WAIT_V
#undef PG8_WAIT_L
#undef PG8_BAR
#undef PG8_SCHED
}
}

#define XB_TMO      128
#define XB_XCNT(j)  (256  + 64 * (j))
#define XB_XSUB(j)  (1280 + 64 * (j))
#define XB_XGEN(j)  (2304 + 64 * (j))
#define XB_TOP      3328
#define XB_TOPGEN   3392
#define XCD_BAR_WORDS 3456
#define XB_SPIN_CAP (1u << 18)
#define LAS __attribute__((address_space(3)))

__device__ __forceinline__ unsigned xb_ld(unsigned* p)              { return __hip_atomic_load(p, __ATOMIC_RELAXED, __HIP_MEMORY_SCOPE_AGENT); }
__device__ __forceinline__ unsigned xb_add(unsigned* p, unsigned v) { return __hip_atomic_fetch_add(p, v, __ATOMIC_RELAXED, __HIP_MEMORY_SCOPE_AGENT); }
__device__ __forceinline__ unsigned xb_xcc_id() { return (unsigned)__builtin_amdgcn_s_getreg((3 << 11) | 20) & 0xFu; }
#define XB_SPIN(cond, bar) do { unsigned _sp = 0; while (cond) { __builtin_amdgcn_s_sleep(1); \
    if ((++_sp & 255u) == 0u) { if (xb_ld(&(bar)[XB_TMO])) break; if (_sp > XB_SPIN_CAP) { atomicAdd(&(bar)[XB_TMO], 1u); break; } } } } while (0)
struct XcdBarrier {
    unsigned* bar; unsigned x;
    volatile LAS unsigned* st;
};

__device__ __forceinline__ XcdBarrier xcd_barrier_post(unsigned* bar, volatile LAS unsigned* st) {
    XcdBarrier b; b.bar = bar; b.x = xb_xcc_id(); b.st = st;
    if (tid_l() == 0) (void)xb_add(&bar[XB_XCNT(b.x)], 1u);
    return b;
}
__device__ __forceinline__ void xcd_barrier_complete(unsigned* bar, unsigned x, unsigned& nloc, unsigned& nx) {
    const unsigned G = gridDim.x * gridDim.y * gridDim.z;
    unsigned sum, cnt, mine, sp = 0u;
    for (;;) {
        sum = 0u; cnt = 0u; mine = 0u;
#pragma unroll
        for (unsigned j = 0; j < 16; ++j) { const unsigned c = xb_ld(&bar[XB_XCNT(j)]); sum += c; cnt += (c > 0u) ? 1u : 0u; mine = (j == x) ? c : mine; }
        if (sum == G) break;
        __builtin_amdgcn_s_sleep(1);
        if ((++sp & 255u) == 0u) { if (xb_ld(&bar[XB_TMO])) break; if (sp > XB_SPIN_CAP) { atomicAdd(&bar[XB_TMO], 1u); break; } }
    }
    nloc = mine > 0u ? mine : 1u; nx = cnt > 0u ? cnt : 1u;
}

__device__ __forceinline__ void xcd_barrier(const XcdBarrier& b) {
    asm volatile("s_waitcnt vmcnt(0)" ::: "memory");
    __syncthreads();
    if (tid_l() == 0) {
        unsigned* bar = b.bar;
        __builtin_amdgcn_s_waitcnt(0);
        unsigned nloc = b.st[0], nx = b.st[1];
        if (nloc == 0u) { xcd_barrier_complete(bar, b.x, nloc, nx); b.st[0] = nloc; b.st[1] = nx; }
        const unsigned old = xb_add(&bar[XB_XSUB(b.x)], 1u);
        const unsigned gen = old / nloc;
        if (old + 1u == (gen + 1u) * nloc) {
            __builtin_amdgcn_fence(__ATOMIC_RELEASE, "agent");
            asm volatile("s_waitcnt vmcnt(0)" ::: "memory");
            const unsigned og = xb_add(&bar[XB_TOP], 1u);
            const unsigned tg = og / nx;
            if (og + 1u == (tg + 1u) * nx) xb_add(&bar[XB_TOPGEN], 1u);
            else XB_SPIN(xb_ld(&bar[XB_TOPGEN]) == tg, bar);
            __builtin_amdgcn_fence(__ATOMIC_ACQUIRE, "agent");
            xb_add(&bar[XB_XGEN(b.x)], 1u);
            asm volatile("s_waitcnt vmcnt(0)" ::: "memory");
        } else {
            XB_SPIN(xb_ld(&bar[XB_XGEN(b.x)]) == gen, bar);
            __builtin_amdgcn_fence(__ATOMIC_ACQUIRE, "agent");
            asm volatile("s_waitcnt vmcnt(0)" ::: "memory");
        }
    }
    __syncthreads();
}

typedef unsigned short bf16_t;
typedef short bf16x8 __attribute__((ext_vector_type(8)));
typedef float f32x4 __attribute__((ext_vector_type(4)));
typedef unsigned u32x4 __attribute__((ext_vector_type(4)));
typedef unsigned u32x2 __attribute__((ext_vector_type(2)));

#ifndef DUP
#define DUP 0
#endif
#ifndef MK_PER_PHASE
#define MK_PER_PHASE 0
#endif

constexpr int TP = 16384, TS = 128, TALL = 16512, M1 = 16640, N1 = 6912, NIN = 6800;
constexpr int C_R = 0, C_K = 1024, C_V = 2048, C_WL = 3072, C_AL = 3136, C_ZR = 3200, C_ZM = 4224, C_XBC = 5248, C_DT = 6784;
constexpr size_t O_YP = 0, O_YS = 16777216, O_PSH = 16908288, O_PWKV = 16924672, O_PCONV = 17973248, O_PSSM = 18046976,
                 O_SSH = 20144128, O_SWKV = 20406272, O_SCONV = 37183488, O_SSSM = 38363136, O_END = 71917568;
constexpr size_t WS_WINT = 0;
constexpr size_t WS_WOUTT = WS_WINT + (size_t)2 * N1 * 1024 * 2;
constexpr size_t WS_A = WS_WOUTT + (size_t)2 * 1024 * 2048 * 2;
constexpr size_t WS_P = WS_A + (size_t)M1 * 2048 * 2;
constexpr size_t WS_ORAW = WS_P + (size_t)M1 * N1 * 2;
constexpr size_t WS_BV = WS_ORAW + (size_t)TALL * 1024 * 4;
constexpr size_t WS_YM = WS_BV + (size_t)TALL * 1024 * 2;
constexpr size_t WS_END = WS_YM + (size_t)TALL * 1024 * 2;
constexpr size_t WS_U = WS_A;
constexpr size_t WS_DT = WS_U + (size_t)TP * 1536 * 2;
constexpr size_t WS_PART = WS_ORAW;
constexpr size_t WS_BAR = (WS_END + 4095) & ~(size_t)4095;
constexpr int LDS_BYTES = 147456, LDS_BARST = 147440;

struct Params { const float* in[26]; float* out; unsigned char* ws; int ph_lo, ph_hi; };
enum { I_XP = 0, I_XS, I_SSHIFT, I_SWKV, I_SCONV, I_SSSM, I_NORMW, I_WIN, I_MU, I_W0, I_W2, I_A0, I_A2, I_KK, I_KA, I_RK, I_LNW, I_LNB, I_CW, I_CB, I_DTB, I_ALOG, I_DSK, I_GNW, I_WOUT, I_FNW };

__device__ __forceinline__ float bf2f(unsigned short b) { return __uint_as_float(((unsigned)b) << 16); }
__device__ __forceinline__ unsigned short f2bf(float f) { unsigned u = __float_as_uint(f); u += 0x7FFFu + ((u >> 16) & 1u); return (unsigned short)(u >> 16); }
__device__ __forceinline__ unsigned pk2(float lo, float hi) { return (unsigned)f2bf(lo) | ((unsigned)f2bf(hi) << 16); }
__device__ __forceinline__ void unpack8(const u32x4 v, float* f) {
    f[0] = __uint_as_float(v.x << 16); f[1] = __uint_as_float(v.x & 0xffff0000u); f[2] = __uint_as_float(v.y << 16); f[3] = __uint_as_float(v.y & 0xffff0000u);
    f[4] = __uint_as_float(v.z << 16); f[5] = __uint_as_float(v.z & 0xffff0000u); f[6] = __uint_as_float(v.w << 16); f[7] = __uint_as_float(v.w & 0xffff0000u); }
__device__ __forceinline__ u32x4 pack8(const float* f) { u32x4 r; r.x = pk2(f[0], f[1]); r.y = pk2(f[2], f[3]); r.z = pk2(f[4], f[5]); r.w = pk2(f[6], f[7]); return r; }
__device__ __forceinline__ float frcp(float x) { return __builtin_amdgcn_rcpf(x); }
__device__ __forceinline__ float sigmoidf_(float x) { return frcp(1.0f + __expf(-x)); }
__device__ __forceinline__ float siluf_(float x) { return x * frcp(1.0f + __expf(-x)); }
__device__ __forceinline__ float softplusf_(float x) { return x > 20.f ? x : log1pf(__expf(x)); }
template <int CTRL> __device__ __forceinline__ float dppf(float v) { return __int_as_float(__builtin_amdgcn_mov_dpp(__float_as_int(v), CTRL, 0xF, 0xF, true)); }
__device__ __forceinline__ float red8(float x) { x += dppf<0xB1>(x); x += dppf<0x4E>(x); x += dppf<0x141>(x); return x; }
__device__ __forceinline__ float red16(float x) { x = red8(x); x += dppf<0x140>(x); return x; }
__device__ __forceinline__ float wave_sum(float x) {
#pragma unroll
    for (int o = 32; o > 0; o >>= 1) x += __shfl_xor(x, o);
    return x; }
__device__ __forceinline__ void lds_fence() { asm volatile("s_waitcnt lgkmcnt(0)" ::: "memory"); }
__device__ __forceinline__ unsigned char* launder_lds(unsigned char* sm) { int off = 0; asm volatile("" : "+s"(off)); return sm + off; }
#define LBAR() do { asm volatile("s_waitcnt lgkmcnt(0)" ::: "memory"); __builtin_amdgcn_s_barrier(); asm volatile("" ::: "memory"); } while (0)
#define MFMA16(a, b, c) __builtin_amdgcn_mfma_f32_16x16x32_bf16((a), (b), (c), 0, 0, 0)

__device__ void phase_convert(const Params& p, unsigned char* smem_) {
    unsigned char* smem = launder_lds(smem_);
    float* tile = (float*)smem;
    const int tid = tid_l();
    constexpr int NT_IN = 16 * 108, NT_OUT = 32 * 16, PER_L = NT_IN + NT_OUT;
    for (int it = blockIdx.x; it < 2 * PER_L; it += gridDim.x) {
        const int l = it / PER_L; int r = it % PER_L;
        const float* src; bf16_t* dst; int K, Nsrc, kt, nt;
        if (r < NT_IN) { src = p.in[I_WIN] + (size_t)l * 1024 * NIN; dst = (bf16_t*)(p.ws + WS_WINT) + (size_t)l * N1 * 1024; K = 1024; Nsrc = NIN; kt = r & 15; nt = r >> 4; }
        else { r -= NT_IN; src = p.in[I_WOUT] + (size_t)l * 2048 * 1024; dst = (bf16_t*)(p.ws + WS_WOUTT) + (size_t)l * 1024 * 2048; K = 2048; Nsrc = 1024; kt = r & 31; nt = r >> 5; }
#pragma unroll
        for (int i = 0; i < 2; ++i) {
            const int rr = (tid >> 4) + 32 * i, c4 = (tid & 15) * 4, col = nt * 64 + c4;
            float4 v = make_float4(0.f, 0.f, 0.f, 0.f);
            if (col < Nsrc) v = *(const float4*)(src + (size_t)(kt * 64 + rr) * Nsrc + col);
            float* tp = tile + rr * 65 + c4; tp[0] = v.x; tp[1] = v.y; tp[2] = v.z; tp[3] = v.w;
        }
        __syncthreads();
        { const int n = tid >> 3, k8 = (tid & 7) * 8; float f[8];
#pragma unroll
          for (int j = 0; j < 8; ++j) f[j] = tile[(k8 + j) * 65 + n];
          *(u32x4*)(dst + (size_t)(nt * 64 + n) * K + kt * 64 + k8) = pack8(f); }
        __syncthreads();
    }
}

__device__ void phase_norm(const Params& p, int l) {
    const int tid_ = tid_l(); const int lane = tid_ & 63, wid = tid_ >> 6;
    bf16_t* A1 = (bf16_t*)(p.ws + WS_A);
    const float* nw = p.in[I_NORMW] + l * 1024;
    for (int row = blockIdx.x * 8 + wid; row < M1; row += gridDim.x * 8) {
        const float* src;
        if (row < TP) src = (l == 0 ? p.in[I_XP] : p.out + O_YP) + (size_t)row * 1024;
        else if (row < TALL) src = (l == 0 ? p.in[I_XS] : p.out + O_YS) + (size_t)(row - TP) * 1024;
        else src = p.in[I_SSHIFT] + ((size_t)l * TS + (row - TALL)) * 1024;
        float4 v[4]; float ss = 0.f;
#pragma unroll
        for (int i = 0; i < 4; ++i) v[i] = *(const float4*)(src + i * 256 + lane * 4);
        if (l == 1 && row >= TP && row < TALL) {
            const float* x0 = p.in[I_XS] + (size_t)(row - TP) * 1024; const float* pt = (const float*)(p.ws + WS_PART) + (size_t)(row - TP) * 1024;
#pragma unroll
            for (int i = 0; i < 4; ++i) { float4 a = *(const float4*)(x0 + i * 256 + lane * 4);
                for (int q = 0; q < 16; ++q) { const float4 t = *(const float4*)(pt + (size_t)q * TS * 1024 + i * 256 + lane * 4); a.x += t.x; a.y += t.y; a.z += t.z; a.w += t.w; }
                v[i] = a; *(float4*)(p.out + O_YS + (size_t)(row - TP) * 1024 + i * 256 + lane * 4) = a; }
        }
#pragma unroll
        for (int i = 0; i < 4; ++i) ss += v[i].x * v[i].x + v[i].y * v[i].y + v[i].z * v[i].z + v[i].w * v[i].w;
        if (row < TALL) {
            ss = wave_sum(ss);
            const float rs = rsqrtf(ss * (1.0f / 1024.0f) + 1e-5f);
#pragma unroll
            for (int i = 0; i < 4; ++i) { const float4 w = *(const float4*)(nw + i * 256 + lane * 4); v[i].x *= rs * w.x; v[i].y *= rs * w.y; v[i].z *= rs * w.z; v[i].w *= rs * w.w; }
            float* so = nullptr;
            if (row < TP) { if ((row & 2047) == 2047) so = p.out + O_PSH + ((size_t)l * 8 + (row >> 11)) * 1024; }
            else so = p.out + O_SSH + ((size_t)l * TS + (row - TP)) * 1024;
            if (so) {
#pragma unroll
                for (int i = 0; i < 4; ++i) *(float4*)(so + i * 256 + lane * 4) = v[i]; }
        }
#pragma unroll
        for (int i = 0; i < 4; ++i) { u32x2 w; w.x = pk2(v[i].x, v[i].y); w.y = pk2(v[i].z, v[i].w); *(u32x2*)(A1 + (size_t)row * 1024 + i * 256 + lane * 4) = w; }
    }
}

__device__ void phase_final(const Params& p) {
    const int tid_ = tid_l(); const int lane = tid_ & 63, wid = tid_ >> 6;
    const float* nw = p.in[I_FNW];
    for (int row = blockIdx.x * 8 + wid; row < TALL; row += gridDim.x * 8) {
        float* src = (row < TP) ? p.out + O_YP + (size_t)row * 1024 : p.out + O_YS + (size_t)(row - TP) * 1024;
        float4 v[4]; float ss = 0.f;
#pragma unroll
        for (int i = 0; i < 4; ++i) v[i] = *(const float4*)(src + i * 256 + lane * 4);
        if (row >= TP) { const float* pt = (const float*)(p.ws + WS_PART) + (size_t)(row - TP) * 1024;
#pragma unroll
            for (int i = 0; i < 4; ++i) for (int q = 0; q < 16; ++q) { const float4 t = *(const float4*)(pt + (size_t)q * TS * 1024 + i * 256 + lane * 4); v[i].x += t.x; v[i].y += t.y; v[i].z += t.z; v[i].w += t.w; } }
#pragma unroll
        for (int i = 0; i < 4; ++i) ss += v[i].x * v[i].x + v[i].y * v[i].y + v[i].z * v[i].z + v[i].w * v[i].w;
        ss = wave_sum(ss);
        const float rs = rsqrtf(ss * (1.0f / 1024.0f) + 1e-5f);
#pragma unroll
        for (int i = 0; i < 4; ++i) { const float4 w = *(const float4*)(nw + i * 256 + lane * 4); v[i].x *= rs * w.x; v[i].y *= rs * w.y; v[i].z *= rs * w.z; v[i].w *= rs * w.w;
            *(float4*)(src + i * 256 + lane * 4) = v[i]; }
    }
}

struct EpiP {
    static constexpr bool PERM = true, AFTER_DRAIN = false;
    bf16_t* O; int ldc;
    __device__ __forceinline__ void operator()(const f32x4 (&acc)[2][2][4][2], const pg8::Unit& u, int wr, int wc, int fr, int fq) const {
        const int row0 = u.pm * 256 + wr * 64 + fr, col0 = u.pn * 256 + wc * 32 + 8 * fq;
#pragma unroll
        for (int ai = 0; ai < 2; ++ai)
#pragma unroll
            for (int m = 0; m < 4; ++m) { bf16_t* rowp = O + (size_t)(row0 + ai * 128 + m * 16) * ldc + col0;
#pragma unroll
                for (int bj = 0; bj < 2; ++bj) { const f32x4 v0 = acc[ai][bj][m][0], v1 = acc[ai][bj][m][1];
                    u32x4 w; w.x = pg8::cvt_pk_bf16(v0[0], v0[1]); w.y = pg8::cvt_pk_bf16(v0[2], v0[3]); w.z = pg8::cvt_pk_bf16(v1[0], v1[1]); w.w = pg8::cvt_pk_bf16(v1[2], v1[3]);
                    *(u32x4*)(rowp + bj * 128) = w; } }
    }
};
struct EpiRes {
    static constexpr bool PERM = false, AFTER_DRAIN = false;
    const float* res_p; float* out_p;
    __device__ __forceinline__ void operator()(const f32x4 (&acc)[2][2][4][2], const pg8::Unit& u, int wr, int wc, int fr, int fq) const {
        const int row0 = u.pm * 256 + wr * 64 + fr, col0 = u.pn * 256 + wc * 32 + 4 * fq;
#pragma unroll
        for (int ai = 0; ai < 2; ++ai)
#pragma unroll
            for (int m = 0; m < 4; ++m) { const size_t ro = (size_t)(row0 + ai * 128 + m * 16) * 1024;
#pragma unroll
                for (int bj = 0; bj < 2; ++bj)
#pragma unroll
                    for (int n = 0; n < 2; ++n) { const int c = col0 + bj * 128 + n * 16; const f32x4 r = *(const f32x4*)(res_p + ro + c); *(f32x4*)(out_p + ro + c) = acc[ai][bj][m][n] + r; } }
    }
};

constexpr int CH_NB = 5, CH_CB = 16384;
constexpr int CB_A1 = 0, CB_A2 = 3328, CB_TT = 6656, CB_ZQ = 7936, CB_ZK = 10240, CB_V = 12544, CB_GQ = 14848;
constexpr int CH_SCR = CH_NB * CH_CB;
constexpr int SCR_TW = 0, SCR_EXL = 4608, SCR_SZ = 8704;
constexpr int CH_NMS = CH_SCR + 4 * SCR_SZ;
constexpr int CH_W2T = CH_NMS + 4 * 1280;
constexpr int CH_CST = CH_W2T + 18432;
constexpr int CH_FLG = CH_CST + 2560;
__device__ __forceinline__ unsigned cvtpk(float lo, float hi) { return pg8::cvt_pk_bf16(lo, hi); }
__device__ void rwkv_chain_item(const Params& p, int l, int item, unsigned char* smem_) {
    unsigned char* smem = launder_lds(smem_);
    const int tid = tid_l(), wid = tid >> 6, lane = tid & 63, fr = lane & 15, fq = lane >> 4;
    const int b = item >> 4, h = item & 15;
    bf16_t* w2t = (bf16_t*)(smem + CH_W2T); bf16_t* a2t = w2t + 4608;
    float* cst = (float*)(smem + CH_CST);
    volatile LAS unsigned* ready = (volatile LAS unsigned*)((LAS unsigned char*)smem + CH_FLG); volatile LAS unsigned* cons = ready + 128; volatile LAS unsigned* ready2 = ready + 256;
    const bf16_t* P = (const bf16_t*)(p.ws + WS_P);
    float* ORAW = (float*)(p.ws + WS_ORAW);
    bf16_t* BV = (bf16_t*)(p.ws + WS_BV);
    __syncthreads();
    for (int i = tid; i < CH_W2T / 4; i += 512) ((unsigned*)smem)[i] = 0u;
    if (tid < 384) ((unsigned*)(smem + CH_FLG))[tid] = 0u;
    { const float* w2 = p.in[I_W2] + (size_t)l * 64 * 1024 + h * 64; const float* a2 = p.in[I_A2] + (size_t)l * 64 * 1024 + h * 64;
#pragma unroll
      for (int i = 0; i < 8; ++i) { const int idx = tid + 512 * i, k = idx >> 6, n = idx & 63; w2t[n * 72 + k] = f2bf(w2[(size_t)k * 1024 + n]); a2t[n * 72 + k] = f2bf(a2[(size_t)k * 1024 + n]); } }
    if (tid < 64) { const float* mu = p.in[I_MU] + (size_t)l * 3200; const int gc = h * 64 + tid;
        cst[tid] = mu[C_R + gc]; cst[64 + tid] = mu[C_K + gc]; cst[128 + tid] = mu[C_V + gc]; cst[192 + tid] = mu[C_WL + tid]; cst[256 + tid] = mu[C_AL + tid];
        cst[320 + tid] = p.in[I_KK][l * 1024 + gc]; cst[384 + tid] = p.in[I_KA][l * 1024 + gc]; cst[448 + tid] = p.in[I_RK][l * 1024 + gc];
        cst[512 + tid] = p.in[I_W0][l * 1024 + gc]; cst[576 + tid] = p.in[I_A0][l * 1024 + gc]; }
    __syncthreads();

    if (wid >= 4) {
        const int hw = wid - 4, tok = lane >> 2, q4 = lane & 3, c0 = q4 * 16;
        unsigned char* scr = smem + CH_SCR + hw * SCR_SZ;
        bf16_t* tw = (bf16_t*)(scr + SCR_TW); bf16_t* ta = tw + 1152;
        float* exl = (float*)(scr + SCR_EXL);
        const int segcol[5] = {C_R + h * 64 + c0, C_K + h * 64 + c0, C_V + h * 64 + c0, C_WL + c0, C_AL + c0};
        float w0c[4], a0c[4];
#pragma unroll
        for (int ct = 0; ct < 4; ++ct) { w0c[ct] = cst[512 + ct * 16 + fr]; a0c[ct] = cst[576 + ct * 16 + fr]; }
        u32x4 qc[5][2], qp[5][2];
#define CLOAD(C) { const int t_ = (C) * 16 + tok; const bf16_t* pr_ = P + ((size_t)b * 2048 + t_) * N1; \
            _Pragma("unroll") for (int sg = 0; sg < 5; ++sg) _Pragma("unroll") for (int hh = 0; hh < 2; ++hh) { qc[sg][hh] = *(const u32x4*)(pr_ + segcol[sg] + hh * 8); \
                if (t_ > 0) qp[sg][hh] = *(const u32x4*)(pr_ - N1 + segcol[sg] + hh * 8); else qp[sg][hh] = (u32x4){0u, 0u, 0u, 0u}; } }
        CLOAD(hw)
        for (int c = hw; c < 128; c += 4) {
            unsigned char* cb = smem + (c % CH_NB) * CH_CB;
            bf16_t* A1 = (bf16_t*)(cb + CB_A1); bf16_t* A2 = (bf16_t*)(cb + CB_A2); bf16_t* ZQ = (bf16_t*)(cb + CB_ZQ); bf16_t* ZK = (bf16_t*)(cb + CB_ZK); bf16_t* Vn = (bf16_t*)(cb + CB_V); float* GQ = (float*)(cb + CB_GQ);
            const size_t grow = (size_t)b * 2048 + c * 16 + tok;
            if (c >= CH_NB) { while (cons[c - CH_NB] < 3u) __builtin_amdgcn_s_sleep(1); }
            asm volatile("" ::: "memory");
            float* exa = (float*)(cb + CB_ZQ);
            float xr[16], xk[16]; unsigned xvp[8];
            { float cur[8], prv[8], xw[8], xa[8], xv[8];
#pragma unroll
              for (int hh = 0; hh < 2; ++hh) {
#define LSEG(dst, sg, mo) { unpack8(qc[sg][hh], cur); unpack8(qp[sg][hh], prv); _Pragma("unroll") for (int e = 0; e < 8; ++e) dst[e] = cur[e] + (prv[e] - cur[e]) * cst[(mo) + c0 + hh * 8 + e]; }
                LSEG((xr + hh * 8), 0, 0) LSEG((xk + hh * 8), 1, 64) LSEG(xv, 2, 128) LSEG(xw, 3, 192) LSEG(xa, 4, 256)
#undef LSEG
                { const u32x4 pv = pack8(xv); xvp[hh * 4] = pv.x; xvp[hh * 4 + 1] = pv.y; xvp[hh * 4 + 2] = pv.z; xvp[hh * 4 + 3] = pv.w; }
#pragma unroll
                for (int e = 0; e < 8; ++e) xw[e] = 1.0f - 2.0f * frcp(__expf(2.0f * xw[e]) + 1.0f);
                *(u32x4*)(tw + tok * 72 + c0 + hh * 8) = pack8(xw); *(u32x4*)(ta + tok * 72 + c0 + hh * 8) = pack8(xa);
              } }
            if (c + 4 < 128) CLOAD(c + 4)
            lds_fence();
#pragma unroll
            for (int ct = 0; ct < 4; ++ct) { f32x4 aw = {0.f, 0.f, 0.f, 0.f}, aa = aw;
#pragma unroll
                for (int ks = 0; ks < 2; ++ks) {
                    aw = MFMA16(*(const bf16x8*)(tw + fr * 72 + ks * 32 + fq * 8), *(const bf16x8*)(w2t + (ct * 16 + fr) * 72 + ks * 32 + fq * 8), aw);
                    aa = MFMA16(*(const bf16x8*)(ta + fr * 72 + ks * 32 + fq * 8), *(const bf16x8*)(a2t + (ct * 16 + fr) * 72 + ks * 32 + fq * 8), aa); }
#pragma unroll
                for (int j = 0; j < 4; ++j) { const int tj = fq * 4 + j, col = ct * 16 + fr;
                    exl[tj * 64 + col] = -0.60653066f * sigmoidf_(w0c[ct] + aw[j]);
                    exa[tj * 64 + col] = sigmoidf_(a0c[ct] + aa[j]); } }
            lds_fence();
            { float Lc = 0.f;
#pragma unroll
              for (int t = 0; t < 16; ++t) { Lc += exl[t * 64 + lane]; exl[t * 64 + lane] = __expf(Lc); }
              GQ[lane] = __expf(Lc); }
            float a16[16];
#pragma unroll
            for (int i = 0; i < 4; ++i) { const float4 t4 = *(const float4*)(exa + tok * 64 + c0 + i * 4); a16[i * 4] = t4.x; a16[i * 4 + 1] = t4.y; a16[i * 4 + 2] = t4.z; a16[i * 4 + 3] = t4.w; }
            float ssq = 0.f, beta = 0.f;
#pragma unroll
            for (int e = 0; e < 16; ++e) { const float kr_ = xk[e] * cst[320 + c0 + e]; ssq += kr_ * kr_; }
            ssq += dppf<0xB1>(ssq); ssq += dppf<0x4E>(ssq);
            const float inv = frcp(fmaxf(__builtin_amdgcn_sqrtf(ssq), 1e-12f));
            lds_fence();
            { *(u32x4*)(Vn + tok * 72 + c0) = (u32x4){xvp[0], xvp[1], xvp[2], xvp[3]}; *(u32x4*)(Vn + tok * 72 + c0 + 8) = (u32x4){xvp[4], xvp[5], xvp[6], xvp[7]};
#pragma unroll
              for (int gI = 0; gI < 4; ++gI) {
                float pt[4], rt[4], qt[4], kt[4];
#pragma unroll
                for (int e3 = 0; e3 < 4; ++e3) { const int e = gI * 4 + e3; const float el = exl[tok * 64 + c0 + e], elm = tok > 0 ? exl[(tok - 1) * 64 + c0 + e] : 1.0f, iv = frcp(el);
                    const float kk_ = xk[e] * cst[320 + c0 + e] * inv, kp_ = xk[e] * (1.0f + (a16[e] - 1.0f) * cst[384 + c0 + e]), bb_ = -kk_ * a16[e];
                    beta += xr[e] * kp_ * cst[448 + c0 + e];
                    pt[e3] = kk_ * elm; rt[e3] = xr[e] * el; qt[e3] = bb_ * iv; kt[e3] = kp_ * iv;
                    }
                const int s0 = (q4 >> 1) * 32 + gI * 8 + (q4 & 1) * 4;
                u32x2 w; w.x = cvtpk(pt[0], pt[1]); w.y = cvtpk(pt[2], pt[3]); *(u32x2*)(A1 + tok * 104 + s0) = w;
                w.x = cvtpk(rt[0], rt[1]); w.y = cvtpk(rt[2], rt[3]); *(u32x2*)(A2 + tok * 104 + s0) = w;
                w.x = cvtpk(qt[0], qt[1]); w.y = cvtpk(qt[2], qt[3]); *(u32x2*)(ZQ + tok * 72 + s0) = w;
                w.x = cvtpk(kt[0], kt[1]); w.y = cvtpk(kt[2], kt[3]); *(u32x2*)(ZK + tok * 72 + s0) = w;
              } }
            beta += dppf<0xB1>(beta); beta += dppf<0x4E>(beta);
            { float bv[16];
#pragma unroll
              for (int e = 0; e < 16; ++e) bv[e] = beta * __uint_as_float((e & 1) ? (xvp[e >> 1] & 0xffff0000u) : (xvp[e >> 1] << 16));
              *(u32x4*)(BV + grow * 1024 + h * 64 + c0) = pack8(bv); *(u32x4*)(BV + grow * 1024 + h * 64 + c0 + 8) = pack8(bv + 8); }
            lds_fence();
            if (lane == 0) ready[c] = 1u;
        }
#undef CLOAD
    } else {
        if (wid == 3) {
            float* Nm = (float*)(smem + CH_NMS);
            for (int c = 0; c < 128; ++c) {
                unsigned char* cbw = smem + (c % CH_NB) * CH_CB;
                bf16_t* A1 = (bf16_t*)(cbw + CB_A1); bf16_t* A2 = (bf16_t*)(cbw + CB_A2); bf16_t* TT = (bf16_t*)(cbw + CB_TT);
                const bf16_t* ZQ = (const bf16_t*)(cbw + CB_ZQ); const bf16_t* ZK = (const bf16_t*)(cbw + CB_ZK);
                while (ready[c] == 0u) __builtin_amdgcn_s_sleep(1);
                asm volatile("" ::: "memory");
                { f32x4 gN = {0.f, 0.f, 0.f, 0.f}, gKP = gN, gQR = gN, gKR = gN;
#pragma unroll
                  for (int ks = 0; ks < 2; ++ks) {
                      const bf16x8 fzq = *(const bf16x8*)(ZQ + fr * 72 + ks * 32 + fq * 8), fzk = *(const bf16x8*)(ZK + fr * 72 + ks * 32 + fq * 8);
                      const bf16x8 fp = *(const bf16x8*)(A1 + fr * 104 + ks * 32 + fq * 8), frr = *(const bf16x8*)(A2 + fr * 104 + ks * 32 + fq * 8);
                      gN = MFMA16(fzq, fp, gN); gKP = MFMA16(fzk, fp, gKP); gQR = MFMA16(fzq, frr, gQR); gKR = MFMA16(fzk, frr, gKR); }
#pragma unroll
                  for (int jj = 0; jj < 4; ++jj) { const int j = fq * 4 + jj; const bool lt = j < fr, le = j <= fr;
                      gN[jj] = lt ? gN[jj] : 0.f; gKP[jj] = lt ? gKP[jj] : 0.f; gQR[jj] = le ? gQR[jj] : 0.f; gKR[jj] = le ? gKR[jj] : 0.f; }
                  u32x4 w1; w1.x = 0u; w1.y = 0u; w1.z = pk2(gKP[0], gKP[1]); w1.w = pk2(gKP[2], gKP[3]); *(u32x4*)(A1 + fr * 104 + 64 + fq * 8) = w1;
                  u32x4 w2; w2.x = pk2(gQR[0], gQR[1]); w2.y = pk2(gQR[2], gQR[3]); w2.z = pk2(gKR[0], gKR[1]); w2.w = pk2(gKR[2], gKR[3]); *(u32x4*)(A2 + fr * 104 + 64 + fq * 8) = w2;
                  float Ti[16]; int i = fr; asm volatile("" : "+v"(i));
#pragma unroll
                  for (int t = 0; t < 16; ++t) { float s_ = (i == t) ? 1.0f : 0.0f;
#pragma unroll
                      for (int j = 0; j < t; ++j) s_ += Ti[j] * __int_as_float(__builtin_amdgcn_readlane(__float_as_int(gN[j & 3]), (j >> 2) * 16 + t));
                      Ti[t] = s_; }
                  if (lane < 16) { const int sq = (i >> 2) * 8 + (i & 3);
#pragma unroll
                      for (int t = 0; t < 16; ++t) TT[t * 40 + sq] = f2bf(Ti[t]); } }
                lds_fence();
                if (lane == 0) ready2[c] = 1u;
            }
        } else {
            const int ng = (wid == 0) ? 2 : 1, g0 = (wid == 0) ? 0 : wid + 1;
            f32x4 acc[2][4];
#pragma unroll
            for (int gi = 0; gi < 2; ++gi)
#pragma unroll
                for (int kt = 0; kt < 4; ++kt) acc[gi][kt] = (f32x4){0.f, 0.f, 0.f, 0.f};
            for (int c = 0; c < 128; ++c) {
                const unsigned char* cbw = smem + (c % CH_NB) * CH_CB;
                const bf16_t* A1 = (const bf16_t*)(cbw + CB_A1); const bf16_t* A2 = (const bf16_t*)(cbw + CB_A2); const bf16_t* TT = (const bf16_t*)(cbw + CB_TT);
                const bf16_t* ZQ = (const bf16_t*)(cbw + CB_ZQ); const bf16_t* ZK = (const bf16_t*)(cbw + CB_ZK); const bf16_t* Vn = (const bf16_t*)(cbw + CB_V); const float* GQ = (const float*)(cbw + CB_GQ);
                while (ready2[c] == 0u) __builtin_amdgcn_s_sleep(1);
                asm volatile("" ::: "memory");
                union U8 { u32x4 u; bf16x8 h; };
                U8 FA[4];
#pragma unroll
                for (int kt = 0; kt < 4; ++kt) { const int sk = (kt >> 1) * 32 + (fr >> 2) * 8 + (kt & 1) * 4 + (fr & 3);
                    const unsigned q0 = ZQ[(fq * 4 + 0) * 72 + sk], q1 = ZQ[(fq * 4 + 1) * 72 + sk], q2 = ZQ[(fq * 4 + 2) * 72 + sk], q3 = ZQ[(fq * 4 + 3) * 72 + sk];
                    const unsigned k0 = ZK[(fq * 4 + 0) * 72 + sk], k1 = ZK[(fq * 4 + 1) * 72 + sk], k2 = ZK[(fq * 4 + 2) * 72 + sk], k3 = ZK[(fq * 4 + 3) * 72 + sk];
                    FA[kt].u.x = q0 | (q1 << 16); FA[kt].u.y = q2 | (q3 << 16); FA[kt].u.z = k0 | (k1 << 16); FA[kt].u.w = k2 | (k3 << 16); }
                const bf16x8 a1f0 = *(const bf16x8*)(A1 + fr * 104 + fq * 8), a1f1 = *(const bf16x8*)(A1 + fr * 104 + 32 + fq * 8), a1f2 = *(const bf16x8*)(A1 + fr * 104 + 64 + fq * 8);
                const bf16x8 a2f0 = *(const bf16x8*)(A2 + fr * 104 + fq * 8), a2f1 = *(const bf16x8*)(A2 + fr * 104 + 32 + fq * 8), a2f2 = *(const bf16x8*)(A2 + fr * 104 + 64 + fq * 8);
                const bf16x8 ttf = *(const bf16x8*)(TT + fr * 40 + fq * 8);
                float4 gq[4];
#pragma unroll
                for (int kt = 0; kt < 4; ++kt) gq[kt] = *(const float4*)(GQ + kt * 16 + fq * 4);
#pragma unroll
                for (int gi = 0; gi < 2; ++gi) if (gi < ng) {
                    const int v0 = (g0 + gi) * 16;
                    U8 B0, B1, BX;
                    B0.u.x = cvtpk(acc[gi][0][0], acc[gi][0][1]); B0.u.y = cvtpk(acc[gi][0][2], acc[gi][0][3]); B0.u.z = cvtpk(acc[gi][1][0], acc[gi][1][1]); B0.u.w = cvtpk(acc[gi][1][2], acc[gi][1][3]);
                    B1.u.x = cvtpk(acc[gi][2][0], acc[gi][2][1]); B1.u.y = cvtpk(acc[gi][2][2], acc[gi][2][3]); B1.u.z = cvtpk(acc[gi][3][0], acc[gi][3][1]); B1.u.w = cvtpk(acc[gi][3][2], acc[gi][3][3]);
                    u32x2 vq;
                    { const unsigned e0 = Vn[(fq * 4 + 0) * 72 + v0 + fr], e1 = Vn[(fq * 4 + 1) * 72 + v0 + fr], e2 = Vn[(fq * 4 + 2) * 72 + v0 + fr], e3 = Vn[(fq * 4 + 3) * 72 + v0 + fr];
                      vq.x = e0 | (e1 << 16); vq.y = e2 | (e3 << 16); }
                    BX.u.x = 0u; BX.u.y = 0u; BX.u.z = vq.x; BX.u.w = vq.y;
                    f32x4 rhs = {0.f, 0.f, 0.f, 0.f};
                    rhs = MFMA16(a1f0, B0.h, rhs); rhs = MFMA16(a1f1, B1.h, rhs); rhs = MFMA16(a1f2, BX.h, rhs);
                    BX.u.x = pk2(rhs[0], rhs[1]); BX.u.y = pk2(rhs[2], rhs[3]); BX.u.z = 0u; BX.u.w = 0u;
                    f32x4 uu = {0.f, 0.f, 0.f, 0.f};
                    uu = MFMA16(ttf, BX.h, uu);
                    BX.u.x = pk2(uu[0], uu[1]); BX.u.y = pk2(uu[2], uu[3]); BX.u.z = vq.x; BX.u.w = vq.y;
                    f32x4 oo = {0.f, 0.f, 0.f, 0.f};
                    oo = MFMA16(a2f0, B0.h, oo); oo = MFMA16(a2f1, B1.h, oo); oo = MFMA16(a2f2, BX.h, oo);
#pragma unroll
                    for (int kt = 0; kt < 4; ++kt) { acc[gi][kt] = MFMA16(FA[kt].h, BX.h, acc[gi][kt]);
                        acc[gi][kt][0] *= gq[kt].x; acc[gi][kt][1] *= gq[kt].y; acc[gi][kt][2] *= gq[kt].z; acc[gi][kt][3] *= gq[kt].w; }
                    float* op = ORAW + ((size_t)b * 2048 + c * 16 + fq * 4) * 1024 + h * 64 + v0 + fr;
#pragma unroll
                    for (int jj = 0; jj < 4; ++jj) op[(size_t)jj * 1024] = oo[jj];
                }
                asm volatile("s_waitcnt lgkmcnt(0)" ::: "memory");
                if (lane == 0) __hip_atomic_fetch_add((LAS unsigned*)&cons[c], 1u, __ATOMIC_RELAXED, __HIP_MEMORY_SCOPE_WORKGROUP);
            }
#pragma unroll
            for (int gi = 0; gi < 2; ++gi) if (gi < ng) {
                float* so = p.out + O_PWKV + ((((size_t)l * 8 + b) * 16 + h) * 64 + (g0 + gi) * 16 + fr) * 64 + fq * 4;
#pragma unroll
                for (int kt = 0; kt < 4; ++kt) *(float4*)(so + kt * 16) = make_float4(acc[gi][kt][0], acc[gi][kt][1], acc[gi][kt][2], acc[gi][kt][3]);
            }
        }
    }
    __syncthreads();
}

__device__ void rwkv_sample_item(const Params& p, int l, int item, unsigned char* smem_) {
    unsigned char* smem = launder_lds(smem_);
    const int tid = tid_l(), lane = tid & 63, ks = tid >> 6;
    const int i = item >> 4, h = item & 15;
    float* part = (float*)smem;
    float* sv = part + 1024;
    float* s_sc = sv + 384;
    const bf16_t* P = (const bf16_t*)(p.ws + WS_P);
    float* ORAW = (float*)(p.ws + WS_ORAW);
    bf16_t* BV = (bf16_t*)(p.ws + WS_BV);
    const size_t rowp = (size_t)TP + i, rows = (size_t)TALL + i;
    const bf16_t* pc = P + rowp * N1; const bf16_t* pp = P + rows * N1;
    const float* mu = p.in[I_MU] + (size_t)l * 3200;
    const int gc = h * 64 + lane;
    const int row = tid >> 3, cs = (tid & 7) * 8;
    const size_t so = ((((size_t)l * TS + i) * 16 + h) * 64 + row) * 64 + cs;
    const float4 a0 = *(const float4*)(p.in[I_SWKV] + so), a1 = *(const float4*)(p.in[I_SWKV] + so + 4);
#define LERP1(col) (bf2f(pc[col]) + (bf2f(pp[col]) - bf2f(pc[col])) * mu[col])
    { const float* w2 = p.in[I_W2] + (size_t)l * 64 * 1024 + gc; const float* a2 = p.in[I_A2] + (size_t)l * 64 * 1024 + gc;
      float lw = 0.f, la = 0.f;
#pragma unroll
      for (int kk = 0; kk < 8; ++kk) { const int k = ks * 8 + kk; const float xwl = LERP1(C_WL + k), xal = LERP1(C_AL + k);
          lw += (1.0f - 2.0f * frcp(__expf(2.0f * xwl) + 1.0f)) * w2[(size_t)k * 1024]; la += xal * a2[(size_t)k * 1024]; }
      __syncthreads();
      part[ks * 64 + lane] = lw; part[512 + ks * 64 + lane] = la; }
    __syncthreads();
    if (tid < 64) {
        const float xr = LERP1(C_R + gc), xk = LERP1(C_K + gc), xv = LERP1(C_V + gc);
        float lw = 0.f, la = 0.f;
#pragma unroll
        for (int q = 0; q < 8; ++q) { lw += part[q * 64 + lane]; la += part[512 + q * 64 + lane]; }
        const float w = __expf(-0.60653066f * sigmoidf_(p.in[I_W0][l * 1024 + gc] + lw));
        const float a = sigmoidf_(p.in[I_A0][l * 1024 + gc] + la);
        float kk = xk * p.in[I_KK][l * 1024 + gc];
        const float ssq = wave_sum(kk * kk);
        kk *= 1.0f / fmaxf(sqrtf(ssq), 1e-12f);
        const float kp = xk * (1.0f + (a - 1.0f) * p.in[I_KA][l * 1024 + gc]);
        const float bb = -kk * a, wr = w * xr;
        const float br = wave_sum(bb * xr), kr = wave_sum(kp * xr), beta = wave_sum(xr * kp * p.in[I_RK][l * 1024 + gc]);
        sv[lane] = w; sv[64 + lane] = kk; sv[128 + lane] = bb; sv[192 + lane] = kp; sv[256 + lane] = wr; sv[320 + lane] = xv;
        if (lane == 0) { s_sc[0] = br; s_sc[1] = kr; }
        BV[rowp * 1024 + gc] = f2bf(beta * xv);
    }
#undef LERP1
    __syncthreads();
    {
        float S[8] = {a0.x, a0.y, a0.z, a0.w, a1.x, a1.y, a1.z, a1.w};
        float dk = 0.f, dr = 0.f;
#pragma unroll
        for (int e = 0; e < 8; ++e) { dk += S[e] * sv[64 + cs + e]; dr += S[e] * sv[256 + cs + e]; }
        dk = red8(dk); dr = red8(dr);
        const float vr = sv[320 + row];
        const float o = dr + dk * s_sc[0] + vr * s_sc[1];
        if ((tid & 7) == 0) ORAW[rowp * 1024 + h * 64 + row] = o;
#pragma unroll
        for (int e = 0; e < 8; ++e) S[e] = S[e] * sv[cs + e] + dk * sv[128 + cs + e] + vr * sv[192 + cs + e];
        float* sout = p.out + O_SWKV + so;
        *(float4*)sout = make_float4(S[0], S[1], S[2], S[3]); *(float4*)(sout + 4) = make_float4(S[4], S[5], S[6], S[7]);
    }
}

__device__ void phase_conv(const Params& p, int l) {
    const int tid = tid_l();
    const bf16_t* P = (const bf16_t*)(p.ws + WS_P);
    bf16_t* U = (bf16_t*)(p.ws + WS_U); float* DT = (float*)(p.ws + WS_DT);
    for (int id = blockIdx.x * 512 + tid; id < 1024 * 384; id += gridDim.x * 512) {
        const int q = id % 384, seg = id / 384, xcol = q * 4;
        const int bb = seg >> 7, tb = (seg & 127) * 16;
        float4 cw0, cw1, cw2, cw3, cbv;
        { const float* cw = p.in[I_CW] + (size_t)l * 4 * 1536 + xcol; cw0 = *(const float4*)cw; cw1 = *(const float4*)(cw + 1536); cw2 = *(const float4*)(cw + 3072); cw3 = *(const float4*)(cw + 4608);
          cbv = *(const float4*)(p.in[I_CB] + (size_t)l * 1536 + xcol); }
        const bf16_t* pb = P + ((size_t)bb * 2048 + tb) * N1 + C_XBC + xcol;
        bf16_t* ub = U + ((size_t)bb * 2048 + tb) * 1536 + xcol;
        float4 w0 = make_float4(0.f, 0.f, 0.f, 0.f), w1 = w0, w2 = w0;
#define LD4(dst, ptr) { const u32x2 _v = *(const u32x2*)(ptr); dst = make_float4(__uint_as_float(_v.x << 16), __uint_as_float(_v.x & 0xffff0000u), __uint_as_float(_v.y << 16), __uint_as_float(_v.y & 0xffff0000u)); }
        if (tb >= 3) { LD4(w0, pb - 3 * (size_t)N1) LD4(w1, pb - 2 * (size_t)N1) LD4(w2, pb - (size_t)N1) }
#pragma unroll
        for (int s = 0; s < 16; ++s) {
            float4 cur; LD4(cur, pb + (size_t)s * N1)
            float4 u;
            u.x = cbv.x + cw0.x * w0.x + cw1.x * w1.x + cw2.x * w2.x + cw3.x * cur.x; u.y = cbv.y + cw0.y * w0.y + cw1.y * w1.y + cw2.y * w2.y + cw3.y * cur.y;
            u.z = cbv.z + cw0.z * w0.z + cw1.z * w1.z + cw2.z * w2.z + cw3.z * cur.z; u.w = cbv.w + cw0.w * w0.w + cw1.w * w1.w + cw2.w * w2.w + cw3.w * cur.w;
            u32x2 pk; pk.x = pk2(siluf_(u.x), siluf_(u.y)); pk.y = pk2(siluf_(u.z), siluf_(u.w));
            *(u32x2*)(ub + (size_t)s * 1536) = pk;
            w0 = w1; w1 = w2; w2 = cur;
        }
#undef LD4
    }
    for (int id = blockIdx.x * 512 + tid; id < TP * 16; id += gridDim.x * 512) {
        const int t = id >> 4, j = id & 15;
        DT[id] = softplusf_(bf2f(P[(size_t)t * N1 + C_DT + j]) + p.in[I_DTB][l * 16 + j]);
    }
}

__device__ void mamba_item(const Params& p, int l, int item, unsigned char* smem_) {
    unsigned char* smem = launder_lds(smem_);
    const int tid = tid_l(), wid = tid >> 6, lane = tid & 63, fr = lane & 15, fq = lane >> 4;
    const int b = item >> 5, j = (item >> 1) & 15, ph = item & 1, g = j >> 3;
    bf16_t* Cm = (bf16_t*)smem;
    bf16_t* Bm = (bf16_t*)(smem + 17408);
    bf16_t* BmT = (bf16_t*)(smem + 34816);
    bf16_t* XT = (bf16_t*)(smem + 53248);
    bf16_t* XwT = (bf16_t*)(smem + 57856);
    bf16_t* G = (bf16_t*)(smem + 62464);
    bf16_t* Hb = (bf16_t*)(smem + 71680);
    float* acs = (float*)(smem + 80384);
    float* dtv = acs + 64;
    const bf16_t* P = (const bf16_t*)(p.ws + WS_P);
    const bf16_t* U = (const bf16_t*)(p.ws + WS_U); const float* DT = (const float*)(p.ws + WS_DT);
    bf16_t* YM = (bf16_t*)(p.ws + WS_YM);
    __syncthreads();
    for (int i = tid; i < 32 * 136; i += 512) Hb[i] = 0;
    const float Aj = -__expf(p.in[I_ALOG][l * 16 + j]), Dj = p.in[I_DSK][l * 16 + j];
    const int c16a = wid * 2, c16b = wid * 2 + 1, c4 = wid & 3;
    const int lt = wid >> 1, pt = wid & 1;
    const bf16_t* ub = U + (size_t)b * 2048 * 1536;
    u32x4 rb0, rb1, rc0, rc1, rx = {0u, 0u, 0u, 0u}; float rdt = 0.f;
#define LOADCHUNK(T0) { const bf16_t* r0 = ub + (size_t)((T0) + lane) * 1536 + g * 128; \
        rb0 = *(const u32x4*)(r0 + 1024 + c16a * 8); rb1 = *(const u32x4*)(r0 + 1024 + c16b * 8); rc0 = *(const u32x4*)(r0 + 1280 + c16a * 8); rc1 = *(const u32x4*)(r0 + 1280 + c16b * 8); \
        if (tid < 256) rx = *(const u32x4*)(ub + (size_t)((T0) + lane) * 1536 + j * 64 + ph * 32 + c4 * 8); \
        if (wid == 5) rdt = DT[((size_t)b * 2048 + (T0) + lane) * 16 + j]; }
    LOADCHUNK(0)
    f32x4 hacc[2] = {{0.f, 0.f, 0.f, 0.f}, {0.f, 0.f, 0.f, 0.f}};
    for (int c = 0; c < 32; ++c) {
        const int t0 = c * 64;
        float zq[4];
#pragma unroll
        for (int jj = 0; jj < 4; ++jj) zq[jj] = bf2f(P[((size_t)b * 2048 + t0 + lt * 16 + fq * 4 + jj) * N1 + C_ZM + j * 64 + ph * 32 + pt * 16 + fr]);
        *(u32x4*)(Cm + lane * 136 + c16a * 8) = rc0; *(u32x4*)(Cm + lane * 136 + c16b * 8) = rc1;
        *(u32x4*)(Bm + lane * 136 + c16a * 8) = rb0; *(u32x4*)(Bm + lane * 136 + c16b * 8) = rb1;
#pragma unroll
        for (int e = 0; e < 8; ++e) { const unsigned v0 = rb0[e >> 1], v1 = rb1[e >> 1];
            BmT[(c16a * 8 + e) * 72 + lane] = (bf16_t)((e & 1) ? (v0 >> 16) : (v0 & 0xffffu)); BmT[(c16b * 8 + e) * 72 + lane] = (bf16_t)((e & 1) ? (v1 >> 16) : (v1 & 0xffffu)); }
        if (tid < 256) {
#pragma unroll
            for (int e = 0; e < 8; ++e) { const unsigned v0 = rx[e >> 1]; XT[(c4 * 8 + e) * 72 + lane] = (bf16_t)((e & 1) ? (v0 >> 16) : (v0 & 0xffffu)); }
        }
        if (wid == 5) {
            float v = rdt * Aj;
#pragma unroll
            for (int off = 1; off < 64; off <<= 1) { const float t = __shfl_up(v, off); if (lane >= off) v += t; }
            acs[lane] = v; dtv[lane] = rdt;
        }
        if (c + 1 < 32) LOADCHUNK(t0 + 64)
        LBAR();
        { const int pp = tid & 31, s4 = (tid >> 5) * 4; const float aend = acs[63];
          const u32x2 xv = *(const u32x2*)(XT + pp * 72 + s4);
          const float x0 = __uint_as_float(xv.x << 16), x1 = __uint_as_float(xv.x & 0xffff0000u), x2 = __uint_as_float(xv.y << 16), x3 = __uint_as_float(xv.y & 0xffff0000u);
          u32x2 bq; bq.x = pk2(x0 * dtv[s4] * __expf(aend - acs[s4]), x1 * dtv[s4 + 1] * __expf(aend - acs[s4 + 1]));
          bq.y = pk2(x2 * dtv[s4 + 2] * __expf(aend - acs[s4 + 2]), x3 * dtv[s4 + 3] * __expf(aend - acs[s4 + 3]));
          *(u32x2*)(XwT + pp * 72 + s4) = bq; }
#pragma unroll
        for (int e = 0; e < 2; ++e) {
            const int id = wid * 2 + e, glt = id >> 2, st = id & 3;
            f32x4 acc = {0.f, 0.f, 0.f, 0.f};
            if (st <= glt) {
#pragma unroll
                for (int ks = 0; ks < 4; ++ks) { const bf16x8 fa = *(const bf16x8*)(Cm + (glt * 16 + fr) * 136 + ks * 32 + fq * 8), fb = *(const bf16x8*)(Bm + (st * 16 + fr) * 136 + ks * 32 + fq * 8); acc = MFMA16(fa, fb, acc); }
            }
#pragma unroll
            for (int jj = 0; jj < 4; ++jj) { const int lr = glt * 16 + fq * 4 + jj, s = st * 16 + fr;
                const float val = (s <= lr) ? acc[jj] * __expf(acs[lr] - acs[s]) * dtv[s] : 0.f;
                G[lr * 72 + s] = f2bf(val); }
        }
        f32x4 accO = {0.f, 0.f, 0.f, 0.f};
#pragma unroll
        for (int ks = 0; ks < 4; ++ks) { const bf16x8 fa = *(const bf16x8*)(Cm + (lt * 16 + fr) * 136 + ks * 32 + fq * 8), fb = *(const bf16x8*)(Hb + (pt * 16 + fr) * 136 + ks * 32 + fq * 8); accO = MFMA16(fa, fb, accO); }
        LBAR();
        {
            f32x4 accD = {0.f, 0.f, 0.f, 0.f};
#pragma unroll
            for (int ks = 0; ks < 2; ++ks) { const bf16x8 fa = *(const bf16x8*)(G + (lt * 16 + fr) * 72 + ks * 32 + fq * 8), fb = *(const bf16x8*)(XT + (pt * 16 + fr) * 72 + ks * 32 + fq * 8); accD = MFMA16(fa, fb, accD); }
#pragma unroll
            for (int jj = 0; jj < 4; ++jj) { const int lr = lt * 16 + fq * 4 + jj, pp = pt * 16 + fr;
                float y = accD[jj] + __expf(acs[lr]) * accO[jj] + Dj * bf2f(XT[pp * 72 + lr]);
                y *= siluf_(zq[jj]);
                YM[((size_t)b * 2048 + t0 + lr) * 1024 + j * 64 + ph * 32 + pp] = f2bf(y); }
            const float cd = __expf(acs[63]); const int ptile = wid >> 2;
#pragma unroll
            for (int e = 0; e < 2; ++e) { const int nt = (wid & 3) * 2 + e;
                hacc[e] *= cd;
#pragma unroll
                for (int ks = 0; ks < 2; ++ks) { const bf16x8 fa = *(const bf16x8*)(XwT + (ptile * 16 + fr) * 72 + ks * 32 + fq * 8), fb = *(const bf16x8*)(BmT + (nt * 16 + fr) * 72 + ks * 32 + fq * 8); hacc[e] = MFMA16(fa, fb, hacc[e]); }
#pragma unroll
                for (int jj = 0; jj < 4; ++jj) Hb[(ptile * 16 + fq * 4 + jj) * 136 + nt * 16 + fr] = f2bf(hacc[e][jj]); }
        }
        LBAR();
    }
#undef LOADCHUNK
    { const int ptile = wid >> 2;
#pragma unroll
      for (int e = 0; e < 2; ++e) { const int nt = (wid & 3) * 2 + e;
#pragma unroll
          for (int jj = 0; jj < 4; ++jj) p.out[O_PSSM + ((((size_t)l * 8 + b) * 16 + j) * 64 + ph * 32 + ptile * 16 + fq * 4 + jj) * 128 + nt * 16 + fr] = hacc[e][jj]; } }
    __syncthreads();
}

__device__ void mamba_sample_item(const Params& p, int l, int item, unsigned char* smem_) {
    unsigned char* smem = launder_lds(smem_);
    const int tid = tid_l();
    const int i = item >> 4, j = item & 15, g = j >> 3;
    float* su = (float*)smem;
    float* sd = su + 320;
    const bf16_t* P = (const bf16_t*)(p.ws + WS_P);
    bf16_t* YM = (bf16_t*)(p.ws + WS_YM);
    const size_t rowp = (size_t)TP + i;
    const int pp = tid >> 3, n0 = (tid & 7) * 16;
    const size_t so = ((((size_t)l * TS + i) * 16 + j) * 64 + pp) * 128 + n0;
    float4 hv4[4];
#pragma unroll
    for (int e = 0; e < 4; ++e) hv4[e] = *(const float4*)(p.in[I_SSSM] + so + e * 4);
    __syncthreads();
    if (tid < 320) {
        const int cc = tid < 64 ? j * 64 + tid : (tid < 192 ? 1024 + g * 128 + (tid - 64) : 1280 + g * 128 + (tid - 192));
        const float* c0 = p.in[I_SCONV] + ((size_t)l * TS + i) * 3 * 1536 + cc;
        const float* cw = p.in[I_CW] + (size_t)l * 4 * 1536 + cc;
        const float v = p.in[I_CB][l * 1536 + cc] + c0[0] * cw[0] + c0[1536] * cw[1536] + c0[3072] * cw[3072] + bf2f(P[rowp * N1 + C_XBC + cc]) * cw[4608];
        su[tid] = siluf_(v);
    } else if (tid == 320) {
        const float dt = softplusf_(bf2f(P[rowp * N1 + C_DT + j]) + p.in[I_DTB][l * 16 + j]);
        sd[0] = dt; sd[1] = __expf(-dt * __expf(p.in[I_ALOG][l * 16 + j]));
    }
    __syncthreads();
    {
        float* hout = p.out + O_SSSM + so;
        const float dt = sd[0], eA = sd[1], x = su[pp], xdt = x * dt;
        float y = 0.f;
#pragma unroll
        for (int e = 0; e < 4; ++e) { float4 hv = hv4[e]; const float* Bp = su + 64 + n0 + e * 4; const float* Cp = su + 192 + n0 + e * 4;
            hv.x = eA * hv.x + xdt * Bp[0]; hv.y = eA * hv.y + xdt * Bp[1]; hv.z = eA * hv.z + xdt * Bp[2]; hv.w = eA * hv.w + xdt * Bp[3];
            y += hv.x * Cp[0] + hv.y * Cp[1] + hv.z * Cp[2] + hv.w * Cp[3];
            *(float4*)(hout + e * 4) = hv; }
        y = red8(y);
        if ((tid & 7) == 0) { y += p.in[I_DSK][l * 16 + j] * x; const float z = bf2f(P[rowp * N1 + C_ZM + j * 64 + pp]); YM[rowp * 1024 + j * 64 + pp] = f2bf(y * siluf_(z)); }
    }
}

__device__ void phase_mixa(const Params& p, int l, unsigned char* smem) {
    phase_conv(p, l);
    for (int rep = 0; rep < (DUP == 3 ? 2 : 1); ++rep)
    for (int it = blockIdx.x; it < 2048; it += gridDim.x) rwkv_sample_item(p, l, it, smem);
    for (int rep = 0; rep < (DUP == 4 ? 2 : 1); ++rep)
    for (int it = blockIdx.x; it < 2048; it += gridDim.x) mamba_sample_item(p, l, it, smem);
}
__device__ void phase_mixb(const Params& p, int l, unsigned char* smem) {
    const int G = (int)gridDim.x, nch = G >= 256 ? 128 : G;
    if ((int)blockIdx.x < nch) {
        for (int rep = 0; rep < (DUP == 1 ? 2 : 1); ++rep)
        for (int it = blockIdx.x; it < 128; it += nch) rwkv_chain_item(p, l, it, smem);
    }
    unsigned* ticket = (unsigned*)(p.ws + WS_BAR) + XCD_BAR_WORDS + 64 * l;
    volatile LAS int* slot = (volatile LAS int*)((LAS unsigned char*)smem + LDS_BARST + 8);
    for (;;) {
        __syncthreads();
        if (tid_l() == 0) *slot = (int)__hip_atomic_fetch_add(ticket, 1u, __ATOMIC_RELAXED, __HIP_MEMORY_SCOPE_AGENT);
        __syncthreads();
        const int it = *slot;
        if (it >= 256 * (DUP == 2 ? 2 : 1)) break;
        mamba_item(p, l, it & 255, smem);
    }
}

__device__ void sample_outproj(const Params& p, int l) {
    const int tid = tid_l(), wid = tid >> 6, lane = tid & 63, fr = lane & 15, fq = lane >> 4;
    const bf16_t* A2 = (const bf16_t*)(p.ws + WS_A) + (size_t)TP * 2048;
    const bf16_t* W = (const bf16_t*)(p.ws + WS_WOUTT) + (size_t)l * 1024 * 2048;
    float* PART = (float*)(p.ws + WS_PART);
    for (int it = blockIdx.x; it < 256; it += gridDim.x) {
        const int nt = it & 15, ksl = it >> 4;
        f32x4 acc[4] = {{0.f, 0.f, 0.f, 0.f}, {0.f, 0.f, 0.f, 0.f}, {0.f, 0.f, 0.f, 0.f}, {0.f, 0.f, 0.f, 0.f}};
#pragma unroll
        for (int kq = 0; kq < 4; ++kq) {
            const bf16x8 fa = *(const bf16x8*)(A2 + (size_t)(wid * 16 + fr) * 2048 + ksl * 128 + kq * 32 + fq * 8);
#pragma unroll
            for (int ct = 0; ct < 4; ++ct) { const bf16x8 fb = *(const bf16x8*)(W + (size_t)(nt * 64 + ct * 16 + fr) * 2048 + ksl * 128 + kq * 32 + fq * 8); acc[ct] = MFMA16(fa, fb, acc[ct]); }
        }
#pragma unroll
        for (int ct = 0; ct < 4; ++ct)
#pragma unroll
            for (int jj = 0; jj < 4; ++jj) PART[((size_t)ksl * TS + wid * 16 + fq * 4 + jj) * 1024 + nt * 64 + ct * 16 + fr] = acc[ct][jj];
    }
}

__device__ void phase_post(const Params& p, int l) {
    const int tid_ = tid_l(); const int lane = tid_ & 63, wid = tid_ >> 6;
    const bf16_t* P = (const bf16_t*)(p.ws + WS_P);
    const float* ORAW = (const float*)(p.ws + WS_ORAW);
    const bf16_t* BV = (const bf16_t*)(p.ws + WS_BV);
    const bf16_t* YM = (const bf16_t*)(p.ws + WS_YM);
    bf16_t* A2 = (bf16_t*)(p.ws + WS_A);
    const int c0 = lane * 16;
    float lnw[16], lnb[16], gnw[16];
#pragma unroll
    for (int e = 0; e < 16; ++e) { lnw[e] = p.in[I_LNW][l * 1024 + c0 + e]; lnb[e] = p.in[I_LNB][l * 1024 + c0 + e]; gnw[e] = p.in[I_GNW][l * 1024 + c0 + e]; }
    for (int row = blockIdx.x * 8 + wid; row < TALL; row += gridDim.x * 8) {
        const bf16_t* prow = P + (size_t)row * N1;
        float o[16], bv[16], z[16], ym[16];
#pragma unroll
        for (int i = 0; i < 4; ++i) { const float4 t = *(const float4*)(ORAW + (size_t)row * 1024 + c0 + i * 4); o[i * 4] = t.x; o[i * 4 + 1] = t.y; o[i * 4 + 2] = t.z; o[i * 4 + 3] = t.w; }
        unpack8(*(const u32x4*)(BV + (size_t)row * 1024 + c0), bv); unpack8(*(const u32x4*)(BV + (size_t)row * 1024 + c0 + 8), bv + 8);
        unpack8(*(const u32x4*)(prow + C_ZR + c0), z); unpack8(*(const u32x4*)(prow + C_ZR + c0 + 8), z + 8);
        unpack8(*(const u32x4*)(YM + (size_t)row * 1024 + c0), ym); unpack8(*(const u32x4*)(YM + (size_t)row * 1024 + c0 + 8), ym + 8);
        float s = 0.f;
#pragma unroll
        for (int e = 0; e < 16; ++e) s += o[e];
        s += dppf<0xB1>(s); s += dppf<0x4E>(s);
        const float mean = s * (1.0f / 64.0f);
        float v = 0.f;
#pragma unroll
        for (int e = 0; e < 16; ++e) { o[e] -= mean; v += o[e] * o[e]; }
        v += dppf<0xB1>(v); v += dppf<0x4E>(v);
        const float rstd = rsqrtf(v * (1.0f / 64.0f) + 64e-5f);
#pragma unroll
        for (int e = 0; e < 16; ++e) o[e] = (o[e] * rstd * lnw[e] + lnb[e] + bv[e]) * siluf_(z[e]);
        *(u32x4*)(A2 + (size_t)row * 2048 + c0) = pack8(o); *(u32x4*)(A2 + (size_t)row * 2048 + c0 + 8) = pack8(o + 8);
        float ss = 0.f;
#pragma unroll
        for (int e = 0; e < 16; ++e) ss += ym[e] * ym[e];
        ss = red16(ss); ss += __shfl_xor(ss, 16);
        const float rs = rsqrtf(ss * (1.0f / 512.0f) + 1e-5f);
#pragma unroll
        for (int e = 0; e < 16; ++e) ym[e] *= rs * gnw[e];
        *(u32x4*)(A2 + (size_t)row * 2048 + 1024 + c0) = pack8(ym); *(u32x4*)(A2 + (size_t)row * 2048 + 1024 + c0 + 8) = pack8(ym + 8);
        if (row < TP) {
            const int tq = row & 2047;
            if (tq >= 2045) { float* dst = p.out + O_PCONV + (((size_t)l * 8 + (row >> 11)) * 3 + (tq - 2045)) * 1536;
                for (int c = lane; c < 1536; c += 64) dst[c] = bf2f(prow[C_XBC + c]); }
        } else {
            const int i = row - TP; float* dst = p.out + O_SCONV + ((size_t)l * TS + i) * 3 * 1536; const float* src = p.in[I_SCONV] + ((size_t)l * TS + i) * 3 * 1536;
            for (int c = lane; c < 1536; c += 64) { dst[c] = src[1536 + c]; dst[1536 + c] = src[3072 + c]; dst[3072 + c] = bf2f(prow[C_XBC + c]); }
        }
    }
}

constexpr int NPHASE = 13;
__global__ __launch_bounds__(512, 2) void mega(Params p) {
    extern __shared__ __attribute__((aligned(16))) unsigned char smem[];
    cg::grid_group grid = cg::this_grid();
    volatile LAS unsigned* st = (volatile LAS unsigned*)((LAS unsigned char*)smem + LDS_BARST);
    { const unsigned hw = (unsigned)__builtin_amdgcn_s_getreg((5 << 11) | 4) & 63u;
      if ((threadIdx.x & 63) == 0) *(volatile LAS int*)((LAS unsigned char*)smem + LDS_WIDTAB + hw * 4u) = (int)(threadIdx.x >> 6);
      if (threadIdx.x == 0) { st[0] = 0u; st[1] = 0u; } }
    __syncthreads();
    const XcdBarrier xbar = xcd_barrier_post((unsigned*)(p.ws + WS_BAR), st);
    if (p.ph_hi > 1000) grid.sync();
#define PHASE(K, BODY) if (p.ph_lo <= (K) && (K) < p.ph_hi) { if ((K) > p.ph_lo) { xcd_barrier(xbar); if (DUP == 13) { xcd_barrier(xbar); xcd_barrier(xbar); } } BODY }
#define GEMM1(L) { pg8::Gemm g{(const bf16_t*)(p.ws + WS_A), (const bf16_t*)(p.ws + WS_WINT) + (size_t)(L) * N1 * 1024, M1, N1, 1024}; \
        pg8::StaticOrder S; S.init(M1, N1, (int)gridDim.x, (int)blockIdx.x); EpiP E{(bf16_t*)(p.ws + WS_P), N1}; \
        pg8::gemm_phase<EpiP, pg8::StaticOrder, false>((PG8_LAS unsigned char*)smem, g, S, E, nullptr); }
#define GEMM2(L) { sample_outproj(p, (L)); \
        pg8::Gemm g{(const bf16_t*)(p.ws + WS_A), (const bf16_t*)(p.ws + WS_WOUTT) + (size_t)(L) * 1024 * 2048, TP, 1024, 2048}; \
        pg8::StaticOrder S; S.init(TP, 1024, (int)gridDim.x, (int)blockIdx.x); EpiRes E{(L) == 0 ? p.in[I_XP] : p.out + O_YP, p.out + O_YP}; \
        pg8::gemm_phase<EpiRes, pg8::StaticOrder, false>((PG8_LAS unsigned char*)smem, g, S, E, nullptr); }
    PHASE(0, phase_convert(p, smem); phase_norm(p, 0);)
    PHASE(1, GEMM1(0))
    PHASE(2, phase_mixa(p, 0, smem);)
    PHASE(3, phase_mixb(p, 0, smem);)
    PHASE(4, phase_post(p, 0);)
    PHASE(5, GEMM2(0))
    PHASE(6, phase_norm(p, 1);)
    PHASE(7, GEMM1(1))
    PHASE(8, phase_mixa(p, 1, smem);)
    PHASE(9, phase_mixb(p, 1, smem);)
    PHASE(10, phase_post(p, 1);)
    PHASE(11, GEMM2(1))
    PHASE(12, phase_final(p);)
}

extern "C" void kernel_launch(void* const* d_in, const int* in_sizes, int n_in, void* d_out, int out_size, void* d_ws, size_t ws_size, hipStream_t stream) {
    static int grid = 0;
    if (grid == 0) {
        if (n_in != 26 || (size_t)out_size != O_END || ws_size < WS_BAR + (size_t)(XCD_BAR_WORDS + 128) * 4) { fprintf(stderr, "kernel_launch: unexpected shapes: n_in %d out %d ws %zu (need %zu)\n", n_in, out_size, ws_size, (size_t)(WS_BAR + XCD_BAR_WORDS * 4)); grid = -1; return; }
        int dev = 0, cus = 0, per_cu = 0;
        hipGetDevice(&dev); hipDeviceGetAttribute(&cus, hipDeviceAttributeMultiprocessorCount, dev);
        if (hipFuncSetAttribute((const void*)mega, hipFuncAttributeMaxDynamicSharedMemorySize, LDS_BYTES) != hipSuccess) { fprintf(stderr, "kernel_launch: hipFuncSetAttribute failed\n"); grid = -1; return; }
        if (hipOccupancyMaxActiveBlocksPerMultiprocessor(&per_cu, (const void*)mega, 512, LDS_BYTES) != hipSuccess || per_cu < 1) { fprintf(stderr, "kernel_launch: occupancy query gave %d\n", per_cu); per_cu = 1; }
        (void)hipGetLastError();
        grid = cus * 1;
    }
    if (grid < 0) return;
    if (hipMemsetAsync((char*)d_ws + WS_BAR, 0, (size_t)(XCD_BAR_WORDS + 128) * 4, stream) != hipSuccess) { fprintf(stderr, "kernel_launch: memset of barrier words failed\n"); return; }
    Params p{};
    for (int i = 0; i < 26; ++i) p.in[i] = (const float*)d_in[i];
    p.out = (float*)d_out; p.ws = (unsigned char*)d_ws;
#if MK_PER_PHASE
    for (int ph = 0; ph < NPHASE; ++ph) { p.ph_lo = ph; p.ph_hi = ph + 1; hipLaunchKernelGGL(mega, dim3(grid), dim3(512), LDS_BYTES, stream, p); }
#else
    p.ph_lo = 0; p.ph_hi = NPHASE;
    void* args[] = {&p};
    hipError_t e = hipLaunchCooperativeKernel((const void*)mega, dim3(grid), dim3(512), args, LDS_BYTES, stream);
    if (e != hipSuccess) fprintf(stderr, "cooperative launch failed: %s (grid %d)\n", hipGetErrorString(e), grid);
#endif
}
```

```cpp
#include <hip/hip_runtime.h>
#include <hip/hip_cooperative_groups.h>
#include <cstdio>
namespace cg = cooperative_groups;

#define LDS_WIDTAB 163328
__device__ __forceinline__ int tid_l() {
    const unsigned hw = (unsigned)__builtin_amdgcn_s_getreg((5 << 11) | 4) & 63u;
    const int wid = *(volatile __attribute__((address_space(3))) int*)(unsigned long)(LDS_WIDTAB + hw * 4u);
    int ln; asm volatile("v_mbcnt_lo_u32_b32 %0, -1, 0\n\tv_mbcnt_hi_u32_b32 %0, -1, %0" : "=v"(ln));
    return __builtin_amdgcn_readfirstlane(wid) * 64 + ln; }
namespace pg8 {
#define PG8_LAS __attribute__((address_space(3)))
typedef unsigned short bf16_t;
typedef short bf16x8 __attribute__((ext_vector_type(8)));
typedef float f32x4 __attribute__((ext_vector_type(4)));
typedef unsigned u32x4 __attribute__((ext_vector_type(4)));
constexpr int BM = 256, BK = 64, HALF = 128, HTB = HALF * BK * 2  , STAGE_BYTES = 8 * HTB, NXCD = 8, WGM = 8;

__host__ __device__ __forceinline__ int lds_byte(int r, int c) { const int st = (r >> 4) * 2 + (c >> 5), rr = r & 15, cc = c & 31, ob = rr * 64 + cc * 2; return st * 1024 + (ob ^ (((ob >> 9) & 1) << 5)); }
__host__ __device__ __forceinline__ void stage_rc(int b, int& R, int& C) { const int st = b / 1024, sb = b % 1024, swz = sb ^ (((sb >> 9) & 1) << 5); R = (st >> 1) * 16 + swz / 64; C = (st & 1) * 32 + (swz % 64) / 2; }
__host__ __device__ __forceinline__ int perm32(int rho) { const int n = rho >> 4, i = rho & 15; return 8 * (i >> 2) + 4 * n + (i & 3); }

struct Unit { int pm, pn; };
struct Gemm { const bf16_t* A; const bf16_t* Bt; int M, N, K; };

struct StaticOrder {
    int nM, nN, nwg, G, c;
    __host__ __device__ void init(int M, int N, int G_, int c_) { nM = M / BM; nN = N / BM; nwg = nM * nN; G = G_; c = c_; }
    __host__ __device__ bool next(int i, Unit& u) const {
        const long L = (long)i * G + c; if (L >= nwg) return false;
        int wgid = (int)L; { const int q = nwg / NXCD, r = nwg % NXCD, xcd = wgid % NXCD, off = wgid / NXCD; wgid = (xcd < r ? xcd * (q + 1) : r * (q + 1) + (xcd - r) * q) + off; }
        const int nig = WGM * nN, gid = wgid / nig, fm = gid * WGM, gsz = (nM - fm) < WGM ? (nM - fm) : WGM;
        u.pm = fm + ((wgid % nig) % gsz); u.pn = (wgid % nig) / gsz; return true;
    }
    __device__ __forceinline__ void a_ready(const Unit&) const {}
    __device__ __forceinline__ void done(const Unit&) const {}
};
__device__ __forceinline__ unsigned cvt_pk_bf16(float lo, float hi) { unsigned r; asm volatile("v_cvt_pk_bf16_f32 %0, %1, %2" : "=v"(r) : "v"(lo), "v"(hi)); return r; }
template <class Epi, class Sched, bool STAMP = false>
__device__ __forceinline__ void gemm_phase(PG8_LAS unsigned char* lds, const Gemm g, const Sched& S, const Epi& E, unsigned long long* stamps) {
    const int tid = tid_l(), wid = __builtin_amdgcn_readfirstlane(tid >> 6), lane = tid & 63, wr = wid >> 2, wc = wid & 3, fr = lane & 15, fq = lane >> 4;
    const int K = g.K, nt = K / BK;
    int ts_lo = 0, ts_hi = 0, nts = 0; const unsigned long long rt_entry = STAMP ? (unsigned long long)wall_clock64() : 0ull;
#define PG8_STAMP() do { if (STAMP && wid == 0 && nts < 64) { const unsigned long long _c = (unsigned long long)clock64(); \
        ts_lo = (lane == nts) ? (int)(unsigned)_c : ts_lo; ts_hi = (lane == nts) ? (int)(unsigned)(_c >> 32) : ts_hi; ++nts; } } while (0)
    PG8_STAMP();
    unsigned voffA[2], voffB[2];
#pragma unroll
    for (int i = 0; i < 2; ++i) { int R, C; stage_rc(tid * 16 + i * 8192, R, C); const int Rb = Epi::PERM ? ((R & ~31) + perm32(R & 31)) : R;
        voffA[i] = (unsigned)(R * K + C) * 2u; voffB[i] = (unsigned)(Rb * K + C) * 2u; }
    const size_t kstep = (size_t)(BK * 2);
    const size_t hstep = (size_t)HALF * K * 2;
    const size_t tstep = 2 * hstep;
    const unsigned ldsw = (unsigned)wid * 1024u;
    const int aoff = lds_byte(wr * 64 + fr, fq * 8), boff = lds_byte(wc * 32 + fr, fq * 8);
#define PG8_SA(b, h) (((b) * 2 + (h)) * HTB)
#define PG8_SB(b, h) ((4 + (b) * 2 + (h)) * HTB)
#define PG8_STAGE(bufoff, gbase, voff) do { _Pragma("unroll") for (int _i = 0; _i < 2; ++_i) \
        __builtin_amdgcn_global_load_lds((const unsigned*)((const char*)(gbase) + (voff)[_i]), (PG8_LAS unsigned*)(lds + (bufoff) + ldsw + _i * 8192), 16, 0, 0); } while (0)
#define PG8_LDA(dst, b, h) do { _Pragma("unroll") for (int m = 0; m < 4; ++m) _Pragma("unroll") for (int k = 0; k < 2; ++k) dst[m][k] = *(const PG8_LAS bf16x8*)(lds + PG8_SA(b, h) + aoff + m * 2048 + k * 1024); } while (0)
#define PG8_LDB(dst, b, h) do { _Pragma("unroll") for (int n = 0; n < 2; ++n) _Pragma("unroll") for (int k = 0; k < 2; ++k) dst[n][k] = *(const PG8_LAS bf16x8*)(lds + PG8_SB(b, h) + boff + n * 2048 + k * 1024); } while (0)
#define PG8_MMA(ai, bj, At, Bt) do { __builtin_amdgcn_s_setprio(1); _Pragma("unroll") for (int m = 0; m < 4; ++m) _Pragma("unroll") for (int n = 0; n < 2; ++n) _Pragma("unroll") for (int k = 0; k < 2; ++k) \
        acc[ai][bj][m][n] = __builtin_amdgcn_mfma_f32_16x16x32_bf16(Bt[n][k], At[m][k], acc[ai][bj][m][n], 0, 0, 0); __builtin_amdgcn_s_setprio(0); } while (0)
#define PG8_WAIT_V(n) asm volatile("s_waitcnt vmcnt(" #n ")" ::: "memory")
#define PG8_WAIT_L(n) asm volatile("s_waitcnt lgkmcnt(" #n ")" ::: "memory")
#define PG8_BAR __builtin_amdgcn_s_barrier()
#define PG8_SCHED __builtin_amdgcn_sched_barrier(0)
    Unit cur, nxt; int ui = 0;
    if (!S.next(0, cur)) return;
    f32x4 acc[2][2][4][2];
#pragma unroll
    for (int a = 0; a < 2; ++a)
#pragma unroll
        for (int b = 0; b < 2; ++b)
#pragma unroll
            for (int m = 0; m < 4; ++m)
#pragma unroll
                for (int n = 0; n < 2; ++n) acc[a][b][m][n] = (f32x4){0.f, 0.f, 0.f, 0.f};
    bf16x8 At[4][2], B0[2][2], B1[2][2];
    const char* cA = (const char*)g.A + (size_t)cur.pm * tstep; const char* cB = (const char*)g.Bt + (size_t)cur.pn * tstep;
    S.a_ready(cur);
    PG8_STAGE(PG8_SB(0, 0), cB, voffB); PG8_STAGE(PG8_SA(0, 0), cA, voffA); PG8_STAGE(PG8_SB(0, 1), cB + hstep, voffB); PG8_STAGE(PG8_SA(0, 1), cA + hstep, voffA);
    if (wr == 1) PG8_BAR;
    PG8_WAIT_V(4); PG8_BAR;
    PG8_STAGE(PG8_SB(1, 0), cB + kstep, voffB); PG8_STAGE(PG8_SA(1, 0), cA + kstep, voffA); PG8_STAGE(PG8_SB(1, 1), cB + hstep + kstep, voffB);
    PG8_WAIT_V(6); PG8_BAR;
    PG8_STAMP();
    for (;;) {
        const bool has_next = S.next(ui + 1, nxt);
        const char* nA = has_next ? (const char*)g.A + (size_t)nxt.pm * tstep : cA; const char* nB = has_next ? (const char*)g.Bt + (size_t)nxt.pn * tstep : cB;
        for (int t = 0; t < nt; t += 2) {
            const bool last = (t == nt - 2);
            const char* a1 = cA + (size_t)(t + 1) * kstep;
            const char* a2 = last ? nA : cA + (size_t)(t + 2) * kstep; const char* b2 = last ? nB : cB + (size_t)(t + 2) * kstep;
            const char* a3 = a2 + kstep; const char* b3 = b2 + kstep;
            if (last && has_next) S.a_ready(nxt);
            PG8_LDB(B0, 0, 0); PG8_SCHED; PG8_LDA(At, 0, 0); PG8_STAGE(PG8_SA(1, 1), a1 + hstep, voffA);
            PG8_WAIT_L(8); PG8_BAR; PG8_WAIT_L(0); PG8_MMA(0, 0, At, B0); PG8_BAR; PG8_SCHED;
            PG8_LDB(B1, 0, 1); PG8_STAGE(PG8_SB(0, 0), b2, voffB);
            PG8_BAR; PG8_WAIT_L(0); PG8_MMA(0, 1, At, B1); PG8_BAR;
            PG8_LDA(At, 0, 1); PG8_STAGE(PG8_SA(0, 0), a2, voffA);
            PG8_BAR; PG8_WAIT_L(0); PG8_MMA(1, 0, At, B0); PG8_BAR; PG8_SCHED;
            PG8_STAGE(PG8_SB(0, 1), b2 + hstep, voffB);
            PG8_WAIT_V(6); PG8_BAR; PG8_MMA(1, 1, At, B1); PG8_BAR;
            PG8_LDB(B0, 1, 0); PG8_SCHED; PG8_LDA(At, 1, 0); PG8_STAGE(PG8_SA(0, 1), a2 + hstep, voffA);
            PG8_WAIT_L(8); PG8_BAR; PG8_WAIT_L(0); PG8_MMA(0, 0, At, B0); PG8_BAR; PG8_SCHED;
            PG8_LDB(B1, 1, 1); PG8_STAGE(PG8_SB(1, 0), b3, voffB);
            PG8_BAR; PG8_WAIT_L(0); PG8_MMA(0, 1, At, B1); PG8_BAR;
            PG8_LDA(At, 1, 1); PG8_STAGE(PG8_SA(1, 0), a3, voffA);
            PG8_BAR; PG8_WAIT_L(0); PG8_MMA(1, 0, At, B0); PG8_BAR; PG8_SCHED;
            PG8_STAGE(PG8_SB(1, 1), b3 + hstep, voffB);
            PG8_WAIT_V(6); PG8_BAR; PG8_MMA(1, 1, At, B1); PG8_BAR;
        }
        PG8_STAMP();
        if constexpr (!Epi::AFTER_DRAIN) { E(acc, cur, wr, wc, fr, fq); S.done(cur); }
        PG8_STAMP();
        if (!has_next) break;
#pragma unroll
        for (int a = 0; a < 2; ++a)
#pragma unroll
            for (int b = 0; b < 2; ++b)
#pragma unroll
                for (int m = 0; m < 4; ++m)
#pragma unroll
                    for (int n = 0; n < 2; ++n) acc[a][b][m][n] = (f32x4){0.f, 0.f, 0.f, 0.f};
        cur = nxt; cA = nA; cB = nB; ++ui;
    }
    PG8_WAIT_V(0);
    if (wr == 0) PG8_BAR;
    PG8_BAR;
    if constexpr (Epi::AFTER_DRAIN) { E.fused(acc, cur, wr, wc, fr, fq, lds, wid, lane); S.done(cur); }
    PG8_STAMP();
    if (STAMP && wid == 0) { stamps[lane] = lane < nts ? (((unsigned long long)(unsigned)ts_hi << 32) | (unsigned)ts_lo) : 0ull;
        if (lane == 62) stamps[62] = rt_entry; if (lane == 63) stamps[63] = (unsigned long long)wall_clock64(); }
#undef PG8_STAMP
#undef PG8_SA
#undef PG8_SB
#undef PG8_STAGE
#undef PG8_LDA
#undef PG8_LDB
#undef PG8_MMA
#undef PG8_WAIT_V
#undef PG8_WAIT_L
#undef PG8_BAR
#undef PG8_SCHED
}
}

#define XB_TMO      128
#define XB_XCNT(j)  (256  + 64 * (j))
#define XB_XSUB(j)  (1280 + 64 * (j))
#define XB_XGEN(j)  (2304 + 64 * (j))
#define XB_TOP      3328
#define XB_TOPGEN   3392
#define XCD_BAR_WORDS 3456
#define XB_SPIN_CAP (1u << 18)
#define LAS __attribute__((address_space(3)))

__device__ __forceinline__ unsigned xb_ld(unsigned* p)              { return __hip_atomic_load(p, __ATOMIC_RELAXED, __HIP_MEMORY_SCOPE_AGENT); }
__device__ __forceinline__ unsigned xb_add(unsigned* p, unsigned v) { return __hip_atomic_fetch_add(p, v, __ATOMIC_RELAXED, __HIP_MEMORY_SCOPE_AGENT); }
__device__ __forceinline__ unsigned xb_xcc_id() { return (unsigned)__builtin_amdgcn_s_getreg((3 << 11) | 20) & 0xFu; }
#define XB_SPIN(cond, bar) do { unsigned _sp = 0; while (cond) { __builtin_amdgcn_s_sleep(1); \
    if ((++_sp & 255u) == 0u) { if (xb_ld(&(bar)[XB_TMO])) break; if (_sp > XB_SPIN_CAP) { atomicAdd(&(bar)[XB_TMO], 1u); break; } } } } while (0)
struct XcdBarrier {
    unsigned* bar; unsigned x;
    volatile LAS unsigned* st;
};

__device__ __forceinline__ XcdBarrier xcd_barrier_post(unsigned* bar, volatile LAS unsigned* st) {
    XcdBarrier b; b.bar = bar; b.x = xb_xcc_id(); b.st = st;
    if (tid_l() == 0) (void)xb_add(&bar[XB_XCNT(b.x)], 1u);
    return b;
}
__device__ __forceinline__ void xcd_barrier_complete(unsigned* bar, unsigned x, unsigned& nloc, unsigned& nx) {
    const unsigned G = gridDim.x * gridDim.y * gridDim.z;
    unsigned sum, cnt, mine, sp = 0u;
    for (;;) {
        sum = 0u; cnt = 0u; mine = 0u;
#pragma unroll
        for (unsigned j = 0; j < 16; ++j) { const unsigned c = xb_ld(&bar[XB_XCNT(j)]); sum += c; cnt += (c > 0u) ? 1u : 0u; mine = (j == x) ? c : mine; }
        if (sum == G) break;
        __builtin_amdgcn_s_sleep(1);
        if ((++sp & 255u) == 0u) { if (xb_ld(&bar[XB_TMO])) break; if (sp > XB_SPIN_CAP) { atomicAdd(&bar[XB_TMO], 1u); break; } }
    }
    nloc = mine > 0u ? mine : 1u; nx = cnt > 0u ? cnt : 1u;
}

__device__ __forceinline__ void xcd_barrier(const XcdBarrier& b) {
    asm volatile("s_waitcnt vmcnt(0)" ::: "memory");
    __syncthreads();
    if (tid_l() == 0) {
        unsigned* bar = b.bar;
        __builtin_amdgcn_s_waitcnt(0);
        unsigned nloc = b.st[0], nx = b.st[1];
        if (nloc == 0u) { xcd_barrier_complete(bar, b.x, nloc, nx); b.st[0] = nloc; b.st[1] = nx; }
        const unsigned old = xb_add(&bar[XB_XSUB(b.x)], 1u);
        const unsigned gen = old / nloc;
        if (old + 1u == (gen + 1u) * nloc) {
            __builtin_amdgcn_fence(__ATOMIC_RELEASE, "agent");
            asm volatile("s_waitcnt vmcnt(0)" ::: "memory");
            const unsigned og = xb_add(&bar[XB_TOP], 1u);
            const unsigned tg = og / nx;
            if (og + 1u == (tg + 1u) * nx) xb_add(&bar[XB_TOPGEN], 1u);
            else XB_SPIN(xb_ld(&bar[XB_TOPGEN]) == tg, bar);
            __builtin_amdgcn_fence(__ATOMIC_ACQUIRE, "agent");
            xb_add(&bar[XB_XGEN(b.x)], 1u);
            asm volatile("s_waitcnt vmcnt(0)" ::: "memory");
        } else {
            XB_SPIN(xb_ld(&bar[XB_XGEN(b.x)]) == gen, bar);
            __builtin_amdgcn_fence(__ATOMIC_ACQUIRE, "agent");
            asm volatile("s_waitcnt vmcnt(0)" ::: "memory");
        }
    }
    __syncthreads();
}

typedef unsigned short bf16_t;
typedef short bf16x8 __attribute__((ext_vector_type(8)));
typedef float f32x4 __attribute__((ext_vector_type(4)));
typedef unsigned u32x4 __attribute__((ext_vector_type(4)));
typedef unsigned u32x2 __attribute__((ext_vector_type(2)));

#ifndef DUP
#define DUP 0
#endif
#ifndef MK_PER_PHASE
#define MK_PER_PHASE 0
#endif

constexpr int TP = 16384, TS = 128, TALL = 16512, M1 = 16640, N1 = 6912, NIN = 6800;
constexpr int C_R = 0, C_K = 1024, C_V = 2048, C_WL = 3072, C_AL = 3136, C_ZR = 3200, C_ZM = 4224, C_XBC = 5248, C_DT = 6784;
constexpr size_t O_YP = 0, O_YS = 16777216, O_PSH = 16908288, O_PWKV = 16924672, O_PCONV = 17973248, O_PSSM = 18046976,
                 O_SSH = 20144128, O_SWKV = 20406272, O_SCONV = 37183488, O_SSSM = 38363136, O_END = 71917568;
constexpr size_t WS_WINT = 0;
constexpr size_t WS_WOUTT = WS_WINT + (size_t)2 * N1 * 1024 * 2;
constexpr size_t WS_A = WS_WOUTT + (size_t)2 * 1024 * 2048 * 2;
constexpr size_t WS_P = WS_A + (size_t)M1 * 2048 * 2;
constexpr size_t WS_ORAW = WS_P + (size_t)M1 * N1 * 2;
constexpr size_t WS_BV = WS_ORAW + (size_t)TALL * 1024 * 4;
constexpr size_t WS_YM = WS_BV + (size_t)TALL * 1024 * 2;
constexpr size_t WS_END = WS_YM + (size_t)TALL * 1024 * 2;
constexpr size_t WS_U = WS_A;
constexpr size_t WS_DT = WS_U + (size_t)TP * 1536 * 2;
constexpr size_t WS_PART = WS_ORAW;
constexpr size_t WS_BAR = (WS_END + 4095) & ~(size_t)4095;
constexpr int LDS_BYTES = 163840, LDS_BARST = 163824;

struct Params { const float* in[26]; float* out; unsigned char* ws; int ph_lo, ph_hi; };
enum { I_XP = 0, I_XS, I_SSHIFT, I_SWKV, I_SCONV, I_SSSM, I_NORMW, I_WIN, I_MU, I_W0, I_W2, I_A0, I_A2, I_KK, I_KA, I_RK, I_LNW, I_LNB, I_CW, I_CB, I_DTB, I_ALOG, I_DSK, I_GNW, I_WOUT, I_FNW };

__device__ __forceinline__ float bf2f(unsigned short b) { return __uint_as_float(((unsigned)b) << 16); }
__device__ __forceinline__ unsigned short f2bf(float f) { unsigned u = __float_as_uint(f); u += 0x7FFFu + ((u >> 16) & 1u); return (unsigned short)(u >> 16); }
__device__ __forceinline__ unsigned pk2(float lo, float hi) { return (unsigned)f2bf(lo) | ((unsigned)f2bf(hi) << 16); }
__device__ __forceinline__ void unpack8(const u32x4 v, float* f) {
    f[0] = __uint_as_float(v.x << 16); f[1] = __uint_as_float(v.x & 0xffff0000u); f[2] = __uint_as_float(v.y << 16); f[3] = __uint_as_float(v.y & 0xffff0000u);
    f[4] = __uint_as_float(v.z << 16); f[5] = __uint_as_float(v.z & 0xffff0000u); f[6] = __uint_as_float(v.w << 16); f[7] = __uint_as_float(v.w & 0xffff0000u); }
__device__ __forceinline__ u32x4 pack8(const float* f) { u32x4 r; r.x = pk2(f[0], f[1]); r.y = pk2(f[2], f[3]); r.z = pk2(f[4], f[5]); r.w = pk2(f[6], f[7]); return r; }
__device__ __forceinline__ float frcp(float x) { return __builtin_amdgcn_rcpf(x); }
__device__ __forceinline__ float sigmoidf_(float x) { return frcp(1.0f + __expf(-x)); }
__device__ __forceinline__ float siluf_(float x) { return x * frcp(1.0f + __expf(-x)); }
__device__ __forceinline__ float softplusf_(float x) { return x > 20.f ? x : log1pf(__expf(x)); }
template <int CTRL> __device__ __forceinline__ float dppf(float v) { return __int_as_float(__builtin_amdgcn_mov_dpp(__float_as_int(v), CTRL, 0xF, 0xF, true)); }
__device__ __forceinline__ float red8(float x) { x += dppf<0xB1>(x); x += dppf<0x4E>(x); x += dppf<0x141>(x); return x; }
__device__ __forceinline__ float red16(float x) { x = red8(x); x += dppf<0x140>(x); return x; }
__device__ __forceinline__ float wave_sum(float x) {
#pragma unroll
    for (int o = 32; o > 0; o >>= 1) x += __shfl_xor(x, o);
    return x; }
__device__ __forceinline__ void lds_fence() { asm volatile("s_waitcnt lgkmcnt(0)" ::: "memory"); }
__device__ __forceinline__ unsigned char* launder_lds(unsigned char* sm) { int off = 0; asm volatile("" : "+s"(off)); return sm + off; }
#define LBAR() do { asm volatile("s_waitcnt lgkmcnt(0)" ::: "memory"); __builtin_amdgcn_s_barrier(); asm volatile("" ::: "memory"); } while (0)
#define MFMA16(a, b, c) __builtin_amdgcn_mfma_f32_16x16x32_bf16((a), (b), (c), 0, 0, 0)

__device__ void phase_convert(const Params& p, unsigned char* smem_) {
    unsigned char* smem = launder_lds(smem_);
    float* tile = (float*)smem;
    const int tid = tid_l();
    constexpr int NT_IN = 16 * 108, NT_OUT = 32 * 16, PER_L = NT_IN + NT_OUT;
    for (int it = blockIdx.x; it < 2 * PER_L; it += gridDim.x) {
        const int l = it / PER_L; int r = it % PER_L;
        const float* src; bf16_t* dst; int K, Nsrc, kt, nt;
        if (r < NT_IN) { src = p.in[I_WIN] + (size_t)l * 1024 * NIN; dst = (bf16_t*)(p.ws + WS_WINT) + (size_t)l * N1 * 1024; K = 1024; Nsrc = NIN; kt = r & 15; nt = r >> 4; }
        else { r -= NT_IN; src = p.in[I_WOUT] + (size_t)l * 2048 * 1024; dst = (bf16_t*)(p.ws + WS_WOUTT) + (size_t)l * 1024 * 2048; K = 2048; Nsrc = 1024; kt = r & 31; nt = r >> 5; }
#pragma unroll
        for (int i = 0; i < 2; ++i) {
            const int rr = (tid >> 4) + 32 * i, c4 = (tid & 15) * 4, col = nt * 64 + c4;
            float4 v = make_float4(0.f, 0.f, 0.f, 0.f);
            if (col < Nsrc) v = *(const float4*)(src + (size_t)(kt * 64 + rr) * Nsrc + col);
            float* tp = tile + rr * 65 + c4; tp[0] = v.x; tp[1] = v.y; tp[2] = v.z; tp[3] = v.w;
        }
        __syncthreads();
        { const int n = tid >> 3, k8 = (tid & 7) * 8; float f[8];
#pragma unroll
          for (int j = 0; j < 8; ++j) f[j] = tile[(k8 + j) * 65 + n];
          *(u32x4*)(dst + (size_t)(nt * 64 + n) * K + kt * 64 + k8) = pack8(f); }
        __syncthreads();
    }
}

__device__ void phase_norm(const Params& p, int l) {
    const int tid_ = tid_l(); const int lane = tid_ & 63, wid = tid_ >> 6;
    bf16_t* A1 = (bf16_t*)(p.ws + WS_A);
    const float* nw = p.in[I_NORMW] + l * 1024;
    for (int row = blockIdx.x * 8 + wid; row < M1; row += gridDim.x * 8) {
        const float* src;
        if (row < TP) src = (l == 0 ? p.in[I_XP] : p.out + O_YP) + (size_t)row * 1024;
        else if (row < TALL) src = (l == 0 ? p.in[I_XS] : p.out + O_YS) + (size_t)(row - TP) * 1024;
        else src = p.in[I_SSHIFT] + ((size_t)l * TS + (row - TALL)) * 1024;
        float4 v[4]; float ss = 0.f;
#pragma unroll
        for (int i = 0; i < 4; ++i) v[i] = *(const float4*)(src + i * 256 + lane * 4);
        if (l == 1 && row >= TP && row < TALL) {
            const float* x0 = p.in[I_XS] + (size_t)(row - TP) * 1024; const float* pt = (const float*)(p.ws + WS_PART) + (size_t)(row - TP) * 1024;
#pragma unroll
            for (int i = 0; i < 4; ++i) { float4 a = *(const float4*)(x0 + i * 256 + lane * 4);
                for (int q = 0; q < 16; ++q) { const float4 t = *(const float4*)(pt + (size_t)q * TS * 1024 + i * 256 + lane * 4); a.x += t.x; a.y += t.y; a.z += t.z; a.w += t.w; }
                v[i] = a; *(float4*)(p.out + O_YS + (size_t)(row - TP) * 1024 + i * 256 + lane * 4) = a; }
        }
#pragma unroll
        for (int i = 0; i < 4; ++i) ss += v[i].x * v[i].x + v[i].y * v[i].y + v[i].z * v[i].z + v[i].w * v[i].w;
        if (row < TALL) {
            ss = wave_sum(ss);
            const float rs = rsqrtf(ss * (1.0f / 1024.0f) + 1e-5f);
#pragma unroll
            for (int i = 0; i < 4; ++i) { const float4 w = *(const float4*)(nw + i * 256 + lane * 4); v[i].x *= rs * w.x; v[i].y *= rs * w.y; v[i].z *= rs * w.z; v[i].w *= rs * w.w; }
            float* so = nullptr;
            if (row < TP) { if ((row & 2047) == 2047) so = p.out + O_PSH + ((size_t)l * 8 + (row >> 11)) * 1024; }
            else so = p.out + O_SSH + ((size_t)l * TS + (row - TP)) * 1024;
            if (so) {
#pragma unroll
                for (int i = 0; i < 4; ++i) *(float4*)(so + i * 256 + lane * 4) = v[i]; }
        }
#pragma unroll
        for (int i = 0; i < 4; ++i) { u32x2 w; w.x = pk2(v[i].x, v[i].y); w.y = pk2(v[i].z, v[i].w); *(u32x2*)(A1 + (size_t)row * 1024 + i * 256 + lane * 4) = w; }
    }
}

__device__ void phase_final(const Params& p) {
    const int tid_ = tid_l(); const int lane = tid_ & 63, wid = tid_ >> 6;
    const float* nw = p.in[I_FNW];
    for (int row = blockIdx.x * 8 + wid; row < TALL; row += gridDim.x * 8) {
        float* src = (row < TP) ? p.out + O_YP + (size_t)row * 1024 : p.out + O_YS + (size_t)(row - TP) * 1024;
        float4 v[4]; float ss = 0.f;
#pragma unroll
        for (int i = 0; i < 4; ++i) v[i] = *(const float4*)(src + i * 256 + lane * 4);
        if (row >= TP) { const float* pt = (const float*)(p.ws + WS_PART) + (size_t)(row - TP) * 1024;
#pragma unroll
            for (int i = 0; i < 4; ++i) for (int q = 0; q < 16; ++q) { const float4 t = *(const float4*)(pt + (size_t)q * TS * 1024 + i * 256 + lane * 4); v[i].x += t.x; v[i].y += t.y; v[i].z += t.z; v[i].w += t.w; } }
#pragma unroll
        for (int i = 0; i < 4; ++i) ss += v[i].x * v[i].x + v[i].y * v[i].y + v[i].z * v[i].z + v[i].w * v[i].w;
        ss = wave_sum(ss);
        const float rs = rsqrtf(ss * (1.0f / 1024.0f) + 1e-5f);
#pragma unroll
        for (int i = 0; i < 4; ++i) { const float4 w = *(const float4*)(nw + i * 256 + lane * 4); v[i].x *= rs * w.x; v[i].y *= rs * w.y; v[i].z *= rs * w.z; v[i].w *= rs * w.w;
            *(float4*)(src + i * 256 + lane * 4) = v[i]; }
    }
}

struct EpiP {
    static constexpr bool PERM = true, AFTER_DRAIN = false;
    bf16_t* O; int ldc;
    __device__ __forceinline__ void operator()(const f32x4 (&acc)[2][2][4][2], const pg8::Unit& u, int wr, int wc, int fr, int fq) const {
        const int row0 = u.pm * 256 + wr * 64 + fr, col0 = u.pn * 256 + wc * 32 + 8 * fq;
#pragma unroll
        for (int ai = 0; ai < 2; ++ai)
#pragma unroll
            for (int m = 0; m < 4; ++m) { bf16_t* rowp = O + (size_t)(row0 + ai * 128 + m * 16) * ldc + col0;
#pragma unroll
                for (int bj = 0; bj < 2; ++bj) { const f32x4 v0 = acc[ai][bj][m][0], v1 = acc[ai][bj][m][1];
                    u32x4 w; w.x = pg8::cvt_pk_bf16(v0[0], v0[1]); w.y = pg8::cvt_pk_bf16(v0[2], v0[3]); w.z = pg8::cvt_pk_bf16(v1[0], v1[1]); w.w = pg8::cvt_pk_bf16(v1[2], v1[3]);
                    *(u32x4*)(rowp + bj * 128) = w; } }
    }
};
struct EpiRes {
    static constexpr bool PERM = false, AFTER_DRAIN = false;
    const float* res_p; float* out_p;
    __device__ __forceinline__ void operator()(const f32x4 (&acc)[2][2][4][2], const pg8::Unit& u, int wr, int wc, int fr, int fq) const {
        const int row0 = u.pm * 256 + wr * 64 + fr, col0 = u.pn * 256 + wc * 32 + 4 * fq;
#pragma unroll
        for (int ai = 0; ai < 2; ++ai)
#pragma unroll
            for (int m = 0; m < 4; ++m) { const size_t ro = (size_t)(row0 + ai * 128 + m * 16) * 1024;
#pragma unroll
                for (int bj = 0; bj < 2; ++bj)
#pragma unroll
                    for (int n = 0; n < 2; ++n) { const int c = col0 + bj * 128 + n * 16; const f32x4 r = *(const f32x4*)(res_p + ro + c); *(f32x4*)(out_p + ro + c) = acc[ai][bj][m][n] + r; } }
    }
};

constexpr int CH_NB = 6, CH_CB = 15104, CH_NH = 5;
constexpr int CB_A1 = 0, CB_A2 = 3328, CB_TT = 6656, CB_ZQ = 7936, CB_ZK = 10240, CB_V = 12544, CB_GQ = 14848;
constexpr int CH_SCR = CH_NB * CH_CB;
constexpr int SCR_TW = 0, SCR_EXL = 4608, SCR_SZ = 8704;
constexpr int CH_W2T = CH_SCR + CH_NH * SCR_SZ;
constexpr int CH_CST = CH_W2T + 18432;
constexpr int CH_FLG = CH_CST + 2560;
__device__ __forceinline__ unsigned cvtpk(float lo, float hi) { return pg8::cvt_pk_bf16(lo, hi); }
__device__ void rwkv_chain_item(const Params& p, int l, int item, unsigned char* smem_) {
    unsigned char* smem = launder_lds(smem_);
    const int tid = tid_l(), wid = tid >> 6, lane = tid & 63, fr = lane & 15, fq = lane >> 4;
    const int b = item >> 4, h = item & 15;
    bf16_t* w2t = (bf16_t*)(smem + CH_W2T); bf16_t* a2t = w2t + 4608;
    float* cst = (float*)(smem + CH_CST);
    volatile LAS unsigned* ready = (volatile LAS unsigned*)((LAS unsigned char*)smem + CH_FLG); volatile LAS unsigned* cons = ready + 128; volatile LAS unsigned* ready2 = ready + 256;
    const bf16_t* P = (const bf16_t*)(p.ws + WS_P);
    float* ORAW = (float*)(p.ws + WS_ORAW);
    bf16_t* BV = (bf16_t*)(p.ws + WS_BV);
    __syncthreads();
    for (int i = tid; i < CH_W2T / 4; i += 512) ((unsigned*)smem)[i] = 0u;
    if (tid < 384) ((unsigned*)(smem + CH_FLG))[tid] = 0u;
    { const float* w2 = p.in[I_W2] + (size_t)l * 64 * 1024 + h * 64; const float* a2 = p.in[I_A2] + (size_t)l * 64 * 1024 + h * 64;
#pragma unroll
      for (int i = 0; i < 8; ++i) { const int idx = tid + 512 * i, k = idx >> 6, n = idx & 63; w2t[n * 72 + k] = f2bf(w2[(size_t)k * 1024 + n]); a2t[n * 72 + k] = f2bf(a2[(size_t)k * 1024 + n]); } }
    if (tid < 64) { const float* mu = p.in[I_MU] + (size_t)l * 3200; const int gc = h * 64 + tid;
        cst[tid] = mu[C_R + gc]; cst[64 + tid] = mu[C_K + gc]; cst[128 + tid] = mu[C_V + gc]; cst[192 + tid] = mu[C_WL + tid]; cst[256 + tid] = mu[C_AL + tid];
        cst[320 + tid] = p.in[I_KK][l * 1024 + gc]; cst[384 + tid] = p.in[I_KA][l * 1024 + gc]; cst[448 + tid] = p.in[I_RK][l * 1024 + gc];
        cst[512 + tid] = p.in[I_W0][l * 1024 + gc]; cst[576 + tid] = p.in[I_A0][l * 1024 + gc]; }
    __syncthreads();

    if (wid >= 3) {
        const int hw = wid - 3, tok = lane >> 2, q4 = lane & 3, c0 = q4 * 16;
        unsigned char* scr = smem + CH_SCR + hw * SCR_SZ;
        bf16_t* tw = (bf16_t*)(scr + SCR_TW); bf16_t* ta = tw + 1152;
        float* exl = (float*)(scr + SCR_EXL);
        const int segcol[5] = {C_R + h * 64 + c0, C_K + h * 64 + c0, C_V + h * 64 + c0, C_WL + c0, C_AL + c0};
        float w0c[4], a0c[4];
#pragma unroll
        for (int ct = 0; ct < 4; ++ct) { w0c[ct] = cst[512 + ct * 16 + fr]; a0c[ct] = cst[576 + ct * 16 + fr]; }
        u32x4 qc[5][2], qp[5][2];
#define CLOAD(C) { const int t_ = (C) * 16 + tok; const bf16_t* pr_ = P + ((size_t)b * 2048 + t_) * N1; \
            _Pragma("unroll") for (int sg = 0; sg < 5; ++sg) _Pragma("unroll") for (int hh = 0; hh < 2; ++hh) { qc[sg][hh] = *(const u32x4*)(pr_ + segcol[sg] + hh * 8); \
                if (t_ > 0) qp[sg][hh] = *(const u32x4*)(pr_ - N1 + segcol[sg] + hh * 8); else qp[sg][hh] = (u32x4){0u, 0u, 0u, 0u}; } }
        CLOAD(hw)
        for (int c = hw; c < 128; c += CH_NH) {
            unsigned char* cb = smem + (c % CH_NB) * CH_CB;
            bf16_t* A1 = (bf16_t*)(cb + CB_A1); bf16_t* A2 = (bf16_t*)(cb + CB_A2); bf16_t* ZQ = (bf16_t*)(cb + CB_ZQ); bf16_t* ZK = (bf16_t*)(cb + CB_ZK); bf16_t* Vn = (bf16_t*)(cb + CB_V); float* GQ = (float*)(cb + CB_GQ);
            const size_t grow = (size_t)b * 2048 + c * 16 + tok;
            if (c >= CH_NB) { while (cons[c - CH_NB] < 2u) __builtin_amdgcn_s_sleep(1); }
            asm volatile("" ::: "memory");
            float* exa = (float*)(cb + CB_ZQ);
            float xr[16], xk[16]; unsigned xvp[8];
            { float cur[8], prv[8], xw[8], xa[8], xv[8];
#pragma unroll
              for (int hh = 0; hh < 2; ++hh) {
#define LSEG(dst, sg, mo) { unpack8(qc[sg][hh], cur); unpack8(qp[sg][hh], prv); _Pragma("unroll") for (int e = 0; e < 8; ++e) dst[e] = cur[e] + (prv[e] - cur[e]) * cst[(mo) + c0 + hh * 8 + e]; }
                LSEG((xr + hh * 8), 0, 0) LSEG((xk + hh * 8), 1, 64) LSEG(xv, 2, 128) LSEG(xw, 3, 192) LSEG(xa, 4, 256)
#undef LSEG
                { const u32x4 pv = pack8(xv); xvp[hh * 4] = pv.x; xvp[hh * 4 + 1] = pv.y; xvp[hh * 4 + 2] = pv.z; xvp[hh * 4 + 3] = pv.w; }
#pragma unroll
                for (int e = 0; e < 8; ++e) xw[e] = 1.0f - 2.0f * frcp(__expf(2.0f * xw[e]) + 1.0f);
                *(u32x4*)(tw + tok * 72 + c0 + hh * 8) = pack8(xw); *(u32x4*)(ta + tok * 72 + c0 + hh * 8) = pack8(xa);
              } }
            if (c + CH_NH < 128) CLOAD(c + CH_NH)
            lds_fence();
#pragma unroll
            for (int ct = 0; ct < 4; ++ct) { f32x4 aw = {0.f, 0.f, 0.f, 0.f}, aa = aw;
#pragma unroll
                for (int ks = 0; ks < 2; ++ks) {
                    aw = MFMA16(*(const bf16x8*)(tw + fr * 72 + ks * 32 + fq * 8), *(const bf16x8*)(w2t + (ct * 16 + fr) * 72 + ks * 32 + fq * 8), aw);
                    aa = MFMA16(*(const bf16x8*)(ta + fr * 72 + ks * 32 + fq * 8), *(const bf16x8*)(a2t + (ct * 16 + fr) * 72 + ks * 32 + fq * 8), aa); }
#pragma unroll
                for (int j = 0; j < 4; ++j) { const int tj = fq * 4 + j, col = ct * 16 + fr;
                    exl[tj * 64 + col] = -0.60653066f * sigmoidf_(w0c[ct] + aw[j]);
                    exa[tj * 64 + col] = sigmoidf_(a0c[ct] + aa[j]); } }
            lds_fence();
            { float lv[16];
#pragma unroll
              for (int t = 0; t < 16; ++t) lv[t] = exl[t * 64 + lane];
              float Lc = 0.f;
#pragma unroll
              for (int t = 0; t < 16; ++t) { Lc += lv[t]; lv[t] = __expf(Lc); }
#pragma unroll
              for (int t = 0; t < 16; ++t) exl[t * 64 + lane] = lv[t];
              GQ[lane] = lv[15]; }
            float a16[16];
#pragma unroll
            for (int i = 0; i < 4; ++i) { const float4 t4 = *(const float4*)(exa + tok * 64 + c0 + i * 4); a16[i * 4] = t4.x; a16[i * 4 + 1] = t4.y; a16[i * 4 + 2] = t4.z; a16[i * 4 + 3] = t4.w; }
            float ssq = 0.f, beta = 0.f;
#pragma unroll
            for (int e = 0; e < 16; ++e) { const float kr_ = xk[e] * cst[320 + c0 + e]; ssq += kr_ * kr_; }
            ssq += dppf<0xB1>(ssq); ssq += dppf<0x4E>(ssq);
            const float inv = frcp(fmaxf(__builtin_amdgcn_sqrtf(ssq), 1e-12f));
            lds_fence();
            {
              *(u32x4*)(Vn + tok * 72 + c0) = (u32x4){xvp[0], xvp[1], xvp[2], xvp[3]}; *(u32x4*)(Vn + tok * 72 + c0 + 8) = (u32x4){xvp[4], xvp[5], xvp[6], xvp[7]};
#pragma unroll
              for (int gI = 0; gI < 4; ++gI) {
                float pt[4], rt[4], qt[4], kt[4];
#pragma unroll
                for (int e3 = 0; e3 < 4; ++e3) { const int e = gI * 4 + e3; const float el = exl[tok * 64 + c0 + e], elm = tok > 0 ? exl[(tok - 1) * 64 + c0 + e] : 1.0f, iv = frcp(el);
                    const float kk_ = xk[e] * cst[320 + c0 + e] * inv, kp_ = xk[e] * (1.0f + (a16[e] - 1.0f) * cst[384 + c0 + e]), bb_ = -kk_ * a16[e];
                    beta += xr[e] * kp_ * cst[448 + c0 + e];
                    pt[e3] = kk_ * elm; rt[e3] = xr[e] * el; qt[e3] = bb_ * iv; kt[e3] = kp_ * iv;
                    }
                const int s0 = (q4 >> 1) * 32 + gI * 8 + (q4 & 1) * 4;
                u32x2 w; w.x = cvtpk(pt[0], pt[1]); w.y = cvtpk(pt[2], pt[3]); *(u32x2*)(A1 + tok * 104 + s0) = w;
                w.x = cvtpk(rt[0], rt[1]); w.y = cvtpk(rt[2], rt[3]); *(u32x2*)(A2 + tok * 104 + s0) = w;
                w.x = cvtpk(qt[0], qt[1]); w.y = cvtpk(qt[2], qt[3]); *(u32x2*)(ZQ + tok * 72 + s0) = w;
                w.x = cvtpk(kt[0], kt[1]); w.y = cvtpk(kt[2], kt[3]); *(u32x2*)(ZK + tok * 72 + s0) = w;
              } }
            beta += dppf<0xB1>(beta); beta += dppf<0x4E>(beta);
            { float bv[16];
#pragma unroll
              for (int e = 0; e < 16; ++e) bv[e] = beta * __uint_as_float((e & 1) ? (xvp[e >> 1] & 0xffff0000u) : (xvp[e >> 1] << 16));
              *(u32x4*)(BV + grow * 1024 + h * 64 + c0) = pack8(bv); *(u32x4*)(BV + grow * 1024 + h * 64 + c0 + 8) = pack8(bv + 8); }
            lds_fence();
            if (lane == 0) ready[c] = 1u;
        }
#undef CLOAD
    } else {
        if (wid == 2) {
            for (int c = 0; c < 128; ++c) {
                unsigned char* cbw = smem + (c % CH_NB) * CH_CB;
                bf16_t* A1 = (bf16_t*)(cbw + CB_A1); bf16_t* A2 = (bf16_t*)(cbw + CB_A2); bf16_t* TT = (bf16_t*)(cbw + CB_TT);
                const bf16_t* ZQ = (const bf16_t*)(cbw + CB_ZQ); const bf16_t* ZK = (const bf16_t*)(cbw + CB_ZK);
                while (ready[c] == 0u) __builtin_amdgcn_s_sleep(1);
                asm volatile("" ::: "memory");
                { f32x4 gN = {0.f, 0.f, 0.f, 0.f}, gKP = gN, gQR = gN, gKR = gN;
#pragma unroll
                  for (int ks = 0; ks < 2; ++ks) {
                      const bf16x8 fzq = *(const bf16x8*)(ZQ + fr * 72 + ks * 32 + fq * 8), fzk = *(const bf16x8*)(ZK + fr * 72 + ks * 32 + fq * 8);
                      const bf16x8 fp = *(const bf16x8*)(A1 + fr * 104 + ks * 32 + fq * 8), frr = *(const bf16x8*)(A2 + fr * 104 + ks * 32 + fq * 8);
                      gN = MFMA16(fzq, fp, gN); gKP = MFMA16(fzk, fp, gKP); gQR = MFMA16(fzq, frr, gQR); gKR = MFMA16(fzk, frr, gKR); }
#pragma unroll
                  for (int jj = 0; jj < 4; ++jj) { const int j = fq * 4 + jj; const bool lt = j < fr, le = j <= fr;
                      gN[jj] = lt ? gN[jj] : 0.f; gKP[jj] = lt ? gKP[jj] : 0.f; gQR[jj] = le ? gQR[jj] : 0.f; gKR[jj] = le ? gKR[jj] : 0.f; }
                  u32x4 w1; w1.x = 0u; w1.y = 0u; w1.z = pk2(gKP[0], gKP[1]); w1.w = pk2(gKP[2], gKP[3]); *(u32x4*)(A1 + fr * 104 + 64 + fq * 8) = w1;
                  u32x4 w2; w2.x = pk2(gQR[0], gQR[1]); w2.y = pk2(gQR[2], gQR[3]); w2.z = pk2(gKR[0], gKR[1]); w2.w = pk2(gKR[2], gKR[3]); *(u32x4*)(A2 + fr * 104 + 64 + fq * 8) = w2;
                  float Ti[16]; int i = fr; asm volatile("" : "+v"(i));
#pragma unroll
                  for (int t = 0; t < 16; ++t) { float s_ = (i == t) ? 1.0f : 0.0f;
#pragma unroll
                      for (int j = 0; j < t; ++j) s_ += Ti[j] * __int_as_float(__builtin_amdgcn_readlane(__float_as_int(gN[j & 3]), (j >> 2) * 16 + t));
                      Ti[t] = s_; }
                  if (lane < 16) { const int sq = (i >> 2) * 8 + (i & 3);
#pragma unroll
                      for (int t = 0; t < 16; ++t) TT[t * 40 + sq] = f2bf(Ti[t]); } }
                lds_fence();
                if (lane == 0) ready2[c] = 1u;
            }
        } else {
            const int ng = 2, g0 = wid * 2;
            f32x4 acc[2][4];
#pragma unroll
            for (int gi = 0; gi < 2; ++gi)
#pragma unroll
                for (int kt = 0; kt < 4; ++kt) acc[gi][kt] = (f32x4){0.f, 0.f, 0.f, 0.f};
            for (int c = 0; c < 128; ++c) {
                const unsigned char* cbw = smem + (c % CH_NB) * CH_CB;
                const bf16_t* A1 = (const bf16_t*)(cbw + CB_A1); const bf16_t* A2 = (const bf16_t*)(cbw + CB_A2); const bf16_t* TT = (const bf16_t*)(cbw + CB_TT);
                const bf16_t* ZQ = (const bf16_t*)(cbw + CB_ZQ); const bf16_t* ZK = (const bf16_t*)(cbw + CB_ZK); const bf16_t* Vn = (const bf16_t*)(cbw + CB_V); const float* GQ = (const float*)(cbw + CB_GQ);
                while (ready2[c] == 0u) __builtin_amdgcn_s_sleep(1);
                asm volatile("" ::: "memory");
                union U8 { u32x4 u; bf16x8 h; };
                U8 FA[4];
#pragma unroll
                for (int kt = 0; kt < 4; ++kt) { const int sk = (kt >> 1) * 32 + (fr >> 2) * 8 + (kt & 1) * 4 + (fr & 3);
                    const unsigned q0 = ZQ[(fq * 4 + 0) * 72 + sk], q1 = ZQ[(fq * 4 + 1) * 72 + sk], q2 = ZQ[(fq * 4 + 2) * 72 + sk], q3 = ZQ[(fq * 4 + 3) * 72 + sk];
                    const unsigned k0 = ZK[(fq * 4 + 0) * 72 + sk], k1 = ZK[(fq * 4 + 1) * 72 + sk], k2 = ZK[(fq * 4 + 2) * 72 + sk], k3 = ZK[(fq * 4 + 3) * 72 + sk];
                    FA[kt].u.x = q0 | (q1 << 16); FA[kt].u.y = q2 | (q3 << 16); FA[kt].u.z = k0 | (k1 << 16); FA[kt].u.w = k2 | (k3 << 16); }
                const bf16x8 a1f0 = *(const bf16x8*)(A1 + fr * 104 + fq * 8), a1f1 = *(const bf16x8*)(A1 + fr * 104 + 32 + fq * 8), a1f2 = *(const bf16x8*)(A1 + fr * 104 + 64 + fq * 8);
                const bf16x8 a2f0 = *(const bf16x8*)(A2 + fr * 104 + fq * 8), a2f1 = *(const bf16x8*)(A2 + fr * 104 + 32 + fq * 8), a2f2 = *(const bf16x8*)(A2 + fr * 104 + 64 + fq * 8);
                const bf16x8 ttf = *(const bf16x8*)(TT + fr * 40 + fq * 8);
                float4 gq[4];
#pragma unroll
                for (int kt = 0; kt < 4; ++kt) gq[kt] = *(const float4*)(GQ + kt * 16 + fq * 4);
#pragma unroll
                for (int gi = 0; gi < 2; ++gi) if (gi < ng) {
                    const int v0 = (g0 + gi) * 16;
                    U8 B0, B1, BX;
                    B0.u.x = cvtpk(acc[gi][0][0], acc[gi][0][1]); B0.u.y = cvtpk(acc[gi][0][2], acc[gi][0][3]); B0.u.z = cvtpk(acc[gi][1][0], acc[gi][1][1]); B0.u.w = cvtpk(acc[gi][1][2], acc[gi][1][3]);
                    B1.u.x = cvtpk(acc[gi][2][0], acc[gi][2][1]); B1.u.y = cvtpk(acc[gi][2][2], acc[gi][2][3]); B1.u.z = cvtpk(acc[gi][3][0], acc[gi][3][1]); B1.u.w = cvtpk(acc[gi][3][2], acc[gi][3][3]);
                    u32x2 vq;
                    { const unsigned e0 = Vn[(fq * 4 + 0) * 72 + v0 + fr], e1 = Vn[(fq * 4 + 1) * 72 + v0 + fr], e2 = Vn[(fq * 4 + 2) * 72 + v0 + fr], e3 = Vn[(fq * 4 + 3) * 72 + v0 + fr];
                      vq.x = e0 | (e1 << 16); vq.y = e2 | (e3 << 16); }
                    BX.u.x = 0u; BX.u.y = 0u; BX.u.z = vq.x; BX.u.w = vq.y;
                    f32x4 rhs = {0.f, 0.f, 0.f, 0.f};
                    rhs = MFMA16(a1f0, B0.h, rhs); rhs = MFMA16(a1f1, B1.h, rhs); rhs = MFMA16(a1f2, BX.h, rhs);
                    BX.u.x = pk2(rhs[0], rhs[1]); BX.u.y = pk2(rhs[2], rhs[3]); BX.u.z = 0u; BX.u.w = 0u;
                    f32x4 uu = {0.f, 0.f, 0.f, 0.f};
                    uu = MFMA16(ttf, BX.h, uu);
                    BX.u.x = pk2(uu[0], uu[1]); BX.u.y = pk2(uu[2], uu[3]); BX.u.z = vq.x; BX.u.w = vq.y;
                    f32x4 oo = {0.f, 0.f, 0.f, 0.f};
                    oo = MFMA16(a2f0, B0.h, oo); oo = MFMA16(a2f1, B1.h, oo); oo = MFMA16(a2f2, BX.h, oo);
#pragma unroll
                    for (int kt = 0; kt < 4; ++kt) { acc[gi][kt] = MFMA16(FA[kt].h, BX.h, acc[gi][kt]);
                        acc[gi][kt][0] *= gq[kt].x; acc[gi][kt][1] *= gq[kt].y; acc[gi][kt][2] *= gq[kt].z; acc[gi][kt][3] *= gq[kt].w; }
                    float* op = ORAW + ((size_t)b * 2048 + c * 16 + fq * 4) * 1024 + h * 64 + v0 + fr;
#pragma unroll
                    for (int jj = 0; jj < 4; ++jj) op[(size_t)jj * 1024] = oo[jj];
                }
                asm volatile("s_waitcnt lgkmcnt(0)" ::: "memory");
                if (lane == 0) __hip_atomic_fetch_add((LAS unsigned*)&cons[c], 1u, __ATOMIC_RELAXED, __HIP_MEMORY_SCOPE_WORKGROUP);
            }
#pragma unroll
            for (int gi = 0; gi < 2; ++gi) if (gi < ng) {
                float* so = p.out + O_PWKV + ((((size_t)l * 8 + b) * 16 + h) * 64 + (g0 + gi) * 16 + fr) * 64 + fq * 4;
#pragma unroll
                for (int kt = 0; kt < 4; ++kt) *(float4*)(so + kt * 16) = make_float4(acc[gi][kt][0], acc[gi][kt][1], acc[gi][kt][2], acc[gi][kt][3]);
            }
        }
    }
    __syncthreads();
}

__device__ void rwkv_sample_item(const Params& p, int l, int item, unsigned char* smem_) {
    unsigned char* smem = launder_lds(smem_);
    const int tid = tid_l(), lane = tid & 63, ks = tid >> 6;
    const int i = item >> 4, h = item & 15;
    float* part = (float*)smem;
    float* sv = part + 1024;
    float* s_sc = sv + 384;
    const bf16_t* P = (const bf16_t*)(p.ws + WS_P);
    float* ORAW = (float*)(p.ws + WS_ORAW);
    bf16_t* BV = (bf16_t*)(p.ws + WS_BV);
    const size_t rowp = (size_t)TP + i, rows = (size_t)TALL + i;
    const bf16_t* pc = P + rowp * N1; const bf16_t* pp = P + rows * N1;
    const float* mu = p.in[I_MU] + (size_t)l * 3200;
    const int gc = h * 64 + lane;
    const int row = tid >> 3, cs = (tid & 7) * 8;
    const size_t so = ((((size_t)l * TS + i) * 16 + h) * 64 + row) * 64 + cs;
    const float4 a0 = *(const float4*)(p.in[I_SWKV] + so), a1 = *(const float4*)(p.in[I_SWKV] + so + 4);
#define LERP1(col) (bf2f(pc[col]) + (bf2f(pp[col]) - bf2f(pc[col])) * mu[col])
    { const float* w2 = p.in[I_W2] + (size_t)l * 64 * 1024 + gc; const float* a2 = p.in[I_A2] + (size_t)l * 64 * 1024 + gc;
      float lw = 0.f, la = 0.f;
#pragma unroll
      for (int kk = 0; kk < 8; ++kk) { const int k = ks * 8 + kk; const float xwl = LERP1(C_WL + k), xal = LERP1(C_AL + k);
          lw += (1.0f - 2.0f * frcp(__expf(2.0f * xwl) + 1.0f)) * w2[(size_t)k * 1024]; la += xal * a2[(size_t)k * 1024]; }
      __syncthreads();
      part[ks * 64 + lane] = lw; part[512 + ks * 64 + lane] = la; }
    __syncthreads();
    if (tid < 64) {
        const float xr = LERP1(C_R + gc), xk = LERP1(C_K + gc), xv = LERP1(C_V + gc);
        float lw = 0.f, la = 0.f;
#pragma unroll
        for (int q = 0; q < 8; ++q) { lw += part[q * 64 + lane]; la += part[512 + q * 64 + lane]; }
        const float w = __expf(-0.60653066f * sigmoidf_(p.in[I_W0][l * 1024 + gc] + lw));
        const float a = sigmoidf_(p.in[I_A0][l * 1024 + gc] + la);
        float kk = xk * p.in[I_KK][l * 1024 + gc];
        const float ssq = wave_sum(kk * kk);
        kk *= 1.0f / fmaxf(sqrtf(ssq), 1e-12f);
        const float kp = xk * (1.0f + (a - 1.0f) * p.in[I_KA][l * 1024 + gc]);
        const float bb = -kk * a, wr = w * xr;
        const float br = wave_sum(bb * xr), kr = wave_sum(kp * xr), beta = wave_sum(xr * kp * p.in[I_RK][l * 1024 + gc]);
        sv[lane] = w; sv[64 + lane] = kk; sv[128 + lane] = bb; sv[192 + lane] = kp; sv[256 + lane] = wr; sv[320 + lane] = xv;
        if (lane == 0) { s_sc[0] = br; s_sc[1] = kr; }
        BV[rowp * 1024 + gc] = f2bf(beta * xv);
    }
#undef LERP1
    __syncthreads();
    {
        float S[8] = {a0.x, a0.y, a0.z, a0.w, a1.x, a1.y, a1.z, a1.w};
        float dk = 0.f, dr = 0.f;
#pragma unroll
        for (int e = 0; e < 8; ++e) { dk += S[e] * sv[64 + cs + e]; dr += S[e] * sv[256 + cs + e]; }
        dk = red8(dk); dr = red8(dr);
        const float vr = sv[320 + row];
        const float o = dr + dk * s_sc[0] + vr * s_sc[1];
        if ((tid & 7) == 0) ORAW[rowp * 1024 + h * 64 + row] = o;
#pragma unroll
        for (int e = 0; e < 8; ++e) S[e] = S[e] * sv[cs + e] + dk * sv[128 + cs + e] + vr * sv[192 + cs + e];
        float* sout = p.out + O_SWKV + so;
        *(float4*)sout = make_float4(S[0], S[1], S[2], S[3]); *(float4*)(sout + 4) = make_float4(S[4], S[5], S[6], S[7]);
    }
}

__device__ void phase_conv(const Params& p, int l) {
    const int tid = tid_l();
    const bf16_t* P = (const bf16_t*)(p.ws + WS_P);
    bf16_t* U = (bf16_t*)(p.ws + WS_U); float* DT = (float*)(p.ws + WS_DT);
    for (int id = blockIdx.x * 512 + tid; id < 1024 * 384; id += gridDim.x * 512) {
        const int q = id % 384, seg = id / 384, xcol = q * 4;
        const int bb = seg >> 7, tb = (seg & 127) * 16;
        float4 cw0, cw1, cw2, cw3, cbv;
        { const float* cw = p.in[I_CW] + (size_t)l * 4 * 1536 + xcol; cw0 = *(const float4*)cw; cw1 = *(const float4*)(cw + 1536); cw2 = *(const float4*)(cw + 3072); cw3 = *(const float4*)(cw + 4608);
          cbv = *(const float4*)(p.in[I_CB] + (size_t)l * 1536 + xcol); }
        const bf16_t* pb = P + ((size_t)bb * 2048 + tb) * N1 + C_XBC + xcol;
        bf16_t* ub = U + ((size_t)bb * 2048 + tb) * 1536 + xcol;
        float4 w0 = make_float4(0.f, 0.f, 0.f, 0.f), w1 = w0, w2 = w0;
#define LD4(dst, ptr) { const u32x2 _v = *(const u32x2*)(ptr); dst = make_float4(__uint_as_float(_v.x << 16), __uint_as_float(_v.x & 0xffff0000u), __uint_as_float(_v.y << 16), __uint_as_float(_v.y & 0xffff0000u)); }
        if (tb >= 3) { LD4(w0, pb - 3 * (size_t)N1) LD4(w1, pb - 2 * (size_t)N1) LD4(w2, pb - (size_t)N1) }
#pragma unroll
        for (int s = 0; s < 16; ++s) {
            float4 cur; LD4(cur, pb + (size_t)s * N1)
            float4 u;
            u.x = cbv.x + cw0.x * w0.x + cw1.x * w1.x + cw2.x * w2.x + cw3.x * cur.x; u.y = cbv.y + cw0.y * w0.y + cw1.y * w1.y + cw2.y * w2.y + cw3.y * cur.y;
            u.z = cbv.z + cw0.z * w0.z + cw1.z * w1.z + cw2.z * w2.z + cw3.z * cur.z; u.w = cbv.w + cw0.w * w0.w + cw1.w * w1.w + cw2.w * w2.w + cw3.w * cur.w;
            u32x2 pk; pk.x = pk2(siluf_(u.x), siluf_(u.y)); pk.y = pk2(siluf_(u.z), siluf_(u.w));
            *(u32x2*)(ub + (size_t)s * 1536) = pk;
            w0 = w1; w1 = w2; w2 = cur;
        }
#undef LD4
    }
    for (int id = blockIdx.x * 512 + tid; id < TP * 16; id += gridDim.x * 512) {
        const int t = id >> 4, j = id & 15;
        DT[id] = softplusf_(bf2f(P[(size_t)t * N1 + C_DT + j]) + p.in[I_DTB][l * 16 + j]);
    }
}

__device__ void mamba_item(const Params& p, int l, int item, unsigned char* smem_) {
    unsigned char* smem = launder_lds(smem_);
    const int tid = tid_l(), wid = tid >> 6, lane = tid & 63, fr = lane & 15, fq = lane >> 4;
    const int b = item >> 5, j = (item >> 1) & 15, ph = item & 1, g = j >> 3;
    bf16_t* Cm = (bf16_t*)smem;
    bf16_t* Bm = (bf16_t*)(smem + 17408);
    bf16_t* BmT = (bf16_t*)(smem + 34816);
    bf16_t* XT = (bf16_t*)(smem + 53248);
    bf16_t* XwT = (bf16_t*)(smem + 57856);
    bf16_t* G = (bf16_t*)(smem + 62464);
    bf16_t* Hb = (bf16_t*)(smem + 71680);
    float* acs = (float*)(smem + 80384);
    float* dtv = acs + 64;
    const bf16_t* P = (const bf16_t*)(p.ws + WS_P);
    const bf16_t* U = (const bf16_t*)(p.ws + WS_U); const float* DT = (const float*)(p.ws + WS_DT);
    bf16_t* YM = (bf16_t*)(p.ws + WS_YM);
    __syncthreads();
    for (int i = tid; i < 32 * 136; i += 512) Hb[i] = 0;
    const float Aj = -__expf(p.in[I_ALOG][l * 16 + j]), Dj = p.in[I_DSK][l * 16 + j];
    const int c16a = wid * 2, c16b = wid * 2 + 1, c4 = wid & 3;
    const int lt = wid >> 1, pt = wid & 1;
    const bf16_t* ub = U + (size_t)b * 2048 * 1536;
    u32x4 rb0, rb1, rc0, rc1, rx = {0u, 0u, 0u, 0u}; float rdt = 0.f;
#define LOADCHUNK(T0) { const bf16_t* r0 = ub + (size_t)((T0) + lane) * 1536 + g * 128; \
        rb0 = *(const u32x4*)(r0 + 1024 + c16a * 8); rb1 = *(const u32x4*)(r0 + 1024 + c16b * 8); rc0 = *(const u32x4*)(r0 + 1280 + c16a * 8); rc1 = *(const u32x4*)(r0 + 1280 + c16b * 8); \
        if (tid < 256) rx = *(const u32x4*)(ub + (size_t)((T0) + lane) * 1536 + j * 64 + ph * 32 + c4 * 8); \
        if (wid == 5) rdt = DT[((size_t)b * 2048 + (T0) + lane) * 16 + j]; }
    LOADCHUNK(0)
    f32x4 hacc[2] = {{0.f, 0.f, 0.f, 0.f}, {0.f, 0.f, 0.f, 0.f}};
    for (int c = 0; c < 32; ++c) {
        const int t0 = c * 64;
        float zq[4];
#pragma unroll
        for (int jj = 0; jj < 4; ++jj) zq[jj] = bf2f(P[((size_t)b * 2048 + t0 + lt * 16 + fq * 4 + jj) * N1 + C_ZM + j * 64 + ph * 32 + pt * 16 + fr]);
        *(u32x4*)(Cm + lane * 136 + c16a * 8) = rc0; *(u32x4*)(Cm + lane * 136 + c16b * 8) = rc1;
        *(u32x4*)(Bm + lane * 136 + c16a * 8) = rb0; *(u32x4*)(Bm + lane * 136 + c16b * 8) = rb1;
#pragma unroll
        for (int e = 0; e < 8; ++e) { const unsigned v0 = rb0[e >> 1], v1 = rb1[e >> 1];
            BmT[(c16a * 8 + e) * 72 + lane] = (bf16_t)((e & 1) ? (v0 >> 16) : (v0 & 0xffffu)); BmT[(c16b * 8 + e) * 72 + lane] = (bf16_t)((e & 1) ? (v1 >> 16) : (v1 & 0xffffu)); }
        if (tid < 256) {
#pragma unroll
            for (int e = 0; e < 8; ++e) { const unsigned v0 = rx[e >> 1]; XT[(c4 * 8 + e) * 72 + lane] = (bf16_t)((e & 1) ? (v0 >> 16) : (v0 & 0xffffu)); }
        }
        if (wid == 5) {
            float v = rdt * Aj;
#pragma unroll
            for (int off = 1; off < 64; off <<= 1) { const float t = __shfl_up(v, off); if (lane >= off) v += t; }
            acs[lane] = v; dtv[lane] = rdt;
        }
        if (c + 1 < 32) LOADCHUNK(t0 + 64)
        LBAR();
        { const int pp = tid & 31, s4 = (tid >> 5) * 4; const float aend = acs[63];
          const u32x2 xv = *(const u32x2*)(XT + pp * 72 + s4);
          const float x0 = __uint_as_float(xv.x << 16), x1 = __uint_as_float(xv.x & 0xffff0000u), x2 = __uint_as_float(xv.y << 16), x3 = __uint_as_float(xv.y & 0xffff0000u);
          u32x2 bq; bq.x = pk2(x0 * dtv[s4] * __expf(aend - acs[s4]), x1 * dtv[s4 + 1] * __expf(aend - acs[s4 + 1]));
          bq.y = pk2(x2 * dtv[s4 + 2] * __expf(aend - acs[s4 + 2]), x3 * dtv[s4 + 3] * __expf(aend - acs[s4 + 3]));
          *(u32x2*)(XwT + pp * 72 + s4) = bq; }
#pragma unroll
        for (int e = 0; e < 2; ++e) {
            const int id = wid * 2 + e, glt = id >> 2, st = id & 3;
            f32x4 acc = {0.f, 0.f, 0.f, 0.f};
            if (st <= glt) {
#pragma unroll
                for (int ks = 0; ks < 4; ++ks) { const bf16x8 fa = *(const bf16x8*)(Cm + (glt * 16 + fr) * 136 + ks * 32 + fq * 8), fb = *(const bf16x8*)(Bm + (st * 16 + fr) * 136 + ks * 32 + fq * 8); acc = MFMA16(fa, fb, acc); }
            }
#pragma unroll
            for (int jj = 0; jj < 4; ++jj) { const int lr = glt * 16 + fq * 4 + jj, s = st * 16 + fr;
                const float val = (s <= lr) ? acc[jj] * __expf(acs[lr] - acs[s]) * dtv[s] : 0.f;
                G[lr * 72 + s] = f2bf(val); }
        }
        f32x4 accO = {0.f, 0.f, 0.f, 0.f};
#pragma unroll
        for (int ks = 0; ks < 4; ++ks) { const bf16x8 fa = *(const bf16x8*)(Cm + (lt * 16 + fr) * 136 + ks * 32 + fq * 8), fb = *(const bf16x8*)(Hb + (pt * 16 + fr) * 136 + ks * 32 + fq * 8); accO = MFMA16(fa, fb, accO); }
        LBAR();
        {
            f32x4 accD = {0.f, 0.f, 0.f, 0.f};
#pragma unroll
            for (int ks = 0; ks < 2; ++ks) { const bf16x8 fa = *(const bf16x8*)(G + (lt * 16 + fr) * 72 + ks * 32 + fq * 8), fb = *(const bf16x8*)(XT + (pt * 16 + fr) * 72 + ks * 32 + fq * 8); accD = MFMA16(fa, fb, accD); }
#pragma unroll
            for (int jj = 0; jj < 4; ++jj) { const int lr = lt * 16 + fq * 4 + jj, pp = pt * 16 + fr;
                float y = accD[jj] + __expf(acs[lr]) * accO[jj] + Dj * bf2f(XT[pp * 72 + lr]);
                y *= siluf_(zq[jj]);
                YM[((size_t)b * 2048 + t0 + lr) * 1024 + j * 64 + ph * 32 + pp] = f2bf(y); }
            const float cd = __expf(acs[63]); const int ptile = wid >> 2;
#pragma unroll
            for (int e = 0; e < 2; ++e) { const int nt = (wid & 3) * 2 + e;
                hacc[e] *= cd;
#pragma unroll
                for (int ks = 0; ks < 2; ++ks) { const bf16x8 fa = *(const bf16x8*)(XwT + (ptile * 16 + fr) * 72 + ks * 32 + fq * 8), fb = *(const bf16x8*)(BmT + (nt * 16 + fr) * 72 + ks * 32 + fq * 8); hacc[e] = MFMA16(fa, fb, hacc[e]); }
#pragma unroll
                for (int jj = 0; jj < 4; ++jj) Hb[(ptile * 16 + fq * 4 + jj) * 136 + nt * 16 + fr] = f2bf(hacc[e][jj]); }
        }
        LBAR();
    }
#undef LOADCHUNK
    { const int ptile = wid >> 2;
#pragma unroll
      for (int e = 0; e < 2; ++e) { const int nt = (wid & 3) * 2 + e;
#pragma unroll
          for (int jj = 0; jj < 4; ++jj) p.out[O_PSSM + ((((size_t)l * 8 + b) * 16 + j) * 64 + ph * 32 + ptile * 16 + fq * 4 + jj) * 128 + nt * 16 + fr] = hacc[e][jj]; } }
    __syncthreads();
}

__device__ void mamba_sample_item(const Params& p, int l, int item, unsigned char* smem_) {
    unsigned char* smem = launder_lds(smem_);
    const int tid = tid_l();
    const int i = item >> 4, j = item & 15, g = j >> 3;
    float* su = (float*)smem;
    float* sd = su + 320;
    const bf16_t* P = (const bf16_t*)(p.ws + WS_P);
    bf16_t* YM = (bf16_t*)(p.ws + WS_YM);
    const size_t rowp = (size_t)TP + i;
    const int pp = tid >> 3, n0 = (tid & 7) * 16;
    const size_t so = ((((size_t)l * TS + i) * 16 + j) * 64 + pp) * 128 + n0;
    float4 hv4[4];
#pragma unroll
    for (int e = 0; e < 4; ++e) hv4[e] = *(const float4*)(p.in[I_SSSM] + so + e * 4);
    __syncthreads();
    if (tid < 320) {
        const int cc = tid < 64 ? j * 64 + tid : (tid < 192 ? 1024 + g * 128 + (tid - 64) : 1280 + g * 128 + (tid - 192));
        const float* c0 = p.in[I_SCONV] + ((size_t)l * TS + i) * 3 * 1536 + cc;
        const float* cw = p.in[I_CW] + (size_t)l * 4 * 1536 + cc;
        const float v = p.in[I_CB][l * 1536 + cc] + c0[0] * cw[0] + c0[1536] * cw[1536] + c0[3072] * cw[3072] + bf2f(P[rowp * N1 + C_XBC + cc]) * cw[4608];
        su[tid] = siluf_(v);
    } else if (tid == 320) {
        const float dt = softplusf_(bf2f(P[rowp * N1 + C_DT + j]) + p.in[I_DTB][l * 16 + j]);
        sd[0] = dt; sd[1] = __expf(-dt * __expf(p.in[I_ALOG][l * 16 + j]));
    }
    __syncthreads();
    {
        float* hout = p.out + O_SSSM + so;
        const float dt = sd[0], eA = sd[1], x = su[pp], xdt = x * dt;
        float y = 0.f;
#pragma unroll
        for (int e = 0; e < 4; ++e) { float4 hv = hv4[e]; const float* Bp = su + 64 + n0 + e * 4; const float* Cp = su + 192 + n0 + e * 4;
            hv.x = eA * hv.x + xdt * Bp[0]; hv.y = eA * hv.y + xdt * Bp[1]; hv.z = eA * hv.z + xdt * Bp[2]; hv.w = eA * hv.w + xdt * Bp[3];
            y += hv.x * Cp[0] + hv.y * Cp[1] + hv.z * Cp[2] + hv.w * Cp[3];
            *(float4*)(hout + e * 4) = hv; }
        y = red8(y);
        if ((tid & 7) == 0) { y += p.in[I_DSK][l * 16 + j] * x; const float z = bf2f(P[rowp * N1 + C_ZM + j * 64 + pp]); YM[rowp * 1024 + j * 64 + pp] = f2bf(y * siluf_(z)); }
    }
}

__device__ void phase_mixa(const Params& p, int l, unsigned char* smem) {
    for (int rep = 0; rep < (DUP == 5 ? 2 : 1); ++rep) phase_conv(p, l);
    for (int rep = 0; rep < (DUP == 3 ? 2 : 1); ++rep)
    for (int it = blockIdx.x; it < 2048; it += gridDim.x) rwkv_sample_item(p, l, it, smem);
    for (int rep = 0; rep < (DUP == 4 ? 2 : 1); ++rep)
    for (int it = blockIdx.x; it < 2048; it += gridDim.x) mamba_sample_item(p, l, it, smem);
}
__device__ void phase_mixb(const Params& p, int l, unsigned char* smem) {
    const int G = (int)gridDim.x, nch = G >= 256 ? 128 : G;
    if ((int)blockIdx.x < nch) {
        for (int rep = 0; rep < (DUP == 1 ? 2 : 1); ++rep)
        for (int it = blockIdx.x; it < 128; it += nch) rwkv_chain_item(p, l, it, smem);
    }
    unsigned* ticket = (unsigned*)(p.ws + WS_BAR) + XCD_BAR_WORDS + 64 * l;
    volatile LAS int* slot = (volatile LAS int*)((LAS unsigned char*)smem + LDS_BARST + 8);
    for (;;) {
        __syncthreads();
        if (tid_l() == 0) *slot = (int)__hip_atomic_fetch_add(ticket, 1u, __ATOMIC_RELAXED, __HIP_MEMORY_SCOPE_AGENT);
        __syncthreads();
        const int it = *slot;
        if (it >= 256 * (DUP == 2 ? 2 : 1)) break;
        mamba_item(p, l, it & 255, smem);
    }
}

__device__ void sample_outproj(const Params& p, int l) {
    const int tid = tid_l(), wid = tid >> 6, lane = tid & 63, fr = lane & 15, fq = lane >> 4;
    const bf16_t* A2 = (const bf16_t*)(p.ws + WS_A) + (size_t)TP * 2048;
    const bf16_t* W = (const bf16_t*)(p.ws + WS_WOUTT) + (size_t)l * 1024 * 2048;
    float* PART = (float*)(p.ws + WS_PART);
    for (int it = blockIdx.x; it < 256; it += gridDim.x) {
        const int nt = it & 15, ksl = it >> 4;
        f32x4 acc[4] = {{0.f, 0.f, 0.f, 0.f}, {0.f, 0.f, 0.f, 0.f}, {0.f, 0.f, 0.f, 0.f}, {0.f, 0.f, 0.f, 0.f}};
#pragma unroll
        for (int kq = 0; kq < 4; ++kq) {
            const bf16x8 fa = *(const bf16x8*)(A2 + (size_t)(wid * 16 + fr) * 2048 + ksl * 128 + kq * 32 + fq * 8);
#pragma unroll
            for (int ct = 0; ct < 4; ++ct) { const bf16x8 fb = *(const bf16x8*)(W + (size_t)(nt * 64 + ct * 16 + fr) * 2048 + ksl * 128 + kq * 32 + fq * 8); acc[ct] = MFMA16(fa, fb, acc[ct]); }
        }
#pragma unroll
        for (int ct = 0; ct < 4; ++ct)
#pragma unroll
            for (int jj = 0; jj < 4; ++jj) PART[((size_t)ksl * TS + wid * 16 + fq * 4 + jj) * 1024 + nt * 64 + ct * 16 + fr] = acc[ct][jj];
    }
}

__device__ void phase_post(const Params& p, int l) {
    const int tid_ = tid_l(); const int lane = tid_ & 63, wid = tid_ >> 6;
    const bf16_t* P = (const bf16_t*)(p.ws + WS_P);
    const float* ORAW = (const float*)(p.ws + WS_ORAW);
    const bf16_t* BV = (const bf16_t*)(p.ws + WS_BV);
    const bf16_t* YM = (const bf16_t*)(p.ws + WS_YM);
    bf16_t* A2 = (bf16_t*)(p.ws + WS_A);
    const int c0 = lane * 16;
    float lnw[16], lnb[16], gnw[16];
#pragma unroll
    for (int e = 0; e < 16; ++e) { lnw[e] = p.in[I_LNW][l * 1024 + c0 + e]; lnb[e] = p.in[I_LNB][l * 1024 + c0 + e]; gnw[e] = p.in[I_GNW][l * 1024 + c0 + e]; }
    for (int row = blockIdx.x * 8 + wid; row < TALL; row += gridDim.x * 8) {
        const bf16_t* prow = P + (size_t)row * N1;
        float o[16], bv[16], z[16], ym[16];
#pragma unroll
        for (int i = 0; i < 4; ++i) { const float4 t = *(const float4*)(ORAW + (size_t)row * 1024 + c0 + i * 4); o[i * 4] = t.x; o[i * 4 + 1] = t.y; o[i * 4 + 2] = t.z; o[i * 4 + 3] = t.w; }
        unpack8(*(const u32x4*)(BV + (size_t)row * 1024 + c0), bv); unpack8(*(const u32x4*)(BV + (size_t)row * 1024 + c0 + 8), bv + 8);
        unpack8(*(const u32x4*)(prow + C_ZR + c0), z); unpack8(*(const u32x4*)(prow + C_ZR + c0 + 8), z + 8);
        unpack8(*(const u32x4*)(YM + (size_t)row * 1024 + c0), ym); unpack8(*(const u32x4*)(YM + (size_t)row * 1024 + c0 + 8), ym + 8);
        float s = 0.f;
#pragma unroll
        for (int e = 0; e < 16; ++e) s += o[e];
        s += dppf<0xB1>(s); s += dppf<0x4E>(s);
        const float mean = s * (1.0f / 64.0f);
        float v = 0.f;
#pragma unroll
        for (int e = 0; e < 16; ++e) { o[e] -= mean; v += o[e] * o[e]; }
        v += dppf<0xB1>(v); v += dppf<0x4E>(v);
        const float rstd = rsqrtf(v * (1.0f / 64.0f) + 64e-5f);
#pragma unroll
        for (int e = 0; e < 16; ++e) o[e] = (o[e] * rstd * lnw[e] + lnb[e] + bv[e]) * siluf_(z[e]);
        *(u32x4*)(A2 + (size_t)row * 2048 + c0) = pack8(o); *(u32x4*)(A2 + (size_t)row * 2048 + c0 + 8) = pack8(o + 8);
        float ss = 0.f;
#pragma unroll
        for (int e = 0; e < 16; ++e) ss += ym[e] * ym[e];
        ss = red16(ss); ss += __shfl_xor(ss, 16);
        const float rs = rsqrtf(ss * (1.0f / 512.0f) + 1e-5f);
#pragma unroll
        for (int e = 0; e < 16; ++e) ym[e] *= rs * gnw[e];
        *(u32x4*)(A2 + (size_t)row * 2048 + 1024 + c0) = pack8(ym); *(u32x4*)(A2 + (size_t)row * 2048 + 1024 + c0 + 8) = pack8(ym + 8);
        if (row < TP) {
            const int tq = row & 2047;
            if (tq >= 2045) { float* dst = p.out + O_PCONV + (((size_t)l * 8 + (row >> 11)) * 3 + (tq - 2045)) * 1536;
                for (int c = lane; c < 1536; c += 64) dst[c] = bf2f(prow[C_XBC + c]); }
        } else {
            const int i = row - TP; float* dst = p.out + O_SCONV + ((size_t)l * TS + i) * 3 * 1536; const float* src = p.in[I_SCONV] + ((size_t)l * TS + i) * 3 * 1536;
            for (int c = lane; c < 1536; c += 64) { dst[c] = src[1536 + c]; dst[1536 + c] = src[3072 + c]; dst[3072 + c] = bf2f(prow[C_XBC + c]); }
        }
    }
}

constexpr int NPHASE = 13;
__global__ __launch_bounds__(512, 2) void mega(Params p) {
    extern __shared__ __attribute__((aligned(16))) unsigned char smem[];
    cg::grid_group grid = cg::this_grid();
    volatile LAS unsigned* st = (volatile LAS unsigned*)((LAS unsigned char*)smem + LDS_BARST);
    { const unsigned hw = (unsigned)__builtin_amdgcn_s_getreg((5 << 11) | 4) & 63u;
      if ((threadIdx.x & 63) == 0) *(volatile LAS int*)((LAS unsigned char*)smem + LDS_WIDTAB + hw * 4u) = (int)(threadIdx.x >> 6);
      if (threadIdx.x == 0) { st[0] = 0u; st[1] = 0u; } }
    __syncthreads();
    const XcdBarrier xbar = xcd_barrier_post((unsigned*)(p.ws + WS_BAR), st);
    if (p.ph_hi > 1000) grid.sync();
#define PHASE(K, BODY) if (p.ph_lo <= (K) && (K) < p.ph_hi) { if ((K) > p.ph_lo) { xcd_barrier(xbar); if (DUP == 13) { xcd_barrier(xbar); xcd_barrier(xbar); } } BODY }
#define GEMM1(L) { pg8::Gemm g{(const bf16_t*)(p.ws + WS_A), (const bf16_t*)(p.ws + WS_WINT) + (size_t)(L) * N1 * 1024, M1, N1, 1024}; \
        pg8::StaticOrder S; S.init(M1, N1, (int)gridDim.x, (int)blockIdx.x); EpiP E{(bf16_t*)(p.ws + WS_P), N1}; \
        pg8::gemm_phase<EpiP, pg8::StaticOrder, false>((PG8_LAS unsigned char*)smem, g, S, E, nullptr); }
#define GEMM2(L) { sample_outproj(p, (L)); \
        pg8::Gemm g{(const bf16_t*)(p.ws + WS_A), (const bf16_t*)(p.ws + WS_WOUTT) + (size_t)(L) * 1024 * 2048, TP, 1024, 2048}; \
        pg8::StaticOrder S; S.init(TP, 1024, (int)gridDim.x, (int)blockIdx.x); EpiRes E{(L) == 0 ? p.in[I_XP] : p.out + O_YP, p.out + O_YP}; \
        pg8::gemm_phase<EpiRes, pg8::StaticOrder, false>((PG8_LAS unsigned char*)smem, g, S, E, nullptr); }
    PHASE(0, phase_convert(p, smem); phase_norm(p, 0);)
    PHASE(1, GEMM1(0))
    PHASE(2, phase_mixa(p, 0, smem);)
    PHASE(3, phase_mixb(p, 0, smem);)
    PHASE(4, phase_post(p, 0);)
    PHASE(5, GEMM2(0))
    PHASE(6, phase_norm(p, 1);)
    PHASE(7, GEMM1(1))
    PHASE(8, phase_mixa(p, 1, smem);)
    PHASE(9, phase_mixb(p, 1, smem);)
    PHASE(10, phase_post(p, 1);)
    PHASE(11, GEMM2(1))
    PHASE(12, phase_final(p);)
}

extern "C" void kernel_launch(void* const* d_in, const int* in_sizes, int n_in, void* d_out, int out_size, void* d_ws, size_t ws_size, hipStream_t stream) {
    static int grid = 0;
    if (grid == 0) {
        if (n_in != 26 || (size_t)out_size != O_END || ws_size < WS_BAR + (size_t)(XCD_BAR_WORDS + 128) * 4) { fprintf(stderr, "kernel_launch: unexpected shapes: n_in %d out %d ws %zu (need %zu)\n", n_in, out_size, ws_size, (size_t)(WS_BAR + XCD_BAR_WORDS * 4)); grid = -1; return; }
        int dev = 0, cus = 0, per_cu = 0;
        hipGetDevice(&dev); hipDeviceGetAttribute(&cus, hipDeviceAttributeMultiprocessorCount, dev);
        if (hipFuncSetAttribute((const void*)mega, hipFuncAttributeMaxDynamicSharedMemorySize, LDS_BYTES) != hipSuccess) { fprintf(stderr, "kernel_launch: hipFuncSetAttribute failed\n"); grid = -1; return; }
        if (hipOccupancyMaxActiveBlocksPerMultiprocessor(&per_cu, (const void*)mega, 512, LDS_BYTES) != hipSuccess || per_cu < 1) { fprintf(stderr, "kernel_launch: occupancy query gave %d\n", per_cu); per_cu = 1; }
        (void)hipGetLastError();
        grid = cus * 1;
    }
    if (grid < 0) return;
    if (hipMemsetAsync((char*)d_ws + WS_BAR, 0, (size_t)(XCD_BAR_WORDS + 128) * 4, stream) != hipSuccess) { fprintf(stderr, "kernel_launch: memset of barrier words failed\n"); return; }
    Params p{};
    for (int i = 0; i < 26; ++i) p.in[i] = (const float*)d_in[i];
    p.out = (float*)d_out; p.ws = (unsigned char*)d_ws;
#if MK_PER_PHASE
    for (int ph = 0; ph < NPHASE; ++ph) { p.ph_lo = ph; p.ph_hi = ph + 1; hipLaunchKernelGGL(mega, dim3(grid), dim3(512), LDS_BYTES, stream, p); }
#else
    p.ph_lo = 0; p.ph_hi = NPHASE;
    void* args[] = {&p};
    hipError_t e = hipLaunchCooperativeKernel((const void*)mega, dim3(grid), dim3(512), args, LDS_BYTES, stream);
    if (e != hipSuccess) fprintf(stderr, "cooperative launch failed: %s (grid %d)\n", hipGetErrorString(e), grid);
#endif
}
```

```cpp
#include <hip/hip_runtime.h>
#include <hip/hip_cooperative_groups.h>
#include <cstdio>
namespace cg = cooperative_groups;

#define LDS_WIDTAB 163328
__device__ __forceinline__ int tid_l() {
    const unsigned hw = (unsigned)__builtin_amdgcn_s_getreg((5 << 11) | 4) & 63u;
    const int wid = *(volatile __attribute__((address_space(3))) int*)(unsigned long)(LDS_WIDTAB + hw * 4u);
    int ln; asm volatile("v_mbcnt_lo_u32_b32 %0, -1, 0\n\tv_mbcnt_hi_u32_b32 %0, -1, %0" : "=v"(ln));
    return __builtin_amdgcn_readfirstlane(wid) * 64 + ln; }
namespace pg8 {
#define PG8_LAS __attribute__((address_space(3)))
typedef unsigned short bf16_t;
typedef short bf16x8 __attribute__((ext_vector_type(8)));
typedef float f32x4 __attribute__((ext_vector_type(4)));
typedef unsigned u32x4 __attribute__((ext_vector_type(4)));
constexpr int BM = 256, BK = 64, HALF = 128, HTB = HALF * BK * 2  , STAGE_BYTES = 8 * HTB, NXCD = 8, WGM = 8;

__host__ __device__ __forceinline__ int lds_byte(int r, int c) { const int st = (r >> 4) * 2 + (c >> 5), rr = r & 15, cc = c & 31, ob = rr * 64 + cc * 2; return st * 1024 + (ob ^ (((ob >> 9) & 1) << 5)); }
__host__ __device__ __forceinline__ void stage_rc(int b, int& R, int& C) { const int st = b / 1024, sb = b % 1024, swz = sb ^ (((sb >> 9) & 1) << 5); R = (st >> 1) * 16 + swz / 64; C = (st & 1) * 32 + (swz % 64) / 2; }
__host__ __device__ __forceinline__ int perm32(int rho) { const int n = rho >> 4, i = rho & 15; return 8 * (i >> 2) + 4 * n + (i & 3); }

struct Unit { int pm, pn; };
struct Gemm { const bf16_t* A; const bf16_t* Bt; int M, N, K; };

struct StaticOrder {
    int nM, nN, nwg, G, c;
    __host__ __device__ void init(int M, int N, int G_, int c_) { nM = M / BM; nN = N / BM; nwg = nM * nN; G = G_; c = c_; }
    __host__ __device__ bool next(int i, Unit& u) const {
        const long L = (long)i * G + c; if (L >= nwg) return false;
        int wgid = (int)L; { const int q = nwg / NXCD, r = nwg % NXCD, xcd = wgid % NXCD, off = wgid / NXCD; wgid = (xcd < r ? xcd * (q + 1) : r * (q + 1) + (xcd - r) * q) + off; }
        const int nig = WGM * nN, gid = wgid / nig, fm = gid * WGM, gsz = (nM - fm) < WGM ? (nM - fm) : WGM;
        u.pm = fm + ((wgid % nig) % gsz); u.pn = (wgid % nig) / gsz; return true;
    }
    __device__ __forceinline__ void a_ready(const Unit&) const {}
    __device__ __forceinline__ void done(const Unit&) const {}
};
__device__ __forceinline__ unsigned cvt_pk_bf16(float lo, float hi) { unsigned r; asm volatile("v_cvt_pk_bf16_f32 %0, %1, %2" : "=v"(r) : "v"(lo), "v"(hi)); return r; }
template <class Epi, class Sched, bool STAMP = false>
__device__ __forceinline__ void gemm_phase(PG8_LAS unsigned char* lds, const Gemm g, const Sched& S, const Epi& E, unsigned long long* stamps) {
    const int tid = tid_l(), wid = __builtin_amdgcn_readfirstlane(tid >> 6), lane = tid & 63, wr = wid >> 2, wc = wid & 3, fr = lane & 15, fq = lane >> 4;
    const int K = g.K, nt = K / BK;
    int ts_lo = 0, ts_hi = 0, nts = 0; const unsigned long long rt_entry = STAMP ? (unsigned long long)wall_clock64() : 0ull;
#define PG8_STAMP() do { if (STAMP && wid == 0 && nts < 64) { const unsigned long long _c = (unsigned long long)clock64(); \
        ts_lo = (lane == nts) ? (int)(unsigned)_c : ts_lo; ts_hi = (lane == nts) ? (int)(unsigned)(_c >> 32) : ts_hi; ++nts; } } while (0)
    PG8_STAMP();
    unsigned voffA[2], voffB[2];
#pragma unroll
    for (int i = 0; i < 2; ++i) { int R, C; stage_rc(tid * 16 + i * 8192, R, C); const int Rb = Epi::PERM ? ((R & ~31) + perm32(R & 31)) : R;
        voffA[i] = (unsigned)(R * K + C) * 2u; voffB[i] = (unsigned)(Rb * K + C) * 2u; }
    const size_t kstep = (size_t)(BK * 2);
    const size_t hstep = (size_t)HALF * K * 2;
    const size_t tstep = 2 * hstep;
    const unsigned ldsw = (unsigned)wid * 1024u;
    const int aoff = lds_byte(wr * 64 + fr, fq * 8), boff = lds_byte(wc * 32 + fr, fq * 8);
#define PG8_SA(b, h) (((b) * 2 + (h)) * HTB)
#define PG8_SB(b, h) ((4 + (b) * 2 + (h)) * HTB)
#define PG8_STAGE(bufoff, gbase, voff) do { _Pragma("unroll") for (int _i = 0; _i < 2; ++_i) \
        __builtin_amdgcn_global_load_lds((const unsigned*)((const char*)(gbase) + (voff)[_i]), (PG8_LAS unsigned*)(lds + (bufoff) + ldsw + _i * 8192), 16, 0, 0); } while (0)
#define PG8_LDA(dst, b, h) do { _Pragma("unroll") for (int m = 0; m < 4; ++m) _Pragma("unroll") for (int k = 0; k < 2; ++k) dst[m][k] = *(const PG8_LAS bf16x8*)(lds + PG8_SA(b, h) + aoff + m * 2048 + k * 1024); } while (0)
#define PG8_LDB(dst, b, h) do { _Pragma("unroll") for (int n = 0; n < 2; ++n) _Pragma("unroll") for (int k = 0; k < 2; ++k) dst[n][k] = *(const PG8_LAS bf16x8*)(lds + PG8_SB(b, h) + boff + n * 2048 + k * 1024); } while (0)
#define PG8_MMA(ai, bj, At, Bt) do { __builtin_amdgcn_s_setprio(1); _Pragma("unroll") for (int m = 0; m < 4; ++m) _Pragma("unroll") for (int n = 0; n < 2; ++n) _Pragma("unroll") for (int k = 0; k < 2; ++k) \
        acc[ai][bj][m][n] = __builtin_amdgcn_mfma_f32_16x16x32_bf16(Bt[n][k], At[m][k], acc[ai][bj][m][n], 0, 0, 0); __builtin_amdgcn_s_setprio(0); } while (0)
#define PG8_WAIT_V(n) asm volatile("s_waitcnt vmcnt(" #n ")" ::: "memory")
#define PG8_WAIT_L(n) asm volatile("s_waitcnt lgkmcnt(" #n ")" ::: "memory")
#define PG8_BAR __builtin_amdgcn_s_barrier()
#define PG8_SCHED __builtin_amdgcn_sched_barrier(0)
    Unit cur, nxt; int ui = 0;
    if (!S.next(0, cur)) return;
    f32x4 acc[2][2][4][2];
#pragma unroll
    for (int a = 0; a < 2; ++a)
#pragma unroll
        for (int b = 0; b < 2; ++b)
#pragma unroll
            for (int m = 0; m < 4; ++m)
#pragma unroll
                for (int n = 0; n < 2; ++n) acc[a][b][m][n] = (f32x4){0.f, 0.f, 0.f, 0.f};
    bf16x8 At[4][2], B0[2][2], B1[2][2];
    const char* cA = (const char*)g.A + (size_t)cur.pm * tstep; const char* cB = (const char*)g.Bt + (size_t)cur.pn * tstep;
    S.a_ready(cur);
    PG8_STAGE(PG8_SB(0, 0), cB, voffB); PG8_STAGE(PG8_SA(0, 0), cA, voffA); PG8_STAGE(PG8_SB(0, 1), cB + hstep, voffB); PG8_STAGE(PG8_SA(0, 1), cA + hstep, voffA);
    if (wr == 1) PG8_BAR;
    PG8_WAIT_V(4); PG8_BAR;
    PG8_STAGE(PG8_SB(1, 0), cB + kstep, voffB); PG8_STAGE(PG8_SA(1, 0), cA + kstep, voffA); PG8_STAGE(PG8_SB(1, 1), cB + hstep + kstep, voffB);
    PG8_WAIT_V(6); PG8_BAR;
    PG8_STAMP();
    for (;;) {
        const bool has_next = S.next(ui + 1, nxt);
        const char* nA = has_next ? (const char*)g.A + (size_t)nxt.pm * tstep : cA; const char* nB = has_next ? (const char*)g.Bt + (size_t)nxt.pn * tstep : cB;
        for (int t = 0; t < nt; t += 2) {
            const bool last = (t == nt - 2);
            const char* a1 = cA + (size_t)(t + 1) * kstep;
            const char* a2 = last ? nA : cA + (size_t)(t + 2) * kstep; const char* b2 = last ? nB : cB + (size_t)(t + 2) * kstep;
            const char* a3 = a2 + kstep; const char* b3 = b2 + kstep;
            if (last && has_next) S.a_ready(nxt);
            PG8_LDB(B0, 0, 0); PG8_SCHED; PG8_LDA(At, 0, 0); PG8_STAGE(PG8_SA(1, 1), a1 + hstep, voffA);
            PG8_WAIT_L(8); PG8_BAR; PG8_WAIT_L(0); PG8_MMA(0, 0, At, B0); PG8_BAR; PG8_SCHED;
            PG8_LDB(B1, 0, 1); PG8_STAGE(PG8_SB(0, 0), b2, voffB);
            PG8_BAR; PG8_WAIT_L(0); PG8_MMA(0, 1, At, B1); PG8_BAR;
            PG8_LDA(At, 0, 1); PG8_STAGE(PG8_SA(0, 0), a2, voffA);
            PG8_BAR; PG8_WAIT_L(0); PG8_MMA(1, 0, At, B0); PG8_BAR; PG8_SCHED;
            PG8_STAGE(PG8_SB(0, 1), b2 + hstep, voffB);
            PG8_WAIT_V(6); PG8_BAR; PG8_MMA(1, 1, At, B1); PG8_BAR;
            PG8_LDB(B0, 1, 0); PG8_SCHED; PG8_LDA(At, 1, 0); PG8_STAGE(PG8_SA(0, 1), a2 + hstep, voffA);
            PG8_WAIT_L(8); PG8_BAR; PG8_WAIT_L(0); PG8_MMA(0, 0, At, B0); PG8_BAR; PG8_SCHED;
            PG8_LDB(B1, 1, 1); PG8_STAGE(PG8_SB(1, 0), b3, voffB);
            PG8_BAR; PG8_WAIT_L(0); PG8_MMA(0, 1, At, B1); PG8_BAR;
            PG8_LDA(At, 1, 1); PG8_STAGE(PG8_SA(1, 0), a3, voffA);
            PG8_BAR; PG8_WAIT_L(0); PG8_MMA(1, 0, At, B0); PG8_BAR; PG8_SCHED;
            PG8_STAGE(PG8_SB(1, 1), b3 + hstep, voffB);
            PG8_WAIT_V(6); PG8_BAR; PG8_MMA(1, 1, At, B1); PG8_BAR;
        }
        PG8_STAMP();
        if constexpr (!Epi::AFTER_DRAIN) { E(acc, cur, wr, wc, fr, fq); S.done(cur); }
        PG8_STAMP();
        if (!has_next) break;
#pragma unroll
        for (int a = 0; a < 2; ++a)
#pragma unroll
            for (int b = 0; b < 2; ++b)
#pragma unroll
                for (int m = 0; m < 4; ++m)
#pragma unroll
                    for (int n = 0; n < 2; ++n) acc[a][b][m][n] = (f32x4){0.f, 0.f, 0.f, 0.f};
        cur = nxt; cA = nA; cB = nB; ++ui;
    }
    PG8_WAIT_V(0);
    if (wr == 0) PG8_BAR;
    PG8_BAR;
    if constexpr (Epi::AFTER_DRAIN) { E.fused(acc, cur, wr, wc, fr, fq, lds, wid, lane); S.done(cur); }
    PG8_STAMP();
    if (STAMP && wid == 0) { stamps[lane] = lane < nts ? (((unsigned long long)(unsigned)ts_hi << 32) | (unsigned)ts_lo) : 0ull;
        if (lane == 62) stamps[62] = rt_entry; if (lane == 63) stamps[63] = (unsigned long long)wall_clock64(); }
#undef PG8_STAMP
#undef PG8_SA
#undef PG8_SB
#undef PG8_STAGE
#undef PG8_LDA
#undef PG8_LDB
#undef PG8_MMA
#undef PG8_WAIT_V
#undef PG8_WAIT_L
#undef PG8_BAR
#undef PG8_SCHED
}
}

#define XB_TMO      128
#define XB_XCNT(j)  (256  + 64 * (j))
#define XB_XSUB(j)  (1280 + 64 * (j))
#define XB_XGEN(j)  (2304 + 64 * (j))
#define XB_TOP      3328
#define XB_TOPGEN   3392
#define XCD_BAR_WORDS 3456
#define XB_SPIN_CAP (1u << 18)
#define LAS __attribute__((address_space(3)))

__device__ __forceinline__ unsigned xb_ld(unsigned* p)              { return __hip_atomic_load(p, __ATOMIC_RELAXED, __HIP_MEMORY_SCOPE_AGENT); }
__device__ __forceinline__ unsigned xb_add(unsigned* p, unsigned v) { return __hip_atomic_fetch_add(p, v, __ATOMIC_RELAXED, __HIP_MEMORY_SCOPE_AGENT); }
__device__ __forceinline__ unsigned xb_xcc_id() { return (unsigned)__builtin_amdgcn_s_getreg((3 << 11) | 20) & 0xFu; }
#define XB_SPIN(cond, bar) do { unsigned _sp = 0; while (cond) { __builtin_amdgcn_s_sleep(1); \
    if ((++_sp & 255u) == 0u) { if (xb_ld(&(bar)[XB_TMO])) break; if (_sp > XB_SPIN_CAP) { atomicAdd(&(bar)[XB_TMO], 1u); break; } } } } while (0)
struct XcdBarrier {
    unsigned* bar; unsigned x;
    volatile LAS unsigned* st;
};

__device__ __forceinline__ XcdBarrier xcd_barrier_post(unsigned* bar, volatile LAS unsigned* st) {
    XcdBarrier b; b.bar = bar; b.x = xb_xcc_id(); b.st = st;
    if (tid_l() == 0) (void)xb_add(&bar[XB_XCNT(b.x)], 1u);
    return b;
}
__device__ __forceinline__ void xcd_barrier_complete(unsigned* bar, unsigned x, unsigned& nloc, unsigned& nx) {
    const unsigned G = gridDim.x * gridDim.y * gridDim.z;
    unsigned sum, cnt, mine, sp = 0u;
    for (;;) {
        sum = 0u; cnt = 0u; mine = 0u;
#pragma unroll
        for (unsigned j = 0; j < 16; ++j) { const unsigned c = xb_ld(&bar[XB_XCNT(j)]); sum += c; cnt += (c > 0u) ? 1u : 0u; mine = (j == x) ? c : mine; }
        if (sum == G) break;
        __builtin_amdgcn_s_sleep(1);
        if ((++sp & 255u) == 0u) { if (xb_ld(&bar[XB_TMO])) break; if (sp > XB_SPIN_CAP) { atomicAdd(&bar[XB_TMO], 1u); break; } }
    }
    nloc = mine > 0u ? mine : 1u; nx = cnt > 0u ? cnt : 1u;
}

__device__ __forceinline__ void xcd_barrier(const XcdBarrier& b) {
    asm volatile("s_waitcnt vmcnt(0)" ::: "memory");
    __syncthreads();
    if (tid_l() == 0) {
        unsigned* bar = b.bar;
        __builtin_amdgcn_s_waitcnt(0);
        unsigned nloc = b.st[0], nx = b.st[1];
        if (nloc == 0u) { xcd_barrier_complete(bar, b.x, nloc, nx); b.st[0] = nloc; b.st[1] = nx; }
        const unsigned old = xb_add(&bar[XB_XSUB(b.x)], 1u);
        const unsigned gen = old / nloc;
        if (old + 1u == (gen + 1u) * nloc) {
            __builtin_amdgcn_fence(__ATOMIC_RELEASE, "agent");
            asm volatile("s_waitcnt vmcnt(0)" ::: "memory");
            const unsigned og = xb_add(&bar[XB_TOP], 1u);
            const unsigned tg = og / nx;
            if (og + 1u == (tg + 1u) * nx) xb_add(&bar[XB_TOPGEN], 1u);
            else XB_SPIN(xb_ld(&bar[XB_TOPGEN]) == tg, bar);
            __builtin_amdgcn_fence(__ATOMIC_ACQUIRE, "agent");
            xb_add(&bar[XB_XGEN(b.x)], 1u);
            asm volatile("s_waitcnt vmcnt(0)" ::: "memory");
        } else {
            XB_SPIN(xb_ld(&bar[XB_XGEN(b.x)]) == gen, bar);
            __builtin_amdgcn_fence(__ATOMIC_ACQUIRE, "agent");
            asm volatile("s_waitcnt vmcnt(0)" ::: "memory");
        }
    }
    __syncthreads();
}

typedef unsigned short bf16_t;
typedef short bf16x8 __attribute__((ext_vector_type(8)));
typedef float f32x4 __attribute__((ext_vector_type(4)));
typedef unsigned u32x4 __attribute__((ext_vector_type(4)));
typedef unsigned u32x2 __attribute__((ext_vector_type(2)));

#ifndef DUP
#define DUP 0
#endif
#ifndef MK_PER_PHASE
#define MK_PER_PHASE 0
#endif

constexpr int TP = 16384, TS = 128, TALL = 16512, M1 = 16640, N1 = 6912, NIN = 6800;
constexpr int C_R = 0, C_K = 1024, C_V = 2048, C_WL = 3072, C_AL = 3136, C_ZR = 3200, C_ZM = 4224, C_XBC = 5248, C_DT = 6784;
constexpr size_t O_YP = 0, O_YS = 16777216, O_PSH = 16908288, O_PWKV = 16924672, O_PCONV = 17973248, O_PSSM = 18046976,
                 O_SSH = 20144128, O_SWKV = 20406272, O_SCONV = 37183488, O_SSSM = 38363136, O_END = 71917568;
constexpr size_t WS_WINT = 0;
constexpr size_t WS_WOUTT = WS_WINT + (size_t)2 * N1 * 1024 * 2;
constexpr size_t WS_A = WS_WOUTT + (size_t)2 * 1024 * 2048 * 2;
constexpr size_t WS_P = WS_A + (size_t)M1 * 2048 * 2;
constexpr size_t WS_ORAW = WS_P + (size_t)M1 * N1 * 2;
constexpr size_t WS_BV = WS_ORAW + (size_t)TALL * 1024 * 4;
constexpr size_t WS_YM = WS_BV + (size_t)TALL * 1024 * 2;
constexpr size_t WS_END = WS_YM + (size_t)TALL * 1024 * 2;
constexpr size_t WS_U = WS_A;
constexpr size_t WS_DT = WS_U + (size_t)TP * 1536 * 2;
constexpr size_t WS_PART = WS_ORAW;
constexpr size_t WS_BAR = (WS_END + 4095) & ~(size_t)4095;
constexpr int LDS_BYTES = 163840, LDS_BARST = 163824;

struct Params { const float* in[26]; float* out; unsigned char* ws; int ph_lo, ph_hi; };
enum { I_XP = 0, I_XS, I_SSHIFT, I_SWKV, I_SCONV, I_SSSM, I_NORMW, I_WIN, I_MU, I_W0, I_W2, I_A0, I_A2, I_KK, I_KA, I_RK, I_LNW, I_LNB, I_CW, I_CB, I_DTB, I_ALOG, I_DSK, I_GNW, I_WOUT, I_FNW };

__device__ __forceinline__ float bf2f(unsigned short b) { return __uint_as_float(((unsigned)b) << 16); }
__device__ __forceinline__ unsigned short f2bf(float f) { unsigned u = __float_as_uint(f); u += 0x7FFFu + ((u >> 16) & 1u); return (unsigned short)(u >> 16); }
__device__ __forceinline__ unsigned pk2(float lo, float hi) { return (unsigned)f2bf(lo) | ((unsigned)f2bf(hi) << 16); }
__device__ __forceinline__ void unpack8(const u32x4 v, float* f) {
    f[0] = __uint_as_float(v.x << 16); f[1] = __uint_as_float(v.x & 0xffff0000u); f[2] = __uint_as_float(v.y << 16); f[3] = __uint_as_float(v.y & 0xffff0000u);
    f[4] = __uint_as_float(v.z << 16); f[5] = __uint_as_float(v.z & 0xffff0000u); f[6] = __uint_as_float(v.w << 16); f[7] = __uint_as_float(v.w & 0xffff0000u); }
__device__ __forceinline__ u32x4 pack8(const float* f) { u32x4 r; r.x = pk2(f[0], f[1]); r.y = pk2(f[2], f[3]); r.z = pk2(f[4], f[5]); r.w = pk2(f[6], f[7]); return r; }
__device__ __forceinline__ float frcp(float x) { return __builtin_amdgcn_rcpf(x); }
__device__ __forceinline__ float sigmoidf_(float x) { return frcp(1.0f + __expf(-x)); }
__device__ __forceinline__ float siluf_(float x) { return x * frcp(1.0f + __expf(-x)); }
__device__ __forceinline__ float softplusf_(float x) { return x > 20.f ? x : log1pf(__expf(x)); }
template <int CTRL> __device__ __forceinline__ float dppf(float v) { return __int_as_float(__builtin_amdgcn_mov_dpp(__float_as_int(v), CTRL, 0xF, 0xF, true)); }
__device__ __forceinline__ float red8(float x) { x += dppf<0xB1>(x); x += dppf<0x4E>(x); x += dppf<0x141>(x); return x; }
__device__ __forceinline__ float red16(float x) { x = red8(x); x += dppf<0x140>(x); return x; }
__device__ __forceinline__ float wave_sum(float x) {
#pragma unroll
    for (int o = 32; o > 0; o >>= 1) x += __shfl_xor(x, o);
    return x; }
__device__ __forceinline__ void lds_fence() { asm volatile("s_waitcnt lgkmcnt(0)" ::: "memory"); }
__device__ __forceinline__ unsigned char* launder_lds(unsigned char* sm) { int off = 0; asm volatile("" : "+s"(off)); return sm + off; }
#define LBAR() do { asm volatile("s_waitcnt lgkmcnt(0)" ::: "memory"); __builtin_amdgcn_s_barrier(); asm volatile("" ::: "memory"); } while (0)
#define MFMA16(a, b, c) __builtin_amdgcn_mfma_f32_16x16x32_bf16((a), (b), (c), 0, 0, 0)

__device__ void phase_convert(const Params& p, unsigned char* smem_) {
    unsigned char* smem = launder_lds(smem_);
    float* tile = (float*)smem;
    const int tid = tid_l();
    constexpr int NT_IN = 16 * 108, NT_OUT = 32 * 16, PER_L = NT_IN + NT_OUT;
    for (int it = blockIdx.x; it < 2 * PER_L; it += gridDim.x) {
        const int l = it / PER_L; int r = it % PER_L;
        const float* src; bf16_t* dst; int K, Nsrc, kt, nt;
        if (r < NT_IN) { src = p.in[I_WIN] + (size_t)l * 1024 * NIN; dst = (bf16_t*)(p.ws + WS_WINT) + (size_t)l * N1 * 1024; K = 1024; Nsrc = NIN; kt = r & 15; nt = r >> 4; }
        else { r -= NT_IN; src = p.in[I_WOUT] + (size_t)l * 2048 * 1024; dst = (bf16_t*)(p.ws + WS_WOUTT) + (size_t)l * 1024 * 2048; K = 2048; Nsrc = 1024; kt = r & 31; nt = r >> 5; }
#pragma unroll
        for (int i = 0; i < 2; ++i) {
            const int rr = (tid >> 4) + 32 * i, c4 = (tid & 15) * 4, col = nt * 64 + c4;
            float4 v = make_float4(0.f, 0.f, 0.f, 0.f);
            if (col < Nsrc) v = *(const float4*)(src + (size_t)(kt * 64 + rr) * Nsrc + col);
            float* tp = tile + rr * 65 + c4; tp[0] = v.x; tp[1] = v.y; tp[2] = v.z; tp[3] = v.w;
        }
        __syncthreads();
        { const int n = tid >> 3, k8 = (tid & 7) * 8; float f[8];
#pragma unroll
          for (int j = 0; j < 8; ++j) f[j] = tile[(k8 + j) * 65 + n];
          *(u32x4*)(dst + (size_t)(nt * 64 + n) * K + kt * 64 + k8) = pack8(f); }
        __syncthreads();
    }
}

__device__ void phase_norm(const Params& p, int l) {
    const int tid_ = tid_l(); const int lane = tid_ & 63, wid = tid_ >> 6;
    bf16_t* A1 = (bf16_t*)(p.ws + WS_A);
    const float* nw = p.in[I_NORMW] + l * 1024;
    for (int row = blockIdx.x * 8 + wid; row < M1; row += gridDim.x * 8) {
        const float* src;
        if (row < TP) src = (l == 0 ? p.in[I_XP] : p.out + O_YP) + (size_t)row * 1024;
        else if (row < TALL) src = (l == 0 ? p.in[I_XS] : p.out + O_YS) + (size_t)(row - TP) * 1024;
        else src = p.in[I_SSHIFT] + ((size_t)l * TS + (row - TALL)) * 1024;
        float4 v[4]; float ss = 0.f;
#pragma unroll
        for (int i = 0; i < 4; ++i) v[i] = *(const float4*)(src + i * 256 + lane * 4);
        if (l == 1 && row >= TP && row < TALL) {
            const float* x0 = p.in[I_XS] + (size_t)(row - TP) * 1024; const float* pt = (const float*)(p.ws + WS_PART) + (size_t)(row - TP) * 1024;
#pragma unroll
            for (int i = 0; i < 4; ++i) { float4 a = *(const float4*)(x0 + i * 256 + lane * 4);
                for (int q = 0; q < 16; ++q) { const float4 t = *(const float4*)(pt + (size_t)q * TS * 1024 + i * 256 + lane * 4); a.x += t.x; a.y += t.y; a.z += t.z; a.w += t.w; }
                v[i] = a; *(float4*)(p.out + O_YS + (size_t)(row - TP) * 1024 + i * 256 + lane * 4) = a; }
        }
#pragma unroll
        for (int i = 0; i < 4; ++i) ss += v[i].x * v[i].x + v[i].y * v[i].y + v[i].z * v[i].z + v[i].w * v[i].w;
        if (row < TALL) {
            ss = wave_sum(ss);
            const float rs = rsqrtf(ss * (1.0f / 1024.0f) + 1e-5f);
#pragma unroll
            for (int i = 0; i < 4; ++i) { const float4 w = *(const float4*)(nw + i * 256 + lane * 4); v[i].x *= rs * w.x; v[i].y *= rs * w.y; v[i].z *= rs * w.z; v[i].w *= rs * w.w; }
            float* so = nullptr;
            if (row < TP) { if ((row & 2047) == 2047) so = p.out + O_PSH + ((size_t)l * 8 + (row >> 11)) * 1024; }
            else so = p.out + O_SSH + ((size_t)l * TS + (row - TP)) * 1024;
            if (so) {
#pragma unroll
                for (int i = 0; i < 4; ++i) *(float4*)(so + i * 256 + lane * 4) = v[i]; }
        }
#pragma unroll
        for (int i = 0; i < 4; ++i) { u32x2 w; w.x = pk2(v[i].x, v[i].y); w.y = pk2(v[i].z, v[i].w); *(u32x2*)(A1 + (size_t)row * 1024 + i * 256 + lane * 4) = w; }
    }
}

__device__ void phase_final(const Params& p) {
    const int tid_ = tid_l(); const int lane = tid_ & 63, wid = tid_ >> 6;
    const float* nw = p.in[I_FNW];
    for (int row = blockIdx.x * 8 + wid; row < TALL; row += gridDim.x * 8) {
        float* src = (row < TP) ? p.out + O_YP + (size_t)row * 1024 : p.out + O_YS + (size_t)(row - TP) * 1024;
        float4 v[4]; float ss = 0.f;
#pragma unroll
        for (int i = 0; i < 4; ++i) v[i] = *(const float4*)(src + i * 256 + lane * 4);
        if (row >= TP) { const float* pt = (const float*)(p.ws + WS_PART) + (size_t)(row - TP) * 1024;
#pragma unroll
            for (int i = 0; i < 4; ++i) for (int q = 0; q < 16; ++q) { const float4 t = *(const float4*)(pt + (size_t)q * TS * 1024 + i * 256 + lane * 4); v[i].x += t.x; v[i].y += t.y; v[i].z += t.z; v[i].w += t.w; } }
#pragma unroll
        for (int i = 0; i < 4; ++i) ss += v[i].x * v[i].x + v[i].y * v[i].y + v[i].z * v[i].z + v[i].w * v[i].w;
        ss = wave_sum(ss);
        const float rs = rsqrtf(ss * (1.0f / 1024.0f) + 1e-5f);
#pragma unroll
        for (int i = 0; i < 4; ++i) { const float4 w = *(const float4*)(nw + i * 256 + lane * 4); v[i].x *= rs * w.x; v[i].y *= rs * w.y; v[i].z *= rs * w.z; v[i].w *= rs * w.w;
            *(float4*)(src + i * 256 + lane * 4) = v[i]; }
    }
}

struct EpiP {
    static constexpr bool PERM = true, AFTER_DRAIN = false;
    bf16_t* O; int ldc;
    __device__ __forceinline__ void operator()(const f32x4 (&acc)[2][2][4][2], const pg8::Unit& u, int wr, int wc, int fr, int fq) const {
        const int row0 = u.pm * 256 + wr * 64 + fr, col0 = u.pn * 256 + wc * 32 + 8 * fq;
#pragma unroll
        for (int ai = 0; ai < 2; ++ai)
#pragma unroll
            for (int m = 0; m < 4; ++m) { bf16_t* rowp = O + (size_t)(row0 + ai * 128 + m * 16) * ldc + col0;
#pragma unroll
                for (int bj = 0; bj < 2; ++bj) { const f32x4 v0 = acc[ai][bj][m][0], v1 = acc[ai][bj][m][1];
                    u32x4 w; w.x = pg8::cvt_pk_bf16(v0[0], v0[1]); w.y = pg8::cvt_pk_bf16(v0[2], v0[3]); w.z = pg8::cvt_pk_bf16(v1[0], v1[1]); w.w = pg8::cvt_pk_bf16(v1[2], v1[3]);
                    *(u32x4*)(rowp + bj * 128) = w; } }
    }
};
struct EpiRes {
    static constexpr bool PERM = false, AFTER_DRAIN = false;
    const float* res_p; float* out_p;
    __device__ __forceinline__ void operator()(const f32x4 (&acc)[2][2][4][2], const pg8::Unit& u, int wr, int wc, int fr, int fq) const {
        const int row0 = u.pm * 256 + wr * 64 + fr, col0 = u.pn * 256 + wc * 32 + 4 * fq;
#pragma unroll
        for (int ai = 0; ai < 2; ++ai)
#pragma unroll
            for (int m = 0; m < 4; ++m) { const size_t ro = (size_t)(row0 + ai * 128 + m * 16) * 1024;
#pragma unroll
                for (int bj = 0; bj < 2; ++bj)
#pragma unroll
                    for (int n = 0; n < 2; ++n) { const int c = col0 + bj * 128 + n * 16; const f32x4 r = *(const f32x4*)(res_p + ro + c); *(f32x4*)(out_p + ro + c) = acc[ai][bj][m][n] + r; } }
    }
};

constexpr int CH_NB = 6, CH_CB = 15104, CH_NH = 5;
constexpr int CB_A1 = 0, CB_A2 = 3328, CB_TT = 6656, CB_ZQ = 7936, CB_ZK = 10240, CB_V = 12544, CB_GQ = 14848;
constexpr int CH_SCR = CH_NB * CH_CB;
constexpr int SCR_TW = 0, SCR_EXL = 4608, SCR_SZ = 8704;
constexpr int CH_W2T = CH_SCR + CH_NH * SCR_SZ;
constexpr int CH_CST = CH_W2T + 18432;
constexpr int CH_FLG = CH_CST + 2560;
__device__ __forceinline__ unsigned cvtpk(float lo, float hi) { return pg8::cvt_pk_bf16(lo, hi); }
__device__ void rwkv_chain_item(const Params& p, int l, int item, unsigned char* smem_) {
    unsigned char* smem = launder_lds(smem_);
    const int tid = tid_l(), wid = tid >> 6, lane = tid & 63, fr = lane & 15, fq = lane >> 4;
    const int b = item >> 4, h = item & 15;
    bf16_t* w2t = (bf16_t*)(smem + CH_W2T); bf16_t* a2t = w2t + 4608;
    float* cst = (float*)(smem + CH_CST);
    volatile LAS unsigned* ready = (volatile LAS unsigned*)((LAS unsigned char*)smem + CH_FLG); volatile LAS unsigned* cons = ready + 128; volatile LAS unsigned* ready2 = ready + 256;
    const bf16_t* P = (const bf16_t*)(p.ws + WS_P);
    float* ORAW = (float*)(p.ws + WS_ORAW);
    bf16_t* BV = (bf16_t*)(p.ws + WS_BV);
    __syncthreads();
    for (int i = tid; i < CH_W2T / 4; i += 512) ((unsigned*)smem)[i] = 0u;
    if (tid < 384) ((unsigned*)(smem + CH_FLG))[tid] = 0u;
    { const float* w2 = p.in[I_W2] + (size_t)l * 64 * 1024 + h * 64; const float* a2 = p.in[I_A2] + (size_t)l * 64 * 1024 + h * 64;
#pragma unroll
      for (int i = 0; i < 8; ++i) { const int idx = tid + 512 * i, k = idx >> 6, n = idx & 63; w2t[n * 72 + k] = f2bf(w2[(size_t)k * 1024 + n]); a2t[n * 72 + k] = f2bf(a2[(size_t)k * 1024 + n]); } }
    if (tid < 64) { const float* mu = p.in[I_MU] + (size_t)l * 3200; const int gc = h * 64 + tid;
        cst[tid] = mu[C_R + gc]; cst[64 + tid] = mu[C_K + gc]; cst[128 + tid] = mu[C_V + gc]; cst[192 + tid] = mu[C_WL + tid]; cst[256 + tid] = mu[C_AL + tid];
        cst[320 + tid] = p.in[I_KK][l * 1024 + gc]; cst[384 + tid] = p.in[I_KA][l * 1024 + gc]; cst[448 + tid] = p.in[I_RK][l * 1024 + gc];
        cst[512 + tid] = p.in[I_W0][l * 1024 + gc]; cst[576 + tid] = p.in[I_A0][l * 1024 + gc]; }
    __syncthreads();

    if (wid >= 3) {
        const int hw = wid - 3, tok = lane >> 2, q4 = lane & 3, c0 = q4 * 16;
        unsigned char* scr = smem + CH_SCR + hw * SCR_SZ;
        bf16_t* tw = (bf16_t*)(scr + SCR_TW); bf16_t* ta = tw + 1152;
        float* exl = (float*)(scr + SCR_EXL);
        const int segcol[5] = {C_R + h * 64 + c0, C_K + h * 64 + c0, C_V + h * 64 + c0, C_WL + c0, C_AL + c0};
        float w0c[4], a0c[4];
#pragma unroll
        for (int ct = 0; ct < 4; ++ct) { w0c[ct] = cst[512 + ct * 16 + fr]; a0c[ct] = cst[576 + ct * 16 + fr]; }
        u32x4 qc[5][2], qp[5][2];
#define CLOAD(C) { const int t_ = (C) * 16 + tok; const bf16_t* pr_ = P + ((size_t)b * 2048 + t_) * N1; \
            _Pragma("unroll") for (int sg = 0; sg < 5; ++sg) _Pragma("unroll") for (int hh = 0; hh < 2; ++hh) { qc[sg][hh] = *(const u32x4*)(pr_ + segcol[sg] + hh * 8); \
                if (t_ > 0) qp[sg][hh] = *(const u32x4*)(pr_ - N1 + segcol[sg] + hh * 8); else qp[sg][hh] = (u32x4){0u, 0u, 0u, 0u}; } }
        CLOAD(hw)
        for (int c = hw; c < 128; c += CH_NH) {
            unsigned char* cb = smem + (c % CH_NB) * CH_CB;
            bf16_t* A1 = (bf16_t*)(cb + CB_A1); bf16_t* A2 = (bf16_t*)(cb + CB_A2); bf16_t* ZQ = (bf16_t*)(cb + CB_ZQ); bf16_t* ZK = (bf16_t*)(cb + CB_ZK); bf16_t* Vn = (bf16_t*)(cb + CB_V); float* GQ = (float*)(cb + CB_GQ);
            const size_t grow = (size_t)b * 2048 + c * 16 + tok;
            if (c >= CH_NB) { while (cons[c - CH_NB] < 2u) __builtin_amdgcn_s_sleep(1); }
            asm volatile("" ::: "memory");
            float* exa = (float*)(cb + CB_ZQ);
            float xr[16], xk[16]; unsigned xvp[8];
            { float cur[8], prv[8], xw[8], xa[8], xv[8];
#pragma unroll
              for (int hh = 0; hh < 2; ++hh) {
#define LSEG(dst, sg, mo) { unpack8(qc[sg][hh], cur); unpack8(qp[sg][hh], prv); _Pragma("unroll") for (int e = 0; e < 8; ++e) dst[e] = cur[e] + (prv[e] - cur[e]) * cst[(mo) + c0 + hh * 8 + e]; }
                LSEG((xr + hh * 8), 0, 0) LSEG((xk + hh * 8), 1, 64) LSEG(xv, 2, 128) LSEG(xw, 3, 192) LSEG(xa, 4, 256)
#undef LSEG
                { const u32x4 pv = pack8(xv); xvp[hh * 4] = pv.x; xvp[hh * 4 + 1] = pv.y; xvp[hh * 4 + 2] = pv.z; xvp[hh * 4 + 3] = pv.w; }
#pragma unroll
                for (int e = 0; e < 8; ++e) xw[e] = 1.0f - 2.0f * frcp(__expf(2.0f * xw[e]) + 1.0f);
                *(u32x4*)(tw + tok * 72 + c0 + hh * 8) = pack8(xw); *(u32x4*)(ta + tok * 72 + c0 + hh * 8) = pack8(xa);
              } }
            if (c + CH_NH < 128) CLOAD(c + CH_NH)
            lds_fence();
#pragma unroll
            for (int ct = 0; ct < 4; ++ct) { f32x4 aw = {0.f, 0.f, 0.f, 0.f}, aa = aw;
#pragma unroll
                for (int ks = 0; ks < 2; ++ks) {
                    aw = MFMA16(*(const bf16x8*)(tw + fr * 72 + ks * 32 + fq * 8), *(const bf16x8*)(w2t + (ct * 16 + fr) * 72 + ks * 32 + fq * 8), aw);
                    aa = MFMA16(*(const bf16x8*)(ta + fr * 72 + ks * 32 + fq * 8), *(const bf16x8*)(a2t + (ct * 16 + fr) * 72 + ks * 32 + fq * 8), aa); }
#pragma unroll
                for (int j = 0; j < 4; ++j) { const int tj = fq * 4 + j, col = ct * 16 + fr;
                    exl[tj * 64 + col] = -0.60653066f * sigmoidf_(w0c[ct] + aw[j]);
                    exa[tj * 64 + col] = sigmoidf_(a0c[ct] + aa[j]); } }
            lds_fence();
            { float lv[16];
#pragma unroll
              for (int t = 0; t < 16; ++t) lv[t] = exl[t * 64 + lane];
              float Lc = 0.f;
#pragma unroll
              for (int t = 0; t < 16; ++t) { Lc += lv[t]; lv[t] = __expf(Lc); }
#pragma unroll
              for (int t = 0; t < 16; ++t) exl[t * 64 + lane] = lv[t];
              GQ[lane] = lv[15]; }
            float a16[16];
#pragma unroll
            for (int i = 0; i < 4; ++i) { const float4 t4 = *(const float4*)(exa + tok * 64 + c0 + i * 4); a16[i * 4] = t4.x; a16[i * 4 + 1] = t4.y; a16[i * 4 + 2] = t4.z; a16[i * 4 + 3] = t4.w; }
            float ssq = 0.f, beta = 0.f;
#pragma unroll
            for (int e = 0; e < 16; ++e) { const float kr_ = xk[e] * cst[320 + c0 + e]; ssq += kr_ * kr_; }
            ssq += dppf<0xB1>(ssq); ssq += dppf<0x4E>(ssq);
            const float inv = frcp(fmaxf(__builtin_amdgcn_sqrtf(ssq), 1e-12f));
            lds_fence();
            {
              *(u32x4*)(Vn + tok * 72 + c0) = (u32x4){xvp[0], xvp[1], xvp[2], xvp[3]}; *(u32x4*)(Vn + tok * 72 + c0 + 8) = (u32x4){xvp[4], xvp[5], xvp[6], xvp[7]};
#pragma unroll
              for (int gI = 0; gI < 4; ++gI) {
                float pt[4], rt[4], qt[4], kt[4];
#pragma unroll
                for (int e3 = 0; e3 < 4; ++e3) { const int e = gI * 4 + e3; const float el = exl[tok * 64 + c0 + e], elm = tok > 0 ? exl[(tok - 1) * 64 + c0 + e] : 1.0f, iv = frcp(el);
                    const float kk_ = xk[e] * cst[320 + c0 + e] * inv, kp_ = xk[e] * (1.0f + (a16[e] - 1.0f) * cst[384 + c0 + e]), bb_ = -kk_ * a16[e];
                    beta += xr[e] * kp_ * cst[448 + c0 + e];
                    pt[e3] = kk_ * elm; rt[e3] = xr[e] * el; qt[e3] = bb_ * iv; kt[e3] = kp_ * iv;
                    }
                const int s0 = (q4 >> 1) * 32 + gI * 8 + (q4 & 1) * 4;
                u32x2 w; w.x = cvtpk(pt[0], pt[1]); w.y = cvtpk(pt[2], pt[3]); *(u32x2*)(A1 + tok * 104 + s0) = w;
                w.x = cvtpk(rt[0], rt[1]); w.y = cvtpk(rt[2], rt[3]); *(u32x2*)(A2 + tok * 104 + s0) = w;
                w.x = cvtpk(qt[0], qt[1]); w.y = cvtpk(qt[2], qt[3]); *(u32x2*)(ZQ + tok * 72 + s0) = w;
                w.x = cvtpk(kt[0], kt[1]); w.y = cvtpk(kt[2], kt[3]); *(u32x2*)(ZK + tok * 72 + s0) = w;
              } }
            beta += dppf<0xB1>(beta); beta += dppf<0x4E>(beta);
            { float bv[16];
#pragma unroll
              for (int e = 0; e < 16; ++e) bv[e] = beta * __uint_as_float((e & 1) ? (xvp[e >> 1] & 0xffff0000u) : (xvp[e >> 1] << 16));
              *(u32x4*)(BV + grow * 1024 + h * 64 + c0) = pack8(bv); *(u32x4*)(BV + grow * 1024 + h * 64 + c0 + 8) = pack8(bv + 8); }
            lds_fence();
            if (lane == 0) ready[c] = 1u;
        }
#undef CLOAD
    } else {
        if (wid == 2) {
            for (int c = 0; c < 128; ++c) {
                unsigned char* cbw = smem + (c % CH_NB) * CH_CB;
                bf16_t* A1 = (bf16_t*)(cbw + CB_A1); bf16_t* A2 = (bf16_t*)(cbw + CB_A2); bf16_t* TT = (bf16_t*)(cbw + CB_TT);
                const bf16_t* ZQ = (const bf16_t*)(cbw + CB_ZQ); const bf16_t* ZK = (const bf16_t*)(cbw + CB_ZK);
                while (ready[c] == 0u) __builtin_amdgcn_s_sleep(1);
                asm volatile("" ::: "memory");
                { f32x4 gN = {0.f, 0.f, 0.f, 0.f}, gKP = gN, gQR = gN, gKR = gN;
#pragma unroll
                  for (int ks = 0; ks < 2; ++ks) {
                      const bf16x8 fzq = *(const bf16x8*)(ZQ + fr * 72 + ks * 32 + fq * 8), fzk = *(const bf16x8*)(ZK + fr * 72 + ks * 32 + fq * 8);
                      const bf16x8 fp = *(const bf16x8*)(A1 + fr * 104 + ks * 32 + fq * 8), frr = *(const bf16x8*)(A2 + fr * 104 + ks * 32 + fq * 8);
                      gN = MFMA16(fzq, fp, gN); gKP = MFMA16(fzk, fp, gKP); gQR = MFMA16(fzq, frr, gQR); gKR = MFMA16(fzk, frr, gKR); }
#pragma unroll
                  for (int jj = 0; jj < 4; ++jj) { const int j = fq * 4 + jj; const bool lt = j < fr, le = j <= fr;
                      gN[jj] = lt ? gN[jj] : 0.f; gKP[jj] = lt ? gKP[jj] : 0.f; gQR[jj] = le ? gQR[jj] : 0.f; gKR[jj] = le ? gKR[jj] : 0.f; }
                  u32x4 w1; w1.x = 0u; w1.y = 0u; w1.z = pk2(gKP[0], gKP[1]); w1.w = pk2(gKP[2], gKP[3]); *(u32x4*)(A1 + fr * 104 + 64 + fq * 8) = w1;
                  u32x4 w2; w2.x = pk2(gQR[0], gQR[1]); w2.y = pk2(gQR[2], gQR[3]); w2.z = pk2(gKR[0], gKR[1]); w2.w = pk2(gKR[2], gKR[3]); *(u32x4*)(A2 + fr * 104 + 64 + fq * 8) = w2;
                  float Ti[16]; int i = fr; asm volatile("" : "+v"(i));
#pragma unroll
                  for (int t = 0; t < 16; ++t) { float s_ = (i == t) ? 1.0f : 0.0f;
                      __builtin_amdgcn_sched_barrier(0);
#pragma unroll
                      for (int j = 0; j < t; ++j) s_ += Ti[j] * __int_as_float(__builtin_amdgcn_readlane(__float_as_int(gN[j & 3]), (j >> 2) * 16 + t));
                      Ti[t] = s_; }
                  if (lane < 16) { const int sq = (i >> 2) * 8 + (i & 3);
#pragma unroll
                      for (int t = 0; t < 16; ++t) TT[t * 40 + sq] = f2bf(Ti[t]); } }
                lds_fence();
                if (lane == 0) ready2[c] = 1u;
            }
        } else {
            const int ng = 2, g0 = wid * 2;
            f32x4 acc[2][4];
#pragma unroll
            for (int gi = 0; gi < 2; ++gi)
#pragma unroll
                for (int kt = 0; kt < 4; ++kt) acc[gi][kt] = (f32x4){0.f, 0.f, 0.f, 0.f};
            for (int c = 0; c < 128; ++c) {
                const unsigned char* cbw = smem + (c % CH_NB) * CH_CB;
                const bf16_t* A1 = (const bf16_t*)(cbw + CB_A1); const bf16_t* A2 = (const bf16_t*)(cbw + CB_A2); const bf16_t* TT = (const bf16_t*)(cbw + CB_TT);
                const bf16_t* ZQ = (const bf16_t*)(cbw + CB_ZQ); const bf16_t* ZK = (const bf16_t*)(cbw + CB_ZK); const bf16_t* Vn = (const bf16_t*)(cbw + CB_V); const float* GQ = (const float*)(cbw + CB_GQ);
                while (ready2[c] == 0u) __builtin_amdgcn_s_sleep(1);
                asm volatile("" ::: "memory");
                union U8 { u32x4 u; bf16x8 h; };
                U8 FA[4];
#pragma unroll
                for (int kt = 0; kt < 4; ++kt) { const int sk = (kt >> 1) * 32 + (fr >> 2) * 8 + (kt & 1) * 4 + (fr & 3);
                    const unsigned q0 = ZQ[(fq * 4 + 0) * 72 + sk], q1 = ZQ[(fq * 4 + 1) * 72 + sk], q2 = ZQ[(fq * 4 + 2) * 72 + sk], q3 = ZQ[(fq * 4 + 3) * 72 + sk];
                    const unsigned k0 = ZK[(fq * 4 + 0) * 72 + sk], k1 = ZK[(fq * 4 + 1) * 72 + sk], k2 = ZK[(fq * 4 + 2) * 72 + sk], k3 = ZK[(fq * 4 + 3) * 72 + sk];
                    FA[kt].u.x = q0 | (q1 << 16); FA[kt].u.y = q2 | (q3 << 16); FA[kt].u.z = k0 | (k1 << 16); FA[kt].u.w = k2 | (k3 << 16); }
                const bf16x8 a1f0 = *(const bf16x8*)(A1 + fr * 104 + fq * 8), a1f1 = *(const bf16x8*)(A1 + fr * 104 + 32 + fq * 8), a1f2 = *(const bf16x8*)(A1 + fr * 104 + 64 + fq * 8);
                const bf16x8 a2f0 = *(const bf16x8*)(A2 + fr * 104 + fq * 8), a2f1 = *(const bf16x8*)(A2 + fr * 104 + 32 + fq * 8), a2f2 = *(const bf16x8*)(A2 + fr * 104 + 64 + fq * 8);
                const bf16x8 ttf = *(const bf16x8*)(TT + fr * 40 + fq * 8);
                float4 gq[4];
#pragma unroll
                for (int kt = 0; kt < 4; ++kt) gq[kt] = *(const float4*)(GQ + kt * 16 + fq * 4);
#pragma unroll
                for (int gi = 0; gi < 2; ++gi) if (gi < ng) {
                    const int v0 = (g0 + gi) * 16;
                    U8 B0, B1, BX;
                    B0.u.x = cvtpk(acc[gi][0][0], acc[gi][0][1]); B0.u.y = cvtpk(acc[gi][0][2], acc[gi][0][3]); B0.u.z = cvtpk(acc[gi][1][0], acc[gi][1][1]); B0.u.w = cvtpk(acc[gi][1][2], acc[gi][1][3]);
                    B1.u.x = cvtpk(acc[gi][2][0], acc[gi][2][1]); B1.u.y = cvtpk(acc[gi][2][2], acc[gi][2][3]); B1.u.z = cvtpk(acc[gi][3][0], acc[gi][3][1]); B1.u.w = cvtpk(acc[gi][3][2], acc[gi][3][3]);
                    u32x2 vq;
                    { const unsigned e0 = Vn[(fq * 4 + 0) * 72 + v0 + fr], e1 = Vn[(fq * 4 + 1) * 72 + v0 + fr], e2 = Vn[(fq * 4 + 2) * 72 + v0 + fr], e3 = Vn[(fq * 4 + 3) * 72 + v0 + fr];
                      vq.x = e0 | (e1 << 16); vq.y = e2 | (e3 << 16); }
                    BX.u.x = 0u; BX.u.y = 0u; BX.u.z = vq.x; BX.u.w = vq.y;
                    f32x4 rhs = {0.f, 0.f, 0.f, 0.f};
                    rhs = MFMA16(a1f0, B0.h, rhs); rhs = MFMA16(a1f1, B1.h, rhs); rhs = MFMA16(a1f2, BX.h, rhs);
                    BX.u.x = pk2(rhs[0], rhs[1]); BX.u.y = pk2(rhs[2], rhs[3]); BX.u.z = 0u; BX.u.w = 0u;
                    f32x4 uu = {0.f, 0.f, 0.f, 0.f};
                    uu = MFMA16(ttf, BX.h, uu);
                    BX.u.x = pk2(uu[0], uu[1]); BX.u.y = pk2(uu[2], uu[3]); BX.u.z = vq.x; BX.u.w = vq.y;
                    f32x4 oo = {0.f, 0.f, 0.f, 0.f};
                    oo = MFMA16(a2f0, B0.h, oo); oo = MFMA16(a2f1, B1.h, oo); oo = MFMA16(a2f2, BX.h, oo);
#pragma unroll
                    for (int kt = 0; kt < 4; ++kt) { acc[gi][kt] = MFMA16(FA[kt].h, BX.h, acc[gi][kt]);
                        acc[gi][kt][0] *= gq[kt].x; acc[gi][kt][1] *= gq[kt].y; acc[gi][kt][2] *= gq[kt].z; acc[gi][kt][3] *= gq[kt].w; }
                    float* op = ORAW + ((size_t)b * 2048 + c * 16 + fq * 4) * 1024 + h * 64 + v0 + fr;
#pragma unroll
                    for (int jj = 0; jj < 4; ++jj) op[(size_t)jj * 1024] = oo[jj];
                }
                asm volatile("s_waitcnt lgkmcnt(0)" ::: "memory");
                if (lane == 0) __hip_atomic_fetch_add((LAS unsigned*)&cons[c], 1u, __ATOMIC_RELAXED, __HIP_MEMORY_SCOPE_WORKGROUP);
            }
#pragma unroll
            for (int gi = 0; gi < 2; ++gi) if (gi < ng) {
                float* so = p.out + O_PWKV + ((((size_t)l * 8 + b) * 16 + h) * 64 + (g0 + gi) * 16 + fr) * 64 + fq * 4;
#pragma unroll
                for (int kt = 0; kt < 4; ++kt) *(float4*)(so + kt * 16) = make_float4(acc[gi][kt][0], acc[gi][kt][1], acc[gi][kt][2], acc[gi][kt][3]);
            }
        }
    }
    __syncthreads();
}

__device__ void rwkv_sample_item(const Params& p, int l, int item, unsigned char* smem_) {
    unsigned char* smem = launder_lds(smem_);
    const int tid = tid_l(), lane = tid & 63, ks = tid >> 6;
    const int i = item >> 4, h = item & 15;
    float* part = (float*)smem;
    float* sv = part + 1024;
    float* s_sc = sv + 384;
    const bf16_t* P = (const bf16_t*)(p.ws + WS_P);
    float* ORAW = (float*)(p.ws + WS_ORAW);
    bf16_t* BV = (bf16_t*)(p.ws + WS_BV);
    const size_t rowp = (size_t)TP + i, rows = (size_t)TALL + i;
    const bf16_t* pc = P + rowp * N1; const bf16_t* pp = P + rows * N1;
    const float* mu = p.in[I_MU] + (size_t)l * 3200;
    const int gc = h * 64 + lane;
    const int row = tid >> 3, cs = (tid & 7) * 8;
    const size_t so = ((((size_t)l * TS + i) * 16 + h) * 64 + row) * 64 + cs;
    const float4 a0 = *(const float4*)(p.in[I_SWKV] + so), a1 = *(const float4*)(p.in[I_SWKV] + so + 4);
#define LERP1(col) (bf2f(pc[col]) + (bf2f(pp[col]) - bf2f(pc[col])) * mu[col])
    { const float* w2 = p.in[I_W2] + (size_t)l * 64 * 1024 + gc; const float* a2 = p.in[I_A2] + (size_t)l * 64 * 1024 + gc;
      float lw = 0.f, la = 0.f;
#pragma unroll
      for (int kk = 0; kk < 8; ++kk) { const int k = ks * 8 + kk; const float xwl = LERP1(C_WL + k), xal = LERP1(C_AL + k);
          lw += (1.0f - 2.0f * frcp(__expf(2.0f * xwl) + 1.0f)) * w2[(size_t)k * 1024]; la += xal * a2[(size_t)k * 1024]; }
      __syncthreads();
      part[ks * 64 + lane] = lw; part[512 + ks * 64 + lane] = la; }
    __syncthreads();
    if (tid < 64) {
        const float xr = LERP1(C_R + gc), xk = LERP1(C_K + gc), xv = LERP1(C_V + gc);
        float lw = 0.f, la = 0.f;
#pragma unroll
        for (int q = 0; q < 8; ++q) { lw += part[q * 64 + lane]; la += part[512 + q * 64 + lane]; }
        const float w = __expf(-0.60653066f * sigmoidf_(p.in[I_W0][l * 1024 + gc] + lw));
        const float a = sigmoidf_(p.in[I_A0][l * 1024 + gc] + la);
        float kk = xk * p.in[I_KK][l * 1024 + gc];
        const float ssq = wave_sum(kk * kk);
        kk *= 1.0f / fmaxf(sqrtf(ssq), 1e-12f);
        const float kp = xk * (1.0f + (a - 1.0f) * p.in[I_KA][l * 1024 + gc]);
        const float bb = -kk * a, wr = w * xr;
        const float br = wave_sum(bb * xr), kr = wave_sum(kp * xr), beta = wave_sum(xr * kp * p.in[I_RK][l * 1024 + gc]);
        sv[lane] = w; sv[64 + lane] = kk; sv[128 + lane] = bb; sv[192 + lane] = kp; sv[256 + lane] = wr; sv[320 + lane] = xv;
        if (lane == 0) { s_sc[0] = br; s_sc[1] = kr; }
        BV[rowp * 1024 + gc] = f2bf(beta * xv);
    }
#undef LERP1
    __syncthreads();
    {
        float S[8] = {a0.x, a0.y, a0.z, a0.w, a1.x, a1.y, a1.z, a1.w};
        float dk = 0.f, dr = 0.f;
#pragma unroll
        for (int e = 0; e < 8; ++e) { dk += S[e] * sv[64 + cs + e]; dr += S[e] * sv[256 + cs + e]; }
        dk = red8(dk); dr = red8(dr);
        const float vr = sv[320 + row];
        const float o = dr + dk * s_sc[0] + vr * s_sc[1];
        if ((tid & 7) == 0) ORAW[rowp * 1024 + h * 64 + row] = o;
#pragma unroll
        for (int e = 0; e < 8; ++e) S[e] = S[e] * sv[cs + e] + dk * sv[128 + cs + e] + vr * sv[192 + cs + e];
        float* sout = p.out + O_SWKV + so;
        *(float4*)sout = make_float4(S[0], S[1], S[2], S[3]); *(float4*)(sout + 4) = make_float4(S[4], S[5], S[6], S[7]);
    }
}

__device__ void phase_conv(const Params& p, int l) {
    const int tid = tid_l();
    const bf16_t* P = (const bf16_t*)(p.ws + WS_P);
    bf16_t* U = (bf16_t*)(p.ws + WS_U); float* DT = (float*)(p.ws + WS_DT);
    for (int id = blockIdx.x * 512 + tid; id < 1024 * 384; id += gridDim.x * 512) {
        const int q = id % 384, seg = id / 384, xcol = q * 4;
        const int bb = seg >> 7, tb = (seg & 127) * 16;
        float4 cw0, cw1, cw2, cw3, cbv;
        { const float* cw = p.in[I_CW] + (size_t)l * 4 * 1536 + xcol; cw0 = *(const float4*)cw; cw1 = *(const float4*)(cw + 1536); cw2 = *(const float4*)(cw + 3072); cw3 = *(const float4*)(cw + 4608);
          cbv = *(const float4*)(p.in[I_CB] + (size_t)l * 1536 + xcol); }
        const bf16_t* pb = P + ((size_t)bb * 2048 + tb) * N1 + C_XBC + xcol;
        bf16_t* ub = U + ((size_t)bb * 2048 + tb) * 1536 + xcol;
        float4 w0 = make_float4(0.f, 0.f, 0.f, 0.f), w1 = w0, w2 = w0;
#define LD4(dst, ptr) { const u32x2 _v = *(const u32x2*)(ptr); dst = make_float4(__uint_as_float(_v.x << 16), __uint_as_float(_v.x & 0xffff0000u), __uint_as_float(_v.y << 16), __uint_as_float(_v.y & 0xffff0000u)); }
        if (tb >= 3) { LD4(w0, pb - 3 * (size_t)N1) LD4(w1, pb - 2 * (size_t)N1) LD4(w2, pb - (size_t)N1) }
#pragma unroll
        for (int s = 0; s < 16; ++s) {
            float4 cur; LD4(cur, pb + (size_t)s * N1)
            float4 u;
            u.x = cbv.x + cw0.x * w0.x + cw1.x * w1.x + cw2.x * w2.x + cw3.x * cur.x; u.y = cbv.y + cw0.y * w0.y + cw1.y * w1.y + cw2.y * w2.y + cw3.y * cur.y;
            u.z = cbv.z + cw0.z * w0.z + cw1.z * w1.z + cw2.z * w2.z + cw3.z * cur.z; u.w = cbv.w + cw0.w * w0.w + cw1.w * w1.w + cw2.w * w2.w + cw3.w * cur.w;
            u32x2 pk; pk.x = pk2(siluf_(u.x), siluf_(u.y)); pk.y = pk2(siluf_(u.z), siluf_(u.w));
            *(u32x2*)(ub + (size_t)s * 1536) = pk;
            w0 = w1; w1 = w2; w2 = cur;
        }
#undef LD4
    }
    for (int id = blockIdx.x * 512 + tid; id < TP * 16; id += gridDim.x * 512) {
        const int t = id >> 4, j = id & 15;
        DT[id] = softplusf_(bf2f(P[(size_t)t * N1 + C_DT + j]) + p.in[I_DTB][l * 16 + j]);
    }
}

__device__ void mamba_item(const Params& p, int l, int item, unsigned char* smem_) {
    unsigned char* smem = launder_lds(smem_);
    const int tid = tid_l(), wid = tid >> 6, lane = tid & 63, fr = lane & 15, fq = lane >> 4;
    const int b = item >> 5, j = (item >> 1) & 15, ph = item & 1, g = j >> 3;
    bf16_t* Cm = (bf16_t*)smem;
    bf16_t* Bm = (bf16_t*)(smem + 17408);
    bf16_t* BmT = (bf16_t*)(smem + 34816);
    bf16_t* XT = (bf16_t*)(smem + 53248);
    bf16_t* XwT = (bf16_t*)(smem + 57856);
    bf16_t* G = (bf16_t*)(smem + 62464);
    bf16_t* Hb = (bf16_t*)(smem + 71680);
    float* acs = (float*)(smem + 80384);
    float* dtv = acs + 64;
    const bf16_t* P = (const bf16_t*)(p.ws + WS_P);
    const bf16_t* U = (const bf16_t*)(p.ws + WS_U); const float* DT = (const float*)(p.ws + WS_DT);
    bf16_t* YM = (bf16_t*)(p.ws + WS_YM);
    __syncthreads();
    for (int i = tid; i < 32 * 136; i += 512) Hb[i] = 0;
    const float Aj = -__expf(p.in[I_ALOG][l * 16 + j]), Dj = p.in[I_DSK][l * 16 + j];
    const int c16a = wid * 2, c16b = wid * 2 + 1, c4 = wid & 3;
    const int lt = wid >> 1, pt = wid & 1;
    const bf16_t* ub = U + (size_t)b * 2048 * 1536;
    u32x4 rb0, rb1, rc0, rc1, rx = {0u, 0u, 0u, 0u}; float rdt = 0.f;
#define LOADCHUNK(T0) { const bf16_t* r0 = ub + (size_t)((T0) + lane) * 1536 + g * 128; \
        rb0 = *(const u32x4*)(r0 + 1024 + c16a * 8); rb1 = *(const u32x4*)(r0 + 1024 + c16b * 8); rc0 = *(const u32x4*)(r0 + 1280 + c16a * 8); rc1 = *(const u32x4*)(r0 + 1280 + c16b * 8); \
        if (tid < 256) rx = *(const u32x4*)(ub + (size_t)((T0) + lane) * 1536 + j * 64 + ph * 32 + c4 * 8); \
        if (wid == 5) rdt = DT[((size_t)b * 2048 + (T0) + lane) * 16 + j]; }
    LOADCHUNK(0)
    f32x4 hacc[2] = {{0.f, 0.f, 0.f, 0.f}, {0.f, 0.f, 0.f, 0.f}};
    for (int c = 0; c < 32; ++c) {
        const int t0 = c * 64;
        float zq[4];
#pragma unroll
        for (int jj = 0; jj < 4; ++jj) zq[jj] = bf2f(P[((size_t)b * 2048 + t0 + lt * 16 + fq * 4 + jj) * N1 + C_ZM + j * 64 + ph * 32 + pt * 16 + fr]);
        *(u32x4*)(Cm + lane * 136 + c16a * 8) = rc0; *(u32x4*)(Cm + lane * 136 + c16b * 8) = rc1;
        *(u32x4*)(Bm + lane * 136 + c16a * 8) = rb0; *(u32x4*)(Bm + lane * 136 + c16b * 8) = rb1;
#pragma unroll
        for (int e = 0; e < 8; ++e) { const unsigned v0 = rb0[e >> 1], v1 = rb1[e >> 1];
            BmT[(c16a * 8 + e) * 72 + lane] = (bf16_t)((e & 1) ? (v0 >> 16) : (v0 & 0xffffu)); BmT[(c16b * 8 + e) * 72 + lane] = (bf16_t)((e & 1) ? (v1 >> 16) : (v1 & 0xffffu)); }
        if (tid < 256) {
#pragma unroll
            for (int e = 0; e < 8; ++e) { const unsigned v0 = rx[e >> 1]; XT[(c4 * 8 + e) * 72 + lane] = (bf16_t)((e & 1) ? (v0 >> 16) : (v0 & 0xffffu)); }
        }
        if (wid == 5) {
            float v = rdt * Aj;
#pragma unroll
            for (int off = 1; off < 64; off <<= 1) { const float t = __shfl_up(v, off); if (lane >= off) v += t; }
            acs[lane] = v; dtv[lane] = rdt;
        }
        if (c + 1 < 32) LOADCHUNK(t0 + 64)
        LBAR();
        { const int pp = tid & 31, s4 = (tid >> 5) * 4; const float aend = acs[63];
          const u32x2 xv = *(const u32x2*)(XT + pp * 72 + s4);
          const float x0 = __uint_as_float(xv.x << 16), x1 = __uint_as_float(xv.x & 0xffff0000u), x2 = __uint_as_float(xv.y << 16), x3 = __uint_as_float(xv.y & 0xffff0000u);
          u32x2 bq; bq.x = pk2(x0 * dtv[s4] * __expf(aend - acs[s4]), x1 * dtv[s4 + 1] * __expf(aend - acs[s4 + 1]));
          bq.y = pk2(x2 * dtv[s4 + 2] * __expf(aend - acs[s4 + 2]), x3 * dtv[s4 + 3] * __expf(aend - acs[s4 + 3]));
          *(u32x2*)(XwT + pp * 72 + s4) = bq; }
#pragma unroll
        for (int e = 0; e < 2; ++e) {
            const int id = wid * 2 + e, glt = id >> 2, st = id & 3;
            f32x4 acc = {0.f, 0.f, 0.f, 0.f};
            if (st <= glt) {
#pragma unroll
                for (int ks = 0; ks < 4; ++ks) { const bf16x8 fa = *(const bf16x8*)(Cm + (glt * 16 + fr) * 136 + ks * 32 + fq * 8), fb = *(const bf16x8*)(Bm + (st * 16 + fr) * 136 + ks * 32 + fq * 8); acc = MFMA16(fa, fb, acc); }
            }
#pragma unroll
            for (int jj = 0; jj < 4; ++jj) { const int lr = glt * 16 + fq * 4 + jj, s = st * 16 + fr;
                const float val = (s <= lr) ? acc[jj] * __expf(acs[lr] - acs[s]) * dtv[s] : 0.f;
                G[lr * 72 + s] = f2bf(val); }
        }
        f32x4 accO = {0.f, 0.f, 0.f, 0.f};
#pragma unroll
        for (int ks = 0; ks < 4; ++ks) { const bf16x8 fa = *(const bf16x8*)(Cm + (lt * 16 + fr) * 136 + ks * 32 + fq * 8), fb = *(const bf16x8*)(Hb + (pt * 16 + fr) * 136 + ks * 32 + fq * 8); accO = MFMA16(fa, fb, accO); }
        LBAR();
        {
            f32x4 accD = {0.f, 0.f, 0.f, 0.f};
#pragma unroll
            for (int ks = 0; ks < 2; ++ks) { const bf16x8 fa = *(const bf16x8*)(G + (lt * 16 + fr) * 72 + ks * 32 + fq * 8), fb = *(const bf16x8*)(XT + (pt * 16 + fr) * 72 + ks * 32 + fq * 8); accD = MFMA16(fa, fb, accD); }
#pragma unroll
            for (int jj = 0; jj < 4; ++jj) { const int lr = lt * 16 + fq * 4 + jj, pp = pt * 16 + fr;
                float y = accD[jj] + __expf(acs[lr]) * accO[jj] + Dj * bf2f(XT[pp * 72 + lr]);
                y *= siluf_(zq[jj]);
                YM[((size_t)b * 2048 + t0 + lr) * 1024 + j * 64 + ph * 32 + pp] = f2bf(y); }
            const float cd = __expf(acs[63]); const int ptile = wid >> 2;
#pragma unroll
            for (int e = 0; e < 2; ++e) { const int nt = (wid & 3) * 2 + e;
                hacc[e] *= cd;
#pragma unroll
                for (int ks = 0; ks < 2; ++ks) { const bf16x8 fa = *(const bf16x8*)(XwT + (ptile * 16 + fr) * 72 + ks * 32 + fq * 8), fb = *(const bf16x8*)(BmT + (nt * 16 + fr) * 72 + ks * 32 + fq * 8); hacc[e] = MFMA16(fa, fb, hacc[e]); }
#pragma unroll
                for (int jj = 0; jj < 4; ++jj) Hb[(ptile * 16 + fq * 4 + jj) * 136 + nt * 16 + fr] = f2bf(hacc[e][jj]); }
        }
        LBAR();
    }
#undef LOADCHUNK
    { const int ptile = wid >> 2;
#pragma unroll
      for (int e = 0; e < 2; ++e) { const int nt = (wid & 3) * 2 + e;
#pragma unroll
          for (int jj = 0; jj < 4; ++jj) p.out[O_PSSM + ((((size_t)l * 8 + b) * 16 + j) * 64 + ph * 32 + ptile * 16 + fq * 4 + jj) * 128 + nt * 16 + fr] = hacc[e][jj]; } }
    __syncthreads();
}

__device__ void mamba_sample_item(const Params& p, int l, int item, unsigned char* smem_) {
    unsigned char* smem = launder_lds(smem_);
    const int tid = tid_l();
    const int i = item >> 4, j = item & 15, g = j >> 3;
    float* su = (float*)smem;
    float* sd = su + 320;
    const bf16_t* P = (const bf16_t*)(p.ws + WS_P);
    bf16_t* YM = (bf16_t*)(p.ws + WS_YM);
    const size_t rowp = (size_t)TP + i;
    const int pp = tid >> 3, n0 = (tid & 7) * 16;
    const size_t so = ((((size_t)l * TS + i) * 16 + j) * 64 + pp) * 128 + n0;
    float4 hv4[4];
#pragma unroll
    for (int e = 0; e < 4; ++e) hv4[e] = *(const float4*)(p.in[I_SSSM] + so + e * 4);
    __syncthreads();
    if (tid < 320) {
        const int cc = tid < 64 ? j * 64 + tid : (tid < 192 ? 1024 + g * 128 + (tid - 64) : 1280 + g * 128 + (tid - 192));
        const float* c0 = p.in[I_SCONV] + ((size_t)l * TS + i) * 3 * 1536 + cc;
        const float* cw = p.in[I_CW] + (size_t)l * 4 * 1536 + cc;
        const float v = p.in[I_CB][l * 1536 + cc] + c0[0] * cw[0] + c0[1536] * cw[1536] + c0[3072] * cw[3072] + bf2f(P[rowp * N1 + C_XBC + cc]) * cw[4608];
        su[tid] = siluf_(v);
    } else if (tid == 320) {
        const float dt = softplusf_(bf2f(P[rowp * N1 + C_DT + j]) + p.in[I_DTB][l * 16 + j]);
        sd[0] = dt; sd[1] = __expf(-dt * __expf(p.in[I_ALOG][l * 16 + j]));
    }
    __syncthreads();
    {
        float* hout = p.out + O_SSSM + so;
        const float dt = sd[0], eA = sd[1], x = su[pp], xdt = x * dt;
        float y = 0.f;
#pragma unroll
        for (int e = 0; e < 4; ++e) { float4 hv = hv4[e]; const float* Bp = su + 64 + n0 + e * 4; const float* Cp = su + 192 + n0 + e * 4;
            hv.x = eA * hv.x + xdt * Bp[0]; hv.y = eA * hv.y + xdt * Bp[1]; hv.z = eA * hv.z + xdt * Bp[2]; hv.w = eA * hv.w + xdt * Bp[3];
            y += hv.x * Cp[0] + hv.y * Cp[1] + hv.z * Cp[2] + hv.w * Cp[3];
            *(float4*)(hout + e * 4) = hv; }
        y = red8(y);
        if ((tid & 7) == 0) { y += p.in[I_DSK][l * 16 + j] * x; const float z = bf2f(P[rowp * N1 + C_ZM + j * 64 + pp]); YM[rowp * 1024 + j * 64 + pp] = f2bf(y * siluf_(z)); }
    }
}

__device__ void phase_mixa(const Params& p, int l, unsigned char* smem) {
    for (int rep = 0; rep < (DUP == 5 ? 2 : 1); ++rep) phase_conv(p, l);
    for (int rep = 0; rep < (DUP == 3 ? 2 : 1); ++rep)
    for (int it = blockIdx.x; it < 2048; it += gridDim.x) rwkv_sample_item(p, l, it, smem);
    for (int rep = 0; rep < (DUP == 4 ? 2 : 1); ++rep)
    for (int it = blockIdx.x; it < 2048; it += gridDim.x) mamba_sample_item(p, l, it, smem);
}
__device__ void phase_mixb(const Params& p, int l, unsigned char* smem) {
    const int G = (int)gridDim.x, nch = G >= 256 ? 128 : G;
    if ((int)blockIdx.x < nch) {
        for (int rep = 0; rep < (DUP == 1 ? 2 : 1); ++rep)
        for (int it = blockIdx.x; it < 128; it += nch) rwkv_chain_item(p, l, it, smem);
    }
    unsigned* ticket = (unsigned*)(p.ws + WS_BAR) + XCD_BAR_WORDS + 64 * l;
    volatile LAS int* slot = (volatile LAS int*)((LAS unsigned char*)smem + LDS_BARST + 8);
    for (;;) {
        __syncthreads();
        if (tid_l() == 0) *slot = (int)__hip_atomic_fetch_add(ticket, 1u, __ATOMIC_RELAXED, __HIP_MEMORY_SCOPE_AGENT);
        __syncthreads();
        const int it = *slot;
        if (it >= 256 * (DUP == 2 ? 2 : 1)) break;
        mamba_item(p, l, it & 255, smem);
    }
}

__device__ void sample_outproj(const Params& p, int l) {
    const int tid = tid_l(), wid = tid >> 6, lane = tid & 63, fr = lane & 15, fq = lane >> 4;
    const bf16_t* A2 = (const bf16_t*)(p.ws + WS_A) + (size_t)TP * 2048;
    const bf16_t* W = (const bf16_t*)(p.ws + WS_WOUTT) + (size_t)l * 1024 * 2048;
    float* PART = (float*)(p.ws + WS_PART);
    for (int it = blockIdx.x; it < 256; it += gridDim.x) {
        const int nt = it & 15, ksl = it >> 4;
        f32x4 acc[4] = {{0.f, 0.f, 0.f, 0.f}, {0.f, 0.f, 0.f, 0.f}, {0.f, 0.f, 0.f, 0.f}, {0.f, 0.f, 0.f, 0.f}};
#pragma unroll
        for (int kq = 0; kq < 4; ++kq) {
            const bf16x8 fa = *(const bf16x8*)(A2 + (size_t)(wid * 16 + fr) * 2048 + ksl * 128 + kq * 32 + fq * 8);
#pragma unroll
            for (int ct = 0; ct < 4; ++ct) { const bf16x8 fb = *(const bf16x8*)(W + (size_t)(nt * 64 + ct * 16 + fr) * 2048 + ksl * 128 + kq * 32 + fq * 8); acc[ct] = MFMA16(fa, fb, acc[ct]); }
        }
#pragma unroll
        for (int ct = 0; ct < 4; ++ct)
#pragma unroll
            for (int jj = 0; jj < 4; ++jj) PART[((size_t)ksl * TS + wid * 16 + fq * 4 + jj) * 1024 + nt * 64 + ct * 16 + fr] = acc[ct][jj];
    }
}

__device__ void phase_post(const Params& p, int l) {
    const int tid_ = tid_l(); const int lane = tid_ & 63, wid = tid_ >> 6;
    const bf16_t* P = (const bf16_t*)(p.ws + WS_P);
    const float* ORAW = (const float*)(p.ws + WS_ORAW);
    const bf16_t* BV = (const bf16_t*)(p.ws + WS_BV);
    const bf16_t* YM = (const bf16_t*)(p.ws + WS_YM);
    bf16_t* A2 = (bf16_t*)(p.ws + WS_A);
    const int c0 = lane * 16;
    float lnw[16], lnb[16], gnw[16];
#pragma unroll
    for (int e = 0; e < 16; ++e) { lnw[e] = p.in[I_LNW][l * 1024 + c0 + e]; lnb[e] = p.in[I_LNB][l * 1024 + c0 + e]; gnw[e] = p.in[I_GNW][l * 1024 + c0 + e]; }
    for (int row = blockIdx.x * 8 + wid; row < TALL; row += gridDim.x * 8) {
        const bf16_t* prow = P + (size_t)row * N1;
        float o[16], bv[16], z[16], ym[16];
#pragma unroll
        for (int i = 0; i < 4; ++i) { const float4 t = *(const float4*)(ORAW + (size_t)row * 1024 + c0 + i * 4); o[i * 4] = t.x; o[i * 4 + 1] = t.y; o[i * 4 + 2] = t.z; o[i * 4 + 3] = t.w; }
        unpack8(*(const u32x4*)(BV + (size_t)row * 1024 + c0), bv); unpack8(*(const u32x4*)(BV + (size_t)row * 1024 + c0 + 8), bv + 8);
        unpack8(*(const u32x4*)(prow + C_ZR + c0), z); unpack8(*(const u32x4*)(prow + C_ZR + c0 + 8), z + 8);
        unpack8(*(const u32x4*)(YM + (size_t)row * 1024 + c0), ym); unpack8(*(const u32x4*)(YM + (size_t)row * 1024 + c0 + 8), ym + 8);
        float s = 0.f;
#pragma unroll
        for (int e = 0; e < 16; ++e) s += o[e];
        s += dppf<0xB1>(s); s += dppf<0x4E>(s);
        const float mean = s * (1.0f / 64.0f);
        float v = 0.f;
#pragma unroll
        for (int e = 0; e < 16; ++e) { o[e] -= mean; v += o[e] * o[e]; }
        v += dppf<0xB1>(v); v += dppf<0x4E>(v);
        const float rstd = rsqrtf(v * (1.0f / 64.0f) + 64e-5f);
#pragma unroll
        for (int e = 0; e < 16; ++e) o[e] = (o[e] * rstd * lnw[e] + lnb[e] + bv[e]) * siluf_(z[e]);
        *(u32x4*)(A2 + (size_t)row * 2048 + c0) = pack8(o); *(u32x4*)(A2 + (size_t)row * 2048 + c0 + 8) = pack8(o + 8);
        float ss = 0.f;
#pragma unroll
        for (int e = 0; e < 16; ++e) ss += ym[e] * ym[e];
        ss = red16(ss); ss += __shfl_xor(ss, 16);
        const float rs = rsqrtf(ss * (1.0f / 512.0f) + 1e-5f);
#pragma unroll
        for (int e = 0; e < 16; ++e) ym[e] *= rs * gnw[e];
        *(u32x4*)(A2 + (size_t)row * 2048 + 1024 + c0) = pack8(ym); *(u32x4*)(A2 + (size_t)row * 2048 + 1024 + c0 + 8) = pack8(ym + 8);
        if (row < TP) {
            const int tq = row & 2047;
            if (tq >= 2045) { float* dst = p.out + O_PCONV + (((size_t)l * 8 + (row >> 11)) * 3 + (tq - 2045)) * 1536;
                for (int c = lane; c < 1536; c += 64) dst[c] = bf2f(prow[C_XBC + c]); }
        } else {
            const int i = row - TP; float* dst = p.out + O_SCONV + ((size_t)l * TS + i) * 3 * 1536; const float* src = p.in[I_SCONV] + ((size_t)l * TS + i) * 3 * 1536;
            for (int c = lane; c < 1536; c += 64) { dst[c] = src[1536 + c]; dst[1536 + c] = src[3072 + c]; dst[3072 + c] = bf2f(prow[C_XBC + c]); }
        }
    }
}

constexpr int NPHASE = 13;
__global__ __launch_bounds__(512, 2) void mega(Params p) {
    extern __shared__ __attribute__((aligned(16))) unsigned char smem[];
    cg::grid_group grid = cg::this_grid();
    volatile LAS unsigned* st = (volatile LAS unsigned*)((LAS unsigned char*)smem + LDS_BARST);
    { const unsigned hw = (unsigned)__builtin_amdgcn_s_getreg((5 << 11) | 4) & 63u;
      if ((threadIdx.x & 63) == 0) *(volatile LAS int*)((LAS unsigned char*)smem + LDS_WIDTAB + hw * 4u) = (int)(threadIdx.x >> 6);
      if (threadIdx.x == 0) { st[0] = 0u; st[1] = 0u; } }
    __syncthreads();
    const XcdBarrier xbar = xcd_barrier_post((unsigned*)(p.ws + WS_BAR), st);
    if (p.ph_hi > 1000) grid.sync();
#define PHASE(K, BODY) if (p.ph_lo <= (K) && (K) < p.ph_hi) { if ((K) > p.ph_lo) { xcd_barrier(xbar); if (DUP == 13) { xcd_barrier(xbar); xcd_barrier(xbar); } } BODY }
#define GEMM1(L) { pg8::Gemm g{(const bf16_t*)(p.ws + WS_A), (const bf16_t*)(p.ws + WS_WINT) + (size_t)(L) * N1 * 1024, M1, N1, 1024}; \
        pg8::StaticOrder S; S.init(M1, N1, (int)gridDim.x, (int)blockIdx.x); EpiP E{(bf16_t*)(p.ws + WS_P), N1}; \
        pg8::gemm_phase<EpiP, pg8::StaticOrder, false>((PG8_LAS unsigned char*)smem, g, S, E, nullptr); }
#define GEMM2(L) { sample_outproj(p, (L)); \
        pg8::Gemm g{(const bf16_t*)(p.ws + WS_A), (const bf16_t*)(p.ws + WS_WOUTT) + (size_t)(L) * 1024 * 2048, TP, 1024, 2048}; \
        pg8::StaticOrder S; S.init(TP, 1024, (int)gridDim.x, (int)blockIdx.x); EpiRes E{(L) == 0 ? p.in[I_XP] : p.out + O_YP, p.out + O_YP}; \
        pg8::gemm_phase<EpiRes, pg8::StaticOrder, false>((PG8_LAS unsigned char*)smem, g, S, E, nullptr); }
    PHASE(0, phase_convert(p, smem); phase_norm(p, 0);)
    PHASE(1, GEMM1(0))
    PHASE(2, phase_mixa(p, 0, smem);)
    PHASE(3, phase_mixb(p, 0, smem);)
    PHASE(4, phase_post(p, 0);)
    PHASE(5, GEMM2(0))
    PHASE(6, phase_norm(p, 1);)
    PHASE(7, GEMM1(1))
    PHASE(8, phase_mixa(p, 1, smem);)
    PHASE(9, phase_mixb(p, 1, smem);)
    PHASE(10, phase_post(p, 1);)
    PHASE(11, GEMM2(1))
    PHASE(12, phase_final(p);)
}

extern "C" void kernel_launch(void* const* d_in, const int* in_sizes, int n_in, void* d_out, int out_size, void* d_ws, size_t ws_size, hipStream_t stream) {
    static int grid = 0;
    if (grid == 0) {
        if (n_in != 26 || (size_t)out_size != O_END || ws_size < WS_BAR + (size_t)(XCD_BAR_WORDS + 128) * 4) { fprintf(stderr, "kernel_launch: unexpected shapes: n_in %d out %d ws %zu (need %zu)\n", n_in, out_size, ws_size, (size_t)(WS_BAR + XCD_BAR_WORDS * 4)); grid = -1; return; }
        int dev = 0, cus = 0, per_cu = 0;
        hipGetDevice(&dev); hipDeviceGetAttribute(&cus, hipDeviceAttributeMultiprocessorCount, dev);
        if (hipFuncSetAttribute((const void*)mega, hipFuncAttributeMaxDynamicSharedMemorySize, LDS_BYTES) != hipSuccess) { fprintf(stderr, "kernel_launch: hipFuncSetAttribute failed\n"); grid = -1; return; }
        if (hipOccupancyMaxActiveBlocksPerMultiprocessor(&per_cu, (const void*)mega, 512, LDS_BYTES) != hipSuccess || per_cu < 1) { fprintf(stderr, "kernel_launch: occupancy query gave %d\n", per_cu); per_cu = 1; }
        (void)hipGetLastError();
        grid = cus * 1;
    }
    if (grid < 0) return;
    if (hipMemsetAsync((char*)d_ws + WS_BAR, 0, (size_t)(XCD_BAR_WORDS + 128) * 4, stream) != hipSuccess) { fprintf(stderr, "kernel_launch: memset of barrier words failed\n"); return; }
    Params p{};
    for (int i = 0; i < 26; ++i) p.in[i] = (const float*)d_in[i];
    p.out = (float*)d_out; p.ws = (unsigned char*)d_ws;
#if MK_PER_PHASE
    for (int ph = 0; ph < NPHASE; ++ph) { p.ph_lo = ph; p.ph_hi = ph + 1; hipLaunchKernelGGL(mega, dim3(grid), dim3(512), LDS_BYTES, stream, p); }
#else
    p.ph_lo = 0; p.ph_hi = NPHASE;
    void* args[] = {&p};
    hipError_t e = hipLaunchCooperativeKernel((const void*)mega, dim3(grid), dim3(512), args, LDS_BYTES, stream);
    if (e != hipSuccess) fprintf(stderr, "cooperative launch failed: %s (grid %d)\n", hipGetErrorString(e), grid);
#endif
}
```

```cpp
#include <hip/hip_runtime.h>
#include <hip/hip_cooperative_groups.h>
#include <cstdio>
namespace cg = cooperative_groups;

#define LDS_WIDTAB 163328
__device__ __forceinline__ int tid_l() {
    const unsigned hw = (unsigned)__builtin_amdgcn_s_getreg((5 << 11) | 4) & 63u;
    const int wid = *(volatile __attribute__((address_space(3))) int*)(unsigned long)(LDS_WIDTAB + hw * 4u);
    int ln; asm volatile("v_mbcnt_lo_u32_b32 %0, -1, 0\n\tv_mbcnt_hi_u32_b32 %0, -1, %0" : "=v"(ln));
    return __builtin_amdgcn_readfirstlane(wid) * 64 + ln; }
namespace pg8 {
#define PG8_LAS __attribute__((address_space(3)))
typedef unsigned short bf16_t;
typedef short bf16x8 __attribute__((ext_vector_type(8)));
typedef float f32x4 __attribute__((ext_vector_type(4)));
typedef unsigned u32x4 __attribute__((ext_vector_type(4)));
constexpr int BM = 256, BK = 64, HALF = 128, HTB = HALF * BK * 2  , STAGE_BYTES = 8 * HTB, NXCD = 8, WGM = 8;

__host__ __device__ __forceinline__ int lds_byte(int r, int c) { const int st = (r >> 4) * 2 + (c >> 5), rr = r & 15, cc = c & 31, ob = rr * 64 + cc * 2; return st * 1024 + (ob ^ (((ob >> 9) & 1) << 5)); }
__host__ __device__ __forceinline__ void stage_rc(int b, int& R, int& C) { const int st = b / 1024, sb = b % 1024, swz = sb ^ (((sb >> 9) & 1) << 5); R = (st >> 1) * 16 + swz / 64; C = (st & 1) * 32 + (swz % 64) / 2; }
__host__ __device__ __forceinline__ int perm32(int rho) { const int n = rho >> 4, i = rho & 15; return 8 * (i >> 2) + 4 * n + (i & 3); }

struct Unit { int pm, pn; };
struct Gemm { const bf16_t* A; const bf16_t* Bt; int M, N, K; };

struct StaticOrder {
    int nM, nN, nwg, G, c;
    __host__ __device__ void init(int M, int N, int G_, int c_) { nM = M / BM; nN = N / BM; nwg = nM * nN; G = G_; c = c_; }
    __host__ __device__ bool next(int i, Unit& u) const {
        const long L = (long)i * G + c; if (L >= nwg) return false;
        int wgid = (int)L; { const int q = nwg / NXCD, r = nwg % NXCD, xcd = wgid % NXCD, off = wgid / NXCD; wgid = (xcd < r ? xcd * (q + 1) : r * (q + 1) + (xcd - r) * q) + off; }
        const int nig = WGM * nN, gid = wgid / nig, fm = gid * WGM, gsz = (nM - fm) < WGM ? (nM - fm) : WGM;
        u.pm = fm + ((wgid % nig) % gsz); u.pn = (wgid % nig) / gsz; return true;
    }
    __device__ __forceinline__ void a_ready(const Unit&) const {}
    __device__ __forceinline__ void done(const Unit&) const {}
};
__device__ __forceinline__ unsigned cvt_pk_bf16(float lo, float hi) { unsigned r; asm volatile("v_cvt_pk_bf16_f32 %0, %1, %2" : "=v"(r) : "v"(lo), "v"(hi)); return r; }
template <class Epi, class Sched, bool STAMP = false>
__device__ __forceinline__ void gemm_phase(PG8_LAS unsigned char* lds, const Gemm g, const Sched& S, const Epi& E, unsigned long long* stamps) {
    const int tid = tid_l(), wid = __builtin_amdgcn_readfirstlane(tid >> 6), lane = tid & 63, wr = wid >> 2, wc = wid & 3, fr = lane & 15, fq = lane >> 4;
    const int K = g.K, nt = K / BK;
    int ts_lo = 0, ts_hi = 0, nts = 0; const unsigned long long rt_entry = STAMP ? (unsigned long long)wall_clock64() : 0ull;
#define PG8_STAMP() do { if (STAMP && wid == 0 && nts < 64) { const unsigned long long _c = (unsigned long long)clock64(); \
        ts_lo = (lane == nts) ? (int)(unsigned)_c : ts_lo; ts_hi = (lane == nts) ? (int)(unsigned)(_c >> 32) : ts_hi; ++nts; } } while (0)
    PG8_STAMP();
    unsigned voffA[2], voffB[2];
#pragma unroll
    for (int i = 0; i < 2; ++i) { int R, C; stage_rc(tid * 16 + i * 8192, R, C); const int Rb = Epi::PERM ? ((R & ~31) + perm32(R & 31)) : R;
        voffA[i] = (unsigned)(R * K + C) * 2u; voffB[i] = (unsigned)(Rb * K + C) * 2u; }
    const size_t kstep = (size_t)(BK * 2);
    const size_t hstep = (size_t)HALF * K * 2;
    const size_t tstep = 2 * hstep;
    const unsigned ldsw = (unsigned)wid * 1024u;
    const int aoff = lds_byte(wr * 64 + fr, fq * 8), boff = lds_byte(wc * 32 + fr, fq * 8);
#define PG8_SA(b, h) (((b) * 2 + (h)) * HTB)
#define PG8_SB(b, h) ((4 + (b) * 2 + (h)) * HTB)
#define PG8_STAGE(bufoff, gbase, voff) do { _Pragma("unroll") for (int _i = 0; _i < 2; ++_i) \
        __builtin_amdgcn_global_load_lds((const unsigned*)((const char*)(gbase) + (voff)[_i]), (PG8_LAS unsigned*)(lds + (bufoff) + ldsw + _i * 8192), 16, 0, 0); } while (0)
#define PG8_LDA(dst, b, h) do { _Pragma("unroll") for (int m = 0; m < 4; ++m) _Pragma("unroll") for (int k = 0; k < 2; ++k) dst[m][k] = *(const PG8_LAS bf16x8*)(lds + PG8_SA(b, h) + aoff + m * 2048 + k * 1024); } while (0)
#define PG8_LDB(dst, b, h) do { _Pragma("unroll") for (int n = 0; n < 2; ++n) _Pragma("unroll") for (int k = 0; k < 2; ++k) dst[n][k] = *(const PG8_LAS bf16x8*)(lds + PG8_SB(b, h) + boff + n * 2048 + k * 1024); } while (0)
#define PG8_MMA(ai, bj, At, Bt) do { __builtin_amdgcn_s_setprio(1); _Pragma("unroll") for (int m = 0; m < 4; ++m) _Pragma("unroll") for (int n = 0; n < 2; ++n) _Pragma("unroll") for (int k = 0; k < 2; ++k) \
        acc[ai][bj][m][n] = __builtin_amdgcn_mfma_f32_16x16x32_bf16(Bt[n][k], At[m][k], acc[ai][bj][m][n], 0, 0, 0); __builtin_amdgcn_s_setprio(0); } while (0)
#define PG8_WAIT_V(n) asm volatile("s_waitcnt vmcnt(" #n ")" ::: "memory")
#define PG8_WAIT_L(n) asm volatile("s_waitcnt lgkmcnt(" #n ")" ::: "memory")
#define PG8_BAR __builtin_amdgcn_s_barrier()
#define PG8_SCHED __builtin_amdgcn_sched_barrier(0)
    Unit cur, nxt; int ui = 0;
    if (!S.next(0, cur)) return;
    f32x4 acc[2][2][4][2];
#pragma unroll
    for (int a = 0; a < 2; ++a)
#pragma unroll
        for (int b = 0; b < 2; ++b)
#pragma unroll
            for (int m = 0; m < 4; ++m)
#pragma unroll
                for (int n = 0; n < 2; ++n) acc[a][b][m][n] = (f32x4){0.f, 0.f, 0.f, 0.f};
    bf16x8 At[4][2], B0[2][2], B1[2][2];
    const char* cA = (const char*)g.A + (size_t)cur.pm * tstep; const char* cB = (const char*)g.Bt + (size_t)cur.pn * tstep;
    S.a_ready(cur);
    PG8_STAGE(PG8_SB(0, 0), cB, voffB); PG8_STAGE(PG8_SA(0, 0), cA, voffA); PG8_STAGE(PG8_SB(0, 1), cB + hstep, voffB); PG8_STAGE(PG8_SA(0, 1), cA + hstep, voffA);
    if (wr == 1) PG8_BAR;
    PG8_WAIT_V(4); PG8_BAR;
    PG8_STAGE(PG8_SB(1, 0), cB + kstep, voffB); PG8_STAGE(PG8_SA(1, 0), cA + kstep, voffA); PG8_STAGE(PG8_SB(1, 1), cB + hstep + kstep, voffB);
    PG8_WAIT_V(6); PG8_BAR;
    PG8_STAMP();
    for (;;) {
        const bool has_next = S.next(ui + 1, nxt);
        const char* nA = has_next ? (const char*)g.A + (size_t)nxt.pm * tstep : cA; const char* nB = has_next ? (const char*)g.Bt + (size_t)nxt.pn * tstep : cB;
        for (int t = 0; t < nt; t += 2) {
            const bool last = (t == nt - 2);
            const char* a1 = cA + (size_t)(t + 1) * kstep;
            const char* a2 = last ? nA : cA + (size_t)(t + 2) * kstep; const char* b2 = last ? nB : cB + (size_t)(t + 2) * kstep;
            const char* a3 = a2 + kstep; const char* b3 = b2 + kstep;
            if (last && has_next) S.a_ready(nxt);
            PG8_LDB(B0, 0, 0); PG8_SCHED; PG8_LDA(At, 0, 0); PG8_STAGE(PG8_SA(1, 1), a1 + hstep, voffA);
            PG8_WAIT_L(8); PG8_BAR; PG8_WAIT_L(0); PG8_MMA(0, 0, At, B0); PG8_BAR; PG8_SCHED;
            PG8_LDB(B1, 0, 1); PG8_STAGE(PG8_SB(0, 0), b2, voffB);
            PG8_BAR; PG8_WAIT_L(0); PG8_MMA(0, 1, At, B1); PG8_BAR;
            PG8_LDA(At, 0, 1); PG8_STAGE(PG8_SA(0, 0), a2, voffA);
            PG8_BAR; PG8_WAIT_L(0); PG8_MMA(1, 0, At, B0); PG8_BAR; PG8_SCHED;
            PG8_STAGE(PG8_SB(0, 1), b2 + hstep, voffB);
            PG8_WAIT_V(6); PG8_BAR; PG8_MMA(1, 1, At, B1); PG8_BAR;
            PG8_LDB(B0, 1, 0); PG8_SCHED; PG8_LDA(At, 1, 0); PG8_STAGE(PG8_SA(0, 1), a2 + hstep, voffA);
            PG8_WAIT_L(8); PG8_BAR; PG8_WAIT_L(0); PG8_MMA(0, 0, At, B0); PG8_BAR; PG8_SCHED;
            PG8_LDB(B1, 1, 1); PG8_STAGE(PG8_SB(1, 0), b3, voffB);
            PG8_BAR; PG8_WAIT_L(0); PG8_MMA(0, 1, At, B1); PG8_BAR;
            PG8_LDA(At, 1, 1); PG8_STAGE(PG8_SA(1, 0), a3, voffA);
            PG8_BAR; PG8_WAIT_L(0); PG8_MMA(1, 0, At, B0); PG8_BAR; PG8_SCHED;
            PG8_STAGE(PG8_SB(1, 1), b3 + hstep, voffB);
            PG8_WAIT_V(6); PG8_BAR; PG8_MMA(1, 1, At, B1); PG8_BAR;
        }
        PG8_STAMP();
        if constexpr (!Epi::AFTER_DRAIN) { E(acc, cur, wr, wc, fr, fq); S.done(cur); }
        PG8_STAMP();
        if (!has_next) break;
#pragma unroll
        for (int a = 0; a < 2; ++a)
#pragma unroll
            for (int b = 0; b < 2; ++b)
#pragma unroll
                for (int m = 0; m < 4; ++m)
#pragma unroll
                    for (int n = 0; n < 2; ++n) acc[a][b][m][n] = (f32x4){0.f, 0.f, 0.f, 0.f};
        cur = nxt; cA = nA; cB = nB; ++ui;
    }
    PG8_WAIT_V(0);
    if (wr == 0) PG8_BAR;
    PG8_BAR;
    if constexpr (Epi::AFTER_DRAIN) { E.fused(acc, cur, wr, wc, fr, fq, lds, wid, lane); S.done(cur); }
    PG8_STAMP();
    if (STAMP && wid == 0) { stamps[lane] = lane < nts ? (((unsigned long long)(unsigned)ts_hi << 32) | (unsigned)ts_lo) : 0ull;
        if (lane == 62) stamps[62] = rt_entry; if (lane == 63) stamps[63] = (unsigned long long)wall_clock64(); }
#undef PG8_STAMP
#undef PG8_SA
#undef PG8_SB
#undef PG8_STAGE
#undef PG8_LDA
#undef PG8_LDB
#undef PG8_MMA
#undef PG8_WAIT_V
#undef PG8_WAIT_L
#undef PG8_BAR
#undef PG8_SCHED
}
}

#define XB_TMO      128
#define XB_XCNT(j)  (256  + 64 * (j))
#define XB_XSUB(j)  (1280 + 64 * (j))
#define XB_XGEN(j)  (2304 + 64 * (j))
#define XB_TOP      3328
#define XB_TOPGEN   3392
#define XCD_BAR_WORDS 3456
#define XB_SPIN_CAP (1u << 18)
#define LAS __attribute__((address_space(3)))

__device__ __forceinline__ unsigned xb_ld(unsigned* p)              { return __hip_atomic_load(p, __ATOMIC_RELAXED, __HIP_MEMORY_SCOPE_AGENT); }
__device__ __forceinline__ unsigned xb_add(unsigned* p, unsigned v) { return __hip_atomic_fetch_add(p, v, __ATOMIC_RELAXED, __HIP_MEMORY_SCOPE_AGENT); }
__device__ __forceinline__ unsigned xb_xcc_id() { return (unsigned)__builtin_amdgcn_s_getreg((3 << 11) | 20) & 0xFu; }
#define XB_SPIN(cond, bar) do { unsigned _sp = 0; while (cond) { __builtin_amdgcn_s_sleep(1); \
    if ((++_sp & 255u) == 0u) { if (xb_ld(&(bar)[XB_TMO])) break; if (_sp > XB_SPIN_CAP) { atomicAdd(&(bar)[XB_TMO], 1u); break; } } } } while (0)
struct XcdBarrier {
    unsigned* bar; unsigned x;
    volatile LAS unsigned* st;
};

__device__ __forceinline__ XcdBarrier xcd_barrier_post(unsigned* bar, volatile LAS unsigned* st) {
    XcdBarrier b; b.bar = bar; b.x = xb_xcc_id(); b.st = st;
    if (tid_l() == 0) (void)xb_add(&bar[XB_XCNT(b.x)], 1u);
    return b;
}
__device__ __forceinline__ void xcd_barrier_complete(unsigned* bar, unsigned x, unsigned& nloc, unsigned& nx) {
    const unsigned G = gridDim.x * gridDim.y * gridDim.z;
    unsigned sum, cnt, mine, sp = 0u;
    for (;;) {
        sum = 0u; cnt = 0u; mine = 0u;
#pragma unroll
        for (unsigned j = 0; j < 16; ++j) { const unsigned c = xb_ld(&bar[XB_XCNT(j)]); sum += c; cnt += (c > 0u) ? 1u : 0u; mine = (j == x) ? c : mine; }
        if (sum == G) break;
        __builtin_amdgcn_s_sleep(1);
        if ((++sp & 255u) == 0u) { if (xb_ld(&bar[XB_TMO])) break; if (sp > XB_SPIN_CAP) { atomicAdd(&bar[XB_TMO], 1u); break; } }
    }
    nloc = mine > 0u ? mine : 1u; nx = cnt > 0u ? cnt : 1u;
}

__device__ __forceinline__ void xcd_barrier(const XcdBarrier& b) {
    asm volatile("s_waitcnt vmcnt(0)" ::: "memory");
    __syncthreads();
    if (tid_l() == 0) {
        unsigned* bar = b.bar;
        __builtin_amdgcn_s_waitcnt(0);
        unsigned nloc = b.st[0], nx = b.st[1];
        if (nloc == 0u) { xcd_barrier_complete(bar, b.x, nloc, nx); b.st[0] = nloc; b.st[1] = nx; }
        const unsigned old = xb_add(&bar[XB_XSUB(b.x)], 1u);
        const unsigned gen = old / nloc;
        if (old + 1u == (gen + 1u) * nloc) {
            __builtin_amdgcn_fence(__ATOMIC_RELEASE, "agent");
            asm volatile("s_waitcnt vmcnt(0)" ::: "memory");
            const unsigned og = xb_add(&bar[XB_TOP], 1u);
            const unsigned tg = og / nx;
            if (og + 1u == (tg + 1u) * nx) xb_add(&bar[XB_TOPGEN], 1u);
            else XB_SPIN(xb_ld(&bar[XB_TOPGEN]) == tg, bar);
            __builtin_amdgcn_fence(__ATOMIC_ACQUIRE, "agent");
            xb_add(&bar[XB_XGEN(b.x)], 1u);
            asm volatile("s_waitcnt vmcnt(0)" ::: "memory");
        } else {
            XB_SPIN(xb_ld(&bar[XB_XGEN(b.x)]) == gen, bar);
            __builtin_amdgcn_fence(__ATOMIC_ACQUIRE, "agent");
            asm volatile("s_waitcnt vmcnt(0)" ::: "memory");
        }
    }
    __syncthreads();
}

typedef unsigned short bf16_t;
typedef short bf16x8 __attribute__((ext_vector_type(8)));
typedef float f32x4 __attribute__((ext_vector_type(4)));
typedef unsigned u32x4 __attribute__((ext_vector_type(4)));
typedef unsigned u32x2 __attribute__((ext_vector_type(2)));

#ifndef DUP
#define DUP 0
#endif
#ifndef MK_PER_PHASE
#define MK_PER_PHASE 0
#endif

constexpr int TP = 16384, TS = 128, TALL = 16512, M1 = 16640, N1 = 6912, NIN = 6800;
constexpr int C_R = 0, C_K = 1024, C_V = 2048, C_WL = 3072, C_AL = 3136, C_ZR = 3200, C_ZM = 4224, C_XBC = 5248, C_DT = 6784;
constexpr size_t O_YP = 0, O_YS = 16777216, O_PSH = 16908288, O_PWKV = 16924672, O_PCONV = 17973248, O_PSSM = 18046976,
                 O_SSH = 20144128, O_SWKV = 20406272, O_SCONV = 37183488, O_SSSM = 38363136, O_END = 71917568;
constexpr size_t WS_WINT = 0;
constexpr size_t WS_WOUTT = WS_WINT + (size_t)2 * N1 * 1024 * 2;
constexpr size_t WS_A = WS_WOUTT + (size_t)2 * 1024 * 2048 * 2;
constexpr size_t WS_P = WS_A + (size_t)M1 * 2048 * 2;
constexpr size_t WS_ORAW = WS_P + (size_t)M1 * N1 * 2;
constexpr size_t WS_BV = WS_ORAW + (size_t)TALL * 1024 * 4;
constexpr size_t WS_YM = WS_BV + (size_t)TALL * 1024 * 2;
constexpr size_t WS_END = WS_YM + (size_t)TALL * 1024 * 2;
constexpr size_t WS_U = WS_A;
constexpr size_t WS_DT = WS_U + (size_t)TP * 1536 * 2;
constexpr size_t WS_PART = WS_ORAW;
constexpr size_t WS_BAR = (WS_END + 4095) & ~(size_t)4095;
constexpr int LDS_BYTES = 163840, LDS_BARST = 163824;

struct Params { const float* in[26]; float* out; unsigned char* ws; int ph_lo, ph_hi; };
enum { I_XP = 0, I_XS, I_SSHIFT, I_SWKV, I_SCONV, I_SSSM, I_NORMW, I_WIN, I_MU, I_W0, I_W2, I_A0, I_A2, I_KK, I_KA, I_RK, I_LNW, I_LNB, I_CW, I_CB, I_DTB, I_ALOG, I_DSK, I_GNW, I_WOUT, I_FNW };

__device__ __forceinline__ float bf2f(unsigned short b) { return __uint_as_float(((unsigned)b) << 16); }
__device__ __forceinline__ unsigned short f2bf(float f) { unsigned u = __float_as_uint(f); u += 0x7FFFu + ((u >> 16) & 1u); return (unsigned short)(u >> 16); }
__device__ __forceinline__ unsigned pk2(float lo, float hi) { return (unsigned)f2bf(lo) | ((unsigned)f2bf(hi) << 16); }
__device__ __forceinline__ void unpack8(const u32x4 v, float* f) {
    f[0] = __uint_as_float(v.x << 16); f[1] = __uint_as_float(v.x & 0xffff0000u); f[2] = __uint_as_float(v.y << 16); f[3] = __uint_as_float(v.y & 0xffff0000u);
    f[4] = __uint_as_float(v.z << 16); f[5] = __uint_as_float(v.z & 0xffff0000u); f[6] = __uint_as_float(v.w << 16); f[7] = __uint_as_float(v.w & 0xffff0000u); }
__device__ __forceinline__ u32x4 pack8(const float* f) { u32x4 r; r.x = pk2(f[0], f[1]); r.y = pk2(f[2], f[3]); r.z = pk2(f[4], f[5]); r.w = pk2(f[6], f[7]); return r; }
__device__ __forceinline__ float frcp(float x) { return __builtin_amdgcn_rcpf(x); }
__device__ __forceinline__ float sigmoidf_(float x) { return frcp(1.0f + __expf(-x)); }
__device__ __forceinline__ float siluf_(float x) { return x * frcp(1.0f + __expf(-x)); }
__device__ __forceinline__ float softplusf_(float x) { return x > 20.f ? x : log1pf(__expf(x)); }
template <int CTRL> __device__ __forceinline__ float dppf(float v) { return __int_as_float(__builtin_amdgcn_mov_dpp(__float_as_int(v), CTRL, 0xF, 0xF, true)); }
__device__ __forceinline__ float red8(float x) { x += dppf<0xB1>(x); x += dppf<0x4E>(x); x += dppf<0x141>(x); return x; }
__device__ __forceinline__ float red16(float x) { x = red8(x); x += dppf<0x140>(x); return x; }
__device__ __forceinline__ float wave_sum(float x) {
#pragma unroll
    for (int o = 32; o > 0; o >>= 1) x += __shfl_xor(x, o);
    return x; }
__device__ __forceinline__ void lds_fence() { asm volatile("s_waitcnt lgkmcnt(0)" ::: "memory"); }
__device__ __forceinline__ unsigned char* launder_lds(unsigned char* sm) { int off = 0; asm volatile("" : "+s"(off)); return sm + off; }
#define LBAR() do { asm volatile("s_waitcnt lgkmcnt(0)" ::: "memory"); __builtin_amdgcn_s_barrier(); asm volatile("" ::: "memory"); } while (0)
#define MFMA16(a, b, c) __builtin_amdgcn_mfma_f32_16x16x32_bf16((a), (b), (c), 0, 0, 0)

__device__ void phase_convert(const Params& p, unsigned char* smem_) {
    unsigned char* smem = launder_lds(smem_);
    float* tile = (float*)smem;
    const int tid = tid_l();
    constexpr int NT_IN = 16 * 108, NT_OUT = 32 * 16, PER_L = NT_IN + NT_OUT;
    for (int it = blockIdx.x; it < 2 * PER_L; it += gridDim.x) {
        const int l = it / PER_L; int r = it % PER_L;
        const float* src; bf16_t* dst; int K, Nsrc, kt, nt;
        if (r < NT_IN) { src = p.in[I_WIN] + (size_t)l * 1024 * NIN; dst = (bf16_t*)(p.ws + WS_WINT) + (size_t)l * N1 * 1024; K = 1024; Nsrc = NIN; kt = r & 15; nt = r >> 4; }
        else { r -= NT_IN; src = p.in[I_WOUT] + (size_t)l * 2048 * 1024; dst = (bf16_t*)(p.ws + WS_WOUTT) + (size_t)l * 1024 * 2048; K = 2048; Nsrc = 1024; kt = r & 31; nt = r >> 5; }
#pragma unroll
        for (int i = 0; i < 2; ++i) {
            const int rr = (tid >> 4) + 32 * i, c4 = (tid & 15) * 4, col = nt * 64 + c4;
            float4 v = make_float4(0.f, 0.f, 0.f, 0.f);
            if (col < Nsrc) v = *(const float4*)(src + (size_t)(kt * 64 + rr) * Nsrc + col);
            float* tp = tile + rr * 65 + c4; tp[0] = v.x; tp[1] = v.y; tp[2] = v.z; tp[3] = v.w;
        }
        __syncthreads();
        { const int n = tid >> 3, k8 = (tid & 7) * 8; float f[8];
#pragma unroll
          for (int j = 0; j < 8; ++j) f[j] = tile[(k8 + j) * 65 + n];
          *(u32x4*)(dst + (size_t)(nt * 64 + n) * K + kt * 64 + k8) = pack8(f); }
        __syncthreads();
    }
}

__device__ void phase_norm(const Params& p, int l) {
    const int tid_ = tid_l(); const int lane = tid_ & 63, wid = tid_ >> 6;
    bf16_t* A1 = (bf16_t*)(p.ws + WS_A);
    const float* nw = p.in[I_NORMW] + l * 1024;
    for (int row = blockIdx.x * 8 + wid; row < M1; row += gridDim.x * 8) {
        const float* src;
        if (row < TP) src = (l == 0 ? p.in[I_XP] : p.out + O_YP) + (size_t)row * 1024;
        else if (row < TALL) src = (l == 0 ? p.in[I_XS] : p.out + O_YS) + (size_t)(row - TP) * 1024;
        else src = p.in[I_SSHIFT] + ((size_t)l * TS + (row - TALL)) * 1024;
        float4 v[4]; float ss = 0.f;
#pragma unroll
        for (int i = 0; i < 4; ++i) v[i] = *(const float4*)(src + i * 256 + lane * 4);
        if (l == 1 && row >= TP && row < TALL) {
            const float* x0 = p.in[I_XS] + (size_t)(row - TP) * 1024; const float* pt = (const float*)(p.ws + WS_PART) + (size_t)(row - TP) * 1024;
#pragma unroll
            for (int i = 0; i < 4; ++i) { float4 a = *(const float4*)(x0 + i * 256 + lane * 4);
                for (int q = 0; q < 16; ++q) { const float4 t = *(const float4*)(pt + (size_t)q * TS * 1024 + i * 256 + lane * 4); a.x += t.x; a.y += t.y; a.z += t.z; a.w += t.w; }
                v[i] = a; *(float4*)(p.out + O_YS + (size_t)(row - TP) * 1024 + i * 256 + lane * 4) = a; }
        }
#pragma unroll
        for (int i = 0; i < 4; ++i) ss += v[i].x * v[i].x + v[i].y * v[i].y + v[i].z * v[i].z + v[i].w * v[i].w;
        if (row < TALL) {
            ss = wave_sum(ss);
            const float rs = rsqrtf(ss * (1.0f / 1024.0f) + 1e-5f);
#pragma unroll
            for (int i = 0; i < 4; ++i) { const float4 w = *(const float4*)(nw + i * 256 + lane * 4); v[i].x *= rs * w.x; v[i].y *= rs * w.y; v[i].z *= rs * w.z; v[i].w *= rs * w.w; }
            float* so = nullptr;
            if (row < TP) { if ((row & 2047) == 2047) so = p.out + O_PSH + ((size_t)l * 8 + (row >> 11)) * 1024; }
            else so = p.out + O_SSH + ((size_t)l * TS + (row - TP)) * 1024;
            if (so) {
#pragma unroll
                for (int i = 0; i < 4; ++i) *(float4*)(so + i * 256 + lane * 4) = v[i]; }
        }
#pragma unroll
        for (int i = 0; i < 4; ++i) { u32x2 w; w.x = pk2(v[i].x, v[i].y); w.y = pk2(v[i].z, v[i].w); *(u32x2*)(A1 + (size_t)row * 1024 + i * 256 + lane * 4) = w; }
    }
}

__device__ void phase_final(const Params& p) {
    const int tid_ = tid_l(); const int lane = tid_ & 63, wid = tid_ >> 6;
    const float* nw = p.in[I_FNW];
    for (int row = blockIdx.x * 8 + wid; row < TALL; row += gridDim.x * 8) {
        float* src = (row < TP) ? p.out + O_YP + (size_t)row * 1024 : p.out + O_YS + (size_t)(row - TP) * 1024;
        float4 v[4]; float ss = 0.f;
#pragma unroll
        for (int i = 0; i < 4; ++i) v[i] = *(const float4*)(src + i * 256 + lane * 4);
        if (row >= TP) { const float* pt = (const float*)(p.ws + WS_PART) + (size_t)(row - TP) * 1024;
#pragma unroll
            for (int i = 0; i < 4; ++i) for (int q = 0; q < 16; ++q) { const float4 t = *(const float4*)(pt + (size_t)q * TS * 1024 + i * 256 + lane * 4); v[i].x += t.x; v[i].y += t.y; v[i].z += t.z; v[i].w += t.w; } }
#pragma unroll
        for (int i = 0; i < 4; ++i) ss += v[i].x * v[i].x + v[i].y * v[i].y + v[i].z * v[i].z + v[i].w * v[i].w;
        ss = wave_sum(ss);
        const float rs = rsqrtf(ss * (1.0f / 1024.0f) + 1e-5f);
#pragma unroll
        for (int i = 0; i < 4; ++i) { const float4 w = *(const float4*)(nw + i * 256 + lane * 4); v[i].x *= rs * w.x; v[i].y *= rs * w.y; v[i].z *= rs * w.z; v[i].w *= rs * w.w;
            *(float4*)(src + i * 256 + lane * 4) = v[i]; }
    }
}

struct EpiP {
    static constexpr bool PERM = true, AFTER_DRAIN = false;
    bf16_t* O; int ldc;
    __device__ __forceinline__ void operator()(const f32x4 (&acc)[2][2][4][2], const pg8::Unit& u, int wr, int wc, int fr, int fq) const {
        const int row0 = u.pm * 256 + wr * 64 + fr, col0 = u.pn * 256 + wc * 32 + 8 * fq;
#pragma unroll
        for (int ai = 0; ai < 2; ++ai)
#pragma unroll
            for (int m = 0; m < 4; ++m) { bf16_t* rowp = O + (size_t)(row0 + ai * 128 + m * 16) * ldc + col0;
#pragma unroll
                for (int bj = 0; bj < 2; ++bj) { const f32x4 v0 = acc[ai][bj][m][0], v1 = acc[ai][bj][m][1];
                    u32x4 w; w.x = pg8::cvt_pk_bf16(v0[0], v0[1]); w.y = pg8::cvt_pk_bf16(v0[2], v0[3]); w.z = pg8::cvt_pk_bf16(v1[0], v1[1]); w.w = pg8::cvt_pk_bf16(v1[2], v1[3]);
                    *(u32x4*)(rowp + bj * 128) = w; } }
    }
};
struct EpiRes {
    static constexpr bool PERM = false, AFTER_DRAIN = false;
    const float* res_p; float* out_p;
    __device__ __forceinline__ void operator()(const f32x4 (&acc)[2][2][4][2], const pg8::Unit& u, int wr, int wc, int fr, int fq) const {
        const int row0 = u.pm * 256 + wr * 64 + fr, col0 = u.pn * 256 + wc * 32 + 4 * fq;
#pragma unroll
        for (int ai = 0; ai < 2; ++ai)
#pragma unroll
            for (int m = 0; m < 4; ++m) { const size_t ro = (size_t)(row0 + ai * 128 + m * 16) * 1024;
#pragma unroll
                for (int bj = 0; bj < 2; ++bj)
#pragma unroll
                    for (int n = 0; n < 2; ++n) { const int c = col0 + bj * 128 + n * 16; const f32x4 r = *(const f32x4*)(res_p + ro + c); *(f32x4*)(out_p + ro + c) = acc[ai][bj][m][n] + r; } }
    }
};

constexpr int CH_NB = 6, CH_CB = 15104, CH_NH = 5;
constexpr int CB_A1 = 0, CB_A2 = 3328, CB_TT = 6656, CB_ZQ = 7936, CB_ZK = 10240, CB_V = 12544, CB_GQ = 14848;
constexpr int CH_SCR = CH_NB * CH_CB;
constexpr int SCR_TW = 0, SCR_EXL = 4608, SCR_SZ = 8704;
constexpr int CH_W2T = CH_SCR + CH_NH * SCR_SZ;
constexpr int CH_CST = CH_W2T + 18432;
constexpr int CH_FLG = CH_CST + 2560;
__device__ __forceinline__ unsigned cvtpk(float lo, float hi) { return pg8::cvt_pk_bf16(lo, hi); }
__device__ void rwkv_chain_item(const Params& p, int l, int item, unsigned char* smem_) {
    unsigned char* smem = launder_lds(smem_);
    const int tid = tid_l(), wid = tid >> 6, lane = tid & 63, fr = lane & 15, fq = lane >> 4;
    const int b = item >> 4, h = item & 15;
    bf16_t* w2t = (bf16_t*)(smem + CH_W2T); bf16_t* a2t = w2t + 4608;
    float* cst = (float*)(smem + CH_CST);
    volatile LAS unsigned* ready = (volatile LAS unsigned*)((LAS unsigned char*)smem + CH_FLG); volatile LAS unsigned* cons = ready + 128; volatile LAS unsigned* ready2 = ready + 256;
    const bf16_t* P = (const bf16_t*)(p.ws + WS_P);
    float* ORAW = (float*)(p.ws + WS_ORAW);
    bf16_t* BV = (bf16_t*)(p.ws + WS_BV);
    __syncthreads();
    for (int i = tid; i < CH_W2T / 4; i += 512) ((unsigned*)smem)[i] = 0u;
    if (tid < 384) ((unsigned*)(smem + CH_FLG))[tid] = 0u;
    { const float* w2 = p.in[I_W2] + (size_t)l * 64 * 1024 + h * 64; const float* a2 = p.in[I_A2] + (size_t)l * 64 * 1024 + h * 64;
#pragma unroll
      for (int i = 0; i < 8; ++i) { const int idx = tid + 512 * i, k = idx >> 6, n = idx & 63; w2t[n * 72 + k] = f2bf(w2[(size_t)k * 1024 + n]); a2t[n * 72 + k] = f2bf(a2[(size_t)k * 1024 + n]); } }
    if (tid < 64) { const float* mu = p.in[I_MU] + (size_t)l * 3200; const int gc = h * 64 + tid;
        cst[tid] = mu[C_R + gc]; cst[64 + tid] = mu[C_K + gc]; cst[128 + tid] = mu[C_V + gc]; cst[192 + tid] = mu[C_WL + tid]; cst[256 + tid] = mu[C_AL + tid];
        cst[320 + tid] = p.in[I_KK][l * 1024 + gc]; cst[384 + tid] = p.in[I_KA][l * 1024 + gc]; cst[448 + tid] = p.in[I_RK][l * 1024 + gc];
        cst[512 + tid] = p.in[I_W0][l * 1024 + gc]; cst[576 + tid] = p.in[I_A0][l * 1024 + gc]; }
    __syncthreads();

    if (wid >= 3) {
        const int hw = wid - 3, tok = lane >> 2, q4 = lane & 3, c0 = q4 * 16;
        unsigned char* scr = smem + CH_SCR + hw * SCR_SZ;
        bf16_t* tw = (bf16_t*)(scr + SCR_TW); bf16_t* ta = tw + 1152;
        float* exl = (float*)(scr + SCR_EXL);
        const int segcol[5] = {C_R + h * 64 + c0, C_K + h * 64 + c0, C_V + h * 64 + c0, C_WL + c0, C_AL + c0};
        float w0c[4], a0c[4];
#pragma unroll
        for (int ct = 0; ct < 4; ++ct) { w0c[ct] = cst[512 + ct * 16 + fr]; a0c[ct] = cst[576 + ct * 16 + fr]; }
        u32x4 qc[5][2], qp[5][2];
#define CLOAD(C) { const int t_ = (C) * 16 + tok; const bf16_t* pr_ = P + ((size_t)b * 2048 + t_) * N1; \
            _Pragma("unroll") for (int sg = 0; sg < 5; ++sg) _Pragma("unroll") for (int hh = 0; hh < 2; ++hh) { qc[sg][hh] = *(const u32x4*)(pr_ + segcol[sg] + hh * 8); \
                if (t_ > 0) qp[sg][hh] = *(const u32x4*)(pr_ - N1 + segcol[sg] + hh * 8); else qp[sg][hh] = (u32x4){0u, 0u, 0u, 0u}; } }
        CLOAD(hw)
        for (int c = hw; c < 128; c += CH_NH) {
            unsigned char* cb = smem + (c % CH_NB) * CH_CB;
            bf16_t* A1 = (bf16_t*)(cb + CB_A1); bf16_t* A2 = (bf16_t*)(cb + CB_A2); bf16_t* ZQ = (bf16_t*)(cb + CB_ZQ); bf16_t* ZK = (bf16_t*)(cb + CB_ZK); bf16_t* Vn = (bf16_t*)(cb + CB_V); float* GQ = (float*)(cb + CB_GQ);
            const size_t grow = (size_t)b * 2048 + c * 16 + tok;
            if (c >= CH_NB) { while (cons[c - CH_NB] < 2u) __builtin_amdgcn_s_sleep(1); }
            asm volatile("" ::: "memory");
            float* exa = (float*)(cb + CB_ZQ);
            float xr[16], xk[16]; unsigned xvp[8];
            { float cur[8], prv[8], xw[8], xa[8], xv[8];
#pragma unroll
              for (int hh = 0; hh < 2; ++hh) {
#define LSEG(dst, sg, mo) { unpack8(qc[sg][hh], cur); unpack8(qp[sg][hh], prv); _Pragma("unroll") for (int e = 0; e < 8; ++e) dst[e] = cur[e] + (prv[e] - cur[e]) * cst[(mo) + c0 + hh * 8 + e]; }
                LSEG((xr + hh * 8), 0, 0) LSEG((xk + hh * 8), 1, 64) LSEG(xv, 2, 128) LSEG(xw, 3, 192) LSEG(xa, 4, 256)
#undef LSEG
                { const u32x4 pv = pack8(xv); xvp[hh * 4] = pv.x; xvp[hh * 4 + 1] = pv.y; xvp[hh * 4 + 2] = pv.z; xvp[hh * 4 + 3] = pv.w; }
#pragma unroll
                for (int e = 0; e < 8; ++e) xw[e] = 1.0f - 2.0f * frcp(__expf(2.0f * xw[e]) + 1.0f);
                *(u32x4*)(tw + tok * 72 + c0 + hh * 8) = pack8(xw); *(u32x4*)(ta + tok * 72 + c0 + hh * 8) = pack8(xa);
              } }
            if (c + CH_NH < 128) CLOAD(c + CH_NH)
            lds_fence();
#pragma unroll
            for (int ct = 0; ct < 4; ++ct) { f32x4 aw = {0.f, 0.f, 0.f, 0.f}, aa = aw;
#pragma unroll
                for (int ks = 0; ks < 2; ++ks) {
                    aw = MFMA16(*(const bf16x8*)(tw + fr * 72 + ks * 32 + fq * 8), *(const bf16x8*)(w2t + (ct * 16 + fr) * 72 + ks * 32 + fq * 8), aw);
                    aa = MFMA16(*(const bf16x8*)(ta + fr * 72 + ks * 32 + fq * 8), *(const bf16x8*)(a2t + (ct * 16 + fr) * 72 + ks * 32 + fq * 8), aa); }
#pragma unroll
                for (int j = 0; j < 4; ++j) { const int tj = fq * 4 + j, col = ct * 16 + fr;
                    exl[tj * 64 + col] = -0.60653066f * sigmoidf_(w0c[ct] + aw[j]);
                    exa[tj * 64 + col] = sigmoidf_(a0c[ct] + aa[j]); } }
            lds_fence();
            { float lv[16];
#pragma unroll
              for (int t = 0; t < 16; ++t) lv[t] = exl[t * 64 + lane];
              float Lc = 0.f;
#pragma unroll
              for (int t = 0; t < 16; ++t) { Lc += lv[t]; lv[t] = __expf(Lc); }
#pragma unroll
              for (int t = 0; t < 16; ++t) exl[t * 64 + lane] = lv[t];
              GQ[lane] = lv[15]; }
            float a16[16];
#pragma unroll
            for (int i = 0; i < 4; ++i) { const float4 t4 = *(const float4*)(exa + tok * 64 + c0 + i * 4); a16[i * 4] = t4.x; a16[i * 4 + 1] = t4.y; a16[i * 4 + 2] = t4.z; a16[i * 4 + 3] = t4.w; }
            float ssq = 0.f, beta = 0.f;
#pragma unroll
            for (int e = 0; e < 16; ++e) { const float kr_ = xk[e] * cst[320 + c0 + e]; ssq += kr_ * kr_; }
            ssq += dppf<0xB1>(ssq); ssq += dppf<0x4E>(ssq);
            const float inv = frcp(fmaxf(__builtin_amdgcn_sqrtf(ssq), 1e-12f));
            lds_fence();
            {
              *(u32x4*)(Vn + tok * 72 + c0) = (u32x4){xvp[0], xvp[1], xvp[2], xvp[3]}; *(u32x4*)(Vn + tok * 72 + c0 + 8) = (u32x4){xvp[4], xvp[5], xvp[6], xvp[7]};
#pragma unroll
              for (int gI = 0; gI < 4; ++gI) {
                float pt[4], rt[4], qt[4], kt[4];
#pragma unroll
                for (int e3 = 0; e3 < 4; ++e3) { const int e = gI * 4 + e3; const float el = exl[tok * 64 + c0 + e], elm = tok > 0 ? exl[(tok - 1) * 64 + c0 + e] : 1.0f, iv = frcp(el);
                    const float kk_ = xk[e] * cst[320 + c0 + e] * inv, kp_ = xk[e] * (1.0f + (a16[e] - 1.0f) * cst[384 + c0 + e]), bb_ = -kk_ * a16[e];
                    beta += xr[e] * kp_ * cst[448 + c0 + e];
                    pt[e3] = kk_ * elm; rt[e3] = xr[e] * el; qt[e3] = bb_ * iv; kt[e3] = kp_ * iv;
                    }
                const int s0 = (q4 >> 1) * 32 + gI * 8 + (q4 & 1) * 4;
                u32x2 w; w.x = cvtpk(pt[0], pt[1]); w.y = cvtpk(pt[2], pt[3]); *(u32x2*)(A1 + tok * 104 + s0) = w;
                w.x = cvtpk(rt[0], rt[1]); w.y = cvtpk(rt[2], rt[3]); *(u32x2*)(A2 + tok * 104 + s0) = w;
                w.x = cvtpk(qt[0], qt[1]); w.y = cvtpk(qt[2], qt[3]); *(u32x2*)(ZQ + tok * 72 + s0) = w;
                w.x = cvtpk(kt[0], kt[1]); w.y = cvtpk(kt[2], kt[3]); *(u32x2*)(ZK + tok * 72 + s0) = w;
              } }
            beta += dppf<0xB1>(beta); beta += dppf<0x4E>(beta);
            { float bv[16];
#pragma unroll
              for (int e = 0; e < 16; ++e) bv[e] = beta * __uint_as_float((e & 1) ? (xvp[e >> 1] & 0xffff0000u) : (xvp[e >> 1] << 16));
              *(u32x4*)(BV + grow * 1024 + h * 64 + c0) = pack8(bv); *(u32x4*)(BV + grow * 1024 + h * 64 + c0 + 8) = pack8(bv + 8); }
            lds_fence();
            if (lane == 0) ready[c] = 1u;
        }
#undef CLOAD
    } else {
        if (wid == 2) {
            for (int c = 0; c < 128; ++c) {
                unsigned char* cbw = smem + (c % CH_NB) * CH_CB;
                bf16_t* A1 = (bf16_t*)(cbw + CB_A1); bf16_t* A2 = (bf16_t*)(cbw + CB_A2); bf16_t* TT = (bf16_t*)(cbw + CB_TT);
                const bf16_t* ZQ = (const bf16_t*)(cbw + CB_ZQ); const bf16_t* ZK = (const bf16_t*)(cbw + CB_ZK);
                while (ready[c] == 0u) __builtin_amdgcn_s_sleep(1);
                asm volatile("" ::: "memory");
                { f32x4 gN = {0.f, 0.f, 0.f, 0.f}, gKP = gN, gQR = gN, gKR = gN;
#pragma unroll
                  for (int ks = 0; ks < 2; ++ks) {
                      const bf16x8 fzq = *(const bf16x8*)(ZQ + fr * 72 + ks * 32 + fq * 8), fzk = *(const bf16x8*)(ZK + fr * 72 + ks * 32 + fq * 8);
                      const bf16x8 fp = *(const bf16x8*)(A1 + fr * 104 + ks * 32 + fq * 8), frr = *(const bf16x8*)(A2 + fr * 104 + ks * 32 + fq * 8);
                      gN = MFMA16(fzq, fp, gN); gKP = MFMA16(fzk, fp, gKP); gQR = MFMA16(fzq, frr, gQR); gKR = MFMA16(fzk, frr, gKR); }
#pragma unroll
                  for (int jj = 0; jj < 4; ++jj) { const int j = fq * 4 + jj; const bool lt = j < fr, le = j <= fr;
                      gN[jj] = lt ? gN[jj] : 0.f; gKP[jj] = lt ? gKP[jj] : 0.f; gQR[jj] = le ? gQR[jj] : 0.f; gKR[jj] = le ? gKR[jj] : 0.f; }
                  u32x4 w1; w1.x = 0u; w1.y = 0u; w1.z = pk2(gKP[0], gKP[1]); w1.w = pk2(gKP[2], gKP[3]); *(u32x4*)(A1 + fr * 104 + 64 + fq * 8) = w1;
                  u32x4 w2; w2.x = pk2(gQR[0], gQR[1]); w2.y = pk2(gQR[2], gQR[3]); w2.z = pk2(gKR[0], gKR[1]); w2.w = pk2(gKR[2], gKR[3]); *(u32x4*)(A2 + fr * 104 + 64 + fq * 8) = w2;
                  float Ti[16]; int i = fr; asm volatile("" : "+v"(i));
#pragma unroll
                  for (int t = 0; t < 16; ++t) { float s_ = (i == t) ? 1.0f : 0.0f;
                      __builtin_amdgcn_sched_barrier(0);
#pragma unroll
                      for (int j = 0; j < t; ++j) s_ += Ti[j] * __int_as_float(__builtin_amdgcn_readlane(__float_as_int(gN[j & 3]), (j >> 2) * 16 + t));
                      Ti[t] = s_; }
                  if (lane < 16) { const int sq = (i >> 2) * 8 + (i & 3);
#pragma unroll
                      for (int t = 0; t < 16; ++t) TT[t * 40 + sq] = f2bf(Ti[t]); } }
                lds_fence();
                if (lane == 0) ready2[c] = 1u;
            }
        } else {
            const int ng = 2, g0 = wid * 2;
            f32x4 acc[2][4];
#pragma unroll
            for (int gi = 0; gi < 2; ++gi)
#pragma unroll
                for (int kt = 0; kt < 4; ++kt) acc[gi][kt] = (f32x4){0.f, 0.f, 0.f, 0.f};
            for (int c = 0; c < 128; ++c) {
                const unsigned char* cbw = smem + (c % CH_NB) * CH_CB;
                const bf16_t* A1 = (const bf16_t*)(cbw + CB_A1); const bf16_t* A2 = (const bf16_t*)(cbw + CB_A2); const bf16_t* TT = (const bf16_t*)(cbw + CB_TT);
                const bf16_t* ZQ = (const bf16_t*)(cbw + CB_ZQ); const bf16_t* ZK = (const bf16_t*)(cbw + CB_ZK); const bf16_t* Vn = (const bf16_t*)(cbw + CB_V); const float* GQ = (const float*)(cbw + CB_GQ);
                while (ready2[c] == 0u) __builtin_amdgcn_s_sleep(1);
                asm volatile("" ::: "memory");
                union U8 { u32x4 u; bf16x8 h; };
                U8 FA[4];
#pragma unroll
                for (int kt = 0; kt < 4; ++kt) { const int sk = (kt >> 1) * 32 + (fr >> 2) * 8 + (kt & 1) * 4 + (fr & 3);
                    const unsigned q0 = ZQ[(fq * 4 + 0) * 72 + sk], q1 = ZQ[(fq * 4 + 1) * 72 + sk], q2 = ZQ[(fq * 4 + 2) * 72 + sk], q3 = ZQ[(fq * 4 + 3) * 72 + sk];
                    const unsigned k0 = ZK[(fq * 4 + 0) * 72 + sk], k1 = ZK[(fq * 4 + 1) * 72 + sk], k2 = ZK[(fq * 4 + 2) * 72 + sk], k3 = ZK[(fq * 4 + 3) * 72 + sk];
                    FA[kt].u.x = q0 | (q1 << 16); FA[kt].u.y = q2 | (q3 << 16); FA[kt].u.z = k0 | (k1 << 16); FA[kt].u.w = k2 | (k3 << 16); }
                const bf16x8 a1f0 = *(const bf16x8*)(A1 + fr * 104 + fq * 8), a1f1 = *(const bf16x8*)(A1 + fr * 104 + 32 + fq * 8), a1f2 = *(const bf16x8*)(A1 + fr * 104 + 64 + fq * 8);
                const bf16x8 a2f0 = *(const bf16x8*)(A2 + fr * 104 + fq * 8), a2f1 = *(const bf16x8*)(A2 + fr * 104 + 32 + fq * 8), a2f2 = *(const bf16x8*)(A2 + fr * 104 + 64 + fq * 8);
                const bf16x8 ttf = *(const bf16x8*)(TT + fr * 40 + fq * 8);
                float4 gq[4];
#pragma unroll
                for (int kt = 0; kt < 4; ++kt) gq[kt] = *(const float4*)(GQ + kt * 16 + fq * 4);
#pragma unroll
                for (int gi = 0; gi < 2; ++gi) if (gi < ng) {
                    const int v0 = (g0 + gi) * 16;
                    U8 B0, B1, BX;
                    B0.u.x = cvtpk(acc[gi][0][0], acc[gi][0][1]); B0.u.y = cvtpk(acc[gi][0][2], acc[gi][0][3]); B0.u.z = cvtpk(acc[gi][1][0], acc[gi][1][1]); B0.u.w = cvtpk(acc[gi][1][2], acc[gi][1][3]);
                    B1.u.x = cvtpk(acc[gi][2][0], acc[gi][2][1]); B1.u.y = cvtpk(acc[gi][2][2], acc[gi][2][3]); B1.u.z = cvtpk(acc[gi][3][0], acc[gi][3][1]); B1.u.w = cvtpk(acc[gi][3][2], acc[gi][3][3]);
                    u32x2 vq;
                    { const unsigned e0 = Vn[(fq * 4 + 0) * 72 + v0 + fr], e1 = Vn[(fq * 4 + 1) * 72 + v0 + fr], e2 = Vn[(fq * 4 + 2) * 72 + v0 + fr], e3 = Vn[(fq * 4 + 3) * 72 + v0 + fr];
                      vq.x = e0 | (e1 << 16); vq.y = e2 | (e3 << 16); }
                    BX.u.x = 0u; BX.u.y = 0u; BX.u.z = vq.x; BX.u.w = vq.y;
                    f32x4 rhs = {0.f, 0.f, 0.f, 0.f};
                    rhs = MFMA16(a1f0, B0.h, rhs); rhs = MFMA16(a1f1, B1.h, rhs); rhs = MFMA16(a1f2, BX.h, rhs);
                    BX.u.x = pk2(rhs[0], rhs[1]); BX.u.y = pk2(rhs[2], rhs[3]); BX.u.z = 0u; BX.u.w = 0u;
                    f32x4 uu = {0.f, 0.f, 0.f, 0.f};
                    uu = MFMA16(ttf, BX.h, uu);
                    BX.u.x = pk2(uu[0], uu[1]); BX.u.y = pk2(uu[2], uu[3]); BX.u.z = vq.x; BX.u.w = vq.y;
                    f32x4 oo = {0.f, 0.f, 0.f, 0.f};
                    oo = MFMA16(a2f0, B0.h, oo); oo = MFMA16(a2f1, B1.h, oo); oo = MFMA16(a2f2, BX.h, oo);
#pragma unroll
                    for (int kt = 0; kt < 4; ++kt) { acc[gi][kt] = MFMA16(FA[kt].h, BX.h, acc[gi][kt]);
                        acc[gi][kt][0] *= gq[kt].x; acc[gi][kt][1] *= gq[kt].y; acc[gi][kt][2] *= gq[kt].z; acc[gi][kt][3] *= gq[kt].w; }
                    float* op = ORAW + ((size_t)b * 2048 + c * 16 + fq * 4) * 1024 + h * 64 + v0 + fr;
#pragma unroll
                    for (int jj = 0; jj < 4; ++jj) op[(size_t)jj * 1024] = oo[jj];
                }
                asm volatile("s_waitcnt lgkmcnt(0)" ::: "memory");
                if (lane == 0) __hip_atomic_fetch_add((LAS unsigned*)&cons[c], 1u, __ATOMIC_RELAXED, __HIP_MEMORY_SCOPE_WORKGROUP);
            }
#pragma unroll
            for (int gi = 0; gi < 2; ++gi) if (gi < ng) {
                float* so = p.out + O_PWKV + ((((size_t)l * 8 + b) * 16 + h) * 64 + (g0 + gi) * 16 + fr) * 64 + fq * 4;
#pragma unroll
                for (int kt = 0; kt < 4; ++kt) *(float4*)(so + kt * 16) = make_float4(acc[gi][kt][0], acc[gi][kt][1], acc[gi][kt][2], acc[gi][kt][3]);
            }
        }
    }
    __syncthreads();
}

__device__ void rwkv_sample_item(const Params& p, int l, int item, unsigned char* smem_) {
    unsigned char* smem = launder_lds(smem_);
    const int tid = tid_l(), lane = tid & 63, ks = tid >> 6;
    const int i = item >> 4, h = item & 15;
    float* part = (float*)smem;
    float* sv = part + 1024;
    float* s_sc = sv + 384;
    const bf16_t* P = (const bf16_t*)(p.ws + WS_P);
    float* ORAW = (float*)(p.ws + WS_ORAW);
    bf16_t* BV = (bf16_t*)(p.ws + WS_BV);
    const size_t rowp = (size_t)TP + i, rows = (size_t)TALL + i;
    const bf16_t* pc = P + rowp * N1; const bf16_t* pp = P + rows * N1;
    const float* mu = p.in[I_MU] + (size_t)l * 3200;
    const int gc = h * 64 + lane;
    const int row = tid >> 3, cs = (tid & 7) * 8;
    const size_t so = ((((size_t)l * TS + i) * 16 + h) * 64 + row) * 64 + cs;
    const float4 a0 = *(const float4*)(p.in[I_SWKV] + so), a1 = *(const float4*)(p.in[I_SWKV] + so + 4);
#define LERP1(col) (bf2f(pc[col]) + (bf2f(pp[col]) - bf2f(pc[col])) * mu[col])
    { const float* w2 = p.in[I_W2] + (size_t)l * 64 * 1024 + gc; const float* a2 = p.in[I_A2] + (size_t)l * 64 * 1024 + gc;
      float lw = 0.f, la = 0.f;
#pragma unroll
      for (int kk = 0; kk < 8; ++kk) { const int k = ks * 8 + kk; const float xwl = LERP1(C_WL + k), xal = LERP1(C_AL + k);
          lw += (1.0f - 2.0f * frcp(__expf(2.0f * xwl) + 1.0f)) * w2[(size_t)k * 1024]; la += xal * a2[(size_t)k * 1024]; }
      __syncthreads();
      part[ks * 64 + lane] = lw; part[512 + ks * 64 + lane] = la; }
    __syncthreads();
    if (tid < 64) {
        const float xr = LERP1(C_R + gc), xk = LERP1(C_K + gc), xv = LERP1(C_V + gc);
        float lw = 0.f, la = 0.f;
#pragma unroll
        for (int q = 0; q < 8; ++q) { lw += part[q * 64 + lane]; la += part[512 + q * 64 + lane]; }
        const float w = __expf(-0.60653066f * sigmoidf_(p.in[I_W0][l * 1024 + gc] + lw));
        const float a = sigmoidf_(p.in[I_A0][l * 1024 + gc] + la);
        float kk = xk * p.in[I_KK][l * 1024 + gc];
        const float ssq = wave_sum(kk * kk);
        kk *= 1.0f / fmaxf(sqrtf(ssq), 1e-12f);
        const float kp = xk * (1.0f + (a - 1.0f) * p.in[I_KA][l * 1024 + gc]);
        const float bb = -kk * a, wr = w * xr;
        const float br = wave_sum(bb * xr), kr = wave_sum(kp * xr), beta = wave_sum(xr * kp * p.in[I_RK][l * 1024 + gc]);
        sv[lane] = w; sv[64 + lane] = kk; sv[128 + lane] = bb; sv[192 + lane] = kp; sv[256 + lane] = wr; sv[320 + lane] = xv;
        if (lane == 0) { s_sc[0] = br; s_sc[1] = kr; }
        BV[rowp * 1024 + gc] = f2bf(beta * xv);
    }
#undef LERP1
    __syncthreads();
    {
        float S[8] = {a0.x, a0.y, a0.z, a0.w, a1.x, a1.y, a1.z, a1.w};
        float dk = 0.f, dr = 0.f;
#pragma unroll
        for (int e = 0; e < 8; ++e) { dk += S[e] * sv[64 + cs + e]; dr += S[e] * sv[256 + cs + e]; }
        dk = red8(dk); dr = red8(dr);
        const float vr = sv[320 + row];
        const float o = dr + dk * s_sc[0] + vr * s_sc[1];
        if ((tid & 7) == 0) ORAW[rowp * 1024 + h * 64 + row] = o;
#pragma unroll
        for (int e = 0; e < 8; ++e) S[e] = S[e] * sv[cs + e] + dk * sv[128 + cs + e] + vr * sv[192 + cs + e];
        float* sout = p.out + O_SWKV + so;
        *(float4*)sout = make_float4(S[0], S[1], S[2], S[3]); *(float4*)(sout + 4) = make_float4(S[4], S[5], S[6], S[7]);
    }
}

__device__ void phase_conv(const Params& p, int l) {
    const int tid = tid_l();
    const bf16_t* P = (const bf16_t*)(p.ws + WS_P);
    bf16_t* U = (bf16_t*)(p.ws + WS_U); float* DT = (float*)(p.ws + WS_DT);
    for (int id = blockIdx.x * 512 + tid; id < 512 * 192; id += gridDim.x * 512) {
        const int q = id % 192, seg = id / 192, xcol = q * 8;
        const int bb = seg >> 6, tb = (seg & 63) * 32;
        float cw[4][8], cbv[8];
        { const float* cwp = p.in[I_CW] + (size_t)l * 4 * 1536 + xcol;
#pragma unroll
          for (int w = 0; w < 4; ++w) { const float4 u0 = *(const float4*)(cwp + w * 1536), u1 = *(const float4*)(cwp + w * 1536 + 4);
              cw[w][0] = u0.x; cw[w][1] = u0.y; cw[w][2] = u0.z; cw[w][3] = u0.w; cw[w][4] = u1.x; cw[w][5] = u1.y; cw[w][6] = u1.z; cw[w][7] = u1.w; }
          const float4 b0 = *(const float4*)(p.in[I_CB] + (size_t)l * 1536 + xcol), b1 = *(const float4*)(p.in[I_CB] + (size_t)l * 1536 + xcol + 4);
          cbv[0] = b0.x; cbv[1] = b0.y; cbv[2] = b0.z; cbv[3] = b0.w; cbv[4] = b1.x; cbv[5] = b1.y; cbv[6] = b1.z; cbv[7] = b1.w; }
        const bf16_t* pb = P + ((size_t)bb * 2048 + tb) * N1 + C_XBC + xcol;
        bf16_t* ub = U + ((size_t)bb * 2048 + tb) * 1536 + xcol;
        float w0[8], w1[8], w2[8];
#pragma unroll
        for (int e = 0; e < 8; ++e) { w0[e] = 0.f; w1[e] = 0.f; w2[e] = 0.f; }
        if (tb >= 3) { unpack8(*(const u32x4*)(pb - 3 * (size_t)N1), w0); unpack8(*(const u32x4*)(pb - 2 * (size_t)N1), w1); unpack8(*(const u32x4*)(pb - (size_t)N1), w2); }
#pragma unroll 8
        for (int s_ = 0; s_ < 32; ++s_) {
            float cur[8], u[8];
            unpack8(*(const u32x4*)(pb + (size_t)s_ * N1), cur);
#pragma unroll
            for (int e = 0; e < 8; ++e) { u[e] = siluf_(cbv[e] + cw[0][e] * w0[e] + cw[1][e] * w1[e] + cw[2][e] * w2[e] + cw[3][e] * cur[e]); w0[e] = w1[e]; w1[e] = w2[e]; w2[e] = cur[e]; }
            *(u32x4*)(ub + (size_t)s_ * 1536) = pack8(u);
        }
    }
    for (int id = blockIdx.x * 512 + tid; id < TP * 16; id += gridDim.x * 512) {
        const int t = id >> 4, j = id & 15;
        DT[id] = softplusf_(bf2f(P[(size_t)t * N1 + C_DT + j]) + p.in[I_DTB][l * 16 + j]);
    }
}

__device__ void mamba_item(const Params& p, int l, int item, unsigned char* smem_) {
    unsigned char* smem = launder_lds(smem_);
    const int tid = tid_l(), wid = tid >> 6, lane = tid & 63, fr = lane & 15, fq = lane >> 4;
    const int b = item >> 5, j = (item >> 1) & 15, ph = item & 1, g = j >> 3;
    bf16_t* Cm = (bf16_t*)smem;
    bf16_t* Bm = (bf16_t*)(smem + 17408);
    bf16_t* BmT = (bf16_t*)(smem + 34816);
    bf16_t* XT = (bf16_t*)(smem + 53248);
    bf16_t* XwT = (bf16_t*)(smem + 57856);
    bf16_t* G = (bf16_t*)(smem + 62464);
    bf16_t* Hb = (bf16_t*)(smem + 71680);
    float* acs = (float*)(smem + 80384);
    float* dtv = acs + 64;
    const bf16_t* P = (const bf16_t*)(p.ws + WS_P);
    const bf16_t* U = (const bf16_t*)(p.ws + WS_U); const float* DT = (const float*)(p.ws + WS_DT);
    bf16_t* YM = (bf16_t*)(p.ws + WS_YM);
    __syncthreads();
    for (int i = tid; i < 32 * 136; i += 512) Hb[i] = 0;
    const float Aj = -__expf(p.in[I_ALOG][l * 16 + j]), Dj = p.in[I_DSK][l * 16 + j];
    const int c16a = wid * 2, c16b = wid * 2 + 1, c4 = wid & 3;
    const int lt = wid >> 1, pt = wid & 1;
    const bf16_t* ub = U + (size_t)b * 2048 * 1536;
    u32x4 rb0, rb1, rc0, rc1, rx = {0u, 0u, 0u, 0u}; float rdt = 0.f;
#define LOADCHUNK(T0) { const bf16_t* r0 = ub + (size_t)((T0) + lane) * 1536 + g * 128; \
        rb0 = *(const u32x4*)(r0 + 1024 + c16a * 8); rb1 = *(const u32x4*)(r0 + 1024 + c16b * 8); rc0 = *(const u32x4*)(r0 + 1280 + c16a * 8); rc1 = *(const u32x4*)(r0 + 1280 + c16b * 8); \
        if (tid < 256) rx = *(const u32x4*)(ub + (size_t)((T0) + lane) * 1536 + j * 64 + ph * 32 + c4 * 8); \
        if (wid == 5) rdt = DT[((size_t)b * 2048 + (T0) + lane) * 16 + j]; }
    LOADCHUNK(0)
    f32x4 hacc[2] = {{0.f, 0.f, 0.f, 0.f}, {0.f, 0.f, 0.f, 0.f}};
    for (int c = 0; c < 32; ++c) {
        const int t0 = c * 64;
        float zq[4];
#pragma unroll
        for (int jj = 0; jj < 4; ++jj) zq[jj] = bf2f(P[((size_t)b * 2048 + t0 + lt * 16 + fq * 4 + jj) * N1 + C_ZM + j * 64 + ph * 32 + pt * 16 + fr]);
        *(u32x4*)(Cm + lane * 136 + c16a * 8) = rc0; *(u32x4*)(Cm + lane * 136 + c16b * 8) = rc1;
        *(u32x4*)(Bm + lane * 136 + c16a * 8) = rb0; *(u32x4*)(Bm + lane * 136 + c16b * 8) = rb1;
#pragma unroll
        for (int e = 0; e < 8; ++e) { const unsigned v0 = rb0[e >> 1], v1 = rb1[e >> 1];
            BmT[(c16a * 8 + e) * 72 + lane] = (bf16_t)((e & 1) ? (v0 >> 16) : (v0 & 0xffffu)); BmT[(c16b * 8 + e) * 72 + lane] = (bf16_t)((e & 1) ? (v1 >> 16) : (v1 & 0xffffu)); }
        if (tid < 256) {
#pragma unroll
            for (int e = 0; e < 8; ++e) { const unsigned v0 = rx[e >> 1]; XT[(c4 * 8 + e) * 72 + lane] = (bf16_t)((e & 1) ? (v0 >> 16) : (v0 & 0xffffu)); }
        }
        if (wid == 5) {
            float v = rdt * Aj;
#pragma unroll
            for (int off = 1; off < 64; off <<= 1) { const float t = __shfl_up(v, off); if (lane >= off) v += t; }
            acs[lane] = v; dtv[lane] = rdt;
        }
        if (c + 1 < 32) LOADCHUNK(t0 + 64)
        LBAR();
        { const int pp = tid & 31, s4 = (tid >> 5) * 4; const float aend = acs[63];
          const u32x2 xv = *(const u32x2*)(XT + pp * 72 + s4);
          const float x0 = __uint_as_float(xv.x << 16), x1 = __uint_as_float(xv.x & 0xffff0000u), x2 = __uint_as_float(xv.y << 16), x3 = __uint_as_float(xv.y & 0xffff0000u);
          u32x2 bq; bq.x = pk2(x0 * dtv[s4] * __expf(aend - acs[s4]), x1 * dtv[s4 + 1] * __expf(aend - acs[s4 + 1]));
          bq.y = pk2(x2 * dtv[s4 + 2] * __expf(aend - acs[s4 + 2]), x3 * dtv[s4 + 3] * __expf(aend - acs[s4 + 3]));
          *(u32x2*)(XwT + pp * 72 + s4) = bq; }
#pragma unroll
        for (int e = 0; e < 2; ++e) {
            const int id = wid * 2 + e, glt = id >> 2, st = id & 3;
            f32x4 acc = {0.f, 0.f, 0.f, 0.f};
            if (st <= glt) {
#pragma unroll
                for (int ks = 0; ks < 4; ++ks) { const bf16x8 fa = *(const bf16x8*)(Cm + (glt * 16 + fr) * 136 + ks * 32 + fq * 8), fb = *(const bf16x8*)(Bm + (st * 16 + fr) * 136 + ks * 32 + fq * 8); acc = MFMA16(fa, fb, acc); }
            }
#pragma unroll
            for (int jj = 0; jj < 4; ++jj) { const int lr = glt * 16 + fq * 4 + jj, s = st * 16 + fr;
                const float val = (s <= lr) ? acc[jj] * __expf(acs[lr] - acs[s]) * dtv[s] : 0.f;
                G[lr * 72 + s] = f2bf(val); }
        }
        f32x4 accO = {0.f, 0.f, 0.f, 0.f};
#pragma unroll
        for (int ks = 0; ks < 4; ++ks) { const bf16x8 fa = *(const bf16x8*)(Cm + (lt * 16 + fr) * 136 + ks * 32 + fq * 8), fb = *(const bf16x8*)(Hb + (pt * 16 + fr) * 136 + ks * 32 + fq * 8); accO = MFMA16(fa, fb, accO); }
        LBAR();
        {
            f32x4 accD = {0.f, 0.f, 0.f, 0.f};
#pragma unroll
            for (int ks = 0; ks < 2; ++ks) { const bf16x8 fa = *(const bf16x8*)(G + (lt * 16 + fr) * 72 + ks * 32 + fq * 8), fb = *(const bf16x8*)(XT + (pt * 16 + fr) * 72 + ks * 32 + fq * 8); accD = MFMA16(fa, fb, accD); }
#pragma unroll
            for (int jj = 0; jj < 4; ++jj) { const int lr = lt * 16 + fq * 4 + jj, pp = pt * 16 + fr;
                float y = accD[jj] + __expf(acs[lr]) * accO[jj] + Dj * bf2f(XT[pp * 72 + lr]);
                y *= siluf_(zq[jj]);
                YM[((size_t)b * 2048 + t0 + lr) * 1024 + j * 64 + ph * 32 + pp] = f2bf(y); }
            const float cd = __expf(acs[63]); const int ptile = wid >> 2;
#pragma unroll
            for (int e = 0; e < 2; ++e) { const int nt = (wid & 3) * 2 + e;
                hacc[e] *= cd;
#pragma unroll
                for (int ks = 0; ks < 2; ++ks) { const bf16x8 fa = *(const bf16x8*)(XwT + (ptile * 16 + fr) * 72 + ks * 32 + fq * 8), fb = *(const bf16x8*)(BmT + (nt * 16 + fr) * 72 + ks * 32 + fq * 8); hacc[e] = MFMA16(fa, fb, hacc[e]); }
#pragma unroll
                for (int jj = 0; jj < 4; ++jj) Hb[(ptile * 16 + fq * 4 + jj) * 136 + nt * 16 + fr] = f2bf(hacc[e][jj]); }
        }
        LBAR();
    }
#undef LOADCHUNK
    { const int ptile = wid >> 2;
#pragma unroll
      for (int e = 0; e < 2; ++e) { const int nt = (wid & 3) * 2 + e;
#pragma unroll
          for (int jj = 0; jj < 4; ++jj) p.out[O_PSSM + ((((size_t)l * 8 + b) * 16 + j) * 64 + ph * 32 + ptile * 16 + fq * 4 + jj) * 128 + nt * 16 + fr] = hacc[e][jj]; } }
    __syncthreads();
}

__device__ void mamba_sample_item(const Params& p, int l, int item, unsigned char* smem_) {
    unsigned char* smem = launder_lds(smem_);
    const int tid = tid_l();
    const int i = item >> 4, j = item & 15, g = j >> 3;
    float* su = (float*)smem;
    float* sd = su + 320;
    const bf16_t* P = (const bf16_t*)(p.ws + WS_P);
    bf16_t* YM = (bf16_t*)(p.ws + WS_YM);
    const size_t rowp = (size_t)TP + i;
    const int pp = tid >> 3, n0 = (tid & 7) * 16;
    const size_t so = ((((size_t)l * TS + i) * 16 + j) * 64 + pp) * 128 + n0;
    float4 hv4[4];
#pragma unroll
    for (int e = 0; e < 4; ++e) hv4[e] = *(const float4*)(p.in[I_SSSM] + so + e * 4);
    __syncthreads();
    if (tid < 320) {
        const int cc = tid < 64 ? j * 64 + tid : (tid < 192 ? 1024 + g * 128 + (tid - 64) : 1280 + g * 128 + (tid - 192));
        const float* c0 = p.in[I_SCONV] + ((size_t)l * TS + i) * 3 * 1536 + cc;
        const float* cw = p.in[I_CW] + (size_t)l * 4 * 1536 + cc;
        const float v = p.in[I_CB][l * 1536 + cc] + c0[0] * cw[0] + c0[1536] * cw[1536] + c0[3072] * cw[3072] + bf2f(P[rowp * N1 + C_XBC + cc]) * cw[4608];
        su[tid] = siluf_(v);
    } else if (tid == 320) {
        const float dt = softplusf_(bf2f(P[rowp * N1 + C_DT + j]) + p.in[I_DTB][l * 16 + j]);
        sd[0] = dt; sd[1] = __expf(-dt * __expf(p.in[I_ALOG][l * 16 + j]));
    }
    __syncthreads();
    {
        float* hout = p.out + O_SSSM + so;
        const float dt = sd[0], eA = sd[1], x = su[pp], xdt = x * dt;
        float y = 0.f;
#pragma unroll
        for (int e = 0; e < 4; ++e) { float4 hv = hv4[e]; const float* Bp = su + 64 + n0 + e * 4; const float* Cp = su + 192 + n0 + e * 4;
            hv.x = eA * hv.x + xdt * Bp[0]; hv.y = eA * hv.y + xdt * Bp[1]; hv.z = eA * hv.z + xdt * Bp[2]; hv.w = eA * hv.w + xdt * Bp[3];
            y += hv.x * Cp[0] + hv.y * Cp[1] + hv.z * Cp[2] + hv.w * Cp[3];
            *(float4*)(hout + e * 4) = hv; }
        y = red8(y);
        if ((tid & 7) == 0) { y += p.in[I_DSK][l * 16 + j] * x; const float z = bf2f(P[rowp * N1 + C_ZM + j * 64 + pp]); YM[rowp * 1024 + j * 64 + pp] = f2bf(y * siluf_(z)); }
    }
}

__device__ void phase_mixa(const Params& p, int l, unsigned char* smem) {
    for (int rep = 0; rep < (DUP == 5 ? 2 : 1); ++rep) phase_conv(p, l);
    for (int rep = 0; rep < (DUP == 3 ? 2 : 1); ++rep)
    for (int it = blockIdx.x; it < 2048; it += gridDim.x) rwkv_sample_item(p, l, it, smem);
    for (int rep = 0; rep < (DUP == 4 ? 2 : 1); ++rep)
    for (int it = blockIdx.x; it < 2048; it += gridDim.x) mamba_sample_item(p, l, it, smem);
}
__device__ void phase_mixb(const Params& p, int l, unsigned char* smem) {
    const int G = (int)gridDim.x, nch = G >= 256 ? 128 : G;
    if ((int)blockIdx.x < nch) {
        for (int rep = 0; rep < (DUP == 1 ? 2 : 1); ++rep)
        for (int it = blockIdx.x; it < 128; it += nch) rwkv_chain_item(p, l, it, smem);
    }
    unsigned* ticket = (unsigned*)(p.ws + WS_BAR) + XCD_BAR_WORDS + 64 * l;
    volatile LAS int* slot = (volatile LAS int*)((LAS unsigned char*)smem + LDS_BARST + 8);
    for (;;) {
        __syncthreads();
        if (tid_l() == 0) *slot = (int)__hip_atomic_fetch_add(ticket, 1u, __ATOMIC_RELAXED, __HIP_MEMORY_SCOPE_AGENT);
        __syncthreads();
        const int it = *slot;
        if (it >= 256 * (DUP == 2 ? 2 : 1)) break;
        mamba_item(p, l, it & 255, smem);
    }
}

__device__ void sample_outproj(const Params& p, int l) {
    const int tid = tid_l(), wid = tid >> 6, lane = tid & 63, fr = lane & 15, fq = lane >> 4;
    const bf16_t* A2 = (const bf16_t*)(p.ws + WS_A) + (size_t)TP * 2048;
    const bf16_t* W = (const bf16_t*)(p.ws + WS_WOUTT) + (size_t)l * 1024 * 2048;
    float* PART = (float*)(p.ws + WS_PART);
    for (int it = blockIdx.x; it < 256; it += gridDim.x) {
        const int nt = it & 15, ksl = it >> 4;
        f32x4 acc[4] = {{0.f, 0.f, 0.f, 0.f}, {0.f, 0.f, 0.f, 0.f}, {0.f, 0.f, 0.f, 0.f}, {0.f, 0.f, 0.f, 0.f}};
#pragma unroll
        for (int kq = 0; kq < 4; ++kq) {
            const bf16x8 fa = *(const bf16x8*)(A2 + (size_t)(wid * 16 + fr) * 2048 + ksl * 128 + kq * 32 + fq * 8);
#pragma unroll
            for (int ct = 0; ct < 4; ++ct) { const bf16x8 fb = *(const bf16x8*)(W + (size_t)(nt * 64 + ct * 16 + fr) * 2048 + ksl * 128 + kq * 32 + fq * 8); acc[ct] = MFMA16(fa, fb, acc[ct]); }
        }
#pragma unroll
        for (int ct = 0; ct < 4; ++ct)
#pragma unroll
            for (int jj = 0; jj < 4; ++jj) PART[((size_t)ksl * TS + wid * 16 + fq * 4 + jj) * 1024 + nt * 64 + ct * 16 + fr] = acc[ct][jj];
    }
}

__device__ void phase_post(const Params& p, int l) {
    const int tid_ = tid_l(); const int lane = tid_ & 63, wid = tid_ >> 6;
    const bf16_t* P = (const bf16_t*)(p.ws + WS_P);
    const float* ORAW = (const float*)(p.ws + WS_ORAW);
    const bf16_t* BV = (const bf16_t*)(p.ws + WS_BV);
    const bf16_t* YM = (const bf16_t*)(p.ws + WS_YM);
    bf16_t* A2 = (bf16_t*)(p.ws + WS_A);
    const int c0 = lane * 16;
    float lnw[16], lnb[16], gnw[16];
#pragma unroll
    for (int e = 0; e < 16; ++e) { lnw[e] = p.in[I_LNW][l * 1024 + c0 + e]; lnb[e] = p.in[I_LNB][l * 1024 + c0 + e]; gnw[e] = p.in[I_GNW][l * 1024 + c0 + e]; }
    for (int row = blockIdx.x * 8 + wid; row < TALL; row += gridDim.x * 8) {
        const bf16_t* prow = P + (size_t)row * N1;
        float o[16], bv[16], z[16], ym[16];
#pragma unroll
        for (int i = 0; i < 4; ++i) { const float4 t = *(const float4*)(ORAW + (size_t)row * 1024 + c0 + i * 4); o[i * 4] = t.x; o[i * 4 + 1] = t.y; o[i * 4 + 2] = t.z; o[i * 4 + 3] = t.w; }
        unpack8(*(const u32x4*)(BV + (size_t)row * 1024 + c0), bv); unpack8(*(const u32x4*)(BV + (size_t)row * 1024 + c0 + 8), bv + 8);
        unpack8(*(const u32x4*)(prow + C_ZR + c0), z); unpack8(*(const u32x4*)(prow + C_ZR + c0 + 8), z + 8);
        unpack8(*(const u32x4*)(YM + (size_t)row * 1024 + c0), ym); unpack8(*(const u32x4*)(YM + (size_t)row * 1024 + c0 + 8), ym + 8);
        float s = 0.f;
#pragma unroll
        for (int e = 0; e < 16; ++e) s += o[e];
        s += dppf<0xB1>(s); s += dppf<0x4E>(s);
        const float mean = s * (1.0f / 64.0f);
        float v = 0.f;
#pragma unroll
        for (int e = 0; e < 16; ++e) { o[e] -= mean; v += o[e] * o[e]; }
        v += dppf<0xB1>(v); v += dppf<0x4E>(v);
        const float rstd = rsqrtf(v * (1.0f / 64.0f) + 64e-5f);
#pragma unroll
        for (int e = 0; e < 16; ++e) o[e] = (o[e] * rstd * lnw[e] + lnb[e] + bv[e]) * siluf_(z[e]);
        *(u32x4*)(A2 + (size_t)row * 2048 + c0) = pack8(o); *(u32x4*)(A2 + (size_t)row * 2048 + c0 + 8) = pack8(o + 8);
        float ss = 0.f;
#pragma unroll
        for (int e = 0; e < 16; ++e) ss += ym[e] * ym[e];
        ss = red16(ss); ss += __shfl_xor(ss, 16);
        const float rs = rsqrtf(ss * (1.0f / 512.0f) + 1e-5f);
#pragma unroll
        for (int e = 0; e < 16; ++e) ym[e] *= rs * gnw[e];
        *(u32x4*)(A2 + (size_t)row * 2048 + 1024 + c0) = pack8(ym); *(u32x4*)(A2 + (size_t)row * 2048 + 1024 + c0 + 8) = pack8(ym + 8);
        if (row < TP) {
            const int tq = row & 2047;
            if (tq >= 2045) { float* dst = p.out + O_PCONV + (((size_t)l * 8 + (row >> 11)) * 3 + (tq - 2045)) * 1536;
                for (int c = lane; c < 1536; c += 64) dst[c] = bf2f(prow[C_XBC + c]); }
        } else {
            const int i = row - TP; float* dst = p.out + O_SCONV + ((size_t)l * TS + i) * 3 * 1536; const float* src = p.in[I_SCONV] + ((size_t)l * TS + i) * 3 * 1536;
            for (int c = lane; c < 1536; c += 64) { dst[c] = src[1536 + c]; dst[1536 + c] = src[3072 + c]; dst[3072 + c] = bf2f(prow[C_XBC + c]); }
        }
    }
}

constexpr int NPHASE = 13;
__global__ __launch_bounds__(512, 2) void mega(Params p) {
    extern __shared__ __attribute__((aligned(16))) unsigned char smem[];
    cg::grid_group grid = cg::this_grid();
    volatile LAS unsigned* st = (volatile LAS unsigned*)((LAS unsigned char*)smem + LDS_BARST);
    { const unsigned hw = (unsigned)__builtin_amdgcn_s_getreg((5 << 11) | 4) & 63u;
      if ((threadIdx.x & 63) == 0) *(volatile LAS int*)((LAS unsigned char*)smem + LDS_WIDTAB + hw * 4u) = (int)(threadIdx.x >> 6);
      if (threadIdx.x == 0) { st[0] = 0u; st[1] = 0u; } }
    __syncthreads();
    const XcdBarrier xbar = xcd_barrier_post((unsigned*)(p.ws + WS_BAR), st);
    if (p.ph_hi > 1000) grid.sync();
#define PHASE(K, BODY) if (p.ph_lo <= (K) && (K) < p.ph_hi) { if ((K) > p.ph_lo) { xcd_barrier(xbar); if (DUP == 13) { xcd_barrier(xbar); xcd_barrier(xbar); } } BODY }
#define GEMM1(L) { pg8::Gemm g{(const bf16_t*)(p.ws + WS_A), (const bf16_t*)(p.ws + WS_WINT) + (size_t)(L) * N1 * 1024, M1, N1, 1024}; \
        pg8::StaticOrder S; S.init(M1, N1, (int)gridDim.x, (int)blockIdx.x); EpiP E{(bf16_t*)(p.ws + WS_P), N1}; \
        pg8::gemm_phase<EpiP, pg8::StaticOrder, false>((PG8_LAS unsigned char*)smem, g, S, E, nullptr); }
#define GEMM2(L) { sample_outproj(p, (L)); \
        pg8::Gemm g{(const bf16_t*)(p.ws + WS_A), (const bf16_t*)(p.ws + WS_WOUTT) + (size_t)(L) * 1024 * 2048, TP, 1024, 2048}; \
        pg8::StaticOrder S; S.init(TP, 1024, (int)gridDim.x, (int)blockIdx.x); EpiRes E{(L) == 0 ? p.in[I_XP] : p.out + O_YP, p.out + O_YP}; \
        pg8::gemm_phase<EpiRes, pg8::StaticOrder, false>((PG8_LAS unsigned char*)smem, g, S, E, nullptr); }
    PHASE(0, phase_convert(p, smem); phase_norm(p, 0);)
    PHASE(1, GEMM1(0))
    PHASE(2, phase_mixa(p, 0, smem);)
    PHASE(3, phase_mixb(p, 0, smem);)
    PHASE(4, phase_post(p, 0);)
    PHASE(5, GEMM2(0))
    PHASE(6, phase_norm(p, 1);)
    PHASE(7, GEMM1(1))
    PHASE(8, phase_mixa(p, 1, smem);)
    PHASE(9, phase_mixb(p, 1, smem);)
    PHASE(10, phase_post(p, 1);)
    PHASE(11, GEMM2(1))
    PHASE(12, phase_final(p);)
}

extern "C" void kernel_launch(void* const* d_in, const int* in_sizes, int n_in, void* d_out, int out_size, void* d_ws, size_t ws_size, hipStream_t stream) {
    static int grid = 0;
    if (grid == 0) {
        if (n_in != 26 || (size_t)out_size != O_END || ws_size < WS_BAR + (size_t)(XCD_BAR_WORDS + 128) * 4) { fprintf(stderr, "kernel_launch: unexpected shapes: n_in %d out %d ws %zu (need %zu)\n", n_in, out_size, ws_size, (size_t)(WS_BAR + XCD_BAR_WORDS * 4)); grid = -1; return; }
        int dev = 0, cus = 0, per_cu = 0;
        hipGetDevice(&dev); hipDeviceGetAttribute(&cus, hipDeviceAttributeMultiprocessorCount, dev);
        if (hipFuncSetAttribute((const void*)mega, hipFuncAttributeMaxDynamicSharedMemorySize, LDS_BYTES) != hipSuccess) { fprintf(stderr, "kernel_launch: hipFuncSetAttribute failed\n"); grid = -1; return; }
        if (hipOccupancyMaxActiveBlocksPerMultiprocessor(&per_cu, (const void*)mega, 512, LDS_BYTES) != hipSuccess || per_cu < 1) { fprintf(stderr, "kernel_launch: occupancy query gave %d\n", per_cu); per_cu = 1; }
        (void)hipGetLastError();
        grid = cus * 1;
    }
    if (grid < 0) return;
    if (hipMemsetAsync((char*)d_ws + WS_BAR, 0, (size_t)(XCD_BAR_WORDS + 128) * 4, stream) != hipSuccess) { fprintf(stderr, "kernel_launch: memset of barrier words failed\n"); return; }
    Params p{};
    for (int i = 0; i < 26; ++i) p.in[i] = (const float*)d_in[i];
    p.out = (float*)d_out; p.ws = (unsigned char*)d_ws;
#if MK_PER_PHASE
    for (int ph = 0; ph < NPHASE; ++ph) { p.ph_lo = ph; p.ph_hi = ph + 1; hipLaunchKernelGGL(mega, dim3(grid), dim3(512), LDS_BYTES, stream, p); }
#else
    p.ph_lo = 0; p.ph_hi = NPHASE;
    void* args[] = {&p};
    hipError_t e = hipLaunchCooperativeKernel((const void*)mega, dim3(grid), dim3(512), args, LDS_BYTES, stream);
    if (e != hipSuccess) fprintf(stderr, "cooperative launch failed: %s (grid %d)\n", hipGetErrorString(e), grid);
#endif
}
```

```cpp
#include <hip/hip_runtime.h>
#include <hip/hip_cooperative_groups.h>
#include <cstdio>
namespace cg = cooperative_groups;

#define LDS_WIDTAB 163328
__device__ __forceinline__ int tid_l() {
    const unsigned hw = (unsigned)__builtin_amdgcn_s_getreg((5 << 11) | 4) & 63u;
    const int wid = *(volatile __attribute__((address_space(3))) int*)(unsigned long)(LDS_WIDTAB + hw * 4u);
    int ln; asm volatile("v_mbcnt_lo_u32_b32 %0, -1, 0\n\tv_mbcnt_hi_u32_b32 %0, -1, %0" : "=v"(ln));
    return __builtin_amdgcn_readfirstlane(wid) * 64 + ln; }
namespace pg8 {
#define PG8_LAS __attribute__((address_space(3)))
typedef unsigned short bf16_t;
typedef short bf16x8 __attribute__((ext_vector_type(8)));
typedef float f32x4 __attribute__((ext_vector_type(4)));
typedef unsigned u32x4 __attribute__((ext_vector_type(4)));
constexpr int BM = 256, BK = 64, HALF = 128, HTB = HALF * BK * 2  , STAGE_BYTES = 8 * HTB, NXCD = 8, WGM = 8;

__host__ __device__ __forceinline__ int lds_byte(int r, int c) { const int st = (r >> 4) * 2 + (c >> 5), rr = r & 15, cc = c & 31, ob = rr * 64 + cc * 2; return st * 1024 + (ob ^ (((ob >> 9) & 1) << 5)); }
__host__ __device__ __forceinline__ void stage_rc(int b, int& R, int& C) { const int st = b / 1024, sb = b % 1024, swz = sb ^ (((sb >> 9) & 1) << 5); R = (st >> 1) * 16 + swz / 64; C = (st & 1) * 32 + (swz % 64) / 2; }
__host__ __device__ __forceinline__ int perm32(int rho) { const int n = rho >> 4, i = rho & 15; return 8 * (i >> 2) + 4 * n + (i & 3); }

struct Unit { int pm, pn; };
struct Gemm { const bf16_t* A; const bf16_t* Bt; int M, N, K; };

struct StaticOrder {
    int nM, nN, nwg, G, c;
    __host__ __device__ void init(int M, int N, int G_, int c_) { nM = M / BM; nN = N / BM; nwg = nM * nN; G = G_; c = c_; }
    __host__ __device__ bool next(int i, Unit& u) const {
        const long L = (long)i * G + c; if (L >= nwg) return false;
        int wgid = (int)L; { const int q = nwg / NXCD, r = nwg % NXCD, xcd = wgid % NXCD, off = wgid / NXCD; wgid = (xcd < r ? xcd * (q + 1) : r * (q + 1) + (xcd - r) * q) + off; }
        const int nig = WGM * nN, gid = wgid / nig, fm = gid * WGM, gsz = (nM - fm) < WGM ? (nM - fm) : WGM;
        u.pm = fm + ((wgid % nig) % gsz); u.pn = (wgid % nig) / gsz; return true;
    }
    __device__ __forceinline__ void a_ready(const Unit&) const {}
    __device__ __forceinline__ void done(const Unit&) const {}
};
__device__ __forceinline__ unsigned cvt_pk_bf16(float lo, float hi) { unsigned r; asm volatile("v_cvt_pk_bf16_f32 %0, %1, %2" : "=v"(r) : "v"(lo), "v"(hi)); return r; }
template <class Epi, class Sched, bool STAMP = false>
__device__ __forceinline__ void gemm_phase(PG8_LAS unsigned char* lds, const Gemm g, const Sched& S, const Epi& E, unsigned long long* stamps) {
    const int tid = tid_l(), wid = __builtin_amdgcn_readfirstlane(tid >> 6), lane = tid & 63, wr = wid >> 2, wc = wid & 3, fr = lane & 15, fq = lane >> 4;
    const int K = g.K, nt = K / BK;
    int ts_lo = 0, ts_hi = 0, nts = 0; const unsigned long long rt_entry = STAMP ? (unsigned long long)wall_clock64() : 0ull;
#define PG8_STAMP() do { if (STAMP && wid == 0 && nts < 64) { const unsigned long long _c = (unsigned long long)clock64(); \
        ts_lo = (lane == nts) ? (int)(unsigned)_c : ts_lo; ts_hi = (lane == nts) ? (int)(unsigned)(_c >> 32) : ts_hi; ++nts; } } while (0)
    PG8_STAMP();
    unsigned voffA[2], voffB[2];
#pragma unroll
    for (int i = 0; i < 2; ++i) { int R, C; stage_rc(tid * 16 + i * 8192, R, C); const int Rb = Epi::PERM ? ((R & ~31) + perm32(R & 31)) : R;
        voffA[i] = (unsigned)(R * K + C) * 2u; voffB[i] = (unsigned)(Rb * K + C) * 2u; }
    const size_t kstep = (size_t)(BK * 2);
    const size_t hstep = (size_t)HALF * K * 2;
    const size_t tstep = 2 * hstep;
    const unsigned ldsw = (unsigned)wid * 1024u;
    const int aoff = lds_byte(wr * 64 + fr, fq * 8), boff = lds_byte(wc * 32 + fr, fq * 8);
#define PG8_SA(b, h) (((b) * 2 + (h)) * HTB)
#define PG8_SB(b, h) ((4 + (b) * 2 + (h)) * HTB)
#define PG8_STAGE(bufoff, gbase, voff) do { _Pragma("unroll") for (int _i = 0; _i < 2; ++_i) \
        __builtin_amdgcn_global_load_lds((const unsigned*)((const char*)(gbase) + (voff)[_i]), (PG8_LAS unsigned*)(lds + (bufoff) + ldsw + _i * 8192), 16, 0, 0); } while (0)
#define PG8_LDA(dst, b, h) do { _Pragma("unroll") for (int m = 0; m < 4; ++m) _Pragma("unroll") for (int k = 0; k < 2; ++k) dst[m][k] = *(const PG8_LAS bf16x8*)(lds + PG8_SA(b, h) + aoff + m * 2048 + k * 1024); } while (0)
#define PG8_LDB(dst, b, h) do { _Pragma("unroll") for (int n = 0; n < 2; ++n) _Pragma("unroll") for (int k = 0; k < 2; ++k) dst[n][k] = *(const PG8_LAS bf16x8*)(lds + PG8_SB(b, h) + boff + n * 2048 + k * 1024); } while (0)
#define PG8_MMA(ai, bj, At, Bt) do { __builtin_amdgcn_s_setprio(1); _Pragma("unroll") for (int m = 0; m < 4; ++m) _Pragma("unroll") for (int n = 0; n < 2; ++n) _Pragma("unroll") for (int k = 0; k < 2; ++k) \
        acc[ai][bj][m][n] = __builtin_amdgcn_mfma_f32_16x16x32_bf16(Bt[n][k], At[m][k], acc[ai][bj][m][n], 0, 0, 0); __builtin_amdgcn_s_setprio(0); } while (0)
#define PG8_WAIT_V(n) asm volatile("s_waitcnt vmcnt(" #n ")" ::: "memory")
#define PG8_WAIT_L(n) asm volatile("s_waitcnt lgkmcnt(" #n ")" ::: "memory")
#define PG8_BAR __builtin_amdgcn_s_barrier()
#define PG8_SCHED __builtin_amdgcn_sched_barrier(0)
    Unit cur, nxt; int ui = 0;
    if (!S.next(0, cur)) return;
    f32x4 acc[2][2][4][2];
#pragma unroll
    for (int a = 0; a < 2; ++a)
#pragma unroll
        for (int b = 0; b < 2; ++b)
#pragma unroll
            for (int m = 0; m < 4; ++m)
#pragma unroll
                for (int n = 0; n < 2; ++n) acc[a][b][m][n] = (f32x4){0.f, 0.f, 0.f, 0.f};
    bf16x8 At[4][2], B0[2][2], B1[2][2];
    const char* cA = (const char*)g.A + (size_t)cur.pm * tstep; const char* cB = (const char*)g.Bt + (size_t)cur.pn * tstep;
    S.a_ready(cur);
    PG8_STAGE(PG8_SB(0, 0), cB, voffB); PG8_STAGE(PG8_SA(0, 0), cA, voffA); PG8_STAGE(PG8_SB(0, 1), cB + hstep, voffB); PG8_STAGE(PG8_SA(0, 1), cA + hstep, voffA);
    if (wr == 1) PG8_BAR;
    PG8_WAIT_V(4); PG8_BAR;
    PG8_STAGE(PG8_SB(1, 0), cB + kstep, voffB); PG8_STAGE(PG8_SA(1, 0), cA + kstep, voffA); PG8_STAGE(PG8_SB(1, 1), cB + hstep + kstep, voffB);
    PG8_WAIT_V(6); PG8_BAR;
    PG8_STAMP();
    for (;;) {
        const bool has_next = S.next(ui + 1, nxt);
        const char* nA = has_next ? (const char*)g.A + (size_t)nxt.pm * tstep : cA; const char* nB = has_next ? (const char*)g.Bt + (size_t)nxt.pn * tstep : cB;
        for (int t = 0; t < nt; t += 2) {
            const bool last = (t == nt - 2);
            const char* a1 = cA + (size_t)(t + 1) * kstep;
            const char* a2 = last ? nA : cA + (size_t)(t + 2) * kstep; const char* b2 = last ? nB : cB + (size_t)(t + 2) * kstep;
            const char* a3 = a2 + kstep; const char* b3 = b2 + kstep;
            if (last && has_next) S.a_ready(nxt);
            PG8_LDB(B0, 0, 0); PG8_SCHED; PG8_LDA(At, 0, 0); PG8_STAGE(PG8_SA(1, 1), a1 + hstep, voffA);
            PG8_WAIT_L(8); PG8_BAR; PG8_WAIT_L(0); PG8_MMA(0, 0, At, B0); PG8_BAR; PG8_SCHED;
            PG8_LDB(B1, 0, 1); PG8_STAGE(PG8_SB(0, 0), b2, voffB);
            PG8_BAR; PG8_WAIT_L(0); PG8_MMA(0, 1, At, B1); PG8_BAR;
            PG8_LDA(At, 0, 1); PG8_STAGE(PG8_SA(0, 0), a2, voffA);
            PG8_BAR; PG8_WAIT_L(0); PG8_MMA(1, 0, At, B0); PG8_BAR; PG8_SCHED;
            PG8_STAGE(PG8_SB(0, 1), b2 + hstep, voffB);
            PG8_WAIT_V(6); PG8_BAR; PG8_MMA(1, 1, At, B1); PG8_BAR;
            PG8_LDB(B0, 1, 0); PG8_SCHED; PG8_LDA(At, 1, 0); PG8_STAGE(PG8_SA(0, 1), a2 + hstep, voffA);
            PG8_WAIT_L(8); PG8_BAR; PG8_WAIT_L(0); PG8_MMA(0, 0, At, B0); PG8_BAR; PG8_SCHED;
            PG8_LDB(B1, 1, 1); PG8_STAGE(PG8_SB(1, 0), b3, voffB);
            PG8_BAR; PG8_WAIT_L(0); PG8_MMA(0, 1, At, B1); PG8_BAR;
            PG8_LDA(At, 1, 1); PG8_STAGE(PG8_SA(1, 0), a3, voffA);
            PG8_BAR; PG8_WAIT_L(0); PG8_MMA(1, 0, At, B0); PG8_BAR; PG8_SCHED;
            PG8_STAGE(PG8_SB(1, 1), b3 + hstep, voffB);
            PG8_WAIT_V(6); PG8_BAR; PG8_MMA(1, 1, At, B1); PG8_BAR;
        }
        PG8_STAMP();
        if constexpr (!Epi::AFTER_DRAIN) { E(acc, cur, wr, wc, fr, fq); S.done(cur); }
        PG8_STAMP();
        if (!has_next) break;
#pragma unroll
        for (int a = 0; a < 2; ++a)
#pragma unroll
            for (int b = 0; b < 2; ++b)
#pragma unroll
                for (int m = 0; m < 4; ++m)
#pragma unroll
                    for (int n = 0; n < 2; ++n) acc[a][b][m][n] = (f32x4){0.f, 0.f, 0.f, 0.f};
        cur = nxt; cA = nA; cB = nB; ++ui;
    }
    PG8_WAIT_V(0);
    if (wr == 0) PG8_BAR;
    PG8_BAR;
    if constexpr (Epi::AFTER_DRAIN) { E.fused(acc, cur, wr, wc, fr, fq, lds, wid, lane); S.done(cur); }
    PG8_STAMP();
    if (STAMP && wid == 0) { stamps[lane] = lane < nts ? (((unsigned long long)(unsigned)ts_hi << 32) | (unsigned)ts_lo) : 0ull;
        if (lane == 62) stamps[62] = rt_entry; if (lane == 63) stamps[63] = (unsigned long long)wall_clock64(); }
#undef PG8_STAMP
#undef PG8_SA
#undef PG8_SB
#undef PG8_STAGE
#undef PG8_LDA
#undef PG8_LDB
#undef PG8_MMA
#undef PG8_WAIT_V
#undef PG8_WAIT_L
#undef PG8_BAR
#undef PG8_SCHED
}
}

#define XB_TMO      128
#define XB_XCNT(j)  (256  + 64 * (j))
#define XB_XSUB(j)  (1280 + 64 * (j))
#define XB_XGEN(j)  (2304 + 64 * (j))
#define XB_TOP      3328
#define XB_TOPGEN   3392
#define XCD_BAR_WORDS 3456
#define XB_SPIN_CAP (1u << 18)
#define LAS __attribute__((address_space(3)))

__device__ __forceinline__ unsigned xb_ld(unsigned* p)              { return __hip_atomic_load(p, __ATOMIC_RELAXED, __HIP_MEMORY_SCOPE_AGENT); }
__device__ __forceinline__ unsigned xb_add(unsigned* p, unsigned v) { return __hip_atomic_fetch_add(p, v, __ATOMIC_RELAXED, __HIP_MEMORY_SCOPE_AGENT); }
__device__ __forceinline__ unsigned xb_xcc_id() { return (unsigned)__builtin_amdgcn_s_getreg((3 << 11) | 20) & 0xFu; }
#define XB_SPIN(cond, bar) do { unsigned _sp = 0; while (cond) { __builtin_amdgcn_s_sleep(1); \
    if ((++_sp & 255u) == 0u) { if (xb_ld(&(bar)[XB_TMO])) break; if (_sp > XB_SPIN_CAP) { atomicAdd(&(bar)[XB_TMO], 1u); break; } } } } while (0)
struct XcdBarrier {
    unsigned* bar; unsigned x;
    volatile LAS unsigned* st;
};

__device__ __forceinline__ XcdBarrier xcd_barrier_post(unsigned* bar, volatile LAS unsigned* st) {
    XcdBarrier b; b.bar = bar; b.x = xb_xcc_id(); b.st = st;
    if (tid_l() == 0) (void)xb_add(&bar[XB_XCNT(b.x)], 1u);
    return b;
}
__device__ __forceinline__ void xcd_barrier_complete(unsigned* bar, unsigned x, unsigned& nloc, unsigned& nx) {
    const unsigned G = gridDim.x * gridDim.y * gridDim.z;
    unsigned sum, cnt, mine, sp = 0u;
    for (;;) {
        sum = 0u; cnt = 0u; mine = 0u;
#pragma unroll
        for (unsigned j = 0; j < 16; ++j) { const unsigned c = xb_ld(&bar[XB_XCNT(j)]); sum += c; cnt += (c > 0u) ? 1u : 0u; mine = (j == x) ? c : mine; }
        if (sum == G) break;
        __builtin_amdgcn_s_sleep(1);
        if ((++sp & 255u) == 0u) { if (xb_ld(&bar[XB_TMO])) break; if (sp > XB_SPIN_CAP) { atomicAdd(&bar[XB_TMO], 1u); break; } }
    }
    nloc = mine > 0u ? mine : 1u; nx = cnt > 0u ? cnt : 1u;
}

__device__ __forceinline__ void xcd_barrier(const XcdBarrier& b) {
    asm volatile("s_waitcnt vmcnt(0)" ::: "memory");
    __syncthreads();
    if (tid_l() == 0) {
        unsigned* bar = b.bar;
        __builtin_amdgcn_s_waitcnt(0);
        unsigned nloc = b.st[0], nx = b.st[1];
        if (nloc == 0u) { xcd_barrier_complete(bar, b.x, nloc, nx); b.st[0] = nloc; b.st[1] = nx; }
        const unsigned old = xb_add(&bar[XB_XSUB(b.x)], 1u);
        const unsigned gen = old / nloc;
        if (old + 1u == (gen + 1u) * nloc) {
            __builtin_amdgcn_fence(__ATOMIC_RELEASE, "agent");
            asm volatile("s_waitcnt vmcnt(0)" ::: "memory");
            const unsigned og = xb_add(&bar[XB_TOP], 1u);
            const unsigned tg = og / nx;
            if (og + 1u == (tg + 1u) * nx) xb_add(&bar[XB_TOPGEN], 1u);
            else XB_SPIN(xb_ld(&bar[XB_TOPGEN]) == tg, bar);
            __builtin_amdgcn_fence(__ATOMIC_ACQUIRE, "agent");
            xb_add(&bar[XB_XGEN(b.x)], 1u);
            asm volatile("s_waitcnt vmcnt(0)" ::: "memory");
        } else {
            XB_SPIN(xb_ld(&bar[XB_XGEN(b.x)]) == gen, bar);
            __builtin_amdgcn_fence(__ATOMIC_ACQUIRE, "agent");
            asm volatile("s_waitcnt vmcnt(0)" ::: "memory");
        }
    }
    __syncthreads();
}

typedef unsigned short bf16_t;
typedef short bf16x8 __attribute__((ext_vector_type(8)));
typedef float f32x4 __attribute__((ext_vector_type(4)));
typedef unsigned u32x4 __attribute__((ext_vector_type(4)));
typedef unsigned u32x2 __attribute__((ext_vector_type(2)));

#ifndef DUP
#define DUP 0
#endif
#ifndef MK_PER_PHASE
#define MK_PER_PHASE 0
#endif

constexpr int TP = 16384, TS = 128, TALL = 16512, M1 = 16640, N1 = 6912, NIN = 6800;
constexpr int C_R = 0, C_K = 1024, C_V = 2048, C_WL = 3072, C_AL = 3136, C_ZR = 3200, C_ZM = 4224, C_XBC = 5248, C_DT = 6784;
constexpr size_t O_YP = 0, O_YS = 16777216, O_PSH = 16908288, O_PWKV = 16924672, O_PCONV = 17973248, O_PSSM = 18046976,
                 O_SSH = 20144128, O_SWKV = 20406272, O_SCONV = 37183488, O_SSSM = 38363136, O_END = 71917568;
constexpr size_t WS_WINT = 0;
constexpr size_t WS_WOUTT = WS_WINT + (size_t)2 * N1 * 1024 * 2;
constexpr size_t WS_A = WS_WOUTT + (size_t)2 * 1024 * 2048 * 2;
constexpr size_t WS_P = WS_A + (size_t)M1 * 2048 * 2;
constexpr size_t WS_ORAW = WS_P + (size_t)M1 * N1 * 2;
constexpr size_t WS_BV = WS_ORAW + (size_t)TALL * 1024 * 4;
constexpr size_t WS_YM = WS_BV + (size_t)TALL * 1024 * 2;
constexpr size_t WS_END = WS_YM + (size_t)TALL * 1024 * 2;
constexpr size_t WS_U = WS_A;
constexpr size_t WS_DT = WS_U + (size_t)TP * 1536 * 2;
constexpr size_t WS_PART = WS_ORAW;
constexpr size_t WS_BAR = (WS_END + 4095) & ~(size_t)4095;
constexpr int LDS_BYTES = 163840, LDS_BARST = 163824;

struct Params { const float* in[26]; float* out; unsigned char* ws; int ph_lo, ph_hi; };
enum { I_XP = 0, I_XS, I_SSHIFT, I_SWKV, I_SCONV, I_SSSM, I_NORMW, I_WIN, I_MU, I_W0, I_W2, I_A0, I_A2, I_KK, I_KA, I_RK, I_LNW, I_LNB, I_CW, I_CB, I_DTB, I_ALOG, I_DSK, I_GNW, I_WOUT, I_FNW };

__device__ __forceinline__ float bf2f(unsigned short b) { return __uint_as_float(((unsigned)b) << 16); }
__device__ __forceinline__ unsigned short f2bf(float f) { unsigned u = __float_as_uint(f); u += 0x7FFFu + ((u >> 16) & 1u); return (unsigned short)(u >> 16); }
__device__ __forceinline__ unsigned pk2(float lo, float hi) { return (unsigned)f2bf(lo) | ((unsigned)f2bf(hi) << 16); }
__device__ __forceinline__ void unpack8(const u32x4 v, float* f) {
    f[0] = __uint_as_float(v.x << 16); f[1] = __uint_as_float(v.x & 0xffff0000u); f[2] = __uint_as_float(v.y << 16); f[3] = __uint_as_float(v.y & 0xffff0000u);
    f[4] = __uint_as_float(v.z << 16); f[5] = __uint_as_float(v.z & 0xffff0000u); f[6] = __uint_as_float(v.w << 16); f[7] = __uint_as_float(v.w & 0xffff0000u); }
__device__ __forceinline__ u32x4 pack8(const float* f) { u32x4 r; r.x = pk2(f[0], f[1]); r.y = pk2(f[2], f[3]); r.z = pk2(f[4], f[5]); r.w = pk2(f[6], f[7]); return r; }
__device__ __forceinline__ float frcp(float x) { return __builtin_amdgcn_rcpf(x); }
__device__ __forceinline__ float sigmoidf_(float x) { return frcp(1.0f + __expf(-x)); }
__device__ __forceinline__ float siluf_(float x) { return x * frcp(1.0f + __expf(-x)); }
__device__ __forceinline__ float softplusf_(float x) { return x > 20.f ? x : log1pf(__expf(x)); }
template <int CTRL> __device__ __forceinline__ float dppf(float v) { return __int_as_float(__builtin_amdgcn_mov_dpp(__float_as_int(v), CTRL, 0xF, 0xF, true)); }
__device__ __forceinline__ float red8(float x) { x += dppf<0xB1>(x); x += dppf<0x4E>(x); x += dppf<0x141>(x); return x; }
__device__ __forceinline__ float red16(float x) { x = red8(x); x += dppf<0x140>(x); return x; }
__device__ __forceinline__ float wave_sum(float x) {
    x = red16(x);
    return __int_as_float(__builtin_amdgcn_readlane(__float_as_int(x), 0)) + __int_as_float(__builtin_amdgcn_readlane(__float_as_int(x), 16))
         + __int_as_float(__builtin_amdgcn_readlane(__float_as_int(x), 32)) + __int_as_float(__builtin_amdgcn_readlane(__float_as_int(x), 48)); }
__device__ __forceinline__ void lds_fence() { asm volatile("s_waitcnt lgkmcnt(0)" ::: "memory"); }
__device__ __forceinline__ unsigned char* launder_lds(unsigned char* sm) { int off = 0; asm volatile("" : "+s"(off)); return sm + off; }
#define LBAR() do { asm volatile("s_waitcnt lgkmcnt(0)" ::: "memory"); __builtin_amdgcn_s_barrier(); asm volatile("" ::: "memory"); } while (0)
#define MFMA16(a, b, c) __builtin_amdgcn_mfma_f32_16x16x32_bf16((a), (b), (c), 0, 0, 0)

__device__ void phase_convert(const Params& p, unsigned char* smem_) {
    unsigned char* smem = launder_lds(smem_);
    float* tile = (float*)smem;
    const int tid = tid_l();
    constexpr int NT_IN = 16 * 108, NT_OUT = 32 * 16, PER_L = NT_IN + NT_OUT;
    for (int it = blockIdx.x; it < 2 * PER_L; it += gridDim.x) {
        const int l = it / PER_L; int r = it % PER_L;
        const float* src; bf16_t* dst; int K, Nsrc, kt, nt;
        if (r < NT_IN) { src = p.in[I_WIN] + (size_t)l * 1024 * NIN; dst = (bf16_t*)(p.ws + WS_WINT) + (size_t)l * N1 * 1024; K = 1024; Nsrc = NIN; kt = r & 15; nt = r >> 4; }
        else { r -= NT_IN; src = p.in[I_WOUT] + (size_t)l * 2048 * 1024; dst = (bf16_t*)(p.ws + WS_WOUTT) + (size_t)l * 1024 * 2048; K = 2048; Nsrc = 1024; kt = r & 31; nt = r >> 5; }
#pragma unroll
        for (int i = 0; i < 2; ++i) {
            const int rr = (tid >> 4) + 32 * i, c4 = (tid & 15) * 4, col = nt * 64 + c4;
            float4 v = make_float4(0.f, 0.f, 0.f, 0.f);
            if (col < Nsrc) v = *(const float4*)(src + (size_t)(kt * 64 + rr) * Nsrc + col);
            float* tp = tile + rr * 65 + c4; tp[0] = v.x; tp[1] = v.y; tp[2] = v.z; tp[3] = v.w;
        }
        __syncthreads();
        { const int n = tid >> 3, k8 = (tid & 7) * 8; float f[8];
#pragma unroll
          for (int j = 0; j < 8; ++j) f[j] = tile[(k8 + j) * 65 + n];
          *(u32x4*)(dst + (size_t)(nt * 64 + n) * K + kt * 64 + k8) = pack8(f); }
        __syncthreads();
    }
}

__device__ void phase_norm(const Params& p, int l) {
    const int tid_ = tid_l(); const int lane = tid_ & 63, wid = tid_ >> 6;
    bf16_t* A1 = (bf16_t*)(p.ws + WS_A);
    const float* nw = p.in[I_NORMW] + l * 1024;
    for (int row = blockIdx.x * 8 + wid; row < M1; row += gridDim.x * 8) {
        const float* src;
        if (row < TP) src = (l == 0 ? p.in[I_XP] : p.out + O_YP) + (size_t)row * 1024;
        else if (row < TALL) src = (l == 0 ? p.in[I_XS] : p.out + O_YS) + (size_t)(row - TP) * 1024;
        else src = p.in[I_SSHIFT] + ((size_t)l * TS + (row - TALL)) * 1024;
        float4 v[4]; float ss = 0.f;
#pragma unroll
        for (int i = 0; i < 4; ++i) v[i] = *(const float4*)(src + i * 256 + lane * 4);
        if (l == 1 && row >= TP && row < TALL) {
            const float* x0 = p.in[I_XS] + (size_t)(row - TP) * 1024; const float* pt = (const float*)(p.ws + WS_PART) + (size_t)(row - TP) * 1024;
#pragma unroll
            for (int i = 0; i < 4; ++i) { float4 a = *(const float4*)(x0 + i * 256 + lane * 4);
                for (int q = 0; q < 16; ++q) { const float4 t = *(const float4*)(pt + (size_t)q * TS * 1024 + i * 256 + lane * 4); a.x += t.x; a.y += t.y; a.z += t.z; a.w += t.w; }
                v[i] = a; *(float4*)(p.out + O_YS + (size_t)(row - TP) * 1024 + i * 256 + lane * 4) = a; }
        }
#pragma unroll
        for (int i = 0; i < 4; ++i) ss += v[i].x * v[i].x + v[i].y * v[i].y + v[i].z * v[i].z + v[i].w * v[i].w;
        if (row < TALL) {
            ss = wave_sum(ss);
            const float rs = rsqrtf(ss * (1.0f / 1024.0f) + 1e-5f);
#pragma unroll
            for (int i = 0; i < 4; ++i) { const float4 w = *(const float4*)(nw + i * 256 + lane * 4); v[i].x *= rs * w.x; v[i].y *= rs * w.y; v[i].z *= rs * w.z; v[i].w *= rs * w.w; }
            float* so = nullptr;
            if (row < TP) { if ((row & 2047) == 2047) so = p.out + O_PSH + ((size_t)l * 8 + (row >> 11)) * 1024; }
            else so = p.out + O_SSH + ((size_t)l * TS + (row - TP)) * 1024;
            if (so) {
#pragma unroll
                for (int i = 0; i < 4; ++i) *(float4*)(so + i * 256 + lane * 4) = v[i]; }
        }
#pragma unroll
        for (int i = 0; i < 4; ++i) { u32x2 w; w.x = pk2(v[i].x, v[i].y); w.y = pk2(v[i].z, v[i].w); *(u32x2*)(A1 + (size_t)row * 1024 + i * 256 + lane * 4) = w; }
    }
}

__device__ void phase_final(const Params& p) {
    const int tid_ = tid_l(); const int lane = tid_ & 63, wid = tid_ >> 6;
    const float* nw = p.in[I_FNW];
    for (int row = blockIdx.x * 8 + wid; row < TALL; row += gridDim.x * 8) {
        float* src = (row < TP) ? p.out + O_YP + (size_t)row * 1024 : p.out + O_YS + (size_t)(row - TP) * 1024;
        float4 v[4]; float ss = 0.f;
#pragma unroll
        for (int i = 0; i < 4; ++i) v[i] = *(const float4*)(src + i * 256 + lane * 4);
        if (row >= TP) { const float* pt = (const float*)(p.ws + WS_PART) + (size_t)(row - TP) * 1024;
#pragma unroll
            for (int i = 0; i < 4; ++i) for (int q = 0; q < 16; ++q) { const float4 t = *(const float4*)(pt + (size_t)q * TS * 1024 + i * 256 + lane * 4); v[i].x += t.x; v[i].y += t.y; v[i].z += t.z; v[i].w += t.w; } }
#pragma unroll
        for (int i = 0; i < 4; ++i) ss += v[i].x * v[i].x + v[i].y * v[i].y + v[i].z * v[i].z + v[i].w * v[i].w;
        ss = wave_sum(ss);
        const float rs = rsqrtf(ss * (1.0f / 1024.0f) + 1e-5f);
#pragma unroll
        for (int i = 0; i < 4; ++i) { const float4 w = *(const float4*)(nw + i * 256 + lane * 4); v[i].x *= rs * w.x; v[i].y *= rs * w.y; v[i].z *= rs * w.z; v[i].w *= rs * w.w;
            *(float4*)(src + i * 256 + lane * 4) = v[i]; }
    }
}

struct EpiP {
    static constexpr bool PERM = true, AFTER_DRAIN = false;
    bf16_t* O; int ldc;
    __device__ __forceinline__ void operator()(const f32x4 (&acc)[2][2][4][2], const pg8::Unit& u, int wr, int wc, int fr, int fq) const {
        const int row0 = u.pm * 256 + wr * 64 + fr, col0 = u.pn * 256 + wc * 32 + 8 * fq;
#pragma unroll
        for (int ai = 0; ai < 2; ++ai)
#pragma unroll
            for (int m = 0; m < 4; ++m) { bf16_t* rowp = O + (size_t)(row0 + ai * 128 + m * 16) * ldc + col0;
#pragma unroll
                for (int bj = 0; bj < 2; ++bj) { const f32x4 v0 = acc[ai][bj][m][0], v1 = acc[ai][bj][m][1];
                    u32x4 w; w.x = pg8::cvt_pk_bf16(v0[0], v0[1]); w.y = pg8::cvt_pk_bf16(v0[2], v0[3]); w.z = pg8::cvt_pk_bf16(v1[0], v1[1]); w.w = pg8::cvt_pk_bf16(v1[2], v1[3]);
                    *(u32x4*)(rowp + bj * 128) = w; } }
    }
};
struct EpiRes {
    static constexpr bool PERM = false, AFTER_DRAIN = false;
    const float* res_p; float* out_p;
    __device__ __forceinline__ void operator()(const f32x4 (&acc)[2][2][4][2], const pg8::Unit& u, int wr, int wc, int fr, int fq) const {
        const int row0 = u.pm * 256 + wr * 64 + fr, col0 = u.pn * 256 + wc * 32 + 4 * fq;
#pragma unroll
        for (int ai = 0; ai < 2; ++ai)
#pragma unroll
            for (int m = 0; m < 4; ++m) { const size_t ro = (size_t)(row0 + ai * 128 + m * 16) * 1024;
#pragma unroll
                for (int bj = 0; bj < 2; ++bj)
#pragma unroll
                    for (int n = 0; n < 2; ++n) { const int c = col0 + bj * 128 + n * 16; const f32x4 r = *(const f32x4*)(res_p + ro + c); *(f32x4*)(out_p + ro + c) = acc[ai][bj][m][n] + r; } }
    }
};

constexpr int CH_NB = 6, CH_CB = 15104, CH_NH = 5;
constexpr int CB_A1 = 0, CB_A2 = 3328, CB_TT = 6656, CB_ZQ = 7936, CB_ZK = 10240, CB_V = 12544, CB_GQ = 14848;
constexpr int CH_SCR = CH_NB * CH_CB;
constexpr int SCR_TW = 0, SCR_EXL = 4608, SCR_SZ = 8704;
constexpr int CH_W2T = CH_SCR + CH_NH * SCR_SZ;
constexpr int CH_CST = CH_W2T + 18432;
constexpr int CH_FLG = CH_CST + 2560;
__device__ __forceinline__ unsigned cvtpk(float lo, float hi) { return pg8::cvt_pk_bf16(lo, hi); }
__device__ void rwkv_chain_item(const Params& p, int l, int item, unsigned char* smem_) {
    unsigned char* smem = launder_lds(smem_);
    const int tid = tid_l(), wid = tid >> 6, lane = tid & 63, fr = lane & 15, fq = lane >> 4;
    const int b = item >> 4, h = item & 15;
    bf16_t* w2t = (bf16_t*)(smem + CH_W2T); bf16_t* a2t = w2t + 4608;
    float* cst = (float*)(smem + CH_CST);
    volatile LAS unsigned* ready = (volatile LAS unsigned*)((LAS unsigned char*)smem + CH_FLG); volatile LAS unsigned* cons = ready + 128; volatile LAS unsigned* ready2 = ready + 256;
    const bf16_t* P = (const bf16_t*)(p.ws + WS_P);
    float* ORAW = (float*)(p.ws + WS_ORAW);
    bf16_t* BV = (bf16_t*)(p.ws + WS_BV);
    __syncthreads();
    for (int i = tid; i < CH_W2T / 4; i += 512) ((unsigned*)smem)[i] = 0u;
    if (tid < 384) ((unsigned*)(smem + CH_FLG))[tid] = 0u;
    { const float* w2 = p.in[I_W2] + (size_t)l * 64 * 1024 + h * 64; const float* a2 = p.in[I_A2] + (size_t)l * 64 * 1024 + h * 64;
#pragma unroll
      for (int i = 0; i < 8; ++i) { const int idx = tid + 512 * i, k = idx >> 6, n = idx & 63; w2t[n * 72 + k] = f2bf(w2[(size_t)k * 1024 + n]); a2t[n * 72 + k] = f2bf(a2[(size_t)k * 1024 + n]); } }
    if (tid < 64) { const float* mu = p.in[I_MU] + (size_t)l * 3200; const int gc = h * 64 + tid;
        cst[tid] = mu[C_R + gc]; cst[64 + tid] = mu[C_K + gc]; cst[128 + tid] = mu[C_V + gc]; cst[192 + tid] = mu[C_WL + tid]; cst[256 + tid] = mu[C_AL + tid];
        cst[320 + tid] = p.in[I_KK][l * 1024 + gc]; cst[384 + tid] = p.in[I_KA][l * 1024 + gc]; cst[448 + tid] = p.in[I_RK][l * 1024 + gc];
        cst[512 + tid] = p.in[I_W0][l * 1024 + gc]; cst[576 + tid] = p.in[I_A0][l * 1024 + gc]; }
    __syncthreads();

    if (wid >= 3) {
        const int hw = wid - 3, tok = lane >> 2, q4 = lane & 3, c0 = q4 * 16;
        unsigned char* scr = smem + CH_SCR + hw * SCR_SZ;
        bf16_t* tw = (bf16_t*)(scr + SCR_TW); bf16_t* ta = tw + 1152;
        float* exl = (float*)(scr + SCR_EXL);
        const int segcol[5] = {C_R + h * 64 + c0, C_K + h * 64 + c0, C_V + h * 64 + c0, C_WL + c0, C_AL + c0};
        float w0c[4], a0c[4];
#pragma unroll
        for (int ct = 0; ct < 4; ++ct) { w0c[ct] = cst[512 + ct * 16 + fr]; a0c[ct] = cst[576 + ct * 16 + fr]; }
        u32x4 qc[5][2], qp[5][2];
#define CLOAD(C) { const int t_ = (C) * 16 + tok; const bf16_t* pr_ = P + ((size_t)b * 2048 + t_) * N1; \
            _Pragma("unroll") for (int sg = 0; sg < 5; ++sg) _Pragma("unroll") for (int hh = 0; hh < 2; ++hh) { qc[sg][hh] = *(const u32x4*)(pr_ + segcol[sg] + hh * 8); \
                if (t_ > 0) qp[sg][hh] = *(const u32x4*)(pr_ - N1 + segcol[sg] + hh * 8); else qp[sg][hh] = (u32x4){0u, 0u, 0u, 0u}; } }
        CLOAD(hw)
        for (int c = hw; c < 128; c += CH_NH) {
            unsigned char* cb = smem + (c % CH_NB) * CH_CB;
            bf16_t* A1 = (bf16_t*)(cb + CB_A1); bf16_t* A2 = (bf16_t*)(cb + CB_A2); bf16_t* ZQ = (bf16_t*)(cb + CB_ZQ); bf16_t* ZK = (bf16_t*)(cb + CB_ZK); bf16_t* Vn = (bf16_t*)(cb + CB_V); float* GQ = (float*)(cb + CB_GQ);
            const size_t grow = (size_t)b * 2048 + c * 16 + tok;
            if (c >= CH_NB) { while (cons[c - CH_NB] < 2u) __builtin_amdgcn_s_sleep(1); }
            asm volatile("" ::: "memory");
            float* exa = (float*)(cb + CB_ZQ);
            float xr[16], xk[16]; unsigned xvp[8];
            { float cur[8], prv[8], xw[8], xa[8], xv[8];
#pragma unroll
              for (int hh = 0; hh < 2; ++hh) {
#define LSEG(dst, sg, mo) { unpack8(qc[sg][hh], cur); unpack8(qp[sg][hh], prv); _Pragma("unroll") for (int e = 0; e < 8; ++e) dst[e] = cur[e] + (prv[e] - cur[e]) * cst[(mo) + c0 + hh * 8 + e]; }
                LSEG((xr + hh * 8), 0, 0) LSEG((xk + hh * 8), 1, 64) LSEG(xv, 2, 128) LSEG(xw, 3, 192) LSEG(xa, 4, 256)
#undef LSEG
                { const u32x4 pv = pack8(xv); xvp[hh * 4] = pv.x; xvp[hh * 4 + 1] = pv.y; xvp[hh * 4 + 2] = pv.z; xvp[hh * 4 + 3] = pv.w; }
#pragma unroll
                for (int e = 0; e < 8; ++e) xw[e] = 1.0f - 2.0f * frcp(__expf(2.0f * xw[e]) + 1.0f);
                *(u32x4*)(tw + tok * 72 + c0 + hh * 8) = pack8(xw); *(u32x4*)(ta + tok * 72 + c0 + hh * 8) = pack8(xa);
              } }
            if (c + CH_NH < 128) CLOAD(c + CH_NH)
            lds_fence();
#pragma unroll
            for (int ct = 0; ct < 4; ++ct) { f32x4 aw = {0.f, 0.f, 0.f, 0.f}, aa = aw;
#pragma unroll
                for (int ks = 0; ks < 2; ++ks) {
                    aw = MFMA16(*(const bf16x8*)(tw + fr * 72 + ks * 32 + fq * 8), *(const bf16x8*)(w2t + (ct * 16 + fr) * 72 + ks * 32 + fq * 8), aw);
                    aa = MFMA16(*(const bf16x8*)(ta + fr * 72 + ks * 32 + fq * 8), *(const bf16x8*)(a2t + (ct * 16 + fr) * 72 + ks * 32 + fq * 8), aa); }
#pragma unroll
                for (int j = 0; j < 4; ++j) { const int tj = fq * 4 + j, col = ct * 16 + fr;
                    exl[tj * 64 + col] = -0.60653066f * sigmoidf_(w0c[ct] + aw[j]);
                    exa[tj * 64 + col] = sigmoidf_(a0c[ct] + aa[j]); } }
            lds_fence();
            { float lv[16];
#pragma unroll
              for (int t = 0; t < 16; ++t) lv[t] = exl[t * 64 + lane];
              float Lc = 0.f;
#pragma unroll
              for (int t = 0; t < 16; ++t) { Lc += lv[t]; lv[t] = __expf(Lc); }
#pragma unroll
              for (int t = 0; t < 16; ++t) exl[t * 64 + lane] = lv[t];
              GQ[lane] = lv[15]; }
            float a16[16];
#pragma unroll
            for (int i = 0; i < 4; ++i) { const float4 t4 = *(const float4*)(exa + tok * 64 + c0 + i * 4); a16[i * 4] = t4.x; a16[i * 4 + 1] = t4.y; a16[i * 4 + 2] = t4.z; a16[i * 4 + 3] = t4.w; }
            float ssq = 0.f, beta = 0.f;
#pragma unroll
            for (int e = 0; e < 16; ++e) { const float kr_ = xk[e] * cst[320 + c0 + e]; ssq += kr_ * kr_; }
            ssq += dppf<0xB1>(ssq); ssq += dppf<0x4E>(ssq);
            const float inv = frcp(fmaxf(__builtin_amdgcn_sqrtf(ssq), 1e-12f));
            lds_fence();
            {
              *(u32x4*)(Vn + tok * 72 + c0) = (u32x4){xvp[0], xvp[1], xvp[2], xvp[3]}; *(u32x4*)(Vn + tok * 72 + c0 + 8) = (u32x4){xvp[4], xvp[5], xvp[6], xvp[7]};
#pragma unroll
              for (int gI = 0; gI < 4; ++gI) {
                float pt[4], rt[4], qt[4], kt[4];
#pragma unroll
                for (int e3 = 0; e3 < 4; ++e3) { const int e = gI * 4 + e3; const float el = exl[tok * 64 + c0 + e], elm = tok > 0 ? exl[(tok - 1) * 64 + c0 + e] : 1.0f, iv = frcp(el);
                    const float kk_ = xk[e] * cst[320 + c0 + e] * inv, kp_ = xk[e] * (1.0f + (a16[e] - 1.0f) * cst[384 + c0 + e]), bb_ = -kk_ * a16[e];
                    beta += xr[e] * kp_ * cst[448 + c0 + e];
                    pt[e3] = kk_ * elm; rt[e3] = xr[e] * el; qt[e3] = bb_ * iv; kt[e3] = kp_ * iv;
                    }
                const int s0 = (q4 >> 1) * 32 + gI * 8 + (q4 & 1) * 4;
                u32x2 w; w.x = cvtpk(pt[0], pt[1]); w.y = cvtpk(pt[2], pt[3]); *(u32x2*)(A1 + tok * 104 + s0) = w;
                w.x = cvtpk(rt[0], rt[1]); w.y = cvtpk(rt[2], rt[3]); *(u32x2*)(A2 + tok * 104 + s0) = w;
                w.x = cvtpk(qt[0], qt[1]); w.y = cvtpk(qt[2], qt[3]); *(u32x2*)(ZQ + tok * 72 + s0) = w;
                w.x = cvtpk(kt[0], kt[1]); w.y = cvtpk(kt[2], kt[3]); *(u32x2*)(ZK + tok * 72 + s0) = w;
              } }
            beta += dppf<0xB1>(beta); beta += dppf<0x4E>(beta);
            { float bv[16];
#pragma unroll
              for (int e = 0; e < 16; ++e) bv[e] = beta * __uint_as_float((e & 1) ? (xvp[e >> 1] & 0xffff0000u) : (xvp[e >> 1] << 16));
              *(u32x4*)(BV + grow * 1024 + h * 64 + c0) = pack8(bv); *(u32x4*)(BV + grow * 1024 + h * 64 + c0 + 8) = pack8(bv + 8); }
            lds_fence();
            if (lane == 0) ready[c] = 1u;
        }
#undef CLOAD
    } else {
        if (wid == 2) {
            for (int c = 0; c < 128; ++c) {
                unsigned char* cbw = smem + (c % CH_NB) * CH_CB;
                bf16_t* A1 = (bf16_t*)(cbw + CB_A1); bf16_t* A2 = (bf16_t*)(cbw + CB_A2); bf16_t* TT = (bf16_t*)(cbw + CB_TT);
                const bf16_t* ZQ = (const bf16_t*)(cbw + CB_ZQ); const bf16_t* ZK = (const bf16_t*)(cbw + CB_ZK);
                while (ready[c] == 0u) __builtin_amdgcn_s_sleep(1);
                asm volatile("" ::: "memory");
                { f32x4 gN = {0.f, 0.f, 0.f, 0.f}, gKP = gN, gQR = gN, gKR = gN;
#pragma unroll
                  for (int ks = 0; ks < 2; ++ks) {
                      const bf16x8 fzq = *(const bf16x8*)(ZQ + fr * 72 + ks * 32 + fq * 8), fzk = *(const bf16x8*)(ZK + fr * 72 + ks * 32 + fq * 8);
                      const bf16x8 fp = *(const bf16x8*)(A1 + fr * 104 + ks * 32 + fq * 8), frr = *(const bf16x8*)(A2 + fr * 104 + ks * 32 + fq * 8);
                      gN = MFMA16(fzq, fp, gN); gKP = MFMA16(fzk, fp, gKP); gQR = MFMA16(fzq, frr, gQR); gKR = MFMA16(fzk, frr, gKR); }
#pragma unroll
                  for (int jj = 0; jj < 4; ++jj) { const int j = fq * 4 + jj; const bool lt = j < fr, le = j <= fr;
                      gN[jj] = lt ? gN[jj] : 0.f; gKP[jj] = lt ? gKP[jj] : 0.f; gQR[jj] = le ? gQR[jj] : 0.f; gKR[jj] = le ? gKR[jj] : 0.f; }
                  u32x4 w1; w1.x = 0u; w1.y = 0u; w1.z = pk2(gKP[0], gKP[1]); w1.w = pk2(gKP[2], gKP[3]); *(u32x4*)(A1 + fr * 104 + 64 + fq * 8) = w1;
                  u32x4 w2; w2.x = pk2(gQR[0], gQR[1]); w2.y = pk2(gQR[2], gQR[3]); w2.z = pk2(gKR[0], gKR[1]); w2.w = pk2(gKR[2], gKR[3]); *(u32x4*)(A2 + fr * 104 + 64 + fq * 8) = w2;
                  float Ti[16]; int i = fr; asm volatile("" : "+v"(i));
#pragma unroll
                  for (int t = 0; t < 16; ++t) { float s_ = (i == t) ? 1.0f : 0.0f;
                      __builtin_amdgcn_sched_barrier(0);
#pragma unroll
                      for (int j = 0; j < t; ++j) s_ += Ti[j] * __int_as_float(__builtin_amdgcn_readlane(__float_as_int(gN[j & 3]), (j >> 2) * 16 + t));
                      Ti[t] = s_; }
                  if (lane < 16) { const int sq = (i >> 2) * 8 + (i & 3);
#pragma unroll
                      for (int t = 0; t < 16; ++t) TT[t * 40 + sq] = f2bf(Ti[t]); } }
                lds_fence();
                if (lane == 0) ready2[c] = 1u;
            }
        } else {
            const int ng = 2, g0 = wid * 2;
            f32x4 acc[2][4];
#pragma unroll
            for (int gi = 0; gi < 2; ++gi)
#pragma unroll
                for (int kt = 0; kt < 4; ++kt) acc[gi][kt] = (f32x4){0.f, 0.f, 0.f, 0.f};
            for (int c = 0; c < 128; ++c) {
                const unsigned char* cbw = smem + (c % CH_NB) * CH_CB;
                const bf16_t* A1 = (const bf16_t*)(cbw + CB_A1); const bf16_t* A2 = (const bf16_t*)(cbw + CB_A2); const bf16_t* TT = (const bf16_t*)(cbw + CB_TT);
                const bf16_t* ZQ = (const bf16_t*)(cbw + CB_ZQ); const bf16_t* ZK = (const bf16_t*)(cbw + CB_ZK); const bf16_t* Vn = (const bf16_t*)(cbw + CB_V); const float* GQ = (const float*)(cbw + CB_GQ);
                while (ready2[c] == 0u) __builtin_amdgcn_s_sleep(1);
                asm volatile("" ::: "memory");
                union U8 { u32x4 u; bf16x8 h; };
                U8 FA[4];
#pragma unroll
                for (int kt = 0; kt < 4; ++kt) { const int sk = (kt >> 1) * 32 + (fr >> 2) * 8 + (kt & 1) * 4 + (fr & 3);
                    const unsigned q0 = ZQ[(fq * 4 + 0) * 72 + sk], q1 = ZQ[(fq * 4 + 1) * 72 + sk], q2 = ZQ[(fq * 4 + 2) * 72 + sk], q3 = ZQ[(fq * 4 + 3) * 72 + sk];
                    const unsigned k0 = ZK[(fq * 4 + 0) * 72 + sk], k1 = ZK[(fq * 4 + 1) * 72 + sk], k2 = ZK[(fq * 4 + 2) * 72 + sk], k3 = ZK[(fq * 4 + 3) * 72 + sk];
                    FA[kt].u.x = q0 | (q1 << 16); FA[kt].u.y = q2 | (q3 << 16); FA[kt].u.z = k0 | (k1 << 16); FA[kt].u.w = k2 | (k3 << 16); }
                const bf16x8 a1f0 = *(const bf16x8*)(A1 + fr * 104 + fq * 8), a1f1 = *(const bf16x8*)(A1 + fr * 104 + 32 + fq * 8), a1f2 = *(const bf16x8*)(A1 + fr * 104 + 64 + fq * 8);
                const bf16x8 a2f0 = *(const bf16x8*)(A2 + fr * 104 + fq * 8), a2f1 = *(const bf16x8*)(A2 + fr * 104 + 32 + fq * 8), a2f2 = *(const bf16x8*)(A2 + fr * 104 + 64 + fq * 8);
                const bf16x8 ttf = *(const bf16x8*)(TT + fr * 40 + fq * 8);
                float4 gq[4];
#pragma unroll
                for (int kt = 0; kt < 4; ++kt) gq[kt] = *(const float4*)(GQ + kt * 16 + fq * 4);
#pragma unroll
                for (int gi = 0; gi < 2; ++gi) if (gi < ng) {
                    const int v0 = (g0 + gi) * 16;
                    U8 B0, B1, BX;
                    B0.u.x = cvtpk(acc[gi][0][0], acc[gi][0][1]); B0.u.y = cvtpk(acc[gi][0][2], acc[gi][0][3]); B0.u.z = cvtpk(acc[gi][1][0], acc[gi][1][1]); B0.u.w = cvtpk(acc[gi][1][2], acc[gi][1][3]);
                    B1.u.x = cvtpk(acc[gi][2][0], acc[gi][2][1]); B1.u.y = cvtpk(acc[gi][2][2], acc[gi][2][3]); B1.u.z = cvtpk(acc[gi][3][0], acc[gi][3][1]); B1.u.w = cvtpk(acc[gi][3][2], acc[gi][3][3]);
                    u32x2 vq;
                    { const unsigned e0 = Vn[(fq * 4 + 0) * 72 + v0 + fr], e1 = Vn[(fq * 4 + 1) * 72 + v0 + fr], e2 = Vn[(fq * 4 + 2) * 72 + v0 + fr], e3 = Vn[(fq * 4 + 3) * 72 + v0 + fr];
                      vq.x = e0 | (e1 << 16); vq.y = e2 | (e3 << 16); }
                    BX.u.x = 0u; BX.u.y = 0u; BX.u.z = vq.x; BX.u.w = vq.y;
                    f32x4 rhs = {0.f, 0.f, 0.f, 0.f};
                    rhs = MFMA16(a1f0, B0.h, rhs); rhs = MFMA16(a1f1, B1.h, rhs); rhs = MFMA16(a1f2, BX.h, rhs);
                    BX.u.x = pk2(rhs[0], rhs[1]); BX.u.y = pk2(rhs[2], rhs[3]); BX.u.z = 0u; BX.u.w = 0u;
                    f32x4 uu = {0.f, 0.f, 0.f, 0.f};
                    uu = MFMA16(ttf, BX.h, uu);
                    BX.u.x = pk2(uu[0], uu[1]); BX.u.y = pk2(uu[2], uu[3]); BX.u.z = vq.x; BX.u.w = vq.y;
                    f32x4 oo = {0.f, 0.f, 0.f, 0.f};
                    oo = MFMA16(a2f0, B0.h, oo); oo = MFMA16(a2f1, B1.h, oo); oo = MFMA16(a2f2, BX.h, oo);
#pragma unroll
                    for (int kt = 0; kt < 4; ++kt) { acc[gi][kt] = MFMA16(FA[kt].h, BX.h, acc[gi][kt]);
                        acc[gi][kt][0] *= gq[kt].x; acc[gi][kt][1] *= gq[kt].y; acc[gi][kt][2] *= gq[kt].z; acc[gi][kt][3] *= gq[kt].w; }
                    float* op = ORAW + ((size_t)b * 2048 + c * 16 + fq * 4) * 1024 + h * 64 + v0 + fr;
#pragma unroll
                    for (int jj = 0; jj < 4; ++jj) op[(size_t)jj * 1024] = oo[jj];
                }
                asm volatile("s_waitcnt lgkmcnt(0)" ::: "memory");
                if (lane == 0) __hip_atomic_fetch_add((LAS unsigned*)&cons[c], 1u, __ATOMIC_RELAXED, __HIP_MEMORY_SCOPE_WORKGROUP);
            }
#pragma unroll
            for (int gi = 0; gi < 2; ++gi) if (gi < ng) {
                float* so = p.out + O_PWKV + ((((size_t)l * 8 + b) * 16 + h) * 64 + (g0 + gi) * 16 + fr) * 64 + fq * 4;
#pragma unroll
                for (int kt = 0; kt < 4; ++kt) *(float4*)(so + kt * 16) = make_float4(acc[gi][kt][0], acc[gi][kt][1], acc[gi][kt][2], acc[gi][kt][3]);
            }
        }
    }
    __syncthreads();
}

__device__ void rwkv_sample_item(const Params& p, int l, int item, unsigned char* smem_) {
    unsigned char* smem = launder_lds(smem_);
    const int tid = tid_l(), lane = tid & 63, ks = tid >> 6;
    const int i = item >> 4, h = item & 15;
    float* part = (float*)smem;
    float* sv = part + 1024;
    float* s_sc = sv + 384;
    const bf16_t* P = (const bf16_t*)(p.ws + WS_P);
    float* ORAW = (float*)(p.ws + WS_ORAW);
    bf16_t* BV = (bf16_t*)(p.ws + WS_BV);
    const size_t rowp = (size_t)TP + i, rows = (size_t)TALL + i;
    const bf16_t* pc = P + rowp * N1; const bf16_t* pp = P + rows * N1;
    const float* mu = p.in[I_MU] + (size_t)l * 3200;
    const int gc = h * 64 + lane;
    const int row = tid >> 3, cs = (tid & 7) * 8;
    const size_t so = ((((size_t)l * TS + i) * 16 + h) * 64 + row) * 64 + cs;
    const float4 a0 = *(const float4*)(p.in[I_SWKV] + so), a1 = *(const float4*)(p.in[I_SWKV] + so + 4);
#define LERP1(col) (bf2f(pc[col]) + (bf2f(pp[col]) - bf2f(pc[col])) * mu[col])
    { const float* w2 = p.in[I_W2] + (size_t)l * 64 * 1024 + gc; const float* a2 = p.in[I_A2] + (size_t)l * 64 * 1024 + gc;
      float lw = 0.f, la = 0.f;
#pragma unroll
      for (int kk = 0; kk < 8; ++kk) { const int k = ks * 8 + kk; const float xwl = LERP1(C_WL + k), xal = LERP1(C_AL + k);
          lw += (1.0f - 2.0f * frcp(__expf(2.0f * xwl) + 1.0f)) * w2[(size_t)k * 1024]; la += xal * a2[(size_t)k * 1024]; }
      __syncthreads();
      part[ks * 64 + lane] = lw; part[512 + ks * 64 + lane] = la; }
    __syncthreads();
    if (tid < 64) {
        const float xr = LERP1(C_R + gc), xk = LERP1(C_K + gc), xv = LERP1(C_V + gc);
        float lw = 0.f, la = 0.f;
#pragma unroll
        for (int q = 0; q < 8; ++q) { lw += part[q * 64 + lane]; la += part[512 + q * 64 + lane]; }
        const float w = __expf(-0.60653066f * sigmoidf_(p.in[I_W0][l * 1024 + gc] + lw));
        const float a = sigmoidf_(p.in[I_A0][l * 1024 + gc] + la);
        float kk = xk * p.in[I_KK][l * 1024 + gc];
        const float ssq = wave_sum(kk * kk);
        kk *= 1.0f / fmaxf(sqrtf(ssq), 1e-12f);
        const float kp = xk * (1.0f + (a - 1.0f) * p.in[I_KA][l * 1024 + gc]);
        const float bb = -kk * a, wr = w * xr;
        const float br = wave_sum(bb * xr), kr = wave_sum(kp * xr), beta = wave_sum(xr * kp * p.in[I_RK][l * 1024 + gc]);
        sv[lane] = w; sv[64 + lane] = kk; sv[128 + lane] = bb; sv[192 + lane] = kp; sv[256 + lane] = wr; sv[320 + lane] = xv;
        if (lane == 0) { s_sc[0] = br; s_sc[1] = kr; }
        BV[rowp * 1024 + gc] = f2bf(beta * xv);
    }
#undef LERP1
    __syncthreads();
    {
        float S[8] = {a0.x, a0.y, a0.z, a0.w, a1.x, a1.y, a1.z, a1.w};
        float dk = 0.f, dr = 0.f;
#pragma unroll
        for (int e = 0; e < 8; ++e) { dk += S[e] * sv[64 + cs + e]; dr += S[e] * sv[256 + cs + e]; }
        dk = red8(dk); dr = red8(dr);
        const float vr = sv[320 + row];
        const float o = dr + dk * s_sc[0] + vr * s_sc[1];
        if ((tid & 7) == 0) ORAW[rowp * 1024 + h * 64 + row] = o;
#pragma unroll
        for (int e = 0; e < 8; ++e) S[e] = S[e] * sv[cs + e] + dk * sv[128 + cs + e] + vr * sv[192 + cs + e];
        float* sout = p.out + O_SWKV + so;
        *(float4*)sout = make_float4(S[0], S[1], S[2], S[3]); *(float4*)(sout + 4) = make_float4(S[4], S[5], S[6], S[7]);
    }
}

__device__ void phase_conv(const Params& p, int l) {
    const int tid = tid_l();
    const bf16_t* P = (const bf16_t*)(p.ws + WS_P);
    bf16_t* U = (bf16_t*)(p.ws + WS_U); float* DT = (float*)(p.ws + WS_DT);
    for (int id = blockIdx.x * 512 + tid; id < 512 * 192; id += gridDim.x * 512) {
        const int q = id % 192, seg = id / 192, xcol = q * 8;
        const int bb = seg >> 6, tb = (seg & 63) * 32;
        float cw[4][8], cbv[8];
        { const float* cwp = p.in[I_CW] + (size_t)l * 4 * 1536 + xcol;
#pragma unroll
          for (int w = 0; w < 4; ++w) { const float4 u0 = *(const float4*)(cwp + w * 1536), u1 = *(const float4*)(cwp + w * 1536 + 4);
              cw[w][0] = u0.x; cw[w][1] = u0.y; cw[w][2] = u0.z; cw[w][3] = u0.w; cw[w][4] = u1.x; cw[w][5] = u1.y; cw[w][6] = u1.z; cw[w][7] = u1.w; }
          const float4 b0 = *(const float4*)(p.in[I_CB] + (size_t)l * 1536 + xcol), b1 = *(const float4*)(p.in[I_CB] + (size_t)l * 1536 + xcol + 4);
          cbv[0] = b0.x; cbv[1] = b0.y; cbv[2] = b0.z; cbv[3] = b0.w; cbv[4] = b1.x; cbv[5] = b1.y; cbv[6] = b1.z; cbv[7] = b1.w; }
        const bf16_t* pb = P + ((size_t)bb * 2048 + tb) * N1 + C_XBC + xcol;
        bf16_t* ub = U + ((size_t)bb * 2048 + tb) * 1536 + xcol;
        float w0[8], w1[8], w2[8];
#pragma unroll
        for (int e = 0; e < 8; ++e) { w0[e] = 0.f; w1[e] = 0.f; w2[e] = 0.f; }
        if (tb >= 3) { unpack8(*(const u32x4*)(pb - 3 * (size_t)N1), w0); unpack8(*(const u32x4*)(pb - 2 * (size_t)N1), w1); unpack8(*(const u32x4*)(pb - (size_t)N1), w2); }
#pragma unroll 8
        for (int s_ = 0; s_ < 32; ++s_) {
            float cur[8], u[8];
            unpack8(*(const u32x4*)(pb + (size_t)s_ * N1), cur);
#pragma unroll
            for (int e = 0; e < 8; ++e) { u[e] = siluf_(cbv[e] + cw[0][e] * w0[e] + cw[1][e] * w1[e] + cw[2][e] * w2[e] + cw[3][e] * cur[e]); w0[e] = w1[e]; w1[e] = w2[e]; w2[e] = cur[e]; }
            *(u32x4*)(ub + (size_t)s_ * 1536) = pack8(u);
        }
    }
    for (int id = blockIdx.x * 512 + tid; id < TP * 16; id += gridDim.x * 512) {
        const int t = id >> 4, j = id & 15;
        DT[id] = softplusf_(bf2f(P[(size_t)t * N1 + C_DT + j]) + p.in[I_DTB][l * 16 + j]);
    }
}

__device__ void mamba_item(const Params& p, int l, int item, unsigned char* smem_) {
    unsigned char* smem = launder_lds(smem_);
    const int tid = tid_l(), wid = tid >> 6, lane = tid & 63, fr = lane & 15, fq = lane >> 4;
    const int b = item >> 5, j = (item >> 1) & 15, ph = item & 1, g = j >> 3;
    bf16_t* Cm = (bf16_t*)smem;
    bf16_t* Bm = (bf16_t*)(smem + 17408);
    bf16_t* BmT = (bf16_t*)(smem + 34816);
    bf16_t* XT = (bf16_t*)(smem + 53248);
    bf16_t* XwT = (bf16_t*)(smem + 57856);
    bf16_t* G = (bf16_t*)(smem + 62464);
    bf16_t* Hb = (bf16_t*)(smem + 71680);
    float* acs = (float*)(smem + 80384);
    float* dtv = acs + 64;
    const bf16_t* P = (const bf16_t*)(p.ws + WS_P);
    const bf16_t* U = (const bf16_t*)(p.ws + WS_U); const float* DT = (const float*)(p.ws + WS_DT);
    bf16_t* YM = (bf16_t*)(p.ws + WS_YM);
    __syncthreads();
    for (int i = tid; i < 32 * 136; i += 512) Hb[i] = 0;
    const float Aj = -__expf(p.in[I_ALOG][l * 16 + j]), Dj = p.in[I_DSK][l * 16 + j];
    const int c16a = wid * 2, c16b = wid * 2 + 1, c4 = wid & 3;
    const int lt = wid >> 1, pt = wid & 1;
    const bf16_t* ub = U + (size_t)b * 2048 * 1536;
    u32x4 rb0, rb1, rc0, rc1, rx = {0u, 0u, 0u, 0u}; float rdt = 0.f;
#define LOADCHUNK(T0) { const bf16_t* r0 = ub + (size_t)((T0) + lane) * 1536 + g * 128; \
        rb0 = *(const u32x4*)(r0 + 1024 + c16a * 8); rb1 = *(const u32x4*)(r0 + 1024 + c16b * 8); rc0 = *(const u32x4*)(r0 + 1280 + c16a * 8); rc1 = *(const u32x4*)(r0 + 1280 + c16b * 8); \
        if (tid < 256) rx = *(const u32x4*)(ub + (size_t)((T0) + lane) * 1536 + j * 64 + ph * 32 + c4 * 8); \
        if (wid == 5) rdt = DT[((size_t)b * 2048 + (T0) + lane) * 16 + j]; }
    LOADCHUNK(0)
    f32x4 hacc[2] = {{0.f, 0.f, 0.f, 0.f}, {0.f, 0.f, 0.f, 0.f}};
    for (int c = 0; c < 32; ++c) {
        const int t0 = c * 64;
        float zq[4];
#pragma unroll
        for (int jj = 0; jj < 4; ++jj) zq[jj] = bf2f(P[((size_t)b * 2048 + t0 + lt * 16 + fq * 4 + jj) * N1 + C_ZM + j * 64 + ph * 32 + pt * 16 + fr]);
        *(u32x4*)(Cm + lane * 136 + c16a * 8) = rc0; *(u32x4*)(Cm + lane * 136 + c16b * 8) = rc1;
        *(u32x4*)(Bm + lane * 136 + c16a * 8) = rb0; *(u32x4*)(Bm + lane * 136 + c16b * 8) = rb1;
#pragma unroll
        for (int e = 0; e < 8; ++e) { const unsigned v0 = rb0[e >> 1], v1 = rb1[e >> 1];
            BmT[(c16a * 8 + e) * 72 + lane] = (bf16_t)((e & 1) ? (v0 >> 16) : (v0 & 0xffffu)); BmT[(c16b * 8 + e) * 72 + lane] = (bf16_t)((e & 1) ? (v1 >> 16) : (v1 & 0xffffu)); }
        if (tid < 256) {
#pragma unroll
            for (int e = 0; e < 8; ++e) { const unsigned v0 = rx[e >> 1]; XT[(c4 * 8 + e) * 72 + lane] = (bf16_t)((e & 1) ? (v0 >> 16) : (v0 & 0xffffu)); }
        }
        if (wid == 5) {
            float v = rdt * Aj;
#pragma unroll
            for (int off = 1; off < 64; off <<= 1) { const float t = __shfl_up(v, off); if (lane >= off) v += t; }
            acs[lane] = v; dtv[lane] = rdt;
        }
        if (c + 1 < 32) LOADCHUNK(t0 + 64)
        LBAR();
        { const int pp = tid & 31, s4 = (tid >> 5) * 4; const float aend = acs[63];
          const u32x2 xv = *(const u32x2*)(XT + pp * 72 + s4);
          const float x0 = __uint_as_float(xv.x << 16), x1 = __uint_as_float(xv.x & 0xffff0000u), x2 = __uint_as_float(xv.y << 16), x3 = __uint_as_float(xv.y & 0xffff0000u);
          u32x2 bq; bq.x = pk2(x0 * dtv[s4] * __expf(aend - acs[s4]), x1 * dtv[s4 + 1] * __expf(aend - acs[s4 + 1]));
          bq.y = pk2(x2 * dtv[s4 + 2] * __expf(aend - acs[s4 + 2]), x3 * dtv[s4 + 3] * __expf(aend - acs[s4 + 3]));
          *(u32x2*)(XwT + pp * 72 + s4) = bq; }
#pragma unroll
        for (int e = 0; e < 2; ++e) {
            const int id = wid * 2 + e, glt = id >> 2, st = id & 3;
            f32x4 acc = {0.f, 0.f, 0.f, 0.f};
            if (st <= glt) {
#pragma unroll
                for (int ks = 0; ks < 4; ++ks) { const bf16x8 fa = *(const bf16x8*)(Cm + (glt * 16 + fr) * 136 + ks * 32 + fq * 8), fb = *(const bf16x8*)(Bm + (st * 16 + fr) * 136 + ks * 32 + fq * 8); acc = MFMA16(fa, fb, acc); }
            }
#pragma unroll
            for (int jj = 0; jj < 4; ++jj) { const int lr = glt * 16 + fq * 4 + jj, s = st * 16 + fr;
                const float val = (s <= lr) ? acc[jj] * __expf(acs[lr] - acs[s]) * dtv[s] : 0.f;
                G[lr * 72 + s] = f2bf(val); }
        }
        f32x4 accO = {0.f, 0.f, 0.f, 0.f};
#pragma unroll
        for (int ks = 0; ks < 4; ++ks) { const bf16x8 fa = *(const bf16x8*)(Cm + (lt * 16 + fr) * 136 + ks * 32 + fq * 8), fb = *(const bf16x8*)(Hb + (pt * 16 + fr) * 136 + ks * 32 + fq * 8); accO = MFMA16(fa, fb, accO); }
        LBAR();
        {
            f32x4 accD = {0.f, 0.f, 0.f, 0.f};
#pragma unroll
            for (int ks = 0; ks < 2; ++ks) { const bf16x8 fa = *(const bf16x8*)(G + (lt * 16 + fr) * 72 + ks * 32 + fq * 8), fb = *(const bf16x8*)(XT + (pt * 16 + fr) * 72 + ks * 32 + fq * 8); accD = MFMA16(fa, fb, accD); }
#pragma unroll
            for (int jj = 0; jj < 4; ++jj) { const int lr = lt * 16 + fq * 4 + jj, pp = pt * 16 + fr;
                float y = accD[jj] + __expf(acs[lr]) * accO[jj] + Dj * bf2f(XT[pp * 72 + lr]);
                y *= siluf_(zq[jj]);
                YM[((size_t)b * 2048 + t0 + lr) * 1024 + j * 64 + ph * 32 + pp] = f2bf(y); }
            const float cd = __expf(acs[63]); const int ptile = wid >> 2;
#pragma unroll
            for (int e = 0; e < 2; ++e) { const int nt = (wid & 3) * 2 + e;
                hacc[e] *= cd;
#pragma unroll
                for (int ks = 0; ks < 2; ++ks) { const bf16x8 fa = *(const bf16x8*)(XwT + (ptile * 16 + fr) * 72 + ks * 32 + fq * 8), fb = *(const bf16x8*)(BmT + (nt * 16 + fr) * 72 + ks * 32 + fq * 8); hacc[e] = MFMA16(fa, fb, hacc[e]); }
#pragma unroll
                for (int jj = 0; jj < 4; ++jj) Hb[(ptile * 16 + fq * 4 + jj) * 136 + nt * 16 + fr] = f2bf(hacc[e][jj]); }
        }
        LBAR();
    }
#undef LOADCHUNK
    { const int ptile = wid >> 2;
#pragma unroll
      for (int e = 0; e < 2; ++e) { const int nt = (wid & 3) * 2 + e;
#pragma unroll
          for (int jj = 0; jj < 4; ++jj) p.out[O_PSSM + ((((size_t)l * 8 + b) * 16 + j) * 64 + ph * 32 + ptile * 16 + fq * 4 + jj) * 128 + nt * 16 + fr] = hacc[e][jj]; } }
    __syncthreads();
}

__device__ void mamba_sample_item(const Params& p, int l, int item, unsigned char* smem_) {
    unsigned char* smem = launder_lds(smem_);
    const int tid = tid_l();
    const int i = item >> 4, j = item & 15, g = j >> 3;
    float* su = (float*)smem;
    float* sd = su + 320;
    const bf16_t* P = (const bf16_t*)(p.ws + WS_P);
    bf16_t* YM = (bf16_t*)(p.ws + WS_YM);
    const size_t rowp = (size_t)TP + i;
    const int pp = tid >> 3, n0 = (tid & 7) * 16;
    const size_t so = ((((size_t)l * TS + i) * 16 + j) * 64 + pp) * 128 + n0;
    float4 hv4[4];
#pragma unroll
    for (int e = 0; e < 4; ++e) hv4[e] = *(const float4*)(p.in[I_SSSM] + so + e * 4);
    __syncthreads();
    if (tid < 320) {
        const int cc = tid < 64 ? j * 64 + tid : (tid < 192 ? 1024 + g * 128 + (tid - 64) : 1280 + g * 128 + (tid - 192));
        const float* c0 = p.in[I_SCONV] + ((size_t)l * TS + i) * 3 * 1536 + cc;
        const float* cw = p.in[I_CW] + (size_t)l * 4 * 1536 + cc;
        const float v = p.in[I_CB][l * 1536 + cc] + c0[0] * cw[0] + c0[1536] * cw[1536] + c0[3072] * cw[3072] + bf2f(P[rowp * N1 + C_XBC + cc]) * cw[4608];
        su[tid] = siluf_(v);
    } else if (tid == 320) {
        const float dt = softplusf_(bf2f(P[rowp * N1 + C_DT + j]) + p.in[I_DTB][l * 16 + j]);
        sd[0] = dt; sd[1] = __expf(-dt * __expf(p.in[I_ALOG][l * 16 + j]));
    }
    __syncthreads();
    {
        float* hout = p.out + O_SSSM + so;
        const float dt = sd[0], eA = sd[1], x = su[pp], xdt = x * dt;
        float y = 0.f;
#pragma unroll
        for (int e = 0; e < 4; ++e) { float4 hv = hv4[e]; const float* Bp = su + 64 + n0 + e * 4; const float* Cp = su + 192 + n0 + e * 4;
            hv.x = eA * hv.x + xdt * Bp[0]; hv.y = eA * hv.y + xdt * Bp[1]; hv.z = eA * hv.z + xdt * Bp[2]; hv.w = eA * hv.w + xdt * Bp[3];
            y += hv.x * Cp[0] + hv.y * Cp[1] + hv.z * Cp[2] + hv.w * Cp[3];
            *(float4*)(hout + e * 4) = hv; }
        y = red8(y);
        if ((tid & 7) == 0) { y += p.in[I_DSK][l * 16 + j] * x; const float z = bf2f(P[rowp * N1 + C_ZM + j * 64 + pp]); YM[rowp * 1024 + j * 64 + pp] = f2bf(y * siluf_(z)); }
    }
}

__device__ void phase_mixa(const Params& p, int l, unsigned char* smem) {
    for (int rep = 0; rep < (DUP == 5 ? 2 : 1); ++rep) phase_conv(p, l);
    for (int rep = 0; rep < (DUP == 3 ? 2 : 1); ++rep)
    for (int it = blockIdx.x; it < 2048; it += gridDim.x) rwkv_sample_item(p, l, it, smem);
    for (int rep = 0; rep < (DUP == 4 ? 2 : 1); ++rep)
    for (int it = blockIdx.x; it < 2048; it += gridDim.x) mamba_sample_item(p, l, it, smem);
}
__device__ void phase_mixb(const Params& p, int l, unsigned char* smem) {
    const int G = (int)gridDim.x, nch = G >= 256 ? 128 : G;
    if ((int)blockIdx.x < nch) {
        for (int rep = 0; rep < (DUP == 1 ? 2 : 1); ++rep)
        for (int it = blockIdx.x; it < 128; it += nch) rwkv_chain_item(p, l, it, smem);
    }
    unsigned* ticket = (unsigned*)(p.ws + WS_BAR) + XCD_BAR_WORDS + 64 * l;
    volatile LAS int* slot = (volatile LAS int*)((LAS unsigned char*)smem + LDS_BARST + 8);
    for (;;) {
        __syncthreads();
        if (tid_l() == 0) *slot = (int)__hip_atomic_fetch_add(ticket, 1u, __ATOMIC_RELAXED, __HIP_MEMORY_SCOPE_AGENT);
        __syncthreads();
        const int it = *slot;
        if (it >= 256 * (DUP == 2 ? 2 : 1)) break;
        mamba_item(p, l, it & 255, smem);
    }
}

__device__ void sample_outproj(const Params& p, int l) {
    const int tid = tid_l(), wid = tid >> 6, lane = tid & 63, fr = lane & 15, fq = lane >> 4;
    const bf16_t* A2 = (const bf16_t*)(p.ws + WS_A) + (size_t)TP * 2048;
    const bf16_t* W = (const bf16_t*)(p.ws + WS_WOUTT) + (size_t)l * 1024 * 2048;
    float* PART = (float*)(p.ws + WS_PART);
    for (int it = blockIdx.x; it < 256; it += gridDim.x) {
        const int nt = it & 15, ksl = it >> 4;
        f32x4 acc[4] = {{0.f, 0.f, 0.f, 0.f}, {0.f, 0.f, 0.f, 0.f}, {0.f, 0.f, 0.f, 0.f}, {0.f, 0.f, 0.f, 0.f}};
#pragma unroll
        for (int kq = 0; kq < 4; ++kq) {
            const bf16x8 fa = *(const bf16x8*)(A2 + (size_t)(wid * 16 + fr) * 2048 + ksl * 128 + kq * 32 + fq * 8);
#pragma unroll
            for (int ct = 0; ct < 4; ++ct) { const bf16x8 fb = *(const bf16x8*)(W + (size_t)(nt * 64 + ct * 16 + fr) * 2048 + ksl * 128 + kq * 32 + fq * 8); acc[ct] = MFMA16(fa, fb, acc[ct]); }
        }
#pragma unroll
        for (int ct = 0; ct < 4; ++ct)
#pragma unroll
            for (int jj = 0; jj < 4; ++jj) PART[((size_t)ksl * TS + wid * 16 + fq * 4 + jj) * 1024 + nt * 64 + ct * 16 + fr] = acc[ct][jj];
    }
}

__device__ void phase_post(const Params& p, int l) {
    const int tid_ = tid_l(); const int lane = tid_ & 63, wid = tid_ >> 6;
    const bf16_t* P = (const bf16_t*)(p.ws + WS_P);
    const float* ORAW = (const float*)(p.ws + WS_ORAW);
    const bf16_t* BV = (const bf16_t*)(p.ws + WS_BV);
    const bf16_t* YM = (const bf16_t*)(p.ws + WS_YM);
    bf16_t* A2 = (bf16_t*)(p.ws + WS_A);
    const int c0 = lane * 16;
    float lnw[16], lnb[16], gnw[16];
#pragma unroll
    for (int e = 0; e < 16; ++e) { lnw[e] = p.in[I_LNW][l * 1024 + c0 + e]; lnb[e] = p.in[I_LNB][l * 1024 + c0 + e]; gnw[e] = p.in[I_GNW][l * 1024 + c0 + e]; }
    for (int row = blockIdx.x * 8 + wid; row < TALL; row += gridDim.x * 8) {
        const bf16_t* prow = P + (size_t)row * N1;
        float o[16], bv[16], z[16], ym[16];
#pragma unroll
        for (int i = 0; i < 4; ++i) { const float4 t = *(const float4*)(ORAW + (size_t)row * 1024 + c0 + i * 4); o[i * 4] = t.x; o[i * 4 + 1] = t.y; o[i * 4 + 2] = t.z; o[i * 4 + 3] = t.w; }
        unpack8(*(const u32x4*)(BV + (size_t)row * 1024 + c0), bv); unpack8(*(const u32x4*)(BV + (size_t)row * 1024 + c0 + 8), bv + 8);
        unpack8(*(const u32x4*)(prow + C_ZR + c0), z); unpack8(*(const u32x4*)(prow + C_ZR + c0 + 8), z + 8);
        unpack8(*(const u32x4*)(YM + (size_t)row * 1024 + c0), ym); unpack8(*(const u32x4*)(YM + (size_t)row * 1024 + c0 + 8), ym + 8);
        float s = 0.f;
#pragma unroll
        for (int e = 0; e < 16; ++e) s += o[e];
        s += dppf<0xB1>(s); s += dppf<0x4E>(s);
        const float mean = s * (1.0f / 64.0f);
        float v = 0.f;
#pragma unroll
        for (int e = 0; e < 16; ++e) { o[e] -= mean; v += o[e] * o[e]; }
        v += dppf<0xB1>(v); v += dppf<0x4E>(v);
        const float rstd = rsqrtf(v * (1.0f / 64.0f) + 64e-5f);
#pragma unroll
        for (int e = 0; e < 16; ++e) o[e] = (o[e] * rstd * lnw[e] + lnb[e] + bv[e]) * siluf_(z[e]);
        *(u32x4*)(A2 + (size_t)row * 2048 + c0) = pack8(o); *(u32x4*)(A2 + (size_t)row * 2048 + c0 + 8) = pack8(o + 8);
        float ss = 0.f;
#pragma unroll
        for (int e = 0; e < 16; ++e) ss += ym[e] * ym[e];
        ss = red16(ss); ss += __shfl_xor(ss, 16);
        const float rs = rsqrtf(ss * (1.0f / 512.0f) + 1e-5f);
#pragma unroll
        for (int e = 0; e < 16; ++e) ym[e] *= rs * gnw[e];
        *(u32x4*)(A2 + (size_t)row * 2048 + 1024 + c0) = pack8(ym); *(u32x4*)(A2 + (size_t)row * 2048 + 1024 + c0 + 8) = pack8(ym + 8);
        if (row < TP) {
            const int tq = row & 2047;
            if (tq >= 2045) { float* dst = p.out + O_PCONV + (((size_t)l * 8 + (row >> 11)) * 3 + (tq - 2045)) * 1536;
                for (int c = lane; c < 1536; c += 64) dst[c] = bf2f(prow[C_XBC + c]); }
        } else {
            const int i = row - TP; float* dst = p.out + O_SCONV + ((size_t)l * TS + i) * 3 * 1536; const float* src = p.in[I_SCONV] + ((size_t)l * TS + i) * 3 * 1536;
            for (int c = lane; c < 1536; c += 64) { dst[c] = src[1536 + c]; dst[1536 + c] = src[3072 + c]; dst[3072 + c] = bf2f(prow[C_XBC + c]); }
        }
    }
}

constexpr int NPHASE = 13;
__global__ __launch_bounds__(512, 2) void mega(Params p) {
    extern __shared__ __attribute__((aligned(16))) unsigned char smem[];
    cg::grid_group grid = cg::this_grid();
    volatile LAS unsigned* st = (volatile LAS unsigned*)((LAS unsigned char*)smem + LDS_BARST);
    { const unsigned hw = (unsigned)__builtin_amdgcn_s_getreg((5 << 11) | 4) & 63u;
      if ((threadIdx.x & 63) == 0) *(volatile LAS int*)((LAS unsigned char*)smem + LDS_WIDTAB + hw * 4u) = (int)(threadIdx.x >> 6);
      if (threadIdx.x == 0) { st[0] = 0u; st[1] = 0u; } }
    __syncthreads();
    const XcdBarrier xbar = xcd_barrier_post((unsigned*)(p.ws + WS_BAR), st);
    if (p.ph_hi > 1000) grid.sync();
#define PHASE(K, BODY) if (p.ph_lo <= (K) && (K) < p.ph_hi) { if ((K) > p.ph_lo) { xcd_barrier(xbar); if (DUP == 13) { xcd_barrier(xbar); xcd_barrier(xbar); } } BODY }
#define GEMM1(L) { pg8::Gemm g{(const bf16_t*)(p.ws + WS_A), (const bf16_t*)(p.ws + WS_WINT) + (size_t)(L) * N1 * 1024, M1, N1, 1024}; \
        pg8::StaticOrder S; S.init(M1, N1, (int)gridDim.x, (int)blockIdx.x); EpiP E{(bf16_t*)(p.ws + WS_P), N1}; \
        pg8::gemm_phase<EpiP, pg8::StaticOrder, false>((PG8_LAS unsigned char*)smem, g, S, E, nullptr); }
#define GEMM2(L) { sample_outproj(p, (L)); \
        pg8::Gemm g{(const bf16_t*)(p.ws + WS_A), (const bf16_t*)(p.ws + WS_WOUTT) + (size_t)(L) * 1024 * 2048, TP, 1024, 2048}; \
        pg8::StaticOrder S; S.init(TP, 1024, (int)gridDim.x, (int)blockIdx.x); EpiRes E{(L) == 0 ? p.in[I_XP] : p.out + O_YP, p.out + O_YP}; \
        pg8::gemm_phase<EpiRes, pg8::StaticOrder, false>((PG8_LAS unsigned char*)smem, g, S, E, nullptr); }
    PHASE(0, phase_convert(p, smem); phase_norm(p, 0);)
    PHASE(1, GEMM1(0))
    PHASE(2, phase_mixa(p, 0, smem);)
    PHASE(3, phase_mixb(p, 0, smem);)
    PHASE(4, phase_post(p, 0);)
    PHASE(5, GEMM2(0))
    PHASE(6, phase_norm(p, 1);)
    PHASE(7, GEMM1(1))
    PHASE(8, phase_mixa(p, 1, smem);)
    PHASE(9, phase_mixb(p, 1, smem);)
    PHASE(10, phase_post(p, 1);)
    PHASE(11, GEMM2(1))
    PHASE(12, phase_final(p);)
}

extern "C" void kernel_launch(void* const* d_in, const int* in_sizes, int n_in, void* d_out, int out_size, void* d_ws, size_t ws_size, hipStream_t stream) {
    static int grid = 0;
    if (grid == 0) {
        if (n_in != 26 || (size_t)out_size != O_END || ws_size < WS_BAR + (size_t)(XCD_BAR_WORDS + 128) * 4) { fprintf(stderr, "kernel_launch: unexpected shapes: n_in %d out %d ws %zu (need %zu)\n", n_in, out_size, ws_size, (size_t)(WS_BAR + XCD_BAR_WORDS * 4)); grid = -1; return; }
        int dev = 0, cus = 0, per_cu = 0;
        hipGetDevice(&dev); hipDeviceGetAttribute(&cus, hipDeviceAttributeMultiprocessorCount, dev);
        if (hipFuncSetAttribute((const void*)mega, hipFuncAttributeMaxDynamicSharedMemorySize, LDS_BYTES) != hipSuccess) { fprintf(stderr, "kernel_launch: hipFuncSetAttribute failed\n"); grid = -1; return; }
        if (hipOccupancyMaxActiveBlocksPerMultiprocessor(&per_cu, (const void*)mega, 512, LDS_BYTES) != hipSuccess || per_cu < 1) { fprintf(stderr, "kernel_launch: occupancy query gave %d\n", per_cu); per_cu = 1; }
        (void)hipGetLastError();
        grid = cus * 1;
    }
    if (grid < 0) return;
    if (hipMemsetAsync((char*)d_ws + WS_BAR, 0, (size_t)(XCD_BAR_WORDS + 128) * 4, stream) != hipSuccess) { fprintf(stderr, "kernel_launch: memset of barrier words failed\n"); return; }
    Params p{};
    for (int i = 0; i < 26; ++i) p.in[i] = (const float*)d_in[i];
    p.out = (float*)d_out; p.ws = (unsigned char*)d_ws;
#if MK_PER_PHASE
    for (int ph = 0; ph < NPHASE; ++ph) { p.ph_lo = ph; p.ph_hi = ph + 1; hipLaunchKernelGGL(mega, dim3(grid), dim3(512), LDS_BYTES, stream, p); }
#else
    p.ph_lo = 0; p.ph_hi = NPHASE;
    void* args[] = {&p};
    hipError_t e = hipLaunchCooperativeKernel((const void*)mega, dim3(grid), dim3(512), args, LDS_BYTES, stream);
    if (e != hipSuccess) fprintf(stderr, "cooperative launch failed: %s (grid %d)\n", hipGetErrorString(e), grid);
#endif
}
```
